# Optimizing an MI355X kernel written in HIP

```python
import math
import jax, jax.numpy as jnp
from jax import lax
import numpy as np

D_MODEL = 1024
BATCH = 8
SEQ = 2048
DEPTH = 1

D_MIX = D_MODEL
LRU_WIDTH = D_MIX // 2
LRU_BLOCKS = 8
LRU_BLOCK = LRU_WIDTH // LRU_BLOCKS
CONV_WIDTH = 4
LRU_C = 8.0
N_HEADS = 8
N_KV_HEADS = 2
GROUP = N_HEADS // N_KV_HEADS
HEAD_DIM = 64
ATTN_WIDTH = N_HEADS * HEAD_DIM
KV_WIDTH = N_KV_HEADS * HEAD_DIM
WINDOW = 128
BLOCK = 128
N_BUCKETS = 32
MAX_DISTANCE = 128
PEER_HEADS = 8
N_KEYS = 128
N_EXPERTS = N_KEYS * N_KEYS
D_QUERY = 256
D_HALF = D_QUERY // 2
TOPK = 16
PEER_CHUNK = 128
IN_COLS = 2 * LRU_WIDTH + ATTN_WIDTH + 2 * KV_WIDTH
EPS = 1e-6
NEG_INF = -1e30
SCALE = HEAD_DIM ** -0.5

kernel_name = "hymba_rglru_swa_sink_peer"


def rmsnorm(x, g):
    xf = x.astype(jnp.float32)
    y = xf * lax.rsqrt(jnp.mean(xf * xf, axis=-1, keepdims=True) + EPS)
    return (y * g.astype(jnp.float32)).astype(x.dtype)


def t5_bucket(rel):
    n = jnp.maximum(rel, 0)
    max_exact = N_BUCKETS // 2
    nf = jnp.maximum(n, 1).astype(jnp.float32)
    large = max_exact + (jnp.log(nf / max_exact) / math.log(MAX_DISTANCE / max_exact)
                         * (N_BUCKETS - max_exact)).astype(jnp.int32)
    large = jnp.minimum(large, N_BUCKETS - 1)
    return jnp.where(n < max_exact, n, large)


def band_bias_and_mask(rel_bias, S):
    nb = S // BLOCK
    i = jnp.arange(BLOCK)[:, None]
    j = jnp.arange(2 * BLOCK)[None, :]
    rel = BLOCK + i - j
    bias = rel_bias.astype(jnp.float32)[t5_bucket(rel)]
    bias = jnp.transpose(bias, (2, 0, 1)).reshape(N_KV_HEADS, GROUP, BLOCK, 2 * BLOCK)
    kpos = jnp.arange(nb)[:, None, None] * BLOCK - BLOCK + j[None]
    mask = (rel >= 0)[None] & (rel < WINDOW)[None] & (kpos >= 0)
    return bias, mask


def rglru_mixer(xb, gb, conv_w, conv_b, w_gate_a, b_gate_a, w_gate_x, b_gate_x, lru_L):
    B, S, _ = xb.shape
    xp = jnp.pad(xb, ((0, 0), (CONV_WIDTH - 1, 0), (0, 0)))
    xc = conv_b
    for tap in range(CONV_WIDTH):
        xc = xc + xp[:, tap:tap + S] * conv_w[tap]
    xblk = xc.reshape(B, S, LRU_BLOCKS, LRU_BLOCK)
    r = jax.nn.sigmoid((jnp.einsum('bsni,nij->bsnj', xblk, w_gate_a) + b_gate_a)
                       .astype(jnp.float32)).reshape(B, S, LRU_WIDTH)
    ig = jax.nn.sigmoid((jnp.einsum('bsni,nij->bsnj', xblk, w_gate_x) + b_gate_x)
                        .astype(jnp.float32)).reshape(B, S, LRU_WIDTH)
    log_a = -LRU_C * r * jax.nn.softplus(-lru_L.astype(jnp.float32))
    a = jnp.exp(log_a)
    b = jnp.sqrt(-jnp.expm1(2.0 * log_a)) * (ig * xc.astype(jnp.float32))

    def combine(c1, c2):
        a1, b1 = c1
        a2, b2 = c2
        return a1 * a2, a2 * b1 + b2

    _, h = lax.associative_scan(combine, (a, b), axis=1)
    return (h * jax.nn.gelu(gb.astype(jnp.float32))).astype(xb.dtype)


def swa_mixer(q, k, v, q_norm_g, k_norm_g, sinks, pos_bias, mask):
    B, S, _ = q.shape
    nb = S // BLOCK
    qh = rmsnorm(q.reshape(B, S, N_HEADS, HEAD_DIM), q_norm_g).astype(jnp.float32)
    kh = rmsnorm(k.reshape(B, S, N_KV_HEADS, HEAD_DIM), k_norm_g).astype(jnp.float32)
    vh = v.reshape(B, S, N_KV_HEADS, HEAD_DIM).astype(jnp.float32)
    qb = qh.reshape(B, nb, BLOCK, N_KV_HEADS, GROUP, HEAD_DIM)

    def band(t):
        tp = jnp.pad(t, ((0, 0), (BLOCK, 0), (0, 0), (0, 0)))
        tp = tp.reshape(B, nb + 1, BLOCK, N_KV_HEADS, HEAD_DIM)
        return jnp.concatenate([tp[:, :-1], tp[:, 1:]], axis=2)

    kw, vw = band(kh), band(vh)
    s = jnp.einsum('bnqhgd,bnkhd->bnhgqk', qb, kw) * SCALE + pos_bias
    s = jnp.where(mask[None, :, None, None], s, NEG_INF)
    sink = sinks.astype(jnp.float32).reshape(N_KV_HEADS, GROUP)[None, None, :, :, None]
    m = jnp.maximum(jnp.max(s, axis=-1), sink)
    p = jnp.exp(s - m[..., None])
    denom = jnp.sum(p, axis=-1) + jnp.exp(sink - m)
    o = jnp.einsum('bnhgqk,bnkhd->bnqhgd', p / denom[..., None], vw)
    return o.reshape(B, S, ATTN_WIDTH).astype(q.dtype)


def peer(xn, w_query, sub_keys, expert_u, expert_v):
    B, S, D = xn.shape
    T = B * S
    xt = xn.reshape(T, D)
    q = (xt @ w_query).reshape(T, PEER_HEADS, 2, D_HALF).astype(jnp.float32)
    s = jnp.einsum('thcd,hcnd->thcn', q, sub_keys.astype(jnp.float32))
    s_top, i_top = lax.top_k(s, TOPK)
    cand = (s_top[:, :, 0, :, None] + s_top[:, :, 1, None, :]).reshape(T, PEER_HEADS, TOPK * TOPK)
    cand_idx = (i_top[:, :, 0, :, None] * N_KEYS + i_top[:, :, 1, None, :]).reshape(T, PEER_HEADS, TOPK * TOPK)
    best, pos = lax.top_k(cand, TOPK)
    idx = jnp.take_along_axis(cand_idx, pos, axis=-1)
    g = jax.nn.softmax(best, axis=-1)
    nchunks = T // PEER_CHUNK

    def chunk(args):
        xc, ic, gc = args
        u = expert_u[ic].astype(jnp.float32)
        act = jnp.einsum('chkd,cd->chk', u, xc.astype(jnp.float32))
        w = gc * jax.nn.gelu(act)
        v = expert_v[ic].astype(jnp.float32)
        return jnp.einsum('chk,chkd->cd', w, v)

    out = lax.map(chunk, (xt.reshape(nchunks, PEER_CHUNK, D),
                          idx.reshape(nchunks, PEER_CHUNK, PEER_HEADS, TOPK),
                          g.reshape(nchunks, PEER_CHUNK, PEER_HEADS, TOPK)))
    return out.reshape(B, S, D).astype(xn.dtype)


def setup_inputs(seed: int = 0) -> dict:
    key = jax.random.key(seed)
    ks = jax.random.split(key, 24)
    f32 = jnp.float32
    nrm = lambda k, shape, scale: jax.random.normal(k, shape, f32) * scale
    gain = lambda k, shape: 1.0 + 0.05 * jax.random.normal(k, shape, f32)
    u = jax.random.uniform(ks[9], (DEPTH, LRU_WIDTH), f32, minval=0.9, maxval=0.999)
    a0 = u ** (1.0 / LRU_C)
    lru_L = jnp.log(a0) - jnp.log1p(-a0)
    return {
        "x": nrm(ks[0], (BATCH, SEQ, D_MODEL), 1.0),
        "ln_mix_g": gain(ks[1], (DEPTH, D_MODEL)),
        "w_in": nrm(ks[2], (DEPTH, D_MODEL, IN_COLS), D_MODEL ** -0.5),
        "conv_w": nrm(ks[3], (DEPTH, CONV_WIDTH, LRU_WIDTH), CONV_WIDTH ** -0.5),
        "conv_b": nrm(ks[4], (DEPTH, LRU_WIDTH), 0.02),
        "w_gate_a": nrm(ks[5], (DEPTH, LRU_BLOCKS, LRU_BLOCK, LRU_BLOCK), LRU_BLOCK ** -0.5),
        "b_gate_a": nrm(ks[6], (DEPTH, LRU_BLOCKS, LRU_BLOCK), 0.02),
        "w_gate_x": nrm(ks[7], (DEPTH, LRU_BLOCKS, LRU_BLOCK, LRU_BLOCK), LRU_BLOCK ** -0.5),
        "b_gate_x": nrm(ks[8], (DEPTH, LRU_BLOCKS, LRU_BLOCK), 0.02),
        "lru_L": lru_L,
        "q_norm_g": gain(ks[10], (DEPTH, HEAD_DIM)),
        "k_norm_g": gain(ks[11], (DEPTH, HEAD_DIM)),
        "sinks": nrm(ks[12], (DEPTH, N_HEADS), 0.5),
        "lru_out_g": gain(ks[13], (DEPTH, LRU_WIDTH)),
        "attn_out_g": gain(ks[14], (DEPTH, ATTN_WIDTH)),
        "w_out": nrm(ks[15], (DEPTH, D_MIX, D_MODEL), D_MIX ** -0.5),
        "ln_ffn_g": gain(ks[16], (DEPTH, D_MODEL)),
        "w_query": nrm(ks[17], (DEPTH, D_MODEL, PEER_HEADS * D_QUERY), D_MODEL ** -0.5),
        "sub_keys": nrm(ks[18], (DEPTH, PEER_HEADS, 2, N_KEYS, D_HALF), D_HALF ** -0.5),
        "expert_u": nrm(ks[19], (DEPTH, N_EXPERTS, D_MODEL), D_MODEL ** -0.5),
        "expert_v": nrm(ks[20], (DEPTH, N_EXPERTS, D_MODEL), (PEER_HEADS * TOPK) ** -0.5),
        "rel_bias": nrm(ks[21], (N_BUCKETS, N_HEADS), 0.5),
    }


def reference(x, ln_mix_g, w_in, conv_w, conv_b, w_gate_a, b_gate_a, w_gate_x, b_gate_x,
              lru_L, q_norm_g, k_norm_g, sinks, lru_out_g, attn_out_g, w_out, ln_ffn_g,
              w_query, sub_keys, expert_u, expert_v, rel_bias):
    S = x.shape[1]
    pos_bias, mask = band_bias_and_mask(rel_bias, S)
    splits = [LRU_WIDTH, 2 * LRU_WIDTH, 2 * LRU_WIDTH + ATTN_WIDTH,
              2 * LRU_WIDTH + ATTN_WIDTH + KV_WIDTH]
    for l in range(DEPTH):
        h = rmsnorm(x, ln_mix_g[l])
        proj = h @ w_in[l]
        xb, gb, q, k, v = jnp.split(proj, splits, axis=-1)
        y_lru = rglru_mixer(xb, gb, conv_w[l], conv_b[l], w_gate_a[l], b_gate_a[l],
                            w_gate_x[l], b_gate_x[l], lru_L[l])
        y_att = swa_mixer(q, k, v, q_norm_g[l], k_norm_g[l], sinks[l], pos_bias, mask)
        mix = jnp.concatenate([rmsnorm(y_lru, lru_out_g[l]), rmsnorm(y_att, attn_out_g[l])], axis=-1)
        x = x + mix @ w_out[l]
        x = x + peer(rmsnorm(x, ln_ffn_g[l]), w_query[l], sub_keys[l], expert_u[l], expert_v[l])
    return x
```

```cpp
#include <hip/hip_runtime.h>
#include <cstdio>
#include <cstdint>

#define LAS __attribute__((address_space(3)))
typedef unsigned short bf16;
typedef short bf16x8 __attribute__((ext_vector_type(8)));
typedef float f32x4 __attribute__((ext_vector_type(4)));
typedef unsigned u32x4 __attribute__((ext_vector_type(4)));
typedef unsigned u32x2 __attribute__((ext_vector_type(2)));

constexpr int D = 1024, BATCH = 8, SEQ = 2048, T = BATCH * SEQ;
constexpr int LRU_W = 512, NBLK = 8, BLK = 64;
constexpr int NH = 8, NKV = 2, HD = 64, ATT_W = 512, KV_W = 128, WIN = 128;
constexpr int PH = 8, NKEYS = 128, DQ = 256, DHALF = 128, TOPK = 16, NEXP = NKEYS * NKEYS;
constexpr int NIN = 1792, NQ = PH * DQ;
constexpr int C_XB = 0, C_GB = 512, C_Q = 1024, C_K = 1536, C_V = 1664;
constexpr float EPS = 1e-6f;

constexpr size_t MiB = 1u << 20;
constexpr size_t WS_CTL = 0, CTL_BYTES = 1 * MiB;
constexpr size_t WS_WINT = 1 * MiB;
constexpr size_t WS_WOUTT = 5 * MiB;
constexpr size_t WS_WQT = 7 * MiB;
constexpr size_t WS_SKB = 11 * MiB;
constexpr size_t WS_WGT = 11 * MiB + 512 * 1024;
constexpr size_t WS_BL = 11 * MiB + 768 * 1024;
constexpr size_t WS_SUS = 11 * MiB + 832 * 1024;
constexpr size_t WS_SVS = 11 * MiB + 896 * 1024;
constexpr size_t WS_R1 = 12 * MiB;
constexpr size_t WS_R1X = 12 * MiB + 64 * 1024;
constexpr size_t WS_R2 = 12 * MiB + 256 * 1024;
constexpr size_t WS_SSQL = 12 * MiB + 512 * 1024;
constexpr size_t WS_SSQA = 13 * MiB;
constexpr size_t WS_SSQ2 = 13 * MiB + 512 * 1024;
constexpr size_t WS_EU = 16 * MiB;
constexpr size_t WS_EV = 48 * MiB;
constexpr size_t WS_X1BF = 80 * MiB;
constexpr size_t WS_MIX = 112 * MiB;
constexpr size_t WS_IDX = 144 * MiB;
constexpr size_t WS_GW = 152 * MiB;
constexpr size_t WS_XBF = 160 * MiB;
constexpr size_t WS_PROJ = 192 * MiB;
constexpr size_t WS_Q = 160 * MiB;
constexpr size_t WS_IDX16 = 240 * MiB;
constexpr size_t WS_W = 232 * MiB;
constexpr size_t WS_PART = 160 * MiB;
constexpr size_t WS_END = 248 * MiB;

__device__ __forceinline__ unsigned f2bf(float f) { unsigned u = __builtin_bit_cast(unsigned, f); return (u + 0x7fffu + ((u >> 16) & 1u)) >> 16; }
__device__ __forceinline__ unsigned pk2(float lo, float hi) { return f2bf(lo) | (f2bf(hi) << 16); }
__device__ __forceinline__ float bf2f(unsigned short b) { return __builtin_bit_cast(float, ((unsigned)b) << 16); }
__device__ __forceinline__ float bflo(unsigned w) { return __builtin_bit_cast(float, w << 16); }
__device__ __forceinline__ float bfhi(unsigned w) { return __builtin_bit_cast(float, w & 0xffff0000u); }
__device__ __forceinline__ float wave_sum(float v) {
#pragma unroll
    for (int o = 1; o < 64; o <<= 1) v += __shfl_xor(v, o);
    return v;
}
__device__ __forceinline__ float gelu_tanh(float x) {
    const float u = 0.7978845608028654f * (x + 0.044715f * x * x * x);
    return x * __builtin_amdgcn_rcpf(1.0f + __expf(-2.0f * u));
}
__device__ __forceinline__ float sigmoidf(float z) { return __builtin_amdgcn_rcpf(1.0f + __expf(-z)); }
typedef int i32x4 __attribute__((ext_vector_type(4)));
#define DPP_I(v, ctrl) __builtin_amdgcn_update_dpp(0, (v), (ctrl), 0xf, 0xf, true)
#define DPP_F(v, ctrl) __builtin_bit_cast(float, __builtin_amdgcn_update_dpp(0, __builtin_bit_cast(int, (v)), (ctrl), 0xf, 0xf, true))
__device__ __forceinline__ int t5_bucket(int n) {
    if (n < 16) return n;
    const int th[15] = {19, 21, 24, 27, 31, 35, 40, 46, 52, 59, 67, 77, 87, 99, 113};
    int b = 16;
#pragma unroll
    for (int i = 0; i < 15; ++i) b += (n >= th[i]) ? 1 : 0;
    return b;
}

struct Ptrs {
    const float *x, *ln_mix_g, *w_in, *conv_w, *conv_b, *w_gate_a, *b_gate_a, *w_gate_x, *b_gate_x, *lru_L, *q_norm_g, *k_norm_g, *sinks, *lru_out_g, *attn_out_g, *w_out, *ln_ffn_g, *w_query, *sub_keys, *expert_u, *expert_v, *rel_bias;
    float* out; unsigned char* ws;
};

__device__ __forceinline__ float row_to_bf16(const float* src, const float* g, bf16* dst, int lane) {
    float ss = 0.f;
#pragma unroll
    for (int j = 0; j < 4; ++j) {
        f32x4 v = *(const f32x4*)(src + 4 * lane + 256 * j);
        ss += (v.x * v.x + v.y * v.y) + (v.z * v.z + v.w * v.w);
        if (g) { const f32x4 gg = *(const f32x4*)(g + 4 * lane + 256 * j); v = v * gg; }
        u32x2 o; o.x = pk2(v.x, v.y); o.y = pk2(v.z, v.w);
        *(u32x2*)(dst + 4 * lane + 256 * j) = o;
    }
    return ss;
}
constexpr float FP8_SU = 256.0f, FP8_SV = 64.0f;
__device__ __forceinline__ void row_to_fp8(const float* src, const float* g, float scale, unsigned char* dst, int lane) {
    u32x4 o;
#pragma unroll
    for (int j = 0; j < 4; ++j) {
        f32x4 v = *(const f32x4*)(src + 16 * lane + 4 * j);
        if (g) { const f32x4 gg = *(const f32x4*)(g + 16 * lane + 4 * j); v = v * gg; }
        v = v * scale;
        int w = 0; w = __builtin_amdgcn_cvt_pk_fp8_f32(v.x, v.y, w, false); w = __builtin_amdgcn_cvt_pk_fp8_f32(v.z, v.w, w, true);
        o[j] = (unsigned)w;
    }
    *(u32x4*)(dst + 16 * lane) = o;
}
__device__ __forceinline__ void expert_rows4(const Ptrs& P, int r0, int lane);
constexpr size_t SLICE_BYTES = (size_t)NEXP * 128;
__device__ __forceinline__ void row_to_fp8_sliced(const float* src, const float* g, float scale, unsigned char* base, int e, int lane) {
    u32x4 o;
#pragma unroll
    for (int j = 0; j < 4; ++j) {
        f32x4 v = *(const f32x4*)(src + 16 * lane + 4 * j) * scale;
        if (g) v = v * *(const f32x4*)(g + 16 * lane + 4 * j);
        int w = 0; w = __builtin_amdgcn_cvt_pk_fp8_f32(v.x, v.y, w, false); w = __builtin_amdgcn_cvt_pk_fp8_f32(v.z, v.w, w, true);
        o[j] = (unsigned)w;
    }
    *(u32x4*)(base + (size_t)(lane >> 3) * SLICE_BYTES + (size_t)e * 128 + 16 * (lane & 7)) = o;
}
__device__ __forceinline__ float wave_max_u(float v) {
    v = fmaxf(v, DPP_F(v, 0xB1)); v = fmaxf(v, DPP_F(v, 0x4E)); v = fmaxf(v, DPP_F(v, 0x141)); v = fmaxf(v, DPP_F(v, 0x140));
    const int i = __builtin_bit_cast(int, v);
    return fmaxf(fmaxf(__builtin_bit_cast(float, __builtin_amdgcn_readlane(i, 0)), __builtin_bit_cast(float, __builtin_amdgcn_readlane(i, 16))),
                 fmaxf(__builtin_bit_cast(float, __builtin_amdgcn_readlane(i, 32)), __builtin_bit_cast(float, __builtin_amdgcn_readlane(i, 48))));
}
struct ExpRows {
    f32x4 v[4][4]; int r0;
    __device__ __forceinline__ void load(const Ptrs& P, int r0_, int lane_) {
        r0 = r0_; int lane = lane_; asm volatile("" : "+v"(lane));
        const bool isv = r0 >= NEXP; const int e0 = isv ? r0 - NEXP : r0;
        const float* src = (isv ? P.expert_v : P.expert_u) + (size_t)e0 * D + 16 * lane;
#pragma unroll
        for (int k = 0; k < 4; ++k)
#pragma unroll
            for (int j = 0; j < 4; ++j) v[k][j] = *(const f32x4*)(src + (size_t)k * D + 4 * j);
    }
    __device__ __forceinline__ void finish(const Ptrs& P, int lane_) {
        int lane = lane_; asm volatile("" : "+v"(lane));
        const bool isv = r0 >= NEXP; const int e0 = isv ? r0 - NEXP : r0;
        unsigned char* base = P.ws + (isv ? WS_EV : WS_EU) + (size_t)(lane >> 3) * SLICE_BYTES + 16 * (lane & 7);
        f32x4 g[4];
        if (!isv) {
#pragma unroll
            for (int j = 0; j < 4; ++j) g[j] = *(const f32x4*)(P.ln_ffn_g + 16 * lane + 4 * j); }
        float* scl = (float*)(P.ws + (isv ? WS_SVS : WS_SUS));
#pragma unroll
        for (int k = 0; k < 4; ++k) { float m = 0.f;
#pragma unroll
            for (int j = 0; j < 4; ++j) { if (!isv) v[k][j] = v[k][j] * g[j]; m = fmaxf(m, fmaxf(fmaxf(fabsf(v[k][j].x), fabsf(v[k][j].y)), fmaxf(fabsf(v[k][j].z), fabsf(v[k][j].w)))); }
            m = fmaxf(wave_max_u(m), 1e-30f);
            const float inv = 127.0f * __builtin_amdgcn_rcpf(m);
            if (lane == 0) scl[e0 + k] = m * (1.0f / 127.0f);
            u32x4 o;
#pragma unroll
            for (int j = 0; j < 4; ++j) { const int q0 = (int)rintf(v[k][j].x * inv), q1 = (int)rintf(v[k][j].y * inv), q2 = (int)rintf(v[k][j].z * inv), q3 = (int)rintf(v[k][j].w * inv);
                o[j] = (unsigned)(q0 & 0xff) | ((unsigned)(q1 & 0xff) << 8) | ((unsigned)(q2 & 0xff) << 16) | ((unsigned)q3 << 24); }
            *(u32x4*)(base + (size_t)(e0 + k) * 128) = o; }
    }
};
__device__ __forceinline__ void expert_rows4(const Ptrs& P, int r0, int lane) { ExpRows A; A.load(P, r0, lane); A.finish(P, lane); }
__device__ __forceinline__ void transpose_item(const float* W, int K, int N, const float* g0, const float* g1, int gsplit, bf16* WT, LAS float* scr, int item, int lane) {
    const int nblk = N / 32, kb = item / nblk, nb = item % nblk, k0 = 64 * kb, n0 = 32 * nb;
#pragma unroll
    for (int i = 0; i < 32; ++i) { const int kk = 2 * i + (lane >> 5); const int k = k0 + kk; const float gk = (k < gsplit) ? g0[k] : g1[k - gsplit];
        scr[kk * 33 + (lane & 31)] = W[(size_t)k * N + n0 + (lane & 31)] * gk; }
    asm volatile("s_waitcnt lgkmcnt(0)" ::: "memory");
    const int c = lane & 7;
#pragma unroll
    for (int j = 0; j < 4; ++j) { const int n = (lane >> 3) + 8 * j; const LAS float* s = scr + (8 * c) * 33 + n;
        u32x4 o; o.x = pk2(s[0 * 33], s[1 * 33]); o.y = pk2(s[2 * 33], s[3 * 33]); o.z = pk2(s[4 * 33], s[5 * 33]); o.w = pk2(s[6 * 33], s[7 * 33]);
        *(u32x4*)(WT + (size_t)(n0 + n) * K + k0 + 8 * c) = o; }
    asm volatile("s_waitcnt lgkmcnt(0)" ::: "memory");
}
__device__ __forceinline__ void p0_prep(const Ptrs& P, int gw, int NGW, int lane, LAS float* scr) {
    unsigned char* ws = P.ws;
    constexpr int I_IN = (D / 64) * (NIN / 32), I_OUT = (D / 64) * (D / 32), I_Q = (D / 64) * (NQ / 32);
    for (int it = gw; it < I_IN + I_OUT + I_Q; it += NGW) {
        int r = it;
        if (r < I_IN) { transpose_item(P.w_in, D, NIN, P.ln_mix_g, P.ln_mix_g, D, (bf16*)(ws + WS_WINT), scr, r, lane); continue; } r -= I_IN;
        if (r < I_OUT) { transpose_item(P.w_out, D, D, P.lru_out_g, P.attn_out_g, LRU_W, (bf16*)(ws + WS_WOUTT), scr, r, lane); continue; } r -= I_OUT;
        transpose_item(P.w_query, D, NQ, P.ln_ffn_g, P.ln_ffn_g, D, (bf16*)(ws + WS_WQT), scr, r, lane);
    }
    for (int r0 = gw * 4; r0 < T; r0 += NGW * 4) {
        f32x4 v[4][4];
#pragma unroll
        for (int k = 0; k < 4; ++k)
#pragma unroll
            for (int j = 0; j < 4; ++j) v[k][j] = *(const f32x4*)(P.x + (size_t)(r0 + k) * D + 4 * lane + 256 * j);
#pragma unroll
        for (int k = 0; k < 4; ++k) { float ss = 0.f;
#pragma unroll
            for (int j = 0; j < 4; ++j) ss += (v[k][j].x * v[k][j].x + v[k][j].y * v[k][j].y) + (v[k][j].z * v[k][j].z + v[k][j].w * v[k][j].w);
            const float r1 = __builtin_amdgcn_rsqf(wave_sum(ss) * (1.0f / D) + EPS);
            if (lane == 0) ((float*)(ws + WS_R1X))[r0 + k] = r1;
            bf16* dst = (bf16*)(ws + WS_XBF) + (size_t)(r0 + k) * D;
#pragma unroll
            for (int j = 0; j < 4; ++j) { u32x2 o; o.x = pk2(v[k][j].x * r1, v[k][j].y * r1); o.y = pk2(v[k][j].z * r1, v[k][j].w * r1); *(u32x2*)(dst + 4 * lane + 256 * j) = o; } }
    }
    for (int e = gw; e < 256; e += NGW) (void)row_to_bf16(P.sub_keys + (size_t)e * D, nullptr, (bf16*)(ws + WS_SKB) + (size_t)e * D, lane);
    for (int e = gw * 64 + lane; e < 2 * NBLK * BLK * BLK + NH * WIN; e += NGW * 64) {
        if (e < 2 * NBLK * BLK * BLK) { const int g = e / (NBLK * BLK * BLK), r = e % (NBLK * BLK * BLK), n = r / (BLK * BLK), j = (r / BLK) % BLK, i = r % BLK;
            const float* W = g ? P.w_gate_x : P.w_gate_a;
            ((bf16*)(ws + WS_WGT))[e] = (bf16)f2bf(W[(size_t)n * BLK * BLK + i * BLK + j]); }
        else { const int q = e - 2 * NBLK * BLK * BLK, h = q / WIN, rel = q % WIN;
            ((float*)(ws + WS_BL))[q] = P.rel_bias[t5_bucket(rel) * NH + h]; }
    }
}
namespace pg8 {
typedef unsigned short bf16_t;
constexpr int BM = 256, BK = 64, HALF = 128, HTB = HALF * BK * 2  , STAGE_BYTES = 8 * HTB, NXCD = 8, WGM = 8;
__host__ __device__ __forceinline__ int lds_byte(int r, int c) { const int st = (r >> 4) * 2 + (c >> 5), rr = r & 15, cc = c & 31, ob = rr * 64 + cc * 2; return st * 1024 + (ob ^ (((ob >> 9) & 1) << 5)); }
__host__ __device__ __forceinline__ void stage_rc(int b, int& R, int& C) { const int st = b / 1024, sb = b % 1024, swz = sb ^ (((sb >> 9) & 1) << 5); R = (st >> 1) * 16 + swz / 64; C = (st & 1) * 32 + (swz % 64) / 2; }
__host__ __device__ __forceinline__ int perm32(int rho) { const int n = rho >> 4, i = rho & 15; return 8 * (i >> 2) + 4 * n + (i & 3); }
struct Unit { int pm, pn; };
struct Gemm { const bf16_t* A; const bf16_t* Bt; int M, N, K; };
struct StaticOrder {
    int nM, nN, nwg, G, c;
    __host__ __device__ void init(int M, int N, int G_, int c_) { nM = M / BM; nN = N / BM; nwg = nM * nN; G = G_; c = c_; }
    __host__ __device__ bool next(int i, Unit& u) const {
        const long L = (long)i * G + c; if (L >= nwg) return false;
        int wgid = (int)L; { const int q = nwg / NXCD, r = nwg % NXCD, xcd = wgid % NXCD, off = wgid / NXCD; wgid = (xcd < r ? xcd * (q + 1) : r * (q + 1) + (xcd - r) * q) + off; }
        const int nig = WGM * nN, gid = wgid / nig, fm = gid * WGM, gsz = (nM - fm) < WGM ? (nM - fm) : WGM;
        u.pm = fm + ((wgid % nig) % gsz); u.pn = (wgid % nig) / gsz; return true;
    }
    __device__ __forceinline__ void a_ready(const Unit&) const {}
    __device__ __forceinline__ void done(const Unit&) const {}
};
struct OneUnit {
    Unit u;
    __device__ __forceinline__ bool next(int i, Unit& o) const { if (i != 0) return false; o = u; return true; }
    __device__ __forceinline__ void a_ready(const Unit&) const {}
    __device__ __forceinline__ void done(const Unit&) const {}
};
__device__ __forceinline__ unsigned cvt_pk_bf16(float lo, float hi) { unsigned r; asm volatile("v_cvt_pk_bf16_f32 %0, %1, %2" : "=v"(r) : "v"(lo), "v"(hi)); return r; }

struct EpiRowBf16 {
    static constexpr bool PERM = true, MID = false;
    bf16_t* O; int ldc; const float* rs;
    __device__ __forceinline__ void mid(f32x4 (&)[2][2][4][2], const Unit&, int, int, int, int) const {}
    __device__ __forceinline__ void operator()(const f32x4 (&acc)[2][2][4][2], const Unit& u, int wr, int wc, int fr, int fq) const {
        const int row0 = u.pm * BM + wr * 64 + fr, col0 = u.pn * BM + wc * 32 + 8 * fq;
#pragma unroll
        for (int ai = 0; ai < 2; ++ai)
#pragma unroll
            for (int m = 0; m < 4; ++m) { const int row = row0 + ai * HALF + m * 16; const float sc = rs ? rs[row] : 1.0f; bf16_t* rowp = O + (size_t)row * ldc + col0;
#pragma unroll
                for (int bj = 0; bj < 2; ++bj) { const f32x4 v0 = acc[ai][bj][m][0] * sc, v1 = acc[ai][bj][m][1] * sc;
                    u32x4 w; w.x = cvt_pk_bf16(v0[0], v0[1]); w.y = cvt_pk_bf16(v0[2], v0[3]); w.z = cvt_pk_bf16(v1[0], v1[1]); w.w = cvt_pk_bf16(v1[2], v1[3]);
                    *(u32x4*)(rowp + bj * HALF) = w; } }
    }
};
typedef float f32x2v __attribute__((ext_vector_type(2)));
struct EpiOut {
    static constexpr bool PERM = true, MID = true;
    const bf16_t* xbf; float* x1; bf16_t* x1bf; float* ssq2; const LAS f32x2v* rsl; const LAS float* rxl;
    __device__ __forceinline__ void mid(f32x4 (&acc)[2][2][4][2], const Unit&, int wr, int, int fr, int) const {
#pragma unroll
        for (int ai = 0; ai < 2; ++ai)
#pragma unroll
            for (int m = 0; m < 4; ++m) { const float ratio = rsl[ai * HALF + wr * 64 + m * 16 + fr].x;
#pragma unroll
                for (int bj = 0; bj < 2; ++bj)
#pragma unroll
                    for (int n = 0; n < 2; ++n) acc[ai][bj][m][n] = acc[ai][bj][m][n] * ratio; }
    }
    __device__ __forceinline__ void operator()(const f32x4 (&acc)[2][2][4][2], const Unit& u, int wr, int wc, int fr, int fq) const {
        const int col0 = u.pn * BM + wc * 32 + 8 * fq;
#pragma unroll
        for (int ai = 0; ai < 2; ++ai) {
            u32x2 xw[4][2][2];
#pragma unroll
            for (int m = 0; m < 4; ++m) { const size_t off = (size_t)(u.pm * BM + ai * HALF + wr * 64 + m * 16 + fr) * D + col0;
#pragma unroll
                for (int bj = 0; bj < 2; ++bj)
#pragma unroll
                    for (int n = 0; n < 2; ++n) xw[m][bj][n] = *(const u32x2*)(xbf + off + bj * HALF + n * 4); }
#pragma unroll
            for (int m = 0; m < 4; ++m) { const int r = ai * HALF + wr * 64 + m * 16 + fr; const float ratt = rsl[r].y, rx = rxl[r]; const int row = u.pm * BM + r; const size_t off = (size_t)row * D + col0; float ss = 0.f;
#pragma unroll
                for (int bj = 0; bj < 2; ++bj)
#pragma unroll
                    for (int n = 0; n < 2; ++n) { const u32x2 w2 = xw[m][bj][n]; const f32x4 xs = (f32x4){__builtin_bit_cast(float, w2.x << 16), __builtin_bit_cast(float, w2.x & 0xffff0000u), __builtin_bit_cast(float, w2.y << 16), __builtin_bit_cast(float, w2.y & 0xffff0000u)} * rx;
                        const f32x4 o = xs + acc[ai][bj][m][n] * ratt;
                        u32x2 w; w.x = cvt_pk_bf16(o[0], o[1]); w.y = cvt_pk_bf16(o[2], o[3]); *(u32x2*)(x1bf + off + bj * HALF + n * 4) = w;
                        ss += (o[0] * o[0] + o[1] * o[1]) + (o[2] * o[2] + o[3] * o[3]); }
                ss += __shfl_xor(ss, 16); ss += __shfl_xor(ss, 32);
                if (fq == 0) ssq2[(size_t)row * 16 + u.pn * 4 + wc] = ss; }
        }
    }
};

template <class Epi, class Sched, bool ALIGN_EPI = false, bool SP2 = false>
__device__ __forceinline__ void gemm_phase(LAS unsigned char* lds, const Gemm g, const Sched& S, const Epi& E) {
    const int tid = threadIdx.x, wid = __builtin_amdgcn_readfirstlane(tid >> 6), lane = tid & 63, wr = wid >> 2, wc = wid & 3, fr = lane & 15, fq = lane >> 4;
    const int K = g.K, nt = K / BK;
    unsigned voffA[2], voffB[2];
#pragma unroll
    for (int i = 0; i < 2; ++i) { int R, C; stage_rc(tid * 16 + i * 8192, R, C); const int Rb = Epi::PERM ? ((R & ~31) + perm32(R & 31)) : R;
        voffA[i] = (unsigned)(R * K + C) * 2u; voffB[i] = (unsigned)(Rb * K + C) * 2u; }
    const size_t kstep = (size_t)(BK * 2);
    const size_t hstep = (size_t)HALF * K * 2;
    const size_t tstep = 2 * hstep;
    const unsigned ldsw = (unsigned)wid * 1024u;
    const int aoff = lds_byte(wr * 64 + fr, fq * 8), boff = lds_byte(wc * 32 + fr, fq * 8);
#define PG8_SA(b, h) (((b) * 2 + (h)) * HTB)
#define PG8_SB(b, h) ((4 + (b) * 2 + (h)) * HTB)
#define PG8_STAGE(bufoff, gbase, voff) do { _Pragma("unroll") for (int _i = 0; _i < 2; ++_i) \
        __builtin_amdgcn_global_load_lds((const unsigned*)((const char*)(gbase) + (voff)[_i]), (LAS unsigned*)(lds + (bufoff) + ldsw + _i * 8192), 16, 0, 0); } while (0)
#define PG8_LDA(dst, b, h) do { _Pragma("unroll") for (int m = 0; m < 4; ++m) _Pragma("unroll") for (int k = 0; k < 2; ++k) dst[m][k] = *(const LAS bf16x8*)(lds + PG8_SA(b, h) + aoff + m * 2048 + k * 1024); } while (0)
#define PG8_LDB(dst, b, h) do { _Pragma("unroll") for (int n = 0; n < 2; ++n) _Pragma("unroll") for (int k = 0; k < 2; ++k) dst[n][k] = *(const LAS bf16x8*)(lds + PG8_SB(b, h) + boff + n * 2048 + k * 1024); } while (0)
#define PG8_MMA(ai, bj, At, Bt) do { __builtin_amdgcn_s_setprio(1); _Pragma("unroll") for (int m = 0; m < 4; ++m) _Pragma("unroll") for (int n = 0; n < 2; ++n) _Pragma("unroll") for (int k = 0; k < 2; ++k) \
        acc[ai][bj][m][n] = __builtin_amdgcn_mfma_f32_16x16x32_bf16(Bt[n][k], At[m][k], acc[ai][bj][m][n], 0, 0, 0); __builtin_amdgcn_s_setprio(0); } while (0)
#define PG8_WAIT_V(n) asm volatile("s_waitcnt vmcnt(" #n ")" ::: "memory")
#define PG8_WAIT_L(n) asm volatile("s_waitcnt lgkmcnt(" #n ")" ::: "memory")
#define PG8_BAR __builtin_amdgcn_s_barrier()
#define PG8_SCHED __builtin_amdgcn_sched_barrier(0)
    Unit cur, nxt; int ui = 0;
    if (!S.next(0, cur)) return;
    f32x4 acc[2][2][4][2];
#pragma unroll
    for (int a = 0; a < 2; ++a)
#pragma unroll
        for (int b = 0; b < 2; ++b)
#pragma unroll
            for (int m = 0; m < 4; ++m)
#pragma unroll
                for (int n = 0; n < 2; ++n) acc[a][b][m][n] = (f32x4){0.f, 0.f, 0.f, 0.f};
    bf16x8 At[4][2], B0[2][2], B1[2][2];
    const char* cA = (const char*)g.A + (size_t)cur.pm * tstep; const char* cB = (const char*)g.Bt + (size_t)cur.pn * tstep;
    S.a_ready(cur);
    if constexpr (SP2) {
        PG8_STAGE(PG8_SB(0, 0), cB, voffB); PG8_STAGE(PG8_SB(0, 1), cB + hstep, voffB); PG8_STAGE(PG8_SA(0, 0), cA, voffA); PG8_STAGE(PG8_SA(0, 1), cA + hstep, voffA);
        if (wr == 1) PG8_BAR;
        PG8_WAIT_V(2); PG8_BAR;
        PG8_STAGE(PG8_SB(1, 0), cB + kstep, voffB); PG8_STAGE(PG8_SA(1, 0), cA + kstep, voffA); PG8_STAGE(PG8_SB(1, 1), cB + hstep + kstep, voffB);
        PG8_WAIT_V(6); PG8_BAR;
    } else {
        PG8_STAGE(PG8_SB(0, 0), cB, voffB); PG8_STAGE(PG8_SA(0, 0), cA, voffA); PG8_STAGE(PG8_SB(0, 1), cB + hstep, voffB); PG8_STAGE(PG8_SA(0, 1), cA + hstep, voffA);
        if (wr == 1) PG8_BAR;
        PG8_WAIT_V(4); PG8_BAR;
        PG8_STAGE(PG8_SB(1, 0), cB + kstep, voffB); PG8_STAGE(PG8_SA(1, 0), cA + kstep, voffA); PG8_STAGE(PG8_SB(1, 1), cB + hstep + kstep, voffB);
        PG8_WAIT_V(6); PG8_BAR;
    }
    for (;;) {
        const bool has_next = S.next(ui + 1, nxt);
        const char* nA = has_next ? (const char*)g.A + (size_t)nxt.pm * tstep : cA; const char* nB = has_next ? (const char*)g.Bt + (size_t)nxt.pn * tstep : cB;
        for (int t = 0; t < nt; t += 2) {
            const bool last = (t == nt - 2);
            const char* a1 = cA + (size_t)(t + 1) * kstep;
            const char* a2 = last ? nA : cA + (size_t)(t + 2) * kstep; const char* b2 = last ? nB : cB + (size_t)(t + 2) * kstep;
            const char* a3 = a2 + kstep; const char* b3 = b2 + kstep;
            if (last && has_next) S.a_ready(nxt);
            if (Epi::MID && t == nt / 2) { E.mid(acc, cur, wr, wc, fr, fq); PG8_WAIT_L(0); PG8_SCHED; }
            if constexpr (SP2) {
            PG8_LDB(B0, 0, 0); PG8_LDB(B1, 0, 1); PG8_SCHED; PG8_LDA(At, 0, 0); PG8_STAGE(PG8_SA(1, 1), a1 + hstep, voffA);
            PG8_WAIT_V(8); PG8_WAIT_L(0); PG8_BAR; PG8_MMA(0, 0, At, B0); PG8_MMA(0, 1, At, B1); PG8_BAR; PG8_SCHED;
            PG8_LDA(At, 0, 1); PG8_STAGE(PG8_SB(0, 0), b2, voffB); PG8_STAGE(PG8_SB(0, 1), b2 + hstep, voffB); PG8_STAGE(PG8_SA(0, 0), a2, voffA);
            PG8_WAIT_V(8); PG8_WAIT_L(0); PG8_BAR; PG8_MMA(1, 0, At, B0); PG8_MMA(1, 1, At, B1); PG8_BAR; PG8_SCHED;
            PG8_LDB(B0, 1, 0); PG8_LDB(B1, 1, 1); PG8_SCHED; PG8_LDA(At, 1, 0); PG8_STAGE(PG8_SA(0, 1), a2 + hstep, voffA);
            PG8_WAIT_V(8); PG8_WAIT_L(0); PG8_BAR; PG8_MMA(0, 0, At, B0); PG8_MMA(0, 1, At, B1); PG8_BAR; PG8_SCHED;
            PG8_LDA(At, 1, 1); PG8_STAGE(PG8_SB(1, 0), b3, voffB); PG8_STAGE(PG8_SB(1, 1), b3 + hstep, voffB); PG8_STAGE(PG8_SA(1, 0), a3, voffA);
            PG8_WAIT_V(8); PG8_WAIT_L(0); PG8_BAR; PG8_MMA(1, 0, At, B0); PG8_MMA(1, 1, At, B1); PG8_BAR; PG8_SCHED;
            } else {
            PG8_LDB(B0, 0, 0); PG8_SCHED; PG8_LDA(At, 0, 0); PG8_STAGE(PG8_SA(1, 1), a1 + hstep, voffA);
            PG8_WAIT_L(8); PG8_BAR; PG8_WAIT_L(0); PG8_MMA(0, 0, At, B0); PG8_BAR; PG8_SCHED;
            PG8_LDB(B1, 0, 1); PG8_STAGE(PG8_SB(0, 0), b2, voffB);
            PG8_BAR; PG8_WAIT_L(0); PG8_MMA(0, 1, At, B1); PG8_BAR;
            PG8_LDA(At, 0, 1); PG8_STAGE(PG8_SA(0, 0), a2, voffA);
            PG8_BAR; PG8_WAIT_L(0); PG8_MMA(1, 0, At, B0); PG8_BAR; PG8_SCHED;
            PG8_STAGE(PG8_SB(0, 1), b2 + hstep, voffB);
            PG8_WAIT_V(6); PG8_BAR; PG8_MMA(1, 1, At, B1); PG8_BAR;
            PG8_LDB(B0, 1, 0); PG8_SCHED; PG8_LDA(At, 1, 0); PG8_STAGE(PG8_SA(0, 1), a2 + hstep, voffA);
            PG8_WAIT_L(8); PG8_BAR; PG8_WAIT_L(0); PG8_MMA(0, 0, At, B0); PG8_BAR; PG8_SCHED;
            PG8_LDB(B1, 1, 1); PG8_STAGE(PG8_SB(1, 0), b3, voffB);
            PG8_BAR; PG8_WAIT_L(0); PG8_MMA(0, 1, At, B1); PG8_BAR;
            PG8_LDA(At, 1, 1); PG8_STAGE(PG8_SA(1, 0), a3, voffA);
            PG8_BAR; PG8_WAIT_L(0); PG8_MMA(1, 0, At, B0); PG8_BAR; PG8_SCHED;
            PG8_STAGE(PG8_SB(1, 1), b3 + hstep, voffB);
            PG8_WAIT_V(6); PG8_BAR; PG8_MMA(1, 1, At, B1); PG8_BAR;
            }
        }
        if constexpr (ALIGN_EPI) { if (wr == 0) PG8_BAR; }
        E(acc, cur, wr, wc, fr, fq); S.done(cur);
        if (!has_next) break;
#pragma unroll
        for (int a = 0; a < 2; ++a)
#pragma unroll
            for (int b = 0; b < 2; ++b)
#pragma unroll
                for (int m = 0; m < 4; ++m)
#pragma unroll
                    for (int n = 0; n < 2; ++n) acc[a][b][m][n] = (f32x4){0.f, 0.f, 0.f, 0.f};
        cur = nxt; cA = nA; cB = nB; ++ui;
        if constexpr (ALIGN_EPI) { if (wr == 1) PG8_BAR; }
    }
    PG8_WAIT_V(0);
    if constexpr (!ALIGN_EPI) { if (wr == 0) PG8_BAR; }
    PG8_BAR;
#undef PG8_SA
#undef PG8_SB
#undef PG8_STAGE
#undef PG8_LDA
#undef PG8_LDB
#undef PG8_MMA
#undef PG8_WAIT_V
#undef PG8_WAIT_L
#undef PG8_BAR
#undef PG8_SCHED
}
}

#define XB_TMO      128
#define XB_XCNT(j)  (256  + 64 * (j))
#define XB_XSUB(j)  (1280 + 64 * (j))
#define XB_XGEN(j)  (2304 + 64 * (j))
#define XB_TOP      3328
#define XB_TOPGEN   3392
#define XCD_BAR_WORDS 3456
#define XB_SPIN_CAP (1u << 18)
__device__ __forceinline__ unsigned xb_ld(unsigned* p)              { return __hip_atomic_load(p, __ATOMIC_RELAXED, __HIP_MEMORY_SCOPE_AGENT); }
__device__ __forceinline__ unsigned xb_add(unsigned* p, unsigned v) { return __hip_atomic_fetch_add(p, v, __ATOMIC_RELAXED, __HIP_MEMORY_SCOPE_AGENT); }
__device__ __forceinline__ unsigned xb_xcc_id() { return (unsigned)__builtin_amdgcn_s_getreg((3 << 11) | 20) & 0xFu; }
#define XB_SPIN(cond, bar) do { unsigned _sp = 0; while (cond) { __builtin_amdgcn_s_sleep(1); \
    if ((++_sp & 255u) == 0u) { if (xb_ld(&(bar)[XB_TMO])) break; if (_sp > XB_SPIN_CAP) { atomicAdd(&(bar)[XB_TMO], 1u); break; } } } } while (0)
struct XcdBarrier { unsigned* bar; unsigned x; volatile LAS unsigned* st; };
__device__ __forceinline__ XcdBarrier xcd_barrier_post(unsigned* bar, volatile LAS unsigned* st) {
    XcdBarrier b; b.bar = bar; b.x = xb_xcc_id(); b.st = st;
    if (threadIdx.x == 0) (void)xb_add(&bar[XB_XCNT(b.x)], 1u);
    return b;
}
__device__ __forceinline__ void xcd_barrier_complete(unsigned* bar, unsigned x, unsigned& nloc, unsigned& nx) {
    const unsigned G = gridDim.x * gridDim.y * gridDim.z;
    unsigned sum, cnt, mine, sp = 0u;
    for (;;) {
        sum = 0u; cnt = 0u; mine = 0u;
#pragma unroll
        for (unsigned j = 0; j < 16; ++j) { const unsigned c = xb_ld(&bar[XB_XCNT(j)]); sum += c; cnt += (c > 0u) ? 1u : 0u; mine = (j == x) ? c : mine; }
        if (sum == G) break;
        __builtin_amdgcn_s_sleep(1);
        if ((++sp & 255u) == 0u) { if (xb_ld(&bar[XB_TMO])) break; if (sp > XB_SPIN_CAP) { atomicAdd(&bar[XB_TMO], 1u); break; } }
    }
    nloc = mine > 0u ? mine : 1u; nx = cnt > 0u ? cnt : 1u;
}
__device__ __forceinline__ void xcd_barrier(const XcdBarrier& b) {
    asm volatile("s_waitcnt vmcnt(0)" ::: "memory");
    __syncthreads();
    if (threadIdx.x == 0) {
        unsigned* bar = b.bar;
        __builtin_amdgcn_s_waitcnt(0);
        unsigned nloc = b.st[0], nx = b.st[1];
        if (nloc == 0u) { xcd_barrier_complete(bar, b.x, nloc, nx); b.st[0] = nloc; b.st[1] = nx; }
        const unsigned old = xb_add(&bar[XB_XSUB(b.x)], 1u);
        const unsigned gen = old / nloc;
        if (old + 1u == (gen + 1u) * nloc) {
            __builtin_amdgcn_fence(__ATOMIC_RELEASE, "agent");
            asm volatile("s_waitcnt vmcnt(0)" ::: "memory");
            const unsigned og = xb_add(&bar[XB_TOP], 1u);
            const unsigned tg = og / nx;
            if (og + 1u == (tg + 1u) * nx) xb_add(&bar[XB_TOPGEN], 1u);
            else XB_SPIN(xb_ld(&bar[XB_TOPGEN]) == tg, bar);
            __builtin_amdgcn_fence(__ATOMIC_ACQUIRE, "agent");
            xb_add(&bar[XB_XGEN(b.x)], 1u);
            asm volatile("s_waitcnt vmcnt(0)" ::: "memory");
        } else {
            XB_SPIN(xb_ld(&bar[XB_XGEN(b.x)]) == gen, bar);
            __builtin_amdgcn_fence(__ATOMIC_ACQUIRE, "agent");
            asm volatile("s_waitcnt vmcnt(0)" ::: "memory");
        }
    }
    __syncthreads();
}

constexpr int NWAVES = 8;
constexpr int RING_BYTES = 131072, MISC_OFF = RING_BYTES, RS_OFF = RING_BYTES + 512, LDS_BYTES = 147456;
constexpr int CW_BAR = 4096;
constexpr int CW_ATTQ = 64;

__device__ __forceinline__ float dpp_add(float v, float o) { return v + o; }
__device__ __forceinline__ float row16_sum(float v) {
    v += DPP_F(v, 0xB1); v += DPP_F(v, 0x4E); v += DPP_F(v, 0x141); v += DPP_F(v, 0x140); return v;
}
__device__ __forceinline__ float wave_sum_u(float v) {
    v = row16_sum(v);
    const int i = __builtin_bit_cast(int, v);
    return (__builtin_bit_cast(float, __builtin_amdgcn_readlane(i, 0)) + __builtin_bit_cast(float, __builtin_amdgcn_readlane(i, 16))) +
           (__builtin_bit_cast(float, __builtin_amdgcn_readlane(i, 32)) + __builtin_bit_cast(float, __builtin_amdgcn_readlane(i, 48)));
}
typedef __bf16 bf16x2_t __attribute__((ext_vector_type(2)));
__device__ __forceinline__ float dot2(unsigned a, unsigned b, float acc) { return __builtin_amdgcn_fdot2_f32_bf16(__builtin_bit_cast(bf16x2_t, a), __builtin_bit_cast(bf16x2_t, b), acc, false); }

__device__ __forceinline__ void unpack8(const u32x4 w, float (&f)[8]) {
#pragma unroll
    for (int i = 0; i < 4; ++i) { f[2 * i] = bflo(w[i]); f[2 * i + 1] = bfhi(w[i]); }
}
typedef float f32x2 __attribute__((ext_vector_type(2)));
constexpr int CW_QU = 8192, CW_QV = 8192 + 512;
template <int M> __device__ __forceinline__ float xor_lane(float v) {
    if (M < 32) return __builtin_bit_cast(float, __builtin_amdgcn_ds_swizzle(__builtin_bit_cast(int, v), (M << 10) | 0x1f));
    return __shfl_xor(v, M);
}
__device__ __forceinline__ float fsel(int m, float a, float b) { return __builtin_bit_cast(float, (__builtin_bit_cast(int, a) & m) | (__builtin_bit_cast(int, b) & ~m)); }
__device__ __forceinline__ void fp8x16_to_f32(const u32x4 w, float (&f)[16]) {
#pragma unroll
    for (int q = 0; q < 4; ++q) { const f32x2 lo = __builtin_amdgcn_cvt_pk_f32_fp8((int)w[q], false), hi = __builtin_amdgcn_cvt_pk_f32_fp8((int)w[q], true);
        f[4 * q] = lo.x; f[4 * q + 1] = lo.y; f[4 * q + 2] = hi.x; f[4 * q + 3] = hi.y; }
}
template <int WHICH> struct SliceTok {
    u32x4 vv[16]; f32x2 o; float r0, r1, wsc; int t, ia, ib, wd;
    __device__ __forceinline__ void idx(const Ptrs& P, int t_, int lane) { const unsigned short* ip = (const unsigned short*)(P.ws + WS_IDX16) + (size_t)t_ * 128; ia = ip[(unsigned)lane]; ib = ip[(unsigned)(64 + lane)]; }
    __device__ __forceinline__ void load(const Ptrs& P, int t_, int j, int lane) {
        t = t_;
        const unsigned char* ws = P.ws;
        const int sl = lane >> 3, p = lane & 7;
        const unsigned char* TAB = ws + (WHICH ? WS_EV : WS_EU) + (size_t)j * SLICE_BYTES;
        const int baddr = 4 * sl;
        if (WHICH == 1) { wd = ((const int*)(ws + WS_W))[(unsigned)(t * 32 + (lane & 31))]; wsc = ((const float*)(ws + WS_R1))[t];
            const int col = 128 * j + 16 * p + 8 * ((lane >> 5) & 1) + 4 * ((lane >> 4) & 1) + 2 * ((lane >> 3) & 1); { const unsigned xw = *(const unsigned*)((const bf16*)(ws + WS_X1BF) + (size_t)t * D + (unsigned)col); o = (f32x2){bflo(xw), bfhi(xw)}; } }
#pragma unroll
        for (int i = 0; i < 16; ++i) { const int e = __builtin_amdgcn_ds_bpermute(baddr + 32 * (i & 7), (i < 8) ? ia : ib); vv[i] = *(const u32x4*)(TAB + (unsigned)(e * 128 + 16 * p)); }
    }
    __device__ __forceinline__ void compute(int lane, const LAS unsigned char* xqp, float sx) {
        const int sl = lane >> 3;
        const int baddr = 4 * sl;
        if (WHICH == 0) {
            const i32x4 xq = *(const LAS i32x4*)xqp;
            int d[16];
#pragma unroll
            for (int i = 0; i < 16; ++i) { int a = 0;
#pragma unroll
                for (int q = 0; q < 4; ++q) a = __builtin_amdgcn_sdot4((int)vv[i][q], xq[q], a, false);
                d[i] = a; }
#pragma unroll
            for (int st = 0; st < 3; ++st) { const int M = 1 << st, n = 8 >> st; const int hm = (lane & M) ? -1 : 0;
#pragma unroll
                for (int i = 0; i < 8; ++i) if (i < n) { const int keep = (d[n + i] & hm) | (d[i] & ~hm), send = (d[i] & hm) | (d[n + i] & ~hm);
                    d[i] = keep + ((st == 0) ? DPP_I(send, 0xB1) : (st == 1) ? DPP_I(send, 0x4E) : __builtin_amdgcn_ds_swizzle(send, (4 << 10) | 0x1f)); } }
            r0 = (float)d[0] * sx; r1 = (float)d[1] * sx;
            (void)baddr;
        } else {
            int wq[4];
#pragma unroll
            for (int b = 0; b < 4; ++b) wq[b] = __builtin_amdgcn_ds_bpermute(16 * sl + 4 * b, wd);
            int acc[16];
#pragma unroll
            for (int c = 0; c < 16; ++c) acc[c] = 0;
#pragma unroll
            for (int b = 0; b < 4; ++b)
#pragma unroll
                for (int q = 0; q < 4; ++q) { const unsigned r0_ = vv[4 * b][q], r1_ = vv[4 * b + 1][q], r2_ = vv[4 * b + 2][q], r3_ = vv[4 * b + 3][q];
                    const unsigned t01l = __builtin_amdgcn_perm(r1_, r0_, 0x05010400u), t01h = __builtin_amdgcn_perm(r1_, r0_, 0x07030602u);
                    const unsigned t23l = __builtin_amdgcn_perm(r3_, r2_, 0x05010400u), t23h = __builtin_amdgcn_perm(r3_, r2_, 0x07030602u);
                    const unsigned c0 = __builtin_amdgcn_perm(t23l, t01l, 0x05040100u), c1 = __builtin_amdgcn_perm(t23l, t01l, 0x07060302u);
                    const unsigned c2 = __builtin_amdgcn_perm(t23h, t01h, 0x05040100u), c3 = __builtin_amdgcn_perm(t23h, t01h, 0x07060302u);
                    acc[4 * q] = __builtin_amdgcn_sdot4((int)c0, wq[b], acc[4 * q], false); acc[4 * q + 1] = __builtin_amdgcn_sdot4((int)c1, wq[b], acc[4 * q + 1], false);
                    acc[4 * q + 2] = __builtin_amdgcn_sdot4((int)c2, wq[b], acc[4 * q + 2], false); acc[4 * q + 3] = __builtin_amdgcn_sdot4((int)c3, wq[b], acc[4 * q + 3], false); }
#pragma unroll
            for (int st = 0; st < 3; ++st) { const int M = 32 >> st, n = 8 >> st; const int hm = (lane & M) ? -1 : 0;
#pragma unroll
                for (int i = 0; i < 8; ++i) if (i < n) { const int keep = (acc[n + i] & hm) | (acc[i] & ~hm), send = (acc[i] & hm) | (acc[n + i] & ~hm);
                    acc[i] = keep + ((st == 0) ? __shfl_xor(send, 32) : (st == 1) ? __builtin_amdgcn_ds_swizzle(send, (16 << 10) | 0x1f) : __builtin_amdgcn_ds_swizzle(send, (8 << 10) | 0x1f)); } }
            r0 = (float)acc[0] * wsc; r1 = (float)acc[1] * wsc;
        }
    }
    __device__ __forceinline__ void store(const Ptrs& P, int j, int lane) {
        const int sl = lane >> 3, p = lane & 7;
        if (WHICH == 0) { const int i0 = 8 * (lane & 1) + 4 * ((lane >> 1) & 1) + 2 * ((lane >> 2) & 1);
            float* pp = (float*)(P.ws + WS_PART) + ((size_t)j * T + t) * 128;
            pp[(unsigned)(8 * i0 + sl)] = r0; pp[(unsigned)(8 * i0 + 8 + sl)] = r1; }
        else { const int col = 128 * j + 16 * p + 8 * ((lane >> 5) & 1) + 4 * ((lane >> 4) & 1) + 2 * ((lane >> 3) & 1);
            f32x2 q = o; q.x += r0; q.y += r1; *(f32x2*)(P.out + (size_t)t * D + (unsigned)col) = q; }
    }
};
template <int WHICH> __device__ __forceinline__ void p6_sliced(const Ptrs& P, LAS unsigned char* lds, volatile LAS unsigned* MISC, unsigned* ctl, int tid, int lane, int wave) {
    const int my = (int)(xb_xcc_id() & 7u);
    LAS unsigned char* XQ = lds + wave * 1024;
    LAS float* SX = (LAS float*)(lds + 8192 + wave * 32);
    for (int off = 0; off < 8; ++off) {
        const int j = (my + off) & 7;
        unsigned* head = ctl + (WHICH ? CW_QV : CW_QU) + 64 * j;
        for (;;) {
            if (tid == 0) MISC[1] = atomicAdd(head, 1u);
            __syncthreads();
            const int blk = (int)MISC[1];
            __syncthreads();
            if (blk >= T / 64) break;
            const int t0 = blk * 64 + wave * 8;
            int la = lane; asm volatile("" : "+v"(la));
            SliceTok<WHICH> A, B;
            A.idx(P, t0, la); B.idx(P, t0 + 1, la);
            A.load(P, t0, j, la);
            if (WHICH == 0) {
                const bf16* xb = (const bf16*)(P.ws + WS_X1BF) + (size_t)(t0 + (la >> 3)) * D + (unsigned)(128 * j + 16 * (la & 7));
                const u32x4 xw0 = *(const u32x4*)xb, xw1 = *(const u32x4*)(xb + 8);
                float xf[16]; { float t8[8]; unpack8(xw0, t8);
#pragma unroll
                    for (int i = 0; i < 8; ++i) xf[i] = t8[i];
                    unpack8(xw1, t8);
#pragma unroll
                    for (int i = 0; i < 8; ++i) xf[8 + i] = t8[i]; }
                float mx = 0.f;
#pragma unroll
                for (int i = 0; i < 16; ++i) mx = fmaxf(mx, fabsf(xf[i]));
                mx = fmaxf(mx, DPP_F(mx, 0xB1)); mx = fmaxf(mx, DPP_F(mx, 0x4E)); mx = fmaxf(mx, DPP_F(mx, 0x141));
                mx = fmaxf(mx, 1e-30f);
                const float xinv = 127.0f * __builtin_amdgcn_rcpf(mx);
                i32x4 xq;
#pragma unroll
                for (int q = 0; q < 4; ++q) { const int q0 = (int)rintf(xf[4 * q] * xinv), q1 = (int)rintf(xf[4 * q + 1] * xinv), q2 = (int)rintf(xf[4 * q + 2] * xinv), q3 = (int)rintf(xf[4 * q + 3] * xinv);
                    xq[q] = (int)((unsigned)(q0 & 0xff) | ((unsigned)(q1 & 0xff) << 8) | ((unsigned)(q2 & 0xff) << 16) | ((unsigned)q3 << 24)); }
                *(LAS i32x4*)(XQ + 16 * la) = xq;
                if ((la & 7) == 0) SX[la >> 3] = mx * (1.0f / 127.0f);
            }
            const LAS unsigned char* xqp = XQ + 16 * (la & 7);
#pragma unroll
            for (int n = 0; n < 8; n += 2) {
                B.load(P, t0 + n + 1, j, la);
                if (n + 2 < 8) A.idx(P, t0 + n + 2, la);
                A.compute(la, xqp + 128 * n, (WHICH == 0) ? SX[n] : 0.f); A.store(P, j, la);
                if (n + 2 < 8) { A.load(P, t0 + n + 2, j, la); B.idx(P, t0 + n + 3, la); }
                B.compute(la, xqp + 128 * (n + 1), (WHICH == 0) ? SX[n + 1] : 0.f); B.store(P, j, la);
            }
        }
    }
}

__device__ __forceinline__ void p6_v2(const Ptrs& P, volatile LAS unsigned* MISC, unsigned* ctl, int tid, int lane, int wave) {
    const int my = (int)(xb_xcc_id() & 7u);
    const unsigned char* ws = P.ws;
    constexpr int PD = 6;
    for (int off = 0; off < 8; ++off) {
        const int j = (my + off) & 7;
        unsigned* head = ctl + CW_QV + 64 * j;
        const unsigned char* TAB = ws + WS_EV + (size_t)j * SLICE_BYTES;
        for (;;) {
            if (tid == 0) MISC[1] = atomicAdd(head, 1u);
            __syncthreads();
            const int blk = (int)MISC[1];
            __syncthreads();
            if (blk >= T / 64) break;
            int la = lane; asm volatile("" : "+v"(la));
            const int t = blk * 64 + wave * 8 + (la >> 3);
            const unsigned pb = 16u * (unsigned)(la & 7);
            const unsigned char* idp = ws + WS_IDX16 + (unsigned)(t * 256);
            const unsigned char* wp = ws + WS_W + (unsigned)(t * 128);
            u32x4 ids[16];
#pragma unroll
            for (int c = 0; c < 16; ++c) ids[c] = *(const u32x4*)(idp + 16 * c);
            u32x4 vv[PD + 1][4];
#define P6V_ISSUE(q_) do { _Pragma("unroll") for (int e_ = 0; e_ < 4; ++e_) { const int k_ = 4 * (q_) + e_; const unsigned word = ids[k_ >> 3][(k_ & 7) >> 1]; \
                const unsigned ex = (k_ & 1) ? (word >> 16) : (word & 0xffffu); vv[(q_) % (PD + 1)][e_] = *(const u32x4*)(TAB + (ex * 128u + pb)); } } while (0)
#pragma unroll
            for (int q = 0; q < PD; ++q) P6V_ISSUE(q);
            const u32x4 xr0 = *(const u32x4*)((const bf16*)(ws + WS_X1BF) + (size_t)t * D + (unsigned)(128 * j) + pb), xr1 = *(const u32x4*)((const bf16*)(ws + WS_X1BF) + (size_t)t * D + (unsigned)(128 * j) + pb + 8);
            const float wsc = ((const float*)(ws + WS_R1))[t];
            u32x4 wq[8];
#pragma unroll
            for (int c = 0; c < 8; ++c) wq[c] = *(const u32x4*)(wp + 16 * c);
            int acc[16];
#pragma unroll
            for (int c = 0; c < 16; ++c) acc[c] = 0;
#pragma unroll
            for (int q = 0; q < 32; ++q) {
                if (q + PD < 32) P6V_ISSUE(q + PD);
                const int wv = (int)wq[q >> 2][q & 3];
#pragma unroll
                for (int d = 0; d < 4; ++d) { const unsigned r0_ = vv[q % (PD + 1)][0][d], r1_ = vv[q % (PD + 1)][1][d], r2_ = vv[q % (PD + 1)][2][d], r3_ = vv[q % (PD + 1)][3][d];
                    const unsigned t01l = __builtin_amdgcn_perm(r1_, r0_, 0x05010400u), t01h = __builtin_amdgcn_perm(r1_, r0_, 0x07030602u);
                    const unsigned t23l = __builtin_amdgcn_perm(r3_, r2_, 0x05010400u), t23h = __builtin_amdgcn_perm(r3_, r2_, 0x07030602u);
                    const unsigned c0 = __builtin_amdgcn_perm(t23l, t01l, 0x05040100u), c1 = __builtin_amdgcn_perm(t23l, t01l, 0x07060302u);
                    const unsigned c2 = __builtin_amdgcn_perm(t23h, t01h, 0x05040100u), c3 = __builtin_amdgcn_perm(t23h, t01h, 0x07060302u);
                    acc[4 * d] = __builtin_amdgcn_sdot4((int)c0, wv, acc[4 * d], false); acc[4 * d + 1] = __builtin_amdgcn_sdot4((int)c1, wv, acc[4 * d + 1], false);
                    acc[4 * d + 2] = __builtin_amdgcn_sdot4((int)c2, wv, acc[4 * d + 2], false); acc[4 * d + 3] = __builtin_amdgcn_sdot4((int)c3, wv, acc[4 * d + 3], false); }
            }
#undef P6V_ISSUE
            float xf[16]; { float t8[8]; unpack8(xr0, t8);
#pragma unroll
                for (int i = 0; i < 8; ++i) xf[i] = t8[i];
                unpack8(xr1, t8);
#pragma unroll
                for (int i = 0; i < 8; ++i) xf[8 + i] = t8[i]; }
            float* op = P.out + (size_t)t * D + (unsigned)(128 * j) + pb;
#pragma unroll
            for (int c4 = 0; c4 < 4; ++c4) *(f32x4*)(op + 4 * c4) = (f32x4){xf[4 * c4] + (float)acc[4 * c4] * wsc, xf[4 * c4 + 1] + (float)acc[4 * c4 + 1] * wsc, xf[4 * c4 + 2] + (float)acc[4 * c4 + 2] * wsc, xf[4 * c4 + 3] + (float)acc[4 * c4 + 3] * wsc};
        }
    }
}

__device__ __forceinline__ void p6_v3(const Ptrs& P, LAS unsigned char* lds, int bx, int lane, int wave) {
    const unsigned char* ws = P.ws;
    constexpr int NB = 8;
    const int j = bx & 7, wi = (bx >> 3) * 8 + wave, T0 = wi * 64;
    const unsigned char* TAB = ws + WS_EV + (size_t)j * SLICE_BYTES;
    LAS unsigned char* buf = lds + wave * 6144;
    int la = lane; asm volatile("" : "+v"(la));
    const int g = la >> 3;
    const unsigned pb = 16u * (unsigned)(la & 7);
#define V3_FETCH(b_, r0_, r1_, r2_) do { const unsigned char* ip_ = ws + WS_IDX16 + (unsigned)((T0 + 8 * (b_)) * 256) + 16u * (unsigned)la; r0_ = *(const u32x4*)ip_; r1_ = *(const u32x4*)(ip_ + 1024); \
        r2_ = *(const u32x4*)(ws + WS_W + (unsigned)((T0 + 8 * (b_)) * 128) + 16u * (unsigned)la); } while (0)
#define V3_PARK(b_, r0_, r1_, r2_) do { LAS unsigned char* d_ = buf + ((b_) & 1) * 3072; *(LAS u32x4*)(d_ + 16 * la) = r0_; *(LAS u32x4*)(d_ + 1024 + 16 * la) = r1_; *(LAS u32x4*)(d_ + 2048 + 16 * la) = r2_; } while (0)
    u32x4 f0, f1, f2;
    V3_FETCH(0, f0, f1, f2); V3_PARK(0, f0, f1, f2);
    u32x4 V00, V01, V02, V03, V10, V11, V12, V13, V20, V21, V22, V23, V30, V31, V32, V33, V40, V41, V42, V43, V50, V51, V52, V53, V60, V61, V62, V63, V70, V71, V72, V73;
#define V3_ISSUE(S_, bsel_, tq_) do { const u32x2 e2_ = *(const LAS u32x2*)(buf + (bsel_) * 3072 + g * 256 + 8 * (tq_)); \
        V##S_##0 = *(const u32x4*)(TAB + ((e2_.x & 0xffffu) * 128u + pb)); V##S_##1 = *(const u32x4*)(TAB + ((e2_.x >> 16) * 128u + pb)); \
        V##S_##2 = *(const u32x4*)(TAB + ((e2_.y & 0xffffu) * 128u + pb)); V##S_##3 = *(const u32x4*)(TAB + ((e2_.y >> 16) * 128u + pb)); } while (0)
#define V3_MAC(S_, q_) do { const int wv = *(const LAS int*)(buf + bs * 3072 + 2048 + g * 128 + 4 * (q_)); \
        _Pragma("unroll") for (int d = 0; d < 4; ++d) { const unsigned r0_ = V##S_##0[d], r1_ = V##S_##1[d], r2_ = V##S_##2[d], r3_ = V##S_##3[d]; \
            const unsigned t01l = __builtin_amdgcn_perm(r1_, r0_, 0x05010400u), t01h = __builtin_amdgcn_perm(r1_, r0_, 0x07030602u); \
            const unsigned t23l = __builtin_amdgcn_perm(r3_, r2_, 0x05010400u), t23h = __builtin_amdgcn_perm(r3_, r2_, 0x07030602u); \
            const unsigned c0 = __builtin_amdgcn_perm(t23l, t01l, 0x05040100u), c1 = __builtin_amdgcn_perm(t23l, t01l, 0x07060302u); \
            const unsigned c2 = __builtin_amdgcn_perm(t23h, t01h, 0x05040100u), c3 = __builtin_amdgcn_perm(t23h, t01h, 0x07060302u); \
            acc[4 * d] = __builtin_amdgcn_sdot4((int)c0, wv, acc[4 * d], false); acc[4 * d + 1] = __builtin_amdgcn_sdot4((int)c1, wv, acc[4 * d + 1], false); \
            acc[4 * d + 2] = __builtin_amdgcn_sdot4((int)c2, wv, acc[4 * d + 2], false); acc[4 * d + 3] = __builtin_amdgcn_sdot4((int)c3, wv, acc[4 * d + 3], false); } } while (0)
    V3_ISSUE(0, 0, 0);
    V3_ISSUE(1, 0, 1);
    V3_ISSUE(2, 0, 2);
    V3_ISSUE(3, 0, 3);
    V3_ISSUE(4, 0, 4);
    V3_ISSUE(5, 0, 5);
#pragma unroll 1
    for (int b = 0; b < NB; ++b) {
        int acc[16];
#pragma unroll
        for (int c = 0; c < 16; ++c) acc[c] = 0;
        const int bs = b & 1, t = T0 + 8 * b + g;
        const bf16* xrp = (const bf16*)(ws + WS_X1BF) + (size_t)t * D + (unsigned)(128 * j) + pb;
        const u32x4 xr0 = *(const u32x4*)xrp, xr1 = *(const u32x4*)(xrp + 8);
        const float wsc = ((const float*)(ws + WS_R1))[t];
        V3_FETCH((b + 1) & 7, f0, f1, f2);
        V3_ISSUE(6, bs, 6); V3_MAC(0, 0);
        V3_ISSUE(7, bs, 7); V3_MAC(1, 1);
        V3_ISSUE(0, bs, 8); V3_MAC(2, 2);
        V3_ISSUE(1, bs, 9); V3_MAC(3, 3);
        V3_ISSUE(2, bs, 10); V3_MAC(4, 4);
        V3_ISSUE(3, bs, 11); V3_MAC(5, 5);
        V3_ISSUE(4, bs, 12); V3_MAC(6, 6);
        V3_ISSUE(5, bs, 13); V3_MAC(7, 7);
        V3_PARK(b + 1, f0, f1, f2);
        V3_ISSUE(6, bs, 14); V3_MAC(0, 8);
        V3_ISSUE(7, bs, 15); V3_MAC(1, 9);
        V3_ISSUE(0, bs, 16); V3_MAC(2, 10);
        V3_ISSUE(1, bs, 17); V3_MAC(3, 11);
        V3_ISSUE(2, bs, 18); V3_MAC(4, 12);
        V3_ISSUE(3, bs, 19); V3_MAC(5, 13);
        V3_ISSUE(4, bs, 20); V3_MAC(6, 14);
        V3_ISSUE(5, bs, 21); V3_MAC(7, 15);
        V3_ISSUE(6, bs, 22); V3_MAC(0, 16);
        V3_ISSUE(7, bs, 23); V3_MAC(1, 17);
        V3_ISSUE(0, bs, 24); V3_MAC(2, 18);
        V3_ISSUE(1, bs, 25); V3_MAC(3, 19);
        V3_ISSUE(2, bs, 26); V3_MAC(4, 20);
        V3_ISSUE(3, bs, 27); V3_MAC(5, 21);
        V3_ISSUE(4, bs, 28); V3_MAC(6, 22);
        V3_ISSUE(5, bs, 29); V3_MAC(7, 23);
        V3_ISSUE(6, bs, 30); V3_MAC(0, 24);
        V3_ISSUE(7, bs, 31); V3_MAC(1, 25);
        V3_ISSUE(0, bs ^ 1, 0); V3_MAC(2, 26);
        V3_ISSUE(1, bs ^ 1, 1); V3_MAC(3, 27);
        V3_ISSUE(2, bs ^ 1, 2); V3_MAC(4, 28);
        V3_ISSUE(3, bs ^ 1, 3); V3_MAC(5, 29);
        V3_ISSUE(4, bs ^ 1, 4); V3_MAC(6, 30);
        V3_ISSUE(5, bs ^ 1, 5); V3_MAC(7, 31);
        float xf[16]; { float t8[8]; unpack8(xr0, t8);
#pragma unroll
            for (int i = 0; i < 8; ++i) xf[i] = t8[i];
            unpack8(xr1, t8);
#pragma unroll
            for (int i = 0; i < 8; ++i) xf[8 + i] = t8[i]; }
        float* op = P.out + (size_t)t * D + (unsigned)(128 * j) + pb;
#pragma unroll
        for (int c4 = 0; c4 < 4; ++c4) { *(f32x4*)(op + 4 * c4) = (f32x4){xf[4 * c4] + (float)acc[4 * c4] * wsc, xf[4 * c4 + 1] + (float)acc[4 * c4 + 1] * wsc, xf[4 * c4 + 2] + (float)acc[4 * c4 + 2] * wsc, xf[4 * c4 + 3] + (float)acc[4 * c4 + 3] * wsc};
        }
    }
#undef V3_MAC
#undef V3_FETCH
#undef V3_PARK
#undef V3_ISSUE
}

__device__ __forceinline__ void p6_u3(const Ptrs& P, LAS unsigned char* lds, int bx, int lane, int wave) {
    const unsigned char* ws = P.ws;
    constexpr int NB = 8;
    const int j = bx & 7, wi = (bx >> 3) * 8 + wave, T0 = wi * 64;
    const unsigned char* TAB = ws + WS_EU + (size_t)j * SLICE_BYTES;
    LAS unsigned char* buf = lds + wave * 8192;
    int la = lane; asm volatile("" : "+v"(la));
    const int sl = la >> 3, pc = la & 7;
    const unsigned pb = 16u * (unsigned)pc;
    const int i0 = 8 * (la & 1) + 4 * ((la >> 1) & 1) + 2 * ((la >> 2) & 1);
#define U3_FETCH(b_) do { const unsigned char* ip_ = ws + WS_IDX16 + (unsigned)((T0 + 8 * (b_)) * 256) + 16u * (unsigned)la; f0 = *(const u32x4*)ip_; f1 = *(const u32x4*)(ip_ + 1024); \
        const bf16* xb_ = (const bf16*)(ws + WS_X1BF) + (size_t)(T0 + 8 * (b_) + (la >> 3)) * D + (unsigned)(128 * j + 16 * (la & 7)); x0 = *(const u32x4*)xb_; x1 = *(const u32x4*)(xb_ + 8); } while (0)
#define U3_PARK(b_) do { LAS unsigned char* d_ = buf + ((b_) & 1) * 4096; *(LAS u32x4*)(d_ + 16 * la) = f0; *(LAS u32x4*)(d_ + 1024 + 16 * la) = f1; \
        float xf[16]; { float t8[8]; unpack8(x0, t8); _Pragma("unroll") for (int i = 0; i < 8; ++i) xf[i] = t8[i]; unpack8(x1, t8); _Pragma("unroll") for (int i = 0; i < 8; ++i) xf[8 + i] = t8[i]; } \
        float mx = 0.f; _Pragma("unroll") for (int i = 0; i < 16; ++i) mx = fmaxf(mx, fabsf(xf[i])); \
        mx = fmaxf(mx, DPP_F(mx, 0xB1)); mx = fmaxf(mx, DPP_F(mx, 0x4E)); mx = fmaxf(mx, DPP_F(mx, 0x141)); mx = fmaxf(mx, 1e-30f); \
        const float xinv = 127.0f * __builtin_amdgcn_rcpf(mx); i32x4 xq_; \
        _Pragma("unroll") for (int q = 0; q < 4; ++q) { const int q0 = (int)rintf(xf[4 * q] * xinv), q1 = (int)rintf(xf[4 * q + 1] * xinv), q2 = (int)rintf(xf[4 * q + 2] * xinv), q3 = (int)rintf(xf[4 * q + 3] * xinv); \
            xq_[q] = (int)((unsigned)(q0 & 0xff) | ((unsigned)(q1 & 0xff) << 8) | ((unsigned)(q2 & 0xff) << 16) | ((unsigned)q3 << 24)); } \
        *(LAS i32x4*)(d_ + 2048 + 16 * la) = xq_; if ((la & 7) == 0) *(LAS float*)(d_ + 3072 + 4 * (la >> 3)) = mx * (1.0f / 127.0f); } while (0)
    u32x4 f0, f1, x0, x1;
    u32x4 A0, A1, A2, A3, A4, A5, A6, A7, A8, A9, A10, A11, A12, A13, A14, A15;
    u32x4 B0, B1, B2, B3, B4, B5, B6, B7, B8, B9, B10, B11, B12, B13, B14, B15;
    U3_FETCH(0); U3_PARK(0);
    { const LAS unsigned char* ip_ = buf + (0) * 4096 + 0 * 256 + 32 * sl; const u32x4 e0_ = *(const LAS u32x4*)ip_, e1_ = *(const LAS u32x4*)(ip_ + 16);
        A0 = *(const u32x4*)(TAB + ((e0_[0] & 0xffffu) * 128u + pb));
        A1 = *(const u32x4*)(TAB + ((e0_[0] >> 16) * 128u + pb));
        A2 = *(const u32x4*)(TAB + ((e0_[1] & 0xffffu) * 128u + pb));
        A3 = *(const u32x4*)(TAB + ((e0_[1] >> 16) * 128u + pb));
        A4 = *(const u32x4*)(TAB + ((e0_[2] & 0xffffu) * 128u + pb));
        A5 = *(const u32x4*)(TAB + ((e0_[2] >> 16) * 128u + pb));
        A6 = *(const u32x4*)(TAB + ((e0_[3] & 0xffffu) * 128u + pb));
        A7 = *(const u32x4*)(TAB + ((e0_[3] >> 16) * 128u + pb));
        A8 = *(const u32x4*)(TAB + ((e1_[0] & 0xffffu) * 128u + pb));
        A9 = *(const u32x4*)(TAB + ((e1_[0] >> 16) * 128u + pb));
        A10 = *(const u32x4*)(TAB + ((e1_[1] & 0xffffu) * 128u + pb));
        A11 = *(const u32x4*)(TAB + ((e1_[1] >> 16) * 128u + pb));
        A12 = *(const u32x4*)(TAB + ((e1_[2] & 0xffffu) * 128u + pb));
        A13 = *(const u32x4*)(TAB + ((e1_[2] >> 16) * 128u + pb));
        A14 = *(const u32x4*)(TAB + ((e1_[3] & 0xffffu) * 128u + pb));
        A15 = *(const u32x4*)(TAB + ((e1_[3] >> 16) * 128u + pb));
    }
#pragma unroll 1
    for (int b = 0; b < NB; ++b) {
        const int bs = b & 1;
        U3_FETCH((b + 1) & 7);
        { const LAS unsigned char* ip_ = buf + (bs) * 4096 + 1 * 256 + 32 * sl; const u32x4 e0_ = *(const LAS u32x4*)ip_, e1_ = *(const LAS u32x4*)(ip_ + 16);
            B0 = *(const u32x4*)(TAB + ((e0_[0] & 0xffffu) * 128u + pb));
            B1 = *(const u32x4*)(TAB + ((e0_[0] >> 16) * 128u + pb));
            B2 = *(const u32x4*)(TAB + ((e0_[1] & 0xffffu) * 128u + pb));
            B3 = *(const u32x4*)(TAB + ((e0_[1] >> 16) * 128u + pb));
            B4 = *(const u32x4*)(TAB + ((e0_[2] & 0xffffu) * 128u + pb));
            B5 = *(const u32x4*)(TAB + ((e0_[2] >> 16) * 128u + pb));
            B6 = *(const u32x4*)(TAB + ((e0_[3] & 0xffffu) * 128u + pb));
            B7 = *(const u32x4*)(TAB + ((e0_[3] >> 16) * 128u + pb));
            B8 = *(const u32x4*)(TAB + ((e1_[0] & 0xffffu) * 128u + pb));
            B9 = *(const u32x4*)(TAB + ((e1_[0] >> 16) * 128u + pb));
            B10 = *(const u32x4*)(TAB + ((e1_[1] & 0xffffu) * 128u + pb));
            B11 = *(const u32x4*)(TAB + ((e1_[1] >> 16) * 128u + pb));
            B12 = *(const u32x4*)(TAB + ((e1_[2] & 0xffffu) * 128u + pb));
            B13 = *(const u32x4*)(TAB + ((e1_[2] >> 16) * 128u + pb));
            B14 = *(const u32x4*)(TAB + ((e1_[3] & 0xffffu) * 128u + pb));
            B15 = *(const u32x4*)(TAB + ((e1_[3] >> 16) * 128u + pb));
        }
        { const i32x4 xq = *(const LAS i32x4*)(buf + bs * 4096 + 2048 + 0 * 128 + 16 * pc); const float sx = *(const LAS float*)(buf + bs * 4096 + 3072 + 4 * 0);
            int d[16];
            d[0] = __builtin_amdgcn_sdot4((int)A0[3], xq[3], __builtin_amdgcn_sdot4((int)A0[2], xq[2], __builtin_amdgcn_sdot4((int)A0[1], xq[1], __builtin_amdgcn_sdot4((int)A0[0], xq[0], 0, false), false), false), false);
            d[1] = __builtin_amdgcn_sdot4((int)A1[3], xq[3], __builtin_amdgcn_sdot4((int)A1[2], xq[2], __builtin_amdgcn_sdot4((int)A1[1], xq[1], __builtin_amdgcn_sdot4((int)A1[0], xq[0], 0, false), false), false), false);
            d[2] = __builtin_amdgcn_sdot4((int)A2[3], xq[3], __builtin_amdgcn_sdot4((int)A2[2], xq[2], __builtin_amdgcn_sdot4((int)A2[1], xq[1], __builtin_amdgcn_sdot4((int)A2[0], xq[0], 0, false), false), false), false);
            d[3] = __builtin_amdgcn_sdot4((int)A3[3], xq[3], __builtin_amdgcn_sdot4((int)A3[2], xq[2], __builtin_amdgcn_sdot4((int)A3[1], xq[1], __builtin_amdgcn_sdot4((int)A3[0], xq[0], 0, false), false), false), false);
            d[4] = __builtin_amdgcn_sdot4((int)A4[3], xq[3], __builtin_amdgcn_sdot4((int)A4[2], xq[2], __builtin_amdgcn_sdot4((int)A4[1], xq[1], __builtin_amdgcn_sdot4((int)A4[0], xq[0], 0, false), false), false), false);
            d[5] = __builtin_amdgcn_sdot4((int)A5[3], xq[3], __builtin_amdgcn_sdot4((int)A5[2], xq[2], __builtin_amdgcn_sdot4((int)A5[1], xq[1], __builtin_amdgcn_sdot4((int)A5[0], xq[0], 0, false), false), false), false);
            d[6] = __builtin_amdgcn_sdot4((int)A6[3], xq[3], __builtin_amdgcn_sdot4((int)A6[2], xq[2], __builtin_amdgcn_sdot4((int)A6[1], xq[1], __builtin_amdgcn_sdot4((int)A6[0], xq[0], 0, false), false), false), false);
            d[7] = __builtin_amdgcn_sdot4((int)A7[3], xq[3], __builtin_amdgcn_sdot4((int)A7[2], xq[2], __builtin_amdgcn_sdot4((int)A7[1], xq[1], __builtin_amdgcn_sdot4((int)A7[0], xq[0], 0, false), false), false), false);
            d[8] = __builtin_amdgcn_sdot4((int)A8[3], xq[3], __builtin_amdgcn_sdot4((int)A8[2], xq[2], __builtin_amdgcn_sdot4((int)A8[1], xq[1], __builtin_amdgcn_sdot4((int)A8[0], xq[0], 0, false), false), false), false);
            d[9] = __builtin_amdgcn_sdot4((int)A9[3], xq[3], __builtin_amdgcn_sdot4((int)A9[2], xq[2], __builtin_amdgcn_sdot4((int)A9[1], xq[1], __builtin_amdgcn_sdot4((int)A9[0], xq[0], 0, false), false), false), false);
            d[10] = __builtin_amdgcn_sdot4((int)A10[3], xq[3], __builtin_amdgcn_sdot4((int)A10[2], xq[2], __builtin_amdgcn_sdot4((int)A10[1], xq[1], __builtin_amdgcn_sdot4((int)A10[0], xq[0], 0, false), false), false), false);
            d[11] = __builtin_amdgcn_sdot4((int)A11[3], xq[3], __builtin_amdgcn_sdot4((int)A11[2], xq[2], __builtin_amdgcn_sdot4((int)A11[1], xq[1], __builtin_amdgcn_sdot4((int)A11[0], xq[0], 0, false), false), false), false);
            d[12] = __builtin_amdgcn_sdot4((int)A12[3], xq[3], __builtin_amdgcn_sdot4((int)A12[2], xq[2], __builtin_amdgcn_sdot4((int)A12[1], xq[1], __builtin_amdgcn_sdot4((int)A12[0], xq[0], 0, false), false), false), false);
            d[13] = __builtin_amdgcn_sdot4((int)A13[3], xq[3], __builtin_amdgcn_sdot4((int)A13[2], xq[2], __builtin_amdgcn_sdot4((int)A13[1], xq[1], __builtin_amdgcn_sdot4((int)A13[0], xq[0], 0, false), false), false), false);
            d[14] = __builtin_amdgcn_sdot4((int)A14[3], xq[3], __builtin_amdgcn_sdot4((int)A14[2], xq[2], __builtin_amdgcn_sdot4((int)A14[1], xq[1], __builtin_amdgcn_sdot4((int)A14[0], xq[0], 0, false), false), false), false);
            d[15] = __builtin_amdgcn_sdot4((int)A15[3], xq[3], __builtin_amdgcn_sdot4((int)A15[2], xq[2], __builtin_amdgcn_sdot4((int)A15[1], xq[1], __builtin_amdgcn_sdot4((int)A15[0], xq[0], 0, false), false), false), false);
            _Pragma("unroll") for (int st = 0; st < 3; ++st) { const int M = 1 << st, nn = 8 >> st; const int hm = (la & M) ? -1 : 0;
                _Pragma("unroll") for (int i = 0; i < 8; ++i) if (i < nn) { const int keep = (d[nn + i] & hm) | (d[i] & ~hm), send = (d[i] & hm) | (d[nn + i] & ~hm);
                    d[i] = keep + ((st == 0) ? DPP_I(send, 0xB1) : (st == 1) ? DPP_I(send, 0x4E) : __builtin_amdgcn_ds_swizzle(send, (4 << 10) | 0x1f)); } }
            float* pp = (float*)(P.ws + WS_PART) + ((size_t)j * T + (unsigned)(T0 + 8 * b + 0)) * 128;
            *(f32x2*)(pp + (unsigned)(16 * sl + i0)) = (f32x2){(float)d[0] * sx, (float)d[1] * sx}; }
        { const LAS unsigned char* ip_ = buf + (bs) * 4096 + 2 * 256 + 32 * sl; const u32x4 e0_ = *(const LAS u32x4*)ip_, e1_ = *(const LAS u32x4*)(ip_ + 16);
            A0 = *(const u32x4*)(TAB + ((e0_[0] & 0xffffu) * 128u + pb));
            A1 = *(const u32x4*)(TAB + ((e0_[0] >> 16) * 128u + pb));
            A2 = *(const u32x4*)(TAB + ((e0_[1] & 0xffffu) * 128u + pb));
            A3 = *(const u32x4*)(TAB + ((e0_[1] >> 16) * 128u + pb));
            A4 = *(const u32x4*)(TAB + ((e0_[2] & 0xffffu) * 128u + pb));
            A5 = *(const u32x4*)(TAB + ((e0_[2] >> 16) * 128u + pb));
            A6 = *(const u32x4*)(TAB + ((e0_[3] & 0xffffu) * 128u + pb));
            A7 = *(const u32x4*)(TAB + ((e0_[3] >> 16) * 128u + pb));
            A8 = *(const u32x4*)(TAB + ((e1_[0] & 0xffffu) * 128u + pb));
            A9 = *(const u32x4*)(TAB + ((e1_[0] >> 16) * 128u + pb));
            A10 = *(const u32x4*)(TAB + ((e1_[1] & 0xffffu) * 128u + pb));
            A11 = *(const u32x4*)(TAB + ((e1_[1] >> 16) * 128u + pb));
            A12 = *(const u32x4*)(TAB + ((e1_[2] & 0xffffu) * 128u + pb));
            A13 = *(const u32x4*)(TAB + ((e1_[2] >> 16) * 128u + pb));
            A14 = *(const u32x4*)(TAB + ((e1_[3] & 0xffffu) * 128u + pb));
            A15 = *(const u32x4*)(TAB + ((e1_[3] >> 16) * 128u + pb));
        }
        { const i32x4 xq = *(const LAS i32x4*)(buf + bs * 4096 + 2048 + 1 * 128 + 16 * pc); const float sx = *(const LAS float*)(buf + bs * 4096 + 3072 + 4 * 1);
            int d[16];
            d[0] = __builtin_amdgcn_sdot4((int)B0[3], xq[3], __builtin_amdgcn_sdot4((int)B0[2], xq[2], __builtin_amdgcn_sdot4((int)B0[1], xq[1], __builtin_amdgcn_sdot4((int)B0[0], xq[0], 0, false), false), false), false);
            d[1] = __builtin_amdgcn_sdot4((int)B1[3], xq[3], __builtin_amdgcn_sdot4((int)B1[2], xq[2], __builtin_amdgcn_sdot4((int)B1[1], xq[1], __builtin_amdgcn_sdot4((int)B1[0], xq[0], 0, false), false), false), false);
            d[2] = __builtin_amdgcn_sdot4((int)B2[3], xq[3], __builtin_amdgcn_sdot4((int)B2[2], xq[2], __builtin_amdgcn_sdot4((int)B2[1], xq[1], __builtin_amdgcn_sdot4((int)B2[0], xq[0], 0, false), false), false), false);
            d[3] = __builtin_amdgcn_sdot4((int)B3[3], xq[3], __builtin_amdgcn_sdot4((int)B3[2], xq[2], __builtin_amdgcn_sdot4((int)B3[1], xq[1], __builtin_amdgcn_sdot4((int)B3[0], xq[0], 0, false), false), false), false);
            d[4] = __builtin_amdgcn_sdot4((int)B4[3], xq[3], __builtin_amdgcn_sdot4((int)B4[2], xq[2], __builtin_amdgcn_sdot4((int)B4[1], xq[1], __builtin_amdgcn_sdot4((int)B4[0], xq[0], 0, false), false), false), false);
            d[5] = __builtin_amdgcn_sdot4((int)B5[3], xq[3], __builtin_amdgcn_sdot4((int)B5[2], xq[2], __builtin_amdgcn_sdot4((int)B5[1], xq[1], __builtin_amdgcn_sdot4((int)B5[0], xq[0], 0, false), false), false), false);
            d[6] = __builtin_amdgcn_sdot4((int)B6[3], xq[3], __builtin_amdgcn_sdot4((int)B6[2], xq[2], __builtin_amdgcn_sdot4((int)B6[1], xq[1], __builtin_amdgcn_sdot4((int)B6[0], xq[0], 0, false), false), false), false);
            d[7] = __builtin_amdgcn_sdot4((int)B7[3], xq[3], __builtin_amdgcn_sdot4((int)B7[2], xq[2], __builtin_amdgcn_sdot4((int)B7[1], xq[1], __builtin_amdgcn_sdot4((int)B7[0], xq[0], 0, false), false), false), false);
            d[8] = __builtin_amdgcn_sdot4((int)B8[3], xq[3], __builtin_amdgcn_sdot4((int)B8[2], xq[2], __builtin_amdgcn_sdot4((int)B8[1], xq[1], __builtin_amdgcn_sdot4((int)B8[0], xq[0], 0, false), false), false), false);
            d[9] = __builtin_amdgcn_sdot4((int)B9[3], xq[3], __builtin_amdgcn_sdot4((int)B9[2], xq[2], __builtin_amdgcn_sdot4((int)B9[1], xq[1], __builtin_amdgcn_sdot4((int)B9[0], xq[0], 0, false), false), false), false);
            d[10] = __builtin_amdgcn_sdot4((int)B10[3], xq[3], __builtin_amdgcn_sdot4((int)B10[2], xq[2], __builtin_amdgcn_sdot4((int)B10[1], xq[1], __builtin_amdgcn_sdot4((int)B10[0], xq[0], 0, false), false), false), false);
            d[11] = __builtin_amdgcn_sdot4((int)B11[3], xq[3], __builtin_amdgcn_sdot4((int)B11[2], xq[2], __builtin_amdgcn_sdot4((int)B11[1], xq[1], __builtin_amdgcn_sdot4((int)B11[0], xq[0], 0, false), false), false), false);
            d[12] = __builtin_amdgcn_sdot4((int)B12[3], xq[3], __builtin_amdgcn_sdot4((int)B12[2], xq[2], __builtin_amdgcn_sdot4((int)B12[1], xq[1], __builtin_amdgcn_sdot4((int)B12[0], xq[0], 0, false), false), false), false);
            d[13] = __builtin_amdgcn_sdot4((int)B13[3], xq[3], __builtin_amdgcn_sdot4((int)B13[2], xq[2], __builtin_amdgcn_sdot4((int)B13[1], xq[1], __builtin_amdgcn_sdot4((int)B13[0], xq[0], 0, false), false), false), false);
            d[14] = __builtin_amdgcn_sdot4((int)B14[3], xq[3], __builtin_amdgcn_sdot4((int)B14[2], xq[2], __builtin_amdgcn_sdot4((int)B14[1], xq[1], __builtin_amdgcn_sdot4((int)B14[0], xq[0], 0, false), false), false), false);
            d[15] = __builtin_amdgcn_sdot4((int)B15[3], xq[3], __builtin_amdgcn_sdot4((int)B15[2], xq[2], __builtin_amdgcn_sdot4((int)B15[1], xq[1], __builtin_amdgcn_sdot4((int)B15[0], xq[0], 0, false), false), false), false);
            _Pragma("unroll") for (int st = 0; st < 3; ++st) { const int M = 1 << st, nn = 8 >> st; const int hm = (la & M) ? -1 : 0;
                _Pragma("unroll") for (int i = 0; i < 8; ++i) if (i < nn) { const int keep = (d[nn + i] & hm) | (d[i] & ~hm), send = (d[i] & hm) | (d[nn + i] & ~hm);
                    d[i] = keep + ((st == 0) ? DPP_I(send, 0xB1) : (st == 1) ? DPP_I(send, 0x4E) : __builtin_amdgcn_ds_swizzle(send, (4 << 10) | 0x1f)); } }
            float* pp = (float*)(P.ws + WS_PART) + ((size_t)j * T + (unsigned)(T0 + 8 * b + 1)) * 128;
            *(f32x2*)(pp + (unsigned)(16 * sl + i0)) = (f32x2){(float)d[0] * sx, (float)d[1] * sx}; }
        U3_PARK(b + 1);
        { const LAS unsigned char* ip_ = buf + (bs) * 4096 + 3 * 256 + 32 * sl; const u32x4 e0_ = *(const LAS u32x4*)ip_, e1_ = *(const LAS u32x4*)(ip_ + 16);
            B0 = *(const u32x4*)(TAB + ((e0_[0] & 0xffffu) * 128u + pb));
            B1 = *(const u32x4*)(TAB + ((e0_[0] >> 16) * 128u + pb));
            B2 = *(const u32x4*)(TAB + ((e0_[1] & 0xffffu) * 128u + pb));
            B3 = *(const u32x4*)(TAB + ((e0_[1] >> 16) * 128u + pb));
            B4 = *(const u32x4*)(TAB + ((e0_[2] & 0xffffu) * 128u + pb));
            B5 = *(const u32x4*)(TAB + ((e0_[2] >> 16) * 128u + pb));
            B6 = *(const u32x4*)(TAB + ((e0_[3] & 0xffffu) * 128u + pb));
            B7 = *(const u32x4*)(TAB + ((e0_[3] >> 16) * 128u + pb));
            B8 = *(const u32x4*)(TAB + ((e1_[0] & 0xffffu) * 128u + pb));
            B9 = *(const u32x4*)(TAB + ((e1_[0] >> 16) * 128u + pb));
            B10 = *(const u32x4*)(TAB + ((e1_[1] & 0xffffu) * 128u + pb));
            B11 = *(const u32x4*)(TAB + ((e1_[1] >> 16) * 128u + pb));
            B12 = *(const u32x4*)(TAB + ((e1_[2] & 0xffffu) * 128u + pb));
            B13 = *(const u32x4*)(TAB + ((e1_[2] >> 16) * 128u + pb));
            B14 = *(const u32x4*)(TAB + ((e1_[3] & 0xffffu) * 128u + pb));
            B15 = *(const u32x4*)(TAB + ((e1_[3] >> 16) * 128u + pb));
        }
        { const i32x4 xq = *(const LAS i32x4*)(buf + bs * 4096 + 2048 + 2 * 128 + 16 * pc); const float sx = *(const LAS float*)(buf + bs * 4096 + 3072 + 4 * 2);
            int d[16];
            d[0] = __builtin_amdgcn_sdot4((int)A0[3], xq[3], __builtin_amdgcn_sdot4((int)A0[2], xq[2], __builtin_amdgcn_sdot4((int)A0[1], xq[1], __builtin_amdgcn_sdot4((int)A0[0], xq[0], 0, false), false), false), false);
            d[1] = __builtin_amdgcn_sdot4((int)A1[3], xq[3], __builtin_amdgcn_sdot4((int)A1[2], xq[2], __builtin_amdgcn_sdot4((int)A1[1], xq[1], __builtin_amdgcn_sdot4((int)A1[0], xq[0], 0, false), false), false), false);
            d[2] = __builtin_amdgcn_sdot4((int)A2[3], xq[3], __builtin_amdgcn_sdot4((int)A2[2], xq[2], __builtin_amdgcn_sdot4((int)A2[1], xq[1], __builtin_amdgcn_sdot4((int)A2[0], xq[0], 0, false), false), false), false);
            d[3] = __builtin_amdgcn_sdot4((int)A3[3], xq[3], __builtin_amdgcn_sdot4((int)A3[2], xq[2], __builtin_amdgcn_sdot4((int)A3[1], xq[1], __builtin_amdgcn_sdot4((int)A3[0], xq[0], 0, false), false), false), false);
            d[4] = __builtin_amdgcn_sdot4((int)A4[3], xq[3], __builtin_amdgcn_sdot4((int)A4[2], xq[2], __builtin_amdgcn_sdot4((int)A4[1], xq[1], __builtin_amdgcn_sdot4((int)A4[0], xq[0], 0, false), false), false), false);
            d[5] = __builtin_amdgcn_sdot4((int)A5[3], xq[3], __builtin_amdgcn_sdot4((int)A5[2], xq[2], __builtin_amdgcn_sdot4((int)A5[1], xq[1], __builtin_amdgcn_sdot4((int)A5[0], xq[0], 0, false), false), false), false);
            d[6] = __builtin_amdgcn_sdot4((int)A6[3], xq[3], __builtin_amdgcn_sdot4((int)A6[2], xq[2], __builtin_amdgcn_sdot4((int)A6[1], xq[1], __builtin_amdgcn_sdot4((int)A6[0], xq[0], 0, false), false), false), false);
            d[7] = __builtin_amdgcn_sdot4((int)A7[3], xq[3], __builtin_amdgcn_sdot4((int)A7[2], xq[2], __builtin_amdgcn_sdot4((int)A7[1], xq[1], __builtin_amdgcn_sdot4((int)A7[0], xq[0], 0, false), false), false), false);
            d[8] = __builtin_amdgcn_sdot4((int)A8[3], xq[3], __builtin_amdgcn_sdot4((int)A8[2], xq[2], __builtin_amdgcn_sdot4((int)A8[1], xq[1], __builtin_amdgcn_sdot4((int)A8[0], xq[0], 0, false), false), false), false);
            d[9] = __builtin_amdgcn_sdot4((int)A9[3], xq[3], __builtin_amdgcn_sdot4((int)A9[2], xq[2], __builtin_amdgcn_sdot4((int)A9[1], xq[1], __builtin_amdgcn_sdot4((int)A9[0], xq[0], 0, false), false), false), false);
            d[10] = __builtin_amdgcn_sdot4((int)A10[3], xq[3], __builtin_amdgcn_sdot4((int)A10[2], xq[2], __builtin_amdgcn_sdot4((int)A10[1], xq[1], __builtin_amdgcn_sdot4((int)A10[0], xq[0], 0, false), false), false), false);
            d[11] = __builtin_amdgcn_sdot4((int)A11[3], xq[3], __builtin_amdgcn_sdot4((int)A11[2], xq[2], __builtin_amdgcn_sdot4((int)A11[1], xq[1], __builtin_amdgcn_sdot4((int)A11[0], xq[0], 0, false), false), false), false);
            d[12] = __builtin_amdgcn_sdot4((int)A12[3], xq[3], __builtin_amdgcn_sdot4((int)A12[2], xq[2], __builtin_amdgcn_sdot4((int)A12[1], xq[1], __builtin_amdgcn_sdot4((int)A12[0], xq[0], 0, false), false), false), false);
            d[13] = __builtin_amdgcn_sdot4((int)A13[3], xq[3], __builtin_amdgcn_sdot4((int)A13[2], xq[2], __builtin_amdgcn_sdot4((int)A13[1], xq[1], __builtin_amdgcn_sdot4((int)A13[0], xq[0], 0, false), false), false), false);
            d[14] = __builtin_amdgcn_sdot4((int)A14[3], xq[3], __builtin_amdgcn_sdot4((int)A14[2], xq[2], __builtin_amdgcn_sdot4((int)A14[1], xq[1], __builtin_amdgcn_sdot4((int)A14[0], xq[0], 0, false), false), false), false);
            d[15] = __builtin_amdgcn_sdot4((int)A15[3], xq[3], __builtin_amdgcn_sdot4((int)A15[2], xq[2], __builtin_amdgcn_sdot4((int)A15[1], xq[1], __builtin_amdgcn_sdot4((int)A15[0], xq[0], 0, false), false), false), false);
            _Pragma("unroll") for (int st = 0; st < 3; ++st) { const int M = 1 << st, nn = 8 >> st; const int hm = (la & M) ? -1 : 0;
                _Pragma("unroll") for (int i = 0; i < 8; ++i) if (i < nn) { const int keep = (d[nn + i] & hm) | (d[i] & ~hm), send = (d[i] & hm) | (d[nn + i] & ~hm);
                    d[i] = keep + ((st == 0) ? DPP_I(send, 0xB1) : (st == 1) ? DPP_I(send, 0x4E) : __builtin_amdgcn_ds_swizzle(send, (4 << 10) | 0x1f)); } }
            float* pp = (float*)(P.ws + WS_PART) + ((size_t)j * T + (unsigned)(T0 + 8 * b + 2)) * 128;
            *(f32x2*)(pp + (unsigned)(16 * sl + i0)) = (f32x2){(float)d[0] * sx, (float)d[1] * sx}; }
        { const LAS unsigned char* ip_ = buf + (bs) * 4096 + 4 * 256 + 32 * sl; const u32x4 e0_ = *(const LAS u32x4*)ip_, e1_ = *(const LAS u32x4*)(ip_ + 16);
            A0 = *(const u32x4*)(TAB + ((e0_[0] & 0xffffu) * 128u + pb));
            A1 = *(const u32x4*)(TAB + ((e0_[0] >> 16) * 128u + pb));
            A2 = *(const u32x4*)(TAB + ((e0_[1] & 0xffffu) * 128u + pb));
            A3 = *(const u32x4*)(TAB + ((e0_[1] >> 16) * 128u + pb));
            A4 = *(const u32x4*)(TAB + ((e0_[2] & 0xffffu) * 128u + pb));
            A5 = *(const u32x4*)(TAB + ((e0_[2] >> 16) * 128u + pb));
            A6 = *(const u32x4*)(TAB + ((e0_[3] & 0xffffu) * 128u + pb));
            A7 = *(const u32x4*)(TAB + ((e0_[3] >> 16) * 128u + pb));
            A8 = *(const u32x4*)(TAB + ((e1_[0] & 0xffffu) * 128u + pb));
            A9 = *(const u32x4*)(TAB + ((e1_[0] >> 16) * 128u + pb));
            A10 = *(const u32x4*)(TAB + ((e1_[1] & 0xffffu) * 128u + pb));
            A11 = *(const u32x4*)(TAB + ((e1_[1] >> 16) * 128u + pb));
            A12 = *(const u32x4*)(TAB + ((e1_[2] & 0xffffu) * 128u + pb));
            A13 = *(const u32x4*)(TAB + ((e1_[2] >> 16) * 128u + pb));
            A14 = *(const u32x4*)(TAB + ((e1_[3] & 0xffffu) * 128u + pb));
            A15 = *(const u32x4*)(TAB + ((e1_[3] >> 16) * 128u + pb));
        }
        { const i32x4 xq = *(const LAS i32x4*)(buf + bs * 4096 + 2048 + 3 * 128 + 16 * pc); const float sx = *(const LAS float*)(buf + bs * 4096 + 3072 + 4 * 3);
            int d[16];
            d[0] = __builtin_amdgcn_sdot4((int)B0[3], xq[3], __builtin_amdgcn_sdot4((int)B0[2], xq[2], __builtin_amdgcn_sdot4((int)B0[1], xq[1], __builtin_amdgcn_sdot4((int)B0[0], xq[0], 0, false), false), false), false);
            d[1] = __builtin_amdgcn_sdot4((int)B1[3], xq[3], __builtin_amdgcn_sdot4((int)B1[2], xq[2], __builtin_amdgcn_sdot4((int)B1[1], xq[1], __builtin_amdgcn_sdot4((int)B1[0], xq[0], 0, false), false), false), false);
            d[2] = __builtin_amdgcn_sdot4((int)B2[3], xq[3], __builtin_amdgcn_sdot4((int)B2[2], xq[2], __builtin_amdgcn_sdot4((int)B2[1], xq[1], __builtin_amdgcn_sdot4((int)B2[0], xq[0], 0, false), false), false), false);
            d[3] = __builtin_amdgcn_sdot4((int)B3[3], xq[3], __builtin_amdgcn_sdot4((int)B3[2], xq[2], __builtin_amdgcn_sdot4((int)B3[1], xq[1], __builtin_amdgcn_sdot4((int)B3[0], xq[0], 0, false), false), false), false);
            d[4] = __builtin_amdgcn_sdot4((int)B4[3], xq[3], __builtin_amdgcn_sdot4((int)B4[2], xq[2], __builtin_amdgcn_sdot4((int)B4[1], xq[1], __builtin_amdgcn_sdot4((int)B4[0], xq[0], 0, false), false), false), false);
            d[5] = __builtin_amdgcn_sdot4((int)B5[3], xq[3], __builtin_amdgcn_sdot4((int)B5[2], xq[2], __builtin_amdgcn_sdot4((int)B5[1], xq[1], __builtin_amdgcn_sdot4((int)B5[0], xq[0], 0, false), false), false), false);
            d[6] = __builtin_amdgcn_sdot4((int)B6[3], xq[3], __builtin_amdgcn_sdot4((int)B6[2], xq[2], __builtin_amdgcn_sdot4((int)B6[1], xq[1], __builtin_amdgcn_sdot4((int)B6[0], xq[0], 0, false), false), false), false);
            d[7] = __builtin_amdgcn_sdot4((int)B7[3], xq[3], __builtin_amdgcn_sdot4((int)B7[2], xq[2], __builtin_amdgcn_sdot4((int)B7[1], xq[1], __builtin_amdgcn_sdot4((int)B7[0], xq[0], 0, false), false), false), false);
            d[8] = __builtin_amdgcn_sdot4((int)B8[3], xq[3], __builtin_amdgcn_sdot4((int)B8[2], xq[2], __builtin_amdgcn_sdot4((int)B8[1], xq[1], __builtin_amdgcn_sdot4((int)B8[0], xq[0], 0, false), false), false), false);
            d[9] = __builtin_amdgcn_sdot4((int)B9[3], xq[3], __builtin_amdgcn_sdot4((int)B9[2], xq[2], __builtin_amdgcn_sdot4((int)B9[1], xq[1], __builtin_amdgcn_sdot4((int)B9[0], xq[0], 0, false), false), false), false);
            d[10] = __builtin_amdgcn_sdot4((int)B10[3], xq[3], __builtin_amdgcn_sdot4((int)B10[2], xq[2], __builtin_amdgcn_sdot4((int)B10[1], xq[1], __builtin_amdgcn_sdot4((int)B10[0], xq[0], 0, false), false), false), false);
            d[11] = __builtin_amdgcn_sdot4((int)B11[3], xq[3], __builtin_amdgcn_sdot4((int)B11[2], xq[2], __builtin_amdgcn_sdot4((int)B11[1], xq[1], __builtin_amdgcn_sdot4((int)B11[0], xq[0], 0, false), false), false), false);
            d[12] = __builtin_amdgcn_sdot4((int)B12[3], xq[3], __builtin_amdgcn_sdot4((int)B12[2], xq[2], __builtin_amdgcn_sdot4((int)B12[1], xq[1], __builtin_amdgcn_sdot4((int)B12[0], xq[0], 0, false), false), false), false);
            d[13] = __builtin_amdgcn_sdot4((int)B13[3], xq[3], __builtin_amdgcn_sdot4((int)B13[2], xq[2], __builtin_amdgcn_sdot4((int)B13[1], xq[1], __builtin_amdgcn_sdot4((int)B13[0], xq[0], 0, false), false), false), false);
            d[14] = __builtin_amdgcn_sdot4((int)B14[3], xq[3], __builtin_amdgcn_sdot4((int)B14[2], xq[2], __builtin_amdgcn_sdot4((int)B14[1], xq[1], __builtin_amdgcn_sdot4((int)B14[0], xq[0], 0, false), false), false), false);
            d[15] = __builtin_amdgcn_sdot4((int)B15[3], xq[3], __builtin_amdgcn_sdot4((int)B15[2], xq[2], __builtin_amdgcn_sdot4((int)B15[1], xq[1], __builtin_amdgcn_sdot4((int)B15[0], xq[0], 0, false), false), false), false);
            _Pragma("unroll") for (int st = 0; st < 3; ++st) { const int M = 1 << st, nn = 8 >> st; const int hm = (la & M) ? -1 : 0;
                _Pragma("unroll") for (int i = 0; i < 8; ++i) if (i < nn) { const int keep = (d[nn + i] & hm) | (d[i] & ~hm), send = (d[i] & hm) | (d[nn + i] & ~hm);
                    d[i] = keep + ((st == 0) ? DPP_I(send, 0xB1) : (st == 1) ? DPP_I(send, 0x4E) : __builtin_amdgcn_ds_swizzle(send, (4 << 10) | 0x1f)); } }
            float* pp = (float*)(P.ws + WS_PART) + ((size_t)j * T + (unsigned)(T0 + 8 * b + 3)) * 128;
            *(f32x2*)(pp + (unsigned)(16 * sl + i0)) = (f32x2){(float)d[0] * sx, (float)d[1] * sx}; }
        { const LAS unsigned char* ip_ = buf + (bs) * 4096 + 5 * 256 + 32 * sl; const u32x4 e0_ = *(const LAS u32x4*)ip_, e1_ = *(const LAS u32x4*)(ip_ + 16);
            B0 = *(const u32x4*)(TAB + ((e0_[0] & 0xffffu) * 128u + pb));
            B1 = *(const u32x4*)(TAB + ((e0_[0] >> 16) * 128u + pb));
            B2 = *(const u32x4*)(TAB + ((e0_[1] & 0xffffu) * 128u + pb));
            B3 = *(const u32x4*)(TAB + ((e0_[1] >> 16) * 128u + pb));
            B4 = *(const u32x4*)(TAB + ((e0_[2] & 0xffffu) * 128u + pb));
            B5 = *(const u32x4*)(TAB + ((e0_[2] >> 16) * 128u + pb));
            B6 = *(const u32x4*)(TAB + ((e0_[3] & 0xffffu) * 128u + pb));
            B7 = *(const u32x4*)(TAB + ((e0_[3] >> 16) * 128u + pb));
            B8 = *(const u32x4*)(TAB + ((e1_[0] & 0xffffu) * 128u + pb));
            B9 = *(const u32x4*)(TAB + ((e1_[0] >> 16) * 128u + pb));
            B10 = *(const u32x4*)(TAB + ((e1_[1] & 0xffffu) * 128u + pb));
            B11 = *(const u32x4*)(TAB + ((e1_[1] >> 16) * 128u + pb));
            B12 = *(const u32x4*)(TAB + ((e1_[2] & 0xffffu) * 128u + pb));
            B13 = *(const u32x4*)(TAB + ((e1_[2] >> 16) * 128u + pb));
            B14 = *(const u32x4*)(TAB + ((e1_[3] & 0xffffu) * 128u + pb));
            B15 = *(const u32x4*)(TAB + ((e1_[3] >> 16) * 128u + pb));
        }
        { const i32x4 xq = *(const LAS i32x4*)(buf + bs * 4096 + 2048 + 4 * 128 + 16 * pc); const float sx = *(const LAS float*)(buf + bs * 4096 + 3072 + 4 * 4);
            int d[16];
            d[0] = __builtin_amdgcn_sdot4((int)A0[3], xq[3], __builtin_amdgcn_sdot4((int)A0[2], xq[2], __builtin_amdgcn_sdot4((int)A0[1], xq[1], __builtin_amdgcn_sdot4((int)A0[0], xq[0], 0, false), false), false), false);
            d[1] = __builtin_amdgcn_sdot4((int)A1[3], xq[3], __builtin_amdgcn_sdot4((int)A1[2], xq[2], __builtin_amdgcn_sdot4((int)A1[1], xq[1], __builtin_amdgcn_sdot4((int)A1[0], xq[0], 0, false), false), false), false);
            d[2] = __builtin_amdgcn_sdot4((int)A2[3], xq[3], __builtin_amdgcn_sdot4((int)A2[2], xq[2], __builtin_amdgcn_sdot4((int)A2[1], xq[1], __builtin_amdgcn_sdot4((int)A2[0], xq[0], 0, false), false), false), false);
            d[3] = __builtin_amdgcn_sdot4((int)A3[3], xq[3], __builtin_amdgcn_sdot4((int)A3[2], xq[2], __builtin_amdgcn_sdot4((int)A3[1], xq[1], __builtin_amdgcn_sdot4((int)A3[0], xq[0], 0, false), false), false), false);
            d[4] = __builtin_amdgcn_sdot4((int)A4[3], xq[3], __builtin_amdgcn_sdot4((int)A4[2], xq[2], __builtin_amdgcn_sdot4((int)A4[1], xq[1], __builtin_amdgcn_sdot4((int)A4[0], xq[0], 0, false), false), false), false);
            d[5] = __builtin_amdgcn_sdot4((int)A5[3], xq[3], __builtin_amdgcn_sdot4((int)A5[2], xq[2], __builtin_amdgcn_sdot4((int)A5[1], xq[1], __builtin_amdgcn_sdot4((int)A5[0], xq[0], 0, false), false), false), false);
            d[6] = __builtin_amdgcn_sdot4((int)A6[3], xq[3], __builtin_amdgcn_sdot4((int)A6[2], xq[2], __builtin_amdgcn_sdot4((int)A6[1], xq[1], __builtin_amdgcn_sdot4((int)A6[0], xq[0], 0, false), false), false), false);
            d[7] = __builtin_amdgcn_sdot4((int)A7[3], xq[3], __builtin_amdgcn_sdot4((int)A7[2], xq[2], __builtin_amdgcn_sdot4((int)A7[1], xq[1], __builtin_amdgcn_sdot4((int)A7[0], xq[0], 0, false), false), false), false);
            d[8] = __builtin_amdgcn_sdot4((int)A8[3], xq[3], __builtin_amdgcn_sdot4((int)A8[2], xq[2], __builtin_amdgcn_sdot4((int)A8[1], xq[1], __builtin_amdgcn_sdot4((int)A8[0], xq[0], 0, false), false), false), false);
            d[9] = __builtin_amdgcn_sdot4((int)A9[3], xq[3], __builtin_amdgcn_sdot4((int)A9[2], xq[2], __builtin_amdgcn_sdot4((int)A9[1], xq[1], __builtin_amdgcn_sdot4((int)A9[0], xq[0], 0, false), false), false), false);
            d[10] = __builtin_amdgcn_sdot4((int)A10[3], xq[3], __builtin_amdgcn_sdot4((int)A10[2], xq[2], __builtin_amdgcn_sdot4((int)A10[1], xq[1], __builtin_amdgcn_sdot4((int)A10[0], xq[0], 0, false), false), false), false);
            d[11] = __builtin_amdgcn_sdot4((int)A11[3], xq[3], __builtin_amdgcn_sdot4((int)A11[2], xq[2], __builtin_amdgcn_sdot4((int)A11[1], xq[1], __builtin_amdgcn_sdot4((int)A11[0], xq[0], 0, false), false), false), false);
            d[12] = __builtin_amdgcn_sdot4((int)A12[3], xq[3], __builtin_amdgcn_sdot4((int)A12[2], xq[2], __builtin_amdgcn_sdot4((int)A12[1], xq[1], __builtin_amdgcn_sdot4((int)A12[0], xq[0], 0, false), false), false), false);
            d[13] = __builtin_amdgcn_sdot4((int)A13[3], xq[3], __builtin_amdgcn_sdot4((int)A13[2], xq[2], __builtin_amdgcn_sdot4((int)A13[1], xq[1], __builtin_amdgcn_sdot4((int)A13[0], xq[0], 0, false), false), false), false);
            d[14] = __builtin_amdgcn_sdot4((int)A14[3], xq[3], __builtin_amdgcn_sdot4((int)A14[2], xq[2], __builtin_amdgcn_sdot4((int)A14[1], xq[1], __builtin_amdgcn_sdot4((int)A14[0], xq[0], 0, false), false), false), false);
            d[15] = __builtin_amdgcn_sdot4((int)A15[3], xq[3], __builtin_amdgcn_sdot4((int)A15[2], xq[2], __builtin_amdgcn_sdot4((int)A15[1], xq[1], __builtin_amdgcn_sdot4((int)A15[0], xq[0], 0, false), false), false), false);
            _Pragma("unroll") for (int st = 0; st < 3; ++st) { const int M = 1 << st, nn = 8 >> st; const int hm = (la & M) ? -1 : 0;
                _Pragma("unroll") for (int i = 0; i < 8; ++i) if (i < nn) { const int keep = (d[nn + i] & hm) | (d[i] & ~hm), send = (d[i] & hm) | (d[nn + i] & ~hm);
                    d[i] = keep + ((st == 0) ? DPP_I(send, 0xB1) : (st == 1) ? DPP_I(send, 0x4E) : __builtin_amdgcn_ds_swizzle(send, (4 << 10) | 0x1f)); } }
            float* pp = (float*)(P.ws + WS_PART) + ((size_t)j * T + (unsigned)(T0 + 8 * b + 4)) * 128;
            *(f32x2*)(pp + (unsigned)(16 * sl + i0)) = (f32x2){(float)d[0] * sx, (float)d[1] * sx}; }
        { const LAS unsigned char* ip_ = buf + (bs) * 4096 + 6 * 256 + 32 * sl; const u32x4 e0_ = *(const LAS u32x4*)ip_, e1_ = *(const LAS u32x4*)(ip_ + 16);
            A0 = *(const u32x4*)(TAB + ((e0_[0] & 0xffffu) * 128u + pb));
            A1 = *(const u32x4*)(TAB + ((e0_[0] >> 16) * 128u + pb));
            A2 = *(const u32x4*)(TAB + ((e0_[1] & 0xffffu) * 128u + pb));
            A3 = *(const u32x4*)(TAB + ((e0_[1] >> 16) * 128u + pb));
            A4 = *(const u32x4*)(TAB + ((e0_[2] & 0xffffu) * 128u + pb));
            A5 = *(const u32x4*)(TAB + ((e0_[2] >> 16) * 128u + pb));
            A6 = *(const u32x4*)(TAB + ((e0_[3] & 0xffffu) * 128u + pb));
            A7 = *(const u32x4*)(TAB + ((e0_[3] >> 16) * 128u + pb));
            A8 = *(const u32x4*)(TAB + ((e1_[0] & 0xffffu) * 128u + pb));
            A9 = *(const u32x4*)(TAB + ((e1_[0] >> 16) * 128u + pb));
            A10 = *(const u32x4*)(TAB + ((e1_[1] & 0xffffu) * 128u + pb));
            A11 = *(const u32x4*)(TAB + ((e1_[1] >> 16) * 128u + pb));
            A12 = *(const u32x4*)(TAB + ((e1_[2] & 0xffffu) * 128u + pb));
            A13 = *(const u32x4*)(TAB + ((e1_[2] >> 16) * 128u + pb));
            A14 = *(const u32x4*)(TAB + ((e1_[3] & 0xffffu) * 128u + pb));
            A15 = *(const u32x4*)(TAB + ((e1_[3] >> 16) * 128u + pb));
        }
        { const i32x4 xq = *(const LAS i32x4*)(buf + bs * 4096 + 2048 + 5 * 128 + 16 * pc); const float sx = *(const LAS float*)(buf + bs * 4096 + 3072 + 4 * 5);
            int d[16];
            d[0] = __builtin_amdgcn_sdot4((int)B0[3], xq[3], __builtin_amdgcn_sdot4((int)B0[2], xq[2], __builtin_amdgcn_sdot4((int)B0[1], xq[1], __builtin_amdgcn_sdot4((int)B0[0], xq[0], 0, false), false), false), false);
            d[1] = __builtin_amdgcn_sdot4((int)B1[3], xq[3], __builtin_amdgcn_sdot4((int)B1[2], xq[2], __builtin_amdgcn_sdot4((int)B1[1], xq[1], __builtin_amdgcn_sdot4((int)B1[0], xq[0], 0, false), false), false), false);
            d[2] = __builtin_amdgcn_sdot4((int)B2[3], xq[3], __builtin_amdgcn_sdot4((int)B2[2], xq[2], __builtin_amdgcn_sdot4((int)B2[1], xq[1], __builtin_amdgcn_sdot4((int)B2[0], xq[0], 0, false), false), false), false);
            d[3] = __builtin_amdgcn_sdot4((int)B3[3], xq[3], __builtin_amdgcn_sdot4((int)B3[2], xq[2], __builtin_amdgcn_sdot4((int)B3[1], xq[1], __builtin_amdgcn_sdot4((int)B3[0], xq[0], 0, false), false), false), false);
            d[4] = __builtin_amdgcn_sdot4((int)B4[3], xq[3], __builtin_amdgcn_sdot4((int)B4[2], xq[2], __builtin_amdgcn_sdot4((int)B4[1], xq[1], __builtin_amdgcn_sdot4((int)B4[0], xq[0], 0, false), false), false), false);
            d[5] = __builtin_amdgcn_sdot4((int)B5[3], xq[3], __builtin_amdgcn_sdot4((int)B5[2], xq[2], __builtin_amdgcn_sdot4((int)B5[1], xq[1], __builtin_amdgcn_sdot4((int)B5[0], xq[0], 0, false), false), false), false);
            d[6] = __builtin_amdgcn_sdot4((int)B6[3], xq[3], __builtin_amdgcn_sdot4((int)B6[2], xq[2], __builtin_amdgcn_sdot4((int)B6[1], xq[1], __builtin_amdgcn_sdot4((int)B6[0], xq[0], 0, false), false), false), false);
            d[7] = __builtin_amdgcn_sdot4((int)B7[3], xq[3], __builtin_amdgcn_sdot4((int)B7[2], xq[2], __builtin_amdgcn_sdot4((int)B7[1], xq[1], __builtin_amdgcn_sdot4((int)B7[0], xq[0], 0, false), false), false), false);
            d[8] = __builtin_amdgcn_sdot4((int)B8[3], xq[3], __builtin_amdgcn_sdot4((int)B8[2], xq[2], __builtin_amdgcn_sdot4((int)B8[1], xq[1], __builtin_amdgcn_sdot4((int)B8[0], xq[0], 0, false), false), false), false);
            d[9] = __builtin_amdgcn_sdot4((int)B9[3], xq[3], __builtin_amdgcn_sdot4((int)B9[2], xq[2], __builtin_amdgcn_sdot4((int)B9[1], xq[1], __builtin_amdgcn_sdot4((int)B9[0], xq[0], 0, false), false), false), false);
            d[10] = __builtin_amdgcn_sdot4((int)B10[3], xq[3], __builtin_amdgcn_sdot4((int)B10[2], xq[2], __builtin_amdgcn_sdot4((int)B10[1], xq[1], __builtin_amdgcn_sdot4((int)B10[0], xq[0], 0, false), false), false), false);
            d[11] = __builtin_amdgcn_sdot4((int)B11[3], xq[3], __builtin_amdgcn_sdot4((int)B11[2], xq[2], __builtin_amdgcn_sdot4((int)B11[1], xq[1], __builtin_amdgcn_sdot4((int)B11[0], xq[0], 0, false), false), false), false);
            d[12] = __builtin_amdgcn_sdot4((int)B12[3], xq[3], __builtin_amdgcn_sdot4((int)B12[2], xq[2], __builtin_amdgcn_sdot4((int)B12[1], xq[1], __builtin_amdgcn_sdot4((int)B12[0], xq[0], 0, false), false), false), false);
            d[13] = __builtin_amdgcn_sdot4((int)B13[3], xq[3], __builtin_amdgcn_sdot4((int)B13[2], xq[2], __builtin_amdgcn_sdot4((int)B13[1], xq[1], __builtin_amdgcn_sdot4((int)B13[0], xq[0], 0, false), false), false), false);
            d[14] = __builtin_amdgcn_sdot4((int)B14[3], xq[3], __builtin_amdgcn_sdot4((int)B14[2], xq[2], __builtin_amdgcn_sdot4((int)B14[1], xq[1], __builtin_amdgcn_sdot4((int)B14[0], xq[0], 0, false), false), false), false);
            d[15] = __builtin_amdgcn_sdot4((int)B15[3], xq[3], __builtin_amdgcn_sdot4((int)B15[2], xq[2], __builtin_amdgcn_sdot4((int)B15[1], xq[1], __builtin_amdgcn_sdot4((int)B15[0], xq[0], 0, false), false), false), false);
            _Pragma("unroll") for (int st = 0; st < 3; ++st) { const int M = 1 << st, nn = 8 >> st; const int hm = (la & M) ? -1 : 0;
                _Pragma("unroll") for (int i = 0; i < 8; ++i) if (i < nn) { const int keep = (d[nn + i] & hm) | (d[i] & ~hm), send = (d[i] & hm) | (d[nn + i] & ~hm);
                    d[i] = keep + ((st == 0) ? DPP_I(send, 0xB1) : (st == 1) ? DPP_I(send, 0x4E) : __builtin_amdgcn_ds_swizzle(send, (4 << 10) | 0x1f)); } }
            float* pp = (float*)(P.ws + WS_PART) + ((size_t)j * T + (unsigned)(T0 + 8 * b + 5)) * 128;
            *(f32x2*)(pp + (unsigned)(16 * sl + i0)) = (f32x2){(float)d[0] * sx, (float)d[1] * sx}; }
        { const LAS unsigned char* ip_ = buf + (bs) * 4096 + 7 * 256 + 32 * sl; const u32x4 e0_ = *(const LAS u32x4*)ip_, e1_ = *(const LAS u32x4*)(ip_ + 16);
            B0 = *(const u32x4*)(TAB + ((e0_[0] & 0xffffu) * 128u + pb));
            B1 = *(const u32x4*)(TAB + ((e0_[0] >> 16) * 128u + pb));
            B2 = *(const u32x4*)(TAB + ((e0_[1] & 0xffffu) * 128u + pb));
            B3 = *(const u32x4*)(TAB + ((e0_[1] >> 16) * 128u + pb));
            B4 = *(const u32x4*)(TAB + ((e0_[2] & 0xffffu) * 128u + pb));
            B5 = *(const u32x4*)(TAB + ((e0_[2] >> 16) * 128u + pb));
            B6 = *(const u32x4*)(TAB + ((e0_[3] & 0xffffu) * 128u + pb));
            B7 = *(const u32x4*)(TAB + ((e0_[3] >> 16) * 128u + pb));
            B8 = *(const u32x4*)(TAB + ((e1_[0] & 0xffffu) * 128u + pb));
            B9 = *(const u32x4*)(TAB + ((e1_[0] >> 16) * 128u + pb));
            B10 = *(const u32x4*)(TAB + ((e1_[1] & 0xffffu) * 128u + pb));
            B11 = *(const u32x4*)(TAB + ((e1_[1] >> 16) * 128u + pb));
            B12 = *(const u32x4*)(TAB + ((e1_[2] & 0xffffu) * 128u + pb));
            B13 = *(const u32x4*)(TAB + ((e1_[2] >> 16) * 128u + pb));
            B14 = *(const u32x4*)(TAB + ((e1_[3] & 0xffffu) * 128u + pb));
            B15 = *(const u32x4*)(TAB + ((e1_[3] >> 16) * 128u + pb));
        }
        { const i32x4 xq = *(const LAS i32x4*)(buf + bs * 4096 + 2048 + 6 * 128 + 16 * pc); const float sx = *(const LAS float*)(buf + bs * 4096 + 3072 + 4 * 6);
            int d[16];
            d[0] = __builtin_amdgcn_sdot4((int)A0[3], xq[3], __builtin_amdgcn_sdot4((int)A0[2], xq[2], __builtin_amdgcn_sdot4((int)A0[1], xq[1], __builtin_amdgcn_sdot4((int)A0[0], xq[0], 0, false), false), false), false);
            d[1] = __builtin_amdgcn_sdot4((int)A1[3], xq[3], __builtin_amdgcn_sdot4((int)A1[2], xq[2], __builtin_amdgcn_sdot4((int)A1[1], xq[1], __builtin_amdgcn_sdot4((int)A1[0], xq[0], 0, false), false), false), false);
            d[2] = __builtin_amdgcn_sdot4((int)A2[3], xq[3], __builtin_amdgcn_sdot4((int)A2[2], xq[2], __builtin_amdgcn_sdot4((int)A2[1], xq[1], __builtin_amdgcn_sdot4((int)A2[0], xq[0], 0, false), false), false), false);
            d[3] = __builtin_amdgcn_sdot4((int)A3[3], xq[3], __builtin_amdgcn_sdot4((int)A3[2], xq[2], __builtin_amdgcn_sdot4((int)A3[1], xq[1], __builtin_amdgcn_sdot4((int)A3[0], xq[0], 0, false), false), false), false);
            d[4] = __builtin_amdgcn_sdot4((int)A4[3], xq[3], __builtin_amdgcn_sdot4((int)A4[2], xq[2], __builtin_amdgcn_sdot4((int)A4[1], xq[1], __builtin_amdgcn_sdot4((int)A4[0], xq[0], 0, false), false), false), false);
            d[5] = __builtin_amdgcn_sdot4((int)A5[3], xq[3], __builtin_amdgcn_sdot4((int)A5[2], xq[2], __builtin_amdgcn_sdot4((int)A5[1], xq[1], __builtin_amdgcn_sdot4((int)A5[0], xq[0], 0, false), false), false), false);
            d[6] = __builtin_amdgcn_sdot4((int)A6[3], xq[3], __builtin_amdgcn_sdot4((int)A6[2], xq[2], __builtin_amdgcn_sdot4((int)A6[1], xq[1], __builtin_amdgcn_sdot4((int)A6[0], xq[0], 0, false), false), false), false);
            d[7] = __builtin_amdgcn_sdot4((int)A7[3], xq[3], __builtin_amdgcn_sdot4((int)A7[2], xq[2], __builtin_amdgcn_sdot4((int)A7[1], xq[1], __builtin_amdgcn_sdot4((int)A7[0], xq[0], 0, false), false), false), false);
            d[8] = __builtin_amdgcn_sdot4((int)A8[3], xq[3], __builtin_amdgcn_sdot4((int)A8[2], xq[2], __builtin_amdgcn_sdot4((int)A8[1], xq[1], __builtin_amdgcn_sdot4((int)A8[0], xq[0], 0, false), false), false), false);
            d[9] = __builtin_amdgcn_sdot4((int)A9[3], xq[3], __builtin_amdgcn_sdot4((int)A9[2], xq[2], __builtin_amdgcn_sdot4((int)A9[1], xq[1], __builtin_amdgcn_sdot4((int)A9[0], xq[0], 0, false), false), false), false);
            d[10] = __builtin_amdgcn_sdot4((int)A10[3], xq[3], __builtin_amdgcn_sdot4((int)A10[2], xq[2], __builtin_amdgcn_sdot4((int)A10[1], xq[1], __builtin_amdgcn_sdot4((int)A10[0], xq[0], 0, false), false), false), false);
            d[11] = __builtin_amdgcn_sdot4((int)A11[3], xq[3], __builtin_amdgcn_sdot4((int)A11[2], xq[2], __builtin_amdgcn_sdot4((int)A11[1], xq[1], __builtin_amdgcn_sdot4((int)A11[0], xq[0], 0, false), false), false), false);
            d[12] = __builtin_amdgcn_sdot4((int)A12[3], xq[3], __builtin_amdgcn_sdot4((int)A12[2], xq[2], __builtin_amdgcn_sdot4((int)A12[1], xq[1], __builtin_amdgcn_sdot4((int)A12[0], xq[0], 0, false), false), false), false);
            d[13] = __builtin_amdgcn_sdot4((int)A13[3], xq[3], __builtin_amdgcn_sdot4((int)A13[2], xq[2], __builtin_amdgcn_sdot4((int)A13[1], xq[1], __builtin_amdgcn_sdot4((int)A13[0], xq[0], 0, false), false), false), false);
            d[14] = __builtin_amdgcn_sdot4((int)A14[3], xq[3], __builtin_amdgcn_sdot4((int)A14[2], xq[2], __builtin_amdgcn_sdot4((int)A14[1], xq[1], __builtin_amdgcn_sdot4((int)A14[0], xq[0], 0, false), false), false), false);
            d[15] = __builtin_amdgcn_sdot4((int)A15[3], xq[3], __builtin_amdgcn_sdot4((int)A15[2], xq[2], __builtin_amdgcn_sdot4((int)A15[1], xq[1], __builtin_amdgcn_sdot4((int)A15[0], xq[0], 0, false), false), false), false);
            _Pragma("unroll") for (int st = 0; st < 3; ++st) { const int M = 1 << st, nn = 8 >> st; const int hm = (la & M) ? -1 : 0;
                _Pragma("unroll") for (int i = 0; i < 8; ++i) if (i < nn) { const int keep = (d[nn + i] & hm) | (d[i] & ~hm), send = (d[i] & hm) | (d[nn + i] & ~hm);
                    d[i] = keep + ((st == 0) ? DPP_I(send, 0xB1) : (st == 1) ? DPP_I(send, 0x4E) : __builtin_amdgcn_ds_swizzle(send, (4 << 10) | 0x1f)); } }
            float* pp = (float*)(P.ws + WS_PART) + ((size_t)j * T + (unsigned)(T0 + 8 * b + 6)) * 128;
            *(f32x2*)(pp + (unsigned)(16 * sl + i0)) = (f32x2){(float)d[0] * sx, (float)d[1] * sx}; }
        { const LAS unsigned char* ip_ = buf + (bs ^ 1) * 4096 + 0 * 256 + 32 * sl; const u32x4 e0_ = *(const LAS u32x4*)ip_, e1_ = *(const LAS u32x4*)(ip_ + 16);
            A0 = *(const u32x4*)(TAB + ((e0_[0] & 0xffffu) * 128u + pb));
            A1 = *(const u32x4*)(TAB + ((e0_[0] >> 16) * 128u + pb));
            A2 = *(const u32x4*)(TAB + ((e0_[1] & 0xffffu) * 128u + pb));
            A3 = *(const u32x4*)(TAB + ((e0_[1] >> 16) * 128u + pb));
            A4 = *(const u32x4*)(TAB + ((e0_[2] & 0xffffu) * 128u + pb));
            A5 = *(const u32x4*)(TAB + ((e0_[2] >> 16) * 128u + pb));
            A6 = *(const u32x4*)(TAB + ((e0_[3] & 0xffffu) * 128u + pb));
            A7 = *(const u32x4*)(TAB + ((e0_[3] >> 16) * 128u + pb));
            A8 = *(const u32x4*)(TAB + ((e1_[0] & 0xffffu) * 128u + pb));
            A9 = *(const u32x4*)(TAB + ((e1_[0] >> 16) * 128u + pb));
            A10 = *(const u32x4*)(TAB + ((e1_[1] & 0xffffu) * 128u + pb));
            A11 = *(const u32x4*)(TAB + ((e1_[1] >> 16) * 128u + pb));
            A12 = *(const u32x4*)(TAB + ((e1_[2] & 0xffffu) * 128u + pb));
            A13 = *(const u32x4*)(TAB + ((e1_[2] >> 16) * 128u + pb));
            A14 = *(const u32x4*)(TAB + ((e1_[3] & 0xffffu) * 128u + pb));
            A15 = *(const u32x4*)(TAB + ((e1_[3] >> 16) * 128u + pb));
        }
        { const i32x4 xq = *(const LAS i32x4*)(buf + bs * 4096 + 2048 + 7 * 128 + 16 * pc); const float sx = *(const LAS float*)(buf + bs * 4096 + 3072 + 4 * 7);
            int d[16];
            d[0] = __builtin_amdgcn_sdot4((int)B0[3], xq[3], __builtin_amdgcn_sdot4((int)B0[2], xq[2], __builtin_amdgcn_sdot4((int)B0[1], xq[1], __builtin_amdgcn_sdot4((int)B0[0], xq[0], 0, false), false), false), false);
            d[1] = __builtin_amdgcn_sdot4((int)B1[3], xq[3], __builtin_amdgcn_sdot4((int)B1[2], xq[2], __builtin_amdgcn_sdot4((int)B1[1], xq[1], __builtin_amdgcn_sdot4((int)B1[0], xq[0], 0, false), false), false), false);
            d[2] = __builtin_amdgcn_sdot4((int)B2[3], xq[3], __builtin_amdgcn_sdot4((int)B2[2], xq[2], __builtin_amdgcn_sdot4((int)B2[1], xq[1], __builtin_amdgcn_sdot4((int)B2[0], xq[0], 0, false), false), false), false);
            d[3] = __builtin_amdgcn_sdot4((int)B3[3], xq[3], __builtin_amdgcn_sdot4((int)B3[2], xq[2], __builtin_amdgcn_sdot4((int)B3[1], xq[1], __builtin_amdgcn_sdot4((int)B3[0], xq[0], 0, false), false), false), false);
            d[4] = __builtin_amdgcn_sdot4((int)B4[3], xq[3], __builtin_amdgcn_sdot4((int)B4[2], xq[2], __builtin_amdgcn_sdot4((int)B4[1], xq[1], __builtin_amdgcn_sdot4((int)B4[0], xq[0], 0, false), false), false), false);
            d[5] = __builtin_amdgcn_sdot4((int)B5[3], xq[3], __builtin_amdgcn_sdot4((int)B5[2], xq[2], __builtin_amdgcn_sdot4((int)B5[1], xq[1], __builtin_amdgcn_sdot4((int)B5[0], xq[0], 0, false), false), false), false);
            d[6] = __builtin_amdgcn_sdot4((int)B6[3], xq[3], __builtin_amdgcn_sdot4((int)B6[2], xq[2], __builtin_amdgcn_sdot4((int)B6[1], xq[1], __builtin_amdgcn_sdot4((int)B6[0], xq[0], 0, false), false), false), false);
            d[7] = __builtin_amdgcn_sdot4((int)B7[3], xq[3], __builtin_amdgcn_sdot4((int)B7[2], xq[2], __builtin_amdgcn_sdot4((int)B7[1], xq[1], __builtin_amdgcn_sdot4((int)B7[0], xq[0], 0, false), false), false), false);
            d[8] = __builtin_amdgcn_sdot4((int)B8[3], xq[3], __builtin_amdgcn_sdot4((int)B8[2], xq[2], __builtin_amdgcn_sdot4((int)B8[1], xq[1], __builtin_amdgcn_sdot4((int)B8[0], xq[0], 0, false), false), false), false);
            d[9] = __builtin_amdgcn_sdot4((int)B9[3], xq[3], __builtin_amdgcn_sdot4((int)B9[2], xq[2], __builtin_amdgcn_sdot4((int)B9[1], xq[1], __builtin_amdgcn_sdot4((int)B9[0], xq[0], 0, false), false), false), false);
            d[10] = __builtin_amdgcn_sdot4((int)B10[3], xq[3], __builtin_amdgcn_sdot4((int)B10[2], xq[2], __builtin_amdgcn_sdot4((int)B10[1], xq[1], __builtin_amdgcn_sdot4((int)B10[0], xq[0], 0, false), false), false), false);
            d[11] = __builtin_amdgcn_sdot4((int)B11[3], xq[3], __builtin_amdgcn_sdot4((int)B11[2], xq[2], __builtin_amdgcn_sdot4((int)B11[1], xq[1], __builtin_amdgcn_sdot4((int)B11[0], xq[0], 0, false), false), false), false);
            d[12] = __builtin_amdgcn_sdot4((int)B12[3], xq[3], __builtin_amdgcn_sdot4((int)B12[2], xq[2], __builtin_amdgcn_sdot4((int)B12[1], xq[1], __builtin_amdgcn_sdot4((int)B12[0], xq[0], 0, false), false), false), false);
            d[13] = __builtin_amdgcn_sdot4((int)B13[3], xq[3], __builtin_amdgcn_sdot4((int)B13[2], xq[2], __builtin_amdgcn_sdot4((int)B13[1], xq[1], __builtin_amdgcn_sdot4((int)B13[0], xq[0], 0, false), false), false), false);
            d[14] = __builtin_amdgcn_sdot4((int)B14[3], xq[3], __builtin_amdgcn_sdot4((int)B14[2], xq[2], __builtin_amdgcn_sdot4((int)B14[1], xq[1], __builtin_amdgcn_sdot4((int)B14[0], xq[0], 0, false), false), false), false);
            d[15] = __builtin_amdgcn_sdot4((int)B15[3], xq[3], __builtin_amdgcn_sdot4((int)B15[2], xq[2], __builtin_amdgcn_sdot4((int)B15[1], xq[1], __builtin_amdgcn_sdot4((int)B15[0], xq[0], 0, false), false), false), false);
            _Pragma("unroll") for (int st = 0; st < 3; ++st) { const int M = 1 << st, nn = 8 >> st; const int hm = (la & M) ? -1 : 0;
                _Pragma("unroll") for (int i = 0; i < 8; ++i) if (i < nn) { const int keep = (d[nn + i] & hm) | (d[i] & ~hm), send = (d[i] & hm) | (d[nn + i] & ~hm);
                    d[i] = keep + ((st == 0) ? DPP_I(send, 0xB1) : (st == 1) ? DPP_I(send, 0x4E) : __builtin_amdgcn_ds_swizzle(send, (4 << 10) | 0x1f)); } }
            float* pp = (float*)(P.ws + WS_PART) + ((size_t)j * T + (unsigned)(T0 + 8 * b + 7)) * 128;
            *(f32x2*)(pp + (unsigned)(16 * sl + i0)) = (f32x2){(float)d[0] * sx, (float)d[1] * sx}; }
    }
#undef U3_FETCH
#undef U3_PARK
}
__device__ __forceinline__ void p6_combine(const Ptrs& P, int gtid, int nthreads) {
    const unsigned char* ws = P.ws;
    for (int i = gtid; i < T * 128 / 4; i += nthreads) {
        const int t = i >> 5;
        f32x4 a = *(const f32x4*)((const float*)(ws + WS_PART) + (size_t)i * 4);
#pragma unroll
        for (int j = 1; j < 8; ++j) a += *(const f32x4*)((const float*)(ws + WS_PART) + ((size_t)j * T * 128) + (size_t)i * 4);
        const float r2u = ((const float*)(ws + WS_R2))[t];
        const f32x4 g = *(const f32x4*)((const float*)(ws + WS_GW) + (size_t)i * 4);
        const u32x2 e2 = *(const u32x2*)((const unsigned short*)(ws + WS_IDX16) + (size_t)i * 4); const int4 ei = make_int4((int)(e2.x & 0xffffu), (int)(e2.x >> 16), (int)(e2.y & 0xffffu), (int)(e2.y >> 16));
        const float* sus = (const float*)(ws + WS_SUS); const float* svs = (const float*)(ws + WS_SVS);
        f32x4 w; w.x = svs[ei.x] * g.x * gelu_tanh(r2u * sus[ei.x] * a.x); w.y = svs[ei.y] * g.y * gelu_tanh(r2u * sus[ei.y] * a.y); w.z = svs[ei.z] * g.z * gelu_tanh(r2u * sus[ei.z] * a.z); w.w = svs[ei.w] * g.w * gelu_tanh(r2u * sus[ei.w] * a.w);
        float mx = fmaxf(fmaxf(fabsf(w.x), fabsf(w.y)), fmaxf(fabsf(w.z), fabsf(w.w)));
        mx = fmaxf(mx, DPP_F(mx, 0xB1)); mx = fmaxf(mx, DPP_F(mx, 0x4E)); mx = fmaxf(mx, DPP_F(mx, 0x141)); mx = fmaxf(mx, DPP_F(mx, 0x140)); mx = fmaxf(mx, xor_lane<16>(mx));
        mx = fmaxf(mx, 1e-30f);
        const float inv = 127.0f * __builtin_amdgcn_rcpf(mx);
        const int m = i & 31;
        ((unsigned*)(P.ws + WS_W))[i] = (unsigned)((int)rintf(w.x * inv) & 0xff) | ((unsigned)((int)rintf(w.y * inv) & 0xff) << 8) | ((unsigned)((int)rintf(w.z * inv) & 0xff) << 16) | ((unsigned)(int)rintf(w.w * inv) << 24);
        if (m == 0) ((float*)(P.ws + WS_R1))[t] = mx * (1.0f / 127.0f);
    }
}

typedef float f32x16 __attribute__((ext_vector_type(16)));
#define MFMA32(a, b, c) __builtin_amdgcn_mfma_f32_32x32x16_bf16((a), (b), (c), 0, 0, 0)
__device__ __forceinline__ int crow(int reg, int h) { return (reg & 3) + 8 * (reg >> 2) + 4 * h; }
__device__ __forceinline__ unsigned pkbf(float lo, float hi) { const bf16x2_t v = {(__bf16)lo, (__bf16)hi}; return __builtin_bit_cast(unsigned, v); }

constexpr int KL_STRIDE = 72, VT_STRIDE = 196;
constexpr int KL_OFF = 0, VT_OFF = 192 * KL_STRIDE * 2, BIASL_OFF = VT_OFF + 64 * VT_STRIDE * 2;
__device__ __forceinline__ void attn_item(const Ptrs& P, LAS unsigned char* lds, int item, int tid, int lane, int wave) {
    const unsigned char* ws = P.ws;
    const bf16* proj = (const bf16*)(ws + WS_PROJ);
    const int kvh = item & 1, qb = (item >> 1) & 31, b = item >> 6;
    const int tb = b * SEQ, p0 = qb * 64;
    LAS bf16* KL = (LAS bf16*)(lds + KL_OFF); LAS bf16* VT = (LAS bf16*)(lds + VT_OFF); LAS float* BIASL = (LAS float*)(lds + BIASL_OFF);
#pragma unroll
    for (int i = 0; i < 3; ++i) {
        const int p = tid + 512 * i, key = p >> 3, ch = p & 7, kpos = p0 - 128 + key;
        u32x4 kw = (u32x4){0u, 0u, 0u, 0u}, vw = (u32x4){0u, 0u, 0u, 0u};
        if (kpos >= 0) { const bf16* src = proj + (size_t)(tb + kpos) * NIN + kvh * HD + 8 * ch; kw = *(const u32x4*)(src + C_K); vw = *(const u32x4*)(src + C_V); }
        float kf[8]; unpack8(kw, kf);
        float ss = 0.f;
#pragma unroll
        for (int j = 0; j < 8; ++j) ss += kf[j] * kf[j];
        ss += DPP_F(ss, 0xB1); ss += DPP_F(ss, 0x4E); ss += DPP_F(ss, 0x141);
        const float rinv = __builtin_amdgcn_rsqf(ss * (1.0f / HD) + EPS);
        const f32x4 g0 = *(const f32x4*)(P.k_norm_g + 8 * ch), g1 = *(const f32x4*)(P.k_norm_g + 8 * ch + 4);
        u32x4 o; o.x = pkbf(kf[0] * rinv * g0.x, kf[1] * rinv * g0.y); o.y = pkbf(kf[2] * rinv * g0.z, kf[3] * rinv * g0.w);
        o.z = pkbf(kf[4] * rinv * g1.x, kf[5] * rinv * g1.y); o.w = pkbf(kf[6] * rinv * g1.z, kf[7] * rinv * g1.w);
        *(LAS u32x4*)(KL + key * KL_STRIDE + 8 * ch) = o;
#pragma unroll
        for (int j = 0; j < 4; ++j) { VT[(8 * ch + 2 * j) * VT_STRIDE + key] = (bf16)(vw[j] & 0xffffu); VT[(8 * ch + 2 * j + 1) * VT_STRIDE + key] = (bf16)(vw[j] >> 16); }
    }
    for (int e = tid; e < 4 * 192; e += 512) { const int gg = e / 192, rel = e % 192 - 32;
        BIASL[e] = (rel >= 0 && rel < WIN) ? ((const float*)(ws + WS_BL))[(kvh * 4 + gg) * WIN + rel] : -1.0e30f; }
    __syncthreads();
    const int g = wave >> 1, a = wave & 1, head = kvh * 4 + g, q = lane & 31, hh = lane >> 5;
    const int tq = tb + p0 + 32 * a + q;
    bf16x8 Bq[4];
    {
        float qf[4][8]; float ss = 0.f;
#pragma unroll
        for (int s = 0; s < 4; ++s) { const u32x4 w = *(const u32x4*)(proj + (size_t)tq * NIN + C_Q + head * HD + 16 * s + 8 * hh); unpack8(w, qf[s]);
#pragma unroll
            for (int j = 0; j < 8; ++j) ss += qf[s][j] * qf[s][j]; }
        ss += __shfl_xor(ss, 32);
        const float rinv = 0.125f * __builtin_amdgcn_rsqf(ss * (1.0f / HD) + EPS);
#pragma unroll
        for (int s = 0; s < 4; ++s) { const f32x4 g0 = *(const f32x4*)(P.q_norm_g + 16 * s + 8 * hh), g1 = *(const f32x4*)(P.q_norm_g + 16 * s + 8 * hh + 4);
            u32x4 o; o.x = pkbf(qf[s][0] * rinv * g0.x, qf[s][1] * rinv * g0.y); o.y = pkbf(qf[s][2] * rinv * g0.z, qf[s][3] * rinv * g0.w);
            o.z = pkbf(qf[s][4] * rinv * g1.x, qf[s][5] * rinv * g1.y); o.w = pkbf(qf[s][6] * rinv * g1.z, qf[s][7] * rinv * g1.w);
            Bq[s] = __builtin_bit_cast(bf16x8, o); }
    }
    f32x16 sc[5];
#pragma unroll
    for (int c = 0; c < 5; ++c) {
#pragma unroll
        for (int r = 0; r < 16; ++r) sc[c][r] = 0.f;
#pragma unroll
        for (int s = 0; s < 4; ++s) { const bf16x8 A = *(const LAS bf16x8*)(KL + (32 * (a + c) + q) * KL_STRIDE + 16 * s + 8 * hh); sc[c] = MFMA32(A, Bq[s], sc[c]); }
    }
    const float sink = P.sinks[head];
    float m = sink;
    const LAS float* bias_base = BIASL + g * 192 + q + 160 - 4 * hh;
    const int kneg = p0 - 128 + 32 * a + 4 * hh;
#pragma unroll
    for (int c = 0; c < 5; ++c)
#pragma unroll
        for (int r = 0; r < 16; ++r) { const int kw0 = 32 * c + (r & 3) + 8 * (r >> 2);
            const float bv = bias_base[-kw0];
            float v = sc[c][r] + bv; v = (kneg + kw0 >= 0) ? v : -1.0e30f; sc[c][r] = v; m = fmaxf(m, v); }
    m = fmaxf(m, __shfl_xor(m, 32));
    float l = 0.f;
#pragma unroll
    for (int c = 0; c < 5; ++c)
#pragma unroll
        for (int r = 0; r < 16; ++r) { const float p = __expf(sc[c][r] - m); sc[c][r] = p; l += p; }
    l += __shfl_xor(l, 32);
    const float inv = 1.0f / (l + __expf(sink - m));
    f32x16 oacc[2];
#pragma unroll
    for (int dt = 0; dt < 2; ++dt)
#pragma unroll
        for (int r = 0; r < 16; ++r) oacc[dt][r] = 0.f;
#pragma unroll
    for (int c = 0; c < 5; ++c)
#pragma unroll
        for (int s2 = 0; s2 < 2; ++s2) {
            u32x4 pw; pw.x = pkbf(sc[c][8 * s2 + 0], sc[c][8 * s2 + 1]); pw.y = pkbf(sc[c][8 * s2 + 2], sc[c][8 * s2 + 3]); pw.z = pkbf(sc[c][8 * s2 + 4], sc[c][8 * s2 + 5]); pw.w = pkbf(sc[c][8 * s2 + 6], sc[c][8 * s2 + 7]);
            const bf16x8 Pb = __builtin_bit_cast(bf16x8, pw);
            const int kb = 32 * (a + c) + 16 * s2 + 4 * hh;
#pragma unroll
            for (int dt = 0; dt < 2; ++dt) { const LAS bf16* vr = VT + (32 * dt + q) * VT_STRIDE + kb;
                const u32x2 lo = *(const LAS u32x2*)vr, hi = *(const LAS u32x2*)(vr + 8);
                const bf16x8 Av = __builtin_bit_cast(bf16x8, (u32x4){lo.x, lo.y, hi.x, hi.y});
                oacc[dt] = MFMA32(Av, Pb, oacc[dt]); }
        }
    float ss = 0.f;
    bf16* orow = (bf16*)(ws + WS_MIX) + (size_t)tq * D + LRU_W + head * HD + 4 * hh;
#pragma unroll
    for (int dt = 0; dt < 2; ++dt)
#pragma unroll
        for (int r4 = 0; r4 < 4; ++r4) { const float o0 = oacc[dt][4 * r4] * inv, o1 = oacc[dt][4 * r4 + 1] * inv, o2 = oacc[dt][4 * r4 + 2] * inv, o3 = oacc[dt][4 * r4 + 3] * inv;
            ss += (o0 * o0 + o1 * o1) + (o2 * o2 + o3 * o3);
            u32x2 w; w.x = pkbf(o0, o1); w.y = pkbf(o2, o3); *(u32x2*)(orow + 32 * dt + 8 * r4) = w; }
    ss += __shfl_xor(ss, 32);
    if (hh == 0) ((float*)(ws + WS_SSQA))[(size_t)tq * 8 + head] = ss;
    __syncthreads();
}

__device__ __forceinline__ void bar4(volatile LAS unsigned* cnt, unsigned& target, int lane) {
    asm volatile("s_waitcnt vmcnt(0) lgkmcnt(0)" ::: "memory");
    target += 4u;
    if (lane == 0) (void)__hip_atomic_fetch_add((LAS unsigned*)cnt, 1u, __ATOMIC_RELAXED, __HIP_MEMORY_SCOPE_WORKGROUP);
    while (*cnt < target) __builtin_amdgcn_s_sleep(1);
    asm volatile("" ::: "memory");
}
__device__ __forceinline__ void attn_item4(const Ptrs& P, LAS unsigned char* lds, int item, int tid, int lane, int wave, volatile LAS unsigned* bcnt, unsigned& btgt) {
    const unsigned char* ws = P.ws;
    const bf16* proj = (const bf16*)(ws + WS_PROJ);
    const int kvh = item & 1, qb = (item >> 1) & 31, b = item >> 6;
    const int tb = b * SEQ, p0 = qb * 64;
    LAS bf16* KL = (LAS bf16*)(lds + KL_OFF); LAS bf16* VT = (LAS bf16*)(lds + VT_OFF); LAS float* BIASL = (LAS float*)(lds + BIASL_OFF);
#pragma unroll
    for (int i = 0; i < 6; ++i) {
        const int p = tid + 256 * i, key = p >> 3, ch = p & 7, kpos = p0 - 128 + key;
        u32x4 kw = (u32x4){0u, 0u, 0u, 0u}, vw = (u32x4){0u, 0u, 0u, 0u};
        if (kpos >= 0) { const bf16* src = proj + (size_t)(tb + kpos) * NIN + kvh * HD + 8 * ch; kw = *(const u32x4*)(src + C_K); vw = *(const u32x4*)(src + C_V); }
        float kf[8]; unpack8(kw, kf);
        float ss = 0.f;
#pragma unroll
        for (int j = 0; j < 8; ++j) ss += kf[j] * kf[j];
        ss += DPP_F(ss, 0xB1); ss += DPP_F(ss, 0x4E); ss += DPP_F(ss, 0x141);
        const float rinv = __builtin_amdgcn_rsqf(ss * (1.0f / HD) + EPS);
        const f32x4 g0 = *(const f32x4*)(P.k_norm_g + 8 * ch), g1 = *(const f32x4*)(P.k_norm_g + 8 * ch + 4);
        u32x4 o; o.x = pkbf(kf[0] * rinv * g0.x, kf[1] * rinv * g0.y); o.y = pkbf(kf[2] * rinv * g0.z, kf[3] * rinv * g0.w);
        o.z = pkbf(kf[4] * rinv * g1.x, kf[5] * rinv * g1.y); o.w = pkbf(kf[6] * rinv * g1.z, kf[7] * rinv * g1.w);
        *(LAS u32x4*)(KL + key * KL_STRIDE + 8 * ch) = o;
#pragma unroll
        for (int j = 0; j < 4; ++j) { VT[(8 * ch + 2 * j) * VT_STRIDE + key] = (bf16)(vw[j] & 0xffffu); VT[(8 * ch + 2 * j + 1) * VT_STRIDE + key] = (bf16)(vw[j] >> 16); }
    }
    for (int e = tid; e < 4 * 192; e += 256) { const int gg = e / 192, rel = e % 192 - 32;
        BIASL[e] = (rel >= 0 && rel < WIN) ? ((const float*)(ws + WS_BL))[(kvh * 4 + gg) * WIN + rel] : -1.0e30f; }
    bar4(bcnt, btgt, lane);
#pragma unroll 1
    for (int a = 0; a < 2; ++a) {
    const int g = wave, head = kvh * 4 + g, q = lane & 31, hh = lane >> 5;
    const int tq = tb + p0 + 32 * a + q;
    bf16x8 Bq[4];
    {
        float qf[4][8]; float ss = 0.f;
#pragma unroll
        for (int s = 0; s < 4; ++s) { const u32x4 w = *(const u32x4*)(proj + (size_t)tq * NIN + C_Q + head * HD + 16 * s + 8 * hh); unpack8(w, qf[s]);
#pragma unroll
            for (int j = 0; j < 8; ++j) ss += qf[s][j] * qf[s][j]; }
        ss += __shfl_xor(ss, 32);
        const float rinv = 0.125f * __builtin_amdgcn_rsqf(ss * (1.0f / HD) + EPS);
#pragma unroll
        for (int s = 0; s < 4; ++s) { const f32x4 g0 = *(const f32x4*)(P.q_norm_g + 16 * s + 8 * hh), g1 = *(const f32x4*)(P.q_norm_g + 16 * s + 8 * hh + 4);
            u32x4 o; o.x = pkbf(qf[s][0] * rinv * g0.x, qf[s][1] * rinv * g0.y); o.y = pkbf(qf[s][2] * rinv * g0.z, qf[s][3] * rinv * g0.w);
            o.z = pkbf(qf[s][4] * rinv * g1.x, qf[s][5] * rinv * g1.y); o.w = pkbf(qf[s][6] * rinv * g1.z, qf[s][7] * rinv * g1.w);
            Bq[s] = __builtin_bit_cast(bf16x8, o); }
    }
    f32x16 sc[5];
#pragma unroll
    for (int c = 0; c < 5; ++c) {
#pragma unroll
        for (int r = 0; r < 16; ++r) sc[c][r] = 0.f;
#pragma unroll
        for (int s = 0; s < 4; ++s) { const bf16x8 A = *(const LAS bf16x8*)(KL + (32 * (a + c) + q) * KL_STRIDE + 16 * s + 8 * hh); sc[c] = MFMA32(A, Bq[s], sc[c]); }
    }
    const float sink = P.sinks[head];
    float m = sink;
    const LAS float* bias_base = BIASL + g * 192 + q + 160 - 4 * hh;
    const int kneg = p0 - 128 + 32 * a + 4 * hh;
#pragma unroll
    for (int c = 0; c < 5; ++c)
#pragma unroll
        for (int r = 0; r < 16; ++r) { const int kw0 = 32 * c + (r & 3) + 8 * (r >> 2);
            const float bv = bias_base[-kw0];
            float v = sc[c][r] + bv; v = (kneg + kw0 >= 0) ? v : -1.0e30f; sc[c][r] = v; m = fmaxf(m, v); }
    m = fmaxf(m, __shfl_xor(m, 32));
    float l = 0.f;
#pragma unroll
    for (int c = 0; c < 5; ++c)
#pragma unroll
        for (int r = 0; r < 16; ++r) { const float p = __expf(sc[c][r] - m); sc[c][r] = p; l += p; }
    l += __shfl_xor(l, 32);
    const float inv = 1.0f / (l + __expf(sink - m));
    f32x16 oacc[2];
#pragma unroll
    for (int dt = 0; dt < 2; ++dt)
#pragma unroll
        for (int r = 0; r < 16; ++r) oacc[dt][r] = 0.f;
#pragma unroll
    for (int c = 0; c < 5; ++c)
#pragma unroll
        for (int s2 = 0; s2 < 2; ++s2) {
            u32x4 pw; pw.x = pkbf(sc[c][8 * s2 + 0], sc[c][8 * s2 + 1]); pw.y = pkbf(sc[c][8 * s2 + 2], sc[c][8 * s2 + 3]); pw.z = pkbf(sc[c][8 * s2 + 4], sc[c][8 * s2 + 5]); pw.w = pkbf(sc[c][8 * s2 + 6], sc[c][8 * s2 + 7]);
            const bf16x8 Pb = __builtin_bit_cast(bf16x8, pw);
            const int kb = 32 * (a + c) + 16 * s2 + 4 * hh;
#pragma unroll
            for (int dt = 0; dt < 2; ++dt) { const LAS bf16* vr = VT + (32 * dt + q) * VT_STRIDE + kb;
                const u32x2 lo = *(const LAS u32x2*)vr, hi = *(const LAS u32x2*)(vr + 8);
                const bf16x8 Av = __builtin_bit_cast(bf16x8, (u32x4){lo.x, lo.y, hi.x, hi.y});
                oacc[dt] = MFMA32(Av, Pb, oacc[dt]); }
        }
    float ss = 0.f;
    bf16* orow = (bf16*)(ws + WS_MIX) + (size_t)tq * D + LRU_W + head * HD + 4 * hh;
#pragma unroll
    for (int dt = 0; dt < 2; ++dt)
#pragma unroll
        for (int r4 = 0; r4 < 4; ++r4) { const float o0 = oacc[dt][4 * r4] * inv, o1 = oacc[dt][4 * r4 + 1] * inv, o2 = oacc[dt][4 * r4 + 2] * inv, o3 = oacc[dt][4 * r4 + 3] * inv;
            ss += (o0 * o0 + o1 * o1) + (o2 * o2 + o3 * o3);
            u32x2 w; w.x = pkbf(o0, o1); w.y = pkbf(o2, o3); *(u32x2*)(orow + 32 * dt + 8 * r4) = w; }
    ss += __shfl_xor(ss, 32);
    if (hh == 0) ((float*)(ws + WS_SSQA))[(size_t)tq * 8 + head] = ss;
    }
    bar4(bcnt, btgt, lane);
}

constexpr int LR_XB = 0, LR_XCF = 17408, LR_XCB = 33792, LR_LA = 43008, LR_LB = 59392, LR_XG = 75776, LR_GB = 92160, LR_TOT = 108544, LR_H0 = 112640, LR_CW = 113152, LR_PAR = 114432, LR_ASEG = 115200  ;
constexpr int XCB_STRIDE = 72;
constexpr size_t WS_AGG = 14 * MiB + 512 * 1024;
constexpr size_t WS_HLAC = 80 * MiB;
template <int MODE> __device__ __forceinline__ void lru_seg(const Ptrs& P, LAS unsigned char* lds, int item, int tid, int lane, int wave) {
    unsigned char* ws = P.ws;
    const bf16* proj = (const bf16*)(ws + WS_PROJ);
    const int n = item & 7, seg = (item >> 3) & 7, b = item >> 6, tb = b * SEQ, s0 = seg * 256;
    LAS float* XB = (LAS float*)(lds + LR_XB); LAS float* XCF = (LAS float*)(lds + LR_XCF); LAS bf16* XCB = (LAS bf16*)(lds + LR_XCB);
    LAS float* LA = (LAS float*)(lds + LR_LA); LAS float* LB = (LAS float*)(lds + LR_LB); LAS float* XG = (LAS float*)(lds + LR_XG); LAS float* GBL = (LAS float*)(lds + LR_GB);
    LAS float* TOT = (LAS float*)(lds + LR_TOT); LAS float* H0 = (LAS float*)(lds + LR_H0); LAS float* CW = (LAS float*)(lds + LR_CW); LAS float* PAR = (LAS float*)(lds + LR_PAR); LAS float* ASEG = (LAS float*)(lds + LR_ASEG);
    float* agg = (float*)(ws + WS_AGG) + (size_t)((b * NBLK + n) * 8) * 128;
    if (tid < 64) { const int c = n * BLK + tid;
#pragma unroll
        for (int k = 0; k < 4; ++k) CW[k * 64 + tid] = P.conv_w[k * LRU_W + c];
        CW[4 * 64 + tid] = P.conv_b[c];
        PAR[tid] = P.b_gate_a[c]; PAR[64 + tid] = P.b_gate_x[c]; PAR[128 + tid] = log1pf(expf(-P.lru_L[c]));
        float h = 0.f;
        if (MODE) for (int sp = 0; sp < seg; ++sp) h = agg[sp * 128 + tid] * h + agg[sp * 128 + 64 + tid];
        H0[tid] = h; ASEG[tid] = 1.f; ASEG[64 + tid] = 1.f; }
    const int gsel = wave >> 2, tm = (wave >> 1) & 1, tn = wave & 1, jl = lane & 31, hh = lane >> 5;
    bf16x8 Bg[4];
#pragma unroll
    for (int s = 0; s < 4; ++s) Bg[s] = *(const bf16x8*)((const bf16*)(ws + WS_WGT) + ((size_t)(gsel * NBLK + n) * BLK + 32 * tn + jl) * BLK + 16 * s + 8 * hh);
    const int prow = tid >> 3, pch = tid & 7;
    u32x4 pxa, pxb = (u32x4){0u, 0u, 0u, 0u}, pg = (u32x4){0u, 0u, 0u, 0u};
#define LRU_PREFETCH(t0_) do { const int sp_ = (t0_) - 3 + prow; pxa = (u32x4){0u, 0u, 0u, 0u}; \
        if (sp_ >= 0) pxa = *(const u32x4*)(proj + (size_t)(tb + sp_) * NIN + C_XB + n * BLK + 8 * pch); \
        if (tid < 24) pxb = *(const u32x4*)(proj + (size_t)(tb + (t0_) - 3 + 64 + prow) * NIN + C_XB + n * BLK + 8 * pch); \
        if (MODE) pg = *(const u32x4*)(proj + (size_t)(tb + (t0_) + prow) * NIN + C_GB + n * BLK + 8 * pch); } while (0)
    LRU_PREFETCH(s0);
    __syncthreads();
    const int jc = 32 * tn + jl;
    const float gbias = PAR[gsel * 64 + jc], sp8 = -8.0f * PAR[128 + jc];
#pragma unroll 1
    for (int ck = 0; ck < 4; ++ck) {
        const int t0 = s0 + ck * 64, par = ck & 1;
        { float f[8]; unpack8(pxa, f);
            *(LAS f32x4*)(XB + prow * 64 + 8 * pch) = (f32x4){f[0], f[1], f[2], f[3]}; *(LAS f32x4*)(XB + prow * 64 + 8 * pch + 4) = (f32x4){f[4], f[5], f[6], f[7]};
            if (tid < 24) { unpack8(pxb, f); *(LAS f32x4*)(XB + (64 + prow) * 64 + 8 * pch) = (f32x4){f[0], f[1], f[2], f[3]}; *(LAS f32x4*)(XB + (64 + prow) * 64 + 8 * pch + 4) = (f32x4){f[4], f[5], f[6], f[7]}; }
            if (MODE) { unpack8(pg, f);
#pragma unroll
                for (int q = 0; q < 8; ++q) f[q] = gelu_tanh(f[q]);
                *(LAS f32x4*)(GBL + prow * 64 + 8 * pch) = (f32x4){f[0], f[1], f[2], f[3]}; *(LAS f32x4*)(GBL + prow * 64 + 8 * pch + 4) = (f32x4){f[4], f[5], f[6], f[7]}; } }
        if (ck < 3) LRU_PREFETCH(t0 + 64);
        __syncthreads();
        { const int t = tid >> 3, c0 = 8 * (tid & 7); float xc[8];
#pragma unroll
            for (int i = 0; i < 8; ++i) { const int c = c0 + i; float v = CW[4 * 64 + c];
#pragma unroll
                for (int k = 0; k < 4; ++k) v += CW[k * 64 + c] * XB[(t + k) * 64 + c];
                xc[i] = v; }
            *(LAS f32x4*)(XCF + t * 64 + c0) = (f32x4){xc[0], xc[1], xc[2], xc[3]}; *(LAS f32x4*)(XCF + t * 64 + c0 + 4) = (f32x4){xc[4], xc[5], xc[6], xc[7]};
            u32x4 o; o.x = pkbf(xc[0], xc[1]); o.y = pkbf(xc[2], xc[3]); o.z = pkbf(xc[4], xc[5]); o.w = pkbf(xc[6], xc[7]);
            *(LAS u32x4*)(XCB + t * XCB_STRIDE + c0) = o; }
        __syncthreads();
        { f32x16 z;
#pragma unroll
            for (int r = 0; r < 16; ++r) z[r] = 0.f;
#pragma unroll
            for (int s = 0; s < 4; ++s) { const bf16x8 A = *(const LAS bf16x8*)(XCB + (32 * tm + jl) * XCB_STRIDE + 16 * s + 8 * hh); z = MFMA32(A, Bg[s], z); }
            if (gsel == 0) {
#pragma unroll
                for (int r = 0; r < 16; ++r) { const int tt = 32 * tm + crow(r, hh); const float rg = sigmoidf(z[r] + gbias);
                    const float la = sp8 * rg, aa = __expf(la), x2 = 2.0f * la;
                    const float om = -x2 * (1.0f + x2 * (0.5f + x2 * (0.16666667f + x2 * (0.041666668f + x2 * (0.0083333338f + x2 * 0.0013888889f)))));
                    LA[tt * 64 + jc] = aa; LB[tt * 64 + jc] = __builtin_amdgcn_sqrtf(om); }
            } else {
#pragma unroll
                for (int r = 0; r < 16; ++r) { const int tt = 32 * tm + crow(r, hh); XG[tt * 64 + jc] = sigmoidf(z[r] + gbias) * XCF[tt * 64 + jc]; }
            } }
        __syncthreads();
        float Ac[8], Hl[8];
        { float A = 1.f, H = 0.f;
#pragma unroll
            for (int i = 0; i < 8; ++i) { const int t = 8 * wave + i; const float av = LA[t * 64 + lane], bv = LB[t * 64 + lane] * XG[t * 64 + lane]; H = av * H + bv; A = A * av; Ac[i] = A; Hl[i] = H; }
            TOT[(wave * 64 + lane) * 2] = A; TOT[(wave * 64 + lane) * 2 + 1] = H; }
        __syncthreads();
        { float cin = H0[par * 64 + lane], ain = ASEG[par * 64 + lane];
            for (int s = 0; s < wave; ++s) { const float ta = TOT[(s * 64 + lane) * 2]; cin = ta * cin + TOT[(s * 64 + lane) * 2 + 1]; ain *= ta; }
            if (wave == 7) { const float ta = TOT[(7 * 64 + lane) * 2]; H0[(par ^ 1) * 64 + lane] = ta * cin + TOT[(7 * 64 + lane) * 2 + 1]; ASEG[(par ^ 1) * 64 + lane] = ain * ta; }
            if (!MODE) {
                unsigned* hl = (unsigned*)(ws + WS_HLAC) + (size_t)(tb + t0 + 8 * wave) * LRU_W + n * BLK + lane;
#pragma unroll
                for (int i = 0; i < 8; ++i) hl[(size_t)i * LRU_W] = pkbf(Hl[i] + Ac[i] * cin, Ac[i] * ain);
            } else {
#pragma unroll
                for (int i = 0; i < 8; ++i) { const int t = 8 * wave + i; const float h = Hl[i] + Ac[i] * cin; const float y = h * GBL[t * 64 + lane];
                    const size_t tok = (size_t)(tb + t0 + t);
                    ((bf16*)(ws + WS_MIX))[tok * D + n * BLK + lane] = (bf16)f2bf(y);
                    const float ss = wave_sum_u(y * y);
                    if (lane == 0) ((float*)(ws + WS_SSQL))[tok * 8 + n] = ss; } } }
        __syncthreads();
    }
#undef LRU_PREFETCH
    if (!MODE && tid < 64) { agg[seg * 128 + tid] = ASEG[tid]; agg[seg * 128 + 64 + tid] = H0[tid]; }
    __syncthreads();
}

constexpr size_t WS_AGG16 = 14 * MiB + 512 * 1024;
__device__ __forceinline__ void lru_wave_task(const Ptrs& P, LAS float* cwl, int task, int lane) {
    unsigned char* ws = P.ws;
    const bf16* proj = (const bf16*)(ws + WS_PROJ);
    const int nt = task & 1, hs = (task >> 1) & 15, n = (task >> 5) & 7, b = task >> 8, tb = b * SEQ, s0 = hs * 128;
    for (int e = lane; e < 5 * 64; e += 64) { const int k = e >> 6, c = e & 63; cwl[e] = (k < 4) ? P.conv_w[k * LRU_W + n * BLK + c] : P.conv_b[n * BLK + c]; }
    const int jl = lane & 31, hh = lane >> 5, jc = 32 * nt + jl, cg = n * BLK + jc;
    const bf16* wga = (const bf16*)(ws + WS_WGT) + ((size_t)(0 * NBLK + n) * BLK + jc) * BLK + 8 * hh;
    const bf16* wgx = (const bf16*)(ws + WS_WGT) + ((size_t)(1 * NBLK + n) * BLK + jc) * BLK + 8 * hh;
    const float ba = P.b_gate_a[cg], bxg = P.b_gate_x[cg], sp8 = -8.0f * log1pf(expf(-P.lru_L[cg]));
    float cin = 0.f, ain = 1.f;
    LAS bf16* xbl = (LAS bf16*)(cwl + 5 * 64);
    u32x4 pr[5];
#define LRU_PREF(ti_) do { _Pragma("unroll") for (int i = 0; i < 5; ++i) { const int p = lane + 64 * i, row = p >> 3, ch = p & 7, pos = s0 + 32 * (ti_) - 3 + row; pr[i] = (u32x4){0u, 0u, 0u, 0u}; \
        if (p < 35 * 8 && pos >= 0 && (ti_) < 4) pr[i] = *(const u32x4*)(proj + (size_t)(tb + pos) * NIN + C_XB + n * BLK + 8 * ch); } } while (0)
    LRU_PREF(0);
    bf16x8 Ba = *(const bf16x8*)wga, Bx = *(const bf16x8*)wgx;
#pragma unroll 1
    for (int ti = 0; ti < 4; ++ti) {
        const int t0 = s0 + 32 * ti;
#pragma unroll
        for (int i = 0; i < 5; ++i) { const int p = lane + 64 * i; if (p < 35 * 8) *(LAS u32x4*)(xbl + (p >> 3) * 72 + 8 * (p & 7)) = pr[i]; }
        LRU_PREF(ti + 1);
        f32x16 za, zx, zc;
#pragma unroll
        for (int r = 0; r < 16; ++r) { za[r] = 0.f; zx[r] = 0.f; zc[r] = 0.f; }
#pragma unroll
        for (int s = 0; s < 4; ++s) { const int ch0 = 16 * s + 8 * hh;
            const bf16x8 Ban = *(const bf16x8*)(wga + 16 * ((s + 1) & 3)), Bxn = *(const bf16x8*)(wgx + 16 * ((s + 1) & 3));
            float xc[8];
            { const f32x4 b0 = *(const LAS f32x4*)(cwl + 4 * 64 + ch0), b1 = *(const LAS f32x4*)(cwl + 4 * 64 + ch0 + 4);
              xc[0] = b0.x; xc[1] = b0.y; xc[2] = b0.z; xc[3] = b0.w; xc[4] = b1.x; xc[5] = b1.y; xc[6] = b1.z; xc[7] = b1.w; }
#pragma unroll
            for (int tap = 0; tap < 4; ++tap) { const f32x4 w0 = *(const LAS f32x4*)(cwl + tap * 64 + ch0), w1 = *(const LAS f32x4*)(cwl + tap * 64 + ch0 + 4);
                float xf[8]; unpack8(*(const LAS u32x4*)(xbl + (jl + tap) * 72 + ch0), xf);
                xc[0] += w0.x * xf[0]; xc[1] += w0.y * xf[1]; xc[2] += w0.z * xf[2]; xc[3] += w0.w * xf[3]; xc[4] += w1.x * xf[4]; xc[5] += w1.y * xf[5]; xc[6] += w1.z * xf[6]; xc[7] += w1.w * xf[7]; }
            u32x4 o; o.x = pkbf(xc[0], xc[1]); o.y = pkbf(xc[2], xc[3]); o.z = pkbf(xc[4], xc[5]); o.w = pkbf(xc[6], xc[7]);
            const bf16x8 Af = __builtin_bit_cast(bf16x8, o);
            u32x4 idw;
#pragma unroll
            for (int w = 0; w < 4; ++w) { const int k0 = 16 * s + 8 * hh + 2 * w; idw[w] = (k0 == jc ? 0x3F80u : 0u) | (k0 + 1 == jc ? 0x3F800000u : 0u); }
            za = MFMA32(Af, Ba, za); zx = MFMA32(Af, Bx, zx); zc = MFMA32(Af, __builtin_bit_cast(bf16x8, idw), zc);
            Ba = Ban; Bx = Bxn;
            __builtin_amdgcn_sched_barrier(0); }
        float av[16], bv[16];
#pragma unroll
        for (int r = 0; r < 16; ++r) { const float zar = za[r], zxr = zx[r], zcr = zc[r];
            const float rg = sigmoidf(zar + ba), ig = sigmoidf(zxr + bxg), la = sp8 * rg, x2 = 2.0f * la;
            const float om = -x2 * (1.0f + x2 * (0.5f + x2 * (0.16666667f + x2 * (0.041666668f + x2 * (0.0083333338f + x2 * 0.0013888889f)))));
            av[r] = __expf(la); bv[r] = __builtin_amdgcn_sqrtf(om) * ig * zcr; }
        float RA[4], RH[4];
#pragma unroll
        for (int q = 0; q < 4; ++q) { float A = 1.f, H = 0.f;
#pragma unroll
            for (int i = 0; i < 4; ++i) { const int r = 4 * q + i; H = av[r] * H + bv[r]; A = A * av[r]; av[r] = A; bv[r] = H; }
            RA[q] = A; RH[q] = H; }
        const int hm = hh ? -1 : 0;
        float cH[4], cA[4];
#pragma unroll
        for (int q = 0; q < 4; ++q) { const float pa = __shfl_xor(RA[q], 32), ph = __shfl_xor(RH[q], 32);
            const float r0a = fsel(hm, pa, RA[q]), r0h = fsel(hm, ph, RH[q]), r1a = fsel(hm, RA[q], pa), r1h = fsel(hm, RH[q], ph);
            const float mid = r0a * cin + r0h, amid = ain * r0a;
            cH[q] = fsel(hm, mid, cin); cA[q] = fsel(hm, amid, ain);
            cin = r1a * mid + r1h; ain = amid * r1a; }
        unsigned* hl = (unsigned*)(ws + WS_HLAC) + (size_t)(tb + t0 + 4 * hh) * LRU_W + cg;
#pragma unroll
        for (int r = 0; r < 16; ++r) { const int q = r >> 2; hl[(size_t)((r & 3) + 8 * q) * LRU_W] = pkbf(bv[r] + av[r] * cH[q], av[r] * cA[q]); }
    }
#undef LRU_PREF
    if (hh == 0) { float* agg = (float*)(ws + WS_AGG16) + (size_t)((b * NBLK + n) * 16 + hs) * 128; agg[jc] = ain; agg[64 + jc] = cin; }
}

__device__ __forceinline__ void p2_mixer_a(const Ptrs& P, LAS unsigned char* lds, volatile LAS unsigned* MISC, unsigned* ctl, int tid, int lane, int wave, int gw, int NGW) {
    if (wave < 4) {
        unsigned btgt = 0u;
        for (int item = (int)blockIdx.x; item < BATCH * 32 * NKV; item += (int)gridDim.x) attn_item4(P, lds, item, tid, lane, wave, MISC + 24, btgt);
    } else {
        const int lw = (gw >> 3) * 4 + (wave - 4), NLW = NGW / 2;
        for (int task = lw; task < BATCH * NBLK * 16 * 2; task += NLW) lru_wave_task(P, (LAS float*)(lds + 65536 + (wave - 4) * 8192), task, lane);
    }
}
__device__ __forceinline__ void p2_mixer_b(const Ptrs& P, LAS unsigned char* lds, int bx, int G, int tid, int lane, int wave) {
    unsigned char* ws = P.ws;
    LAS float* CAR = (LAS float*)lds;
    for (int item = bx; item < BATCH * 8 * 4; item += G) {
        const int q = item & 3, seg = (item >> 2) & 7, b = item >> 5;
        { const int c = tid, n = c >> 6, j = c & 63, hs = 2 * seg + (q >> 1); const float* agg = (const float*)(ws + WS_AGG16) + (size_t)((b * NBLK + n) * 16) * 128;
            float h = 0.f;
            for (int sp = 0; sp < hs; ++sp) h = agg[sp * 128 + j] * h + agg[sp * 128 + 64 + j];
            CAR[c] = h; }
        __syncthreads();
        const f32x4 c0 = *(const LAS f32x4*)(CAR + 8 * lane), c1 = *(const LAS f32x4*)(CAR + 8 * lane + 4);
        const float car[8] = {c0.x, c0.y, c0.z, c0.w, c1.x, c1.y, c1.z, c1.w};
        const int tok0 = b * SEQ + seg * 256 + q * 64 + wave * 8;
        u32x4 H0[8], H1[8], G4[8];
#pragma unroll
        for (int i = 0; i < 8; ++i) { const size_t tok = (size_t)(tok0 + i);
            const unsigned* hl = (const unsigned*)(ws + WS_HLAC) + tok * LRU_W + 8 * lane;
            H0[i] = *(const u32x4*)hl; H1[i] = *(const u32x4*)(hl + 4);
            G4[i] = *(const u32x4*)((const bf16*)(ws + WS_PROJ) + tok * NIN + C_GB + 8 * lane); }
#pragma unroll
        for (int i = 0; i < 8; ++i) { const size_t tok = (size_t)(tok0 + i);
            const u32x4 h0 = H0[i], h1 = H1[i];
            float gf[8]; unpack8(G4[i], gf);
            const unsigned hw[8] = {h0.x, h0.y, h0.z, h0.w, h1.x, h1.y, h1.z, h1.w};
            float y[8], ss = 0.f;
#pragma unroll
            for (int k = 0; k < 8; ++k) { y[k] = (bflo(hw[k]) + bfhi(hw[k]) * car[k]) * gelu_tanh(gf[k]); ss += y[k] * y[k]; }
            u32x4 o; o.x = pkbf(y[0], y[1]); o.y = pkbf(y[2], y[3]); o.z = pkbf(y[4], y[5]); o.w = pkbf(y[6], y[7]);
            *(u32x4*)((bf16*)(ws + WS_MIX) + tok * D + 8 * lane) = o;
            ss += DPP_F(ss, 0xB1); ss += DPP_F(ss, 0x4E); ss += DPP_F(ss, 0x141);
            if ((lane & 7) == 0) ((float*)(ws + WS_SSQL))[tok * 8 + (lane >> 3)] = ss; }
        __syncthreads();
    }
}

template <int N> __device__ __forceinline__ void bitonic_sort_desc(int (&v)[N]) {
#pragma unroll
    for (int k = 2; k <= N; k <<= 1)
#pragma unroll
        for (int j = k >> 1; j > 0; j >>= 1)
#pragma unroll
            for (int i = 0; i < N; ++i) { const int l = i ^ j; if (l > i) { const bool desc = ((i & k) == 0); const int hi = max(v[i], v[l]), lo = min(v[i], v[l]); v[i] = desc ? hi : lo; v[l] = desc ? lo : hi; } }
}
__device__ __forceinline__ void sort16_desc(int (&a)[16]) {
#define CE(i, j) { const int hi_ = max(a[i], a[j]), lo_ = min(a[i], a[j]); a[i] = hi_; a[j] = lo_; }
    CE(0,13) CE(1,12) CE(2,15) CE(3,14) CE(4,8) CE(5,6) CE(7,11) CE(9,10) CE(0,5) CE(1,7) CE(2,9) CE(3,4) CE(6,13) CE(8,14) CE(10,15) CE(11,12) CE(0,1) CE(2,3) CE(4,5) CE(6,8) CE(7,9) CE(10,11) CE(12,13) CE(14,15) CE(0,2) CE(1,3) CE(4,10) CE(5,11) CE(6,7) CE(8,9) CE(12,14) CE(13,15) CE(1,2) CE(3,12) CE(4,6) CE(5,7) CE(8,10) CE(9,11) CE(13,14) CE(1,4) CE(2,6) CE(5,8) CE(7,10) CE(9,13) CE(11,14) CE(2,4) CE(3,6) CE(9,12) CE(11,13) CE(3,5) CE(6,8) CE(7,9) CE(10,12) CE(3,4) CE(5,6) CE(7,8) CE(9,10) CE(11,12) CE(6,7) CE(8,9)
#undef CE
}
__device__ __forceinline__ void merge_top16(int (&a)[16], const int (&b)[16]) {
#pragma unroll
    for (int i = 0; i < 16; ++i) a[i] = max(a[i], b[15 - i]);
#pragma unroll
    for (int j = 8; j > 0; j >>= 1)
#pragma unroll
        for (int i = 0; i < 16; ++i) { const int l = i ^ j; if (l > i) { const int hi = max(a[i], a[l]), lo = min(a[i], a[l]); a[i] = hi; a[l] = lo; } }
}
__device__ __forceinline__ int f2key(unsigned bits) { const int b = (int)bits; return b ^ ((b >> 31) & 0x7fffffff); }
struct CandTab { int i[64], j[64], n; constexpr CandTab() : i{}, j{}, n(0) { for (int a = 0; a < 16; ++a) for (int b = 0; b < 16; ++b) if ((a + 1) * (b + 1) <= 16) { i[n] = a; j[n] = b; ++n; } } };
constexpr int SKL_STRIDE = 136;
constexpr int SKL_BYTES = 256 * SKL_STRIDE * 2;
__device__ __forceinline__ void p5_topk(const Ptrs& P, LAS unsigned char* lds, const pg8::StaticOrder& S, int tid, int lane, int wave, int gw, int NGW) {
    const unsigned char* ws = P.ws;
    constexpr CandTab CT;
    static_assert(CT.n <= 64, "candidate table");
    const bf16* Q = (const bf16*)(ws + WS_Q); const bf16* SK = (const bf16*)(ws + WS_SKB);
    LAS bf16* SKL = (LAS bf16*)lds;
    LAS unsigned char* ib = lds + SKL_BYTES + (wave * 64 + lane) * 32;
    const int tl = lane & 31, hh = lane >> 5;
    const bool conv = wave >= 4;
    const int NCW = NGW / 2;
    int cvn = (gw >> 3) * 4 + (wave & 3);
#pragma unroll 1
    for (int round = 0; ; ++round) {
        pg8::Unit u; if (!S.next(round, u)) break;
        const int h = u.pn;
#pragma unroll
        for (int i = 0; i < 8; ++i) { const int p = tid + 512 * i, row = p >> 4, ch = p & 15;
            const u32x4 w = *(const u32x4*)(SK + ((size_t)(h * 2) * NKEYS + row) * DHALF + 8 * ch); *(LAS u32x4*)(SKL + row * SKL_STRIDE + 8 * ch) = w; }
        __syncthreads();
        if (conv) {
            constexpr int NGRP = 2 * NEXP / 4;
            ExpRows EA, EB;
            EA.load(P, 4 * min(cvn, NGRP - 1), lane); EB.load(P, 4 * min(cvn + NCW, NGRP - 1), lane);
            EA.finish(P, lane); EA.load(P, 4 * min(cvn + 2 * NCW, NGRP - 1), lane);
            EB.finish(P, lane); EB.load(P, 4 * min(cvn + 3 * NCW, NGRP - 1), lane);
            EA.finish(P, lane); EB.finish(P, lane);
            cvn += 4 * NCW;
        } else
#pragma unroll 1
        for (int sub = 0; sub < 2; ++sub) {
        const int tg = u.pm * 8 + wave + 4 * sub;
        const int t = tg * 32 + tl;
        float r2;
        { const float* sp = (const float*)(ws + WS_SSQ2) + (size_t)t * 16; const f32x4 s0 = *(const f32x4*)sp, s1 = *(const f32x4*)(sp + 4), s2 = *(const f32x4*)(sp + 8), s3 = *(const f32x4*)(sp + 12);
            const float ss = (((s0.x + s0.y) + (s0.z + s0.w)) + ((s1.x + s1.y) + (s1.z + s1.w))) + (((s2.x + s2.y) + (s2.z + s2.w)) + ((s3.x + s3.y) + (s3.z + s3.w)));
            r2 = __builtin_amdgcn_rsqf(ss * (1.0f / D) + EPS); if (h == 0 && hh == 0) ((float*)(ws + WS_R2))[t] = r2; }
        int KS[2][16];
#pragma unroll
        for (int c = 0; c < 2; ++c) {
            f32x16 acc[4];
#pragma unroll
            for (int kt = 0; kt < 4; ++kt)
#pragma unroll
                for (int r = 0; r < 16; ++r) acc[kt][r] = 0.f;
            int hq2 = hh; asm volatile("" : "+v"(hq2));
            const bf16* qrow = Q + (unsigned)(t * NQ + h * DQ + c * DHALF + 8 * hq2);
            bf16x8 Bf[8];
#pragma unroll
            for (int s = 0; s < 8; ++s) Bf[s] = *(const bf16x8*)(qrow + 16 * s);
            const LAS bf16* krow = SKL + (c * NKEYS + tl) * SKL_STRIDE + 8 * hh;
#pragma unroll
            for (int s = 0; s < 8; ++s)
#pragma unroll
                for (int kt = 0; kt < 4; ++kt) { const bf16x8 Af = *(const LAS bf16x8*)(krow + kt * 32 * SKL_STRIDE + 16 * s); acc[kt] = MFMA32(Af, Bf[s], acc[kt]); }
            int kk[4][16];
#pragma unroll
            for (int kt = 0; kt < 4; ++kt) {
#pragma unroll
                for (int r = 0; r < 16; ++r) { const float av = acc[kt][r];
                    kk[kt][r] = f2key((__float_as_uint(av) & ~0x7Fu) | (unsigned)(32 * kt + crow(r, hh))); }
                sort16_desc(kk[kt]); }
            merge_top16(kk[0], kk[1]); merge_top16(kk[2], kk[3]); merge_top16(kk[0], kk[2]);
            int pp[16];
#pragma unroll
            for (int i = 0; i < 16; ++i) pp[i] = __shfl_xor(kk[0][i], 32);
            merge_top16(kk[0], pp);
#pragma unroll
            for (int i = 0; i < 16; ++i) KS[c][i] = kk[0][i];
        }
        float fa[16], fb[16];
        { unsigned wa[4], wb[4];
#pragma unroll
            for (int i = 0; i < 4; ++i) { wa[i] = 0u; wb[i] = 0u; }
#pragma unroll
            for (int i = 0; i < 16; ++i) { const unsigned ua = (unsigned)f2key((unsigned)KS[0][i]), ub = (unsigned)f2key((unsigned)KS[1][i]);
                fa[i] = __builtin_bit_cast(float, ua & ~0x7Fu); fb[i] = __builtin_bit_cast(float, ub & ~0x7Fu);
                wa[i >> 2] |= (ua & 0x7Fu) << (8 * (i & 3)); wb[i >> 2] |= (ub & 0x7Fu) << (8 * (i & 3)); }
            *(LAS u32x4*)ib = (u32x4){wa[0], wa[1], wa[2], wa[3]}; *(LAS u32x4*)(ib + 16) = (u32x4){wb[0], wb[1], wb[2], wb[3]}; }
        int cv[4][16];
#pragma unroll
        for (int q = 0; q < 64; ++q) {
            if (q < CT.n) { const float sum = fa[CT.i[q]] + fb[CT.j[q]]; cv[q >> 4][q & 15] = f2key((__builtin_bit_cast(unsigned, sum) & ~0xFFu) | (unsigned)(CT.i[q] * 16 + CT.j[q])); }
            else cv[q >> 4][q & 15] = (int)0x80000000;
        }
#pragma unroll
        for (int gq = 0; gq < 4; ++gq) sort16_desc(cv[gq]);
        merge_top16(cv[0], cv[1]); merge_top16(cv[2], cv[3]); merge_top16(cv[0], cv[2]);
        asm volatile("s_waitcnt lgkmcnt(0)" ::: "memory");
        int ex[16]; float gv[16]; float den = 0.f; float v0 = 0.f;
#pragma unroll
        for (int k = 0; k < 16; ++k) { const unsigned ub = (unsigned)f2key((unsigned)cv[0][k]); const float val = __builtin_bit_cast(float, ub & ~0xFFu); const unsigned ij = ub & 0xFFu;
            if (k == 0) v0 = val;
            const int n1 = ib[ij >> 4], n2 = ib[16 + (ij & 15u)];
            ex[k] = n1 * NKEYS + n2; gv[k] = __expf(r2 * (val - v0)); den += gv[k]; }
        const float rden = 1.0f / den;
        int hq = hh; asm volatile("" : "+v"(hq));
        float* gp = (float*)(ws + WS_GW) + (unsigned)(t * 128 + h * 16 + 8 * hq);
        int e8[8]; float g8[8];
#pragma unroll
        for (int k = 0; k < 8; ++k) { const int msk = -hh;
            e8[k] = (ex[8 + k] & msk) | (ex[k] & ~msk);
            g8[k] = __builtin_bit_cast(float, (__builtin_bit_cast(int, gv[8 + k]) & msk) | (__builtin_bit_cast(int, gv[k]) & ~msk)) * rden; }
        *(u32x4*)((unsigned short*)(ws + WS_IDX16) + (unsigned)(t * 128 + h * 16 + 8 * hq)) = (u32x4){(unsigned)e8[0] | ((unsigned)e8[1] << 16), (unsigned)e8[2] | ((unsigned)e8[3] << 16), (unsigned)e8[4] | ((unsigned)e8[5] << 16), (unsigned)e8[6] | ((unsigned)e8[7] << 16)};
        *(f32x4*)gp = (f32x4){g8[0], g8[1], g8[2], g8[3]}; *(f32x4*)(gp + 4) = (f32x4){g8[4], g8[5], g8[6], g8[7]};
        }
        __syncthreads();
    }
    if (conv) for (; cvn < 2 * NEXP / 4; cvn += NCW) expert_rows4(P, 4 * cvn, lane);
}

struct Args { Ptrs P; int ph_lo, ph_hi, li, pad; };
constexpr int NPH = 9;
__global__ void __launch_bounds__(NWAVES * 64, 2) fwd(Args a) {
    extern __shared__ __attribute__((aligned(16))) unsigned char lds_raw[];
    LAS unsigned char* lds = (LAS unsigned char*)lds_raw;
    volatile LAS unsigned* MISC = (volatile LAS unsigned*)(lds + MISC_OFF);
    const Ptrs& P = a.P;
    unsigned char* ws = P.ws;
    const int tid = threadIdx.x, lane = tid & 63, wave = __builtin_amdgcn_readfirstlane(tid >> 6);
    const int G = gridDim.x, bx = blockIdx.x, vcu = (G % 8 == 0) ? (bx % 8) * (G / 8) + bx / 8 : bx;
    if (tid < 32) MISC[tid] = 0u;
    __syncthreads();
    unsigned* ctl = (unsigned*)(ws + WS_CTL);
    XcdBarrier bar = xcd_barrier_post(ctl + CW_BAR + a.li * XCD_BAR_WORDS, MISC + 8);
    const int lo = a.ph_lo, hi = a.ph_hi;
#define IN(k) (lo <= (k) && (k) < hi)
#define SEAM(k) do { if (IN(k) && IN((k) + 1)) xcd_barrier(bar); } while (0)
    const int gw = vcu * NWAVES + wave, NGW = G * NWAVES;

    if (IN(0)) { p0_prep(P, gw, NGW, lane, (LAS float*)(lds + wave * 16384)); }
    SEAM(0);
    if (IN(1)) { {
        pg8::Gemm g{(const bf16*)(ws + WS_XBF), (const bf16*)(ws + WS_WINT), T, NIN, D}; pg8::StaticOrder S; S.init(T, NIN, G, bx);
        pg8::EpiRowBf16 E{(bf16*)(ws + WS_PROJ), NIN, nullptr};
        pg8::gemm_phase<pg8::EpiRowBf16, pg8::StaticOrder, true, true>(lds, g, S, E);
    } }
    SEAM(1);
    if (IN(2)) { p2_mixer_a(P, lds, MISC, ctl, tid, lane, wave, gw, NGW); xcd_barrier(bar); p2_mixer_b(P, lds, bx, G, tid, lane, wave); }
    SEAM(2);
    if (IN(3)) {
        pg8::Gemm g{(const bf16*)(ws + WS_MIX), (const bf16*)(ws + WS_WOUTT), T, D, D}; pg8::StaticOrder S; S.init(T, D, G, bx);
        LAS pg8::f32x2v* rsl = (LAS pg8::f32x2v*)(lds + RS_OFF); LAS float* rxl = (LAS float*)(lds + RS_OFF + 2048);
        pg8::Unit u;
        for (int round = 0; S.next(round, u); ++round) {
            if (tid < 256) { const int row = u.pm * 256 + tid; const float* sl = (const float*)(ws + WS_SSQL) + (size_t)row * 8; const float* sa = (const float*)(ws + WS_SSQA) + (size_t)row * 8;
                const f32x4 l0 = *(const f32x4*)sl, l1 = *(const f32x4*)(sl + 4), a0 = *(const f32x4*)sa, a1 = *(const f32x4*)(sa + 4);
                const float sL = ((l0.x + l0.y) + (l0.z + l0.w)) + ((l1.x + l1.y) + (l1.z + l1.w)), sA = ((a0.x + a0.y) + (a0.z + a0.w)) + ((a1.x + a1.y) + (a1.z + a1.w));
                const float rl = __builtin_amdgcn_rsqf(sL * (1.0f / LRU_W) + EPS), ra = __builtin_amdgcn_rsqf(sA * (1.0f / ATT_W) + EPS);
                rsl[tid] = (pg8::f32x2v){rl * __builtin_amdgcn_rcpf(ra), ra}; rxl[tid] = __builtin_amdgcn_rcpf(((const float*)(ws + WS_R1X))[row]); }
            __syncthreads();
            pg8::OneUnit S1{u};
            pg8::EpiOut E{(const bf16*)(ws + WS_XBF), P.out, (bf16*)(ws + WS_X1BF), (float*)(ws + WS_SSQ2), rsl, rxl};
            pg8::gemm_phase<pg8::EpiOut, pg8::OneUnit, false, true>(lds, g, S1, E);
            __syncthreads();
        }
    }
    SEAM(3);
    if (IN(4)) { {
        pg8::Gemm g{(const bf16*)(ws + WS_X1BF), (const bf16*)(ws + WS_WQT), T, NQ, D}; pg8::StaticOrder S; S.init(T, NQ, G, bx);
        pg8::EpiRowBf16 E{(bf16*)(ws + WS_Q), NQ, nullptr};
        pg8::gemm_phase<pg8::EpiRowBf16, pg8::StaticOrder, true, true>(lds, g, S, E);
    } }
    if (IN(5)) { pg8::StaticOrder S; S.init(T, NQ, G, bx); p5_topk(P, lds, S, tid, lane, wave, gw, NGW); }
    SEAM(5);
    if (IN(6)) { if (G == 256) p6_u3(P, lds, bx, lane, wave); else p6_sliced<0>(P, lds, MISC, ctl, tid, lane, wave); }
    SEAM(6);
    if (IN(7)) { p6_combine(P, bx * (NWAVES * 64) + tid, G * NWAVES * 64); }
    SEAM(7);
    if (IN(8)) { if (G == 256) p6_v3(P, lds, bx, lane, wave); else p6_v2(P, MISC, ctl, tid, lane, wave); }
#undef IN
#undef SEAM
}

extern "C" void kernel_launch(void* const* d_in, const int* in_sizes, int n_in, void* d_out, int out_size, void* d_ws, size_t ws_size, hipStream_t stream) {
    static int grid = 0;
    if (grid == 0) {
        if (n_in != 22 || out_size != T * D || ws_size < WS_END) { fprintf(stderr, "kernel_launch: unexpected shapes (n_in %d, out %d, ws %zu)\n", n_in, out_size, ws_size); grid = -1; return; }
        int dev = 0, cus = 0, per_cu = 0;
        if (hipGetDevice(&dev) != hipSuccess || hipDeviceGetAttribute(&cus, hipDeviceAttributeMultiprocessorCount, dev) != hipSuccess) { grid = -1; return; }
        if (hipFuncSetAttribute((const void*)fwd, hipFuncAttributeMaxDynamicSharedMemorySize, LDS_BYTES) != hipSuccess) { fprintf(stderr, "kernel_launch: hipFuncSetAttribute failed\n"); grid = -1; return; }
        if (hipOccupancyMaxActiveBlocksPerMultiprocessor(&per_cu, (const void*)fwd, NWAVES * 64, LDS_BYTES) != hipSuccess || per_cu < 1) fprintf(stderr, "kernel_launch: occupancy query says %d\n", per_cu);
        (void)hipGetLastError();
        grid = cus;
        if (grid != 256) fprintf(stderr, "kernel_launch: %d CUs (built for 256)\n", grid);
    }
    if (grid < 0) return;
    Ptrs P{};
    const float** pp = (const float**)&P;
    for (int i = 0; i < 22; ++i) pp[i] = (const float*)d_in[i];
    P.out = (float*)d_out; P.ws = (unsigned char*)d_ws;
    unsigned char* ws = P.ws;
    (void)hipMemsetAsync(ws + WS_CTL, 0, CTL_BYTES, stream);
    Args a{}; a.P = P;
    int li = 0;
#define FWD(lo_, hi_) do { a.ph_lo = (lo_); a.ph_hi = (hi_); a.li = li++; hipLaunchKernelGGL(fwd, dim3(grid), dim3(NWAVES * 64), LDS_BYTES, stream, a); } while (0)
    FWD(0, NPH);
}
```

```cpp
#include <hip/hip_runtime.h>
#include <cstdio>
#include <cstdint>

#define LAS __attribute__((address_space(3)))
typedef unsigned short bf16;
typedef short bf16x8 __attribute__((ext_vector_type(8)));
typedef float f32x4 __attribute__((ext_vector_type(4)));
typedef unsigned u32x4 __attribute__((ext_vector_type(4)));
typedef unsigned u32x2 __attribute__((ext_vector_type(2)));

constexpr int D = 1024, BATCH = 8, SEQ = 2048, T = BATCH * SEQ;
constexpr int LRU_W = 512, NBLK = 8, BLK = 64;
constexpr int NH = 8, NKV = 2, HD = 64, ATT_W = 512, KV_W = 128, WIN = 128;
constexpr int PH = 8, NKEYS = 128, DQ = 256, DHALF = 128, TOPK = 16, NEXP = NKEYS * NKEYS;
constexpr int NIN = 1792, NQ = PH * DQ;
constexpr int C_XB = 0, C_GB = 512, C_Q = 1024, C_K = 1536, C_V = 1664;
constexpr float EPS = 1e-6f;

constexpr size_t MiB = 1u << 20;
constexpr size_t WS_CTL = 0, CTL_BYTES = 1 * MiB;
constexpr size_t WS_WINT = 1 * MiB;
constexpr size_t WS_WOUTT = 5 * MiB;
constexpr size_t WS_WQT = 7 * MiB;
constexpr size_t WS_SKB = 11 * MiB;
constexpr size_t WS_WGT = 11 * MiB + 512 * 1024;
constexpr size_t WS_BL = 11 * MiB + 768 * 1024;
constexpr size_t WS_SUS = 11 * MiB + 832 * 1024;
constexpr size_t WS_SVS = 11 * MiB + 896 * 1024;
constexpr size_t WS_R1 = 12 * MiB;
constexpr size_t WS_R1X = 12 * MiB + 64 * 1024;
constexpr size_t WS_R2 = 12 * MiB + 256 * 1024;
constexpr size_t WS_SSQL = 12 * MiB + 512 * 1024;
constexpr size_t WS_SSQA = 13 * MiB;
constexpr size_t WS_SSQ2 = 13 * MiB + 512 * 1024;
constexpr size_t WS_EU = 16 * MiB;
constexpr size_t WS_EV = 48 * MiB;
constexpr size_t WS_X1BF = 80 * MiB;
constexpr size_t WS_MIX = 112 * MiB;
constexpr size_t WS_IDX = 144 * MiB;
constexpr size_t WS_GW = 152 * MiB;
constexpr size_t WS_XBF = 160 * MiB;
constexpr size_t WS_PROJ = 192 * MiB;
constexpr size_t WS_Q = 160 * MiB;
constexpr size_t WS_IDX16 = 240 * MiB;
constexpr size_t WS_W = 232 * MiB;
constexpr size_t WS_PART = 160 * MiB;
constexpr size_t WS_END = 248 * MiB;

__device__ __forceinline__ unsigned f2bf(float f) { unsigned u = __builtin_bit_cast(unsigned, f); return (u + 0x7fffu + ((u >> 16) & 1u)) >> 16; }
__device__ __forceinline__ unsigned pk2(float lo, float hi) { return f2bf(lo) | (f2bf(hi) << 16); }
__device__ __forceinline__ float bf2f(unsigned short b) { return __builtin_bit_cast(float, ((unsigned)b) << 16); }
__device__ __forceinline__ float bflo(unsigned w) { return __builtin_bit_cast(float, w << 16); }
__device__ __forceinline__ float bfhi(unsigned w) { return __builtin_bit_cast(float, w & 0xffff0000u); }
__device__ __forceinline__ float wave_sum(float v) {
#pragma unroll
    for (int o = 1; o < 64; o <<= 1) v += __shfl_xor(v, o);
    return v;
}
__device__ __forceinline__ float gelu_tanh(float x) {
    const float u = 0.7978845608028654f * (x + 0.044715f * x * x * x);
    return x * __builtin_amdgcn_rcpf(1.0f + __expf(-2.0f * u));
}
__device__ __forceinline__ float sigmoidf(float z) { return __builtin_amdgcn_rcpf(1.0f + __expf(-z)); }
typedef int i32x4 __attribute__((ext_vector_type(4)));
#define DPP_I(v, ctrl) __builtin_amdgcn_update_dpp(0, (v), (ctrl), 0xf, 0xf, true)
#define DPP_F(v, ctrl) __builtin_bit_cast(float, __builtin_amdgcn_update_dpp(0, __builtin_bit_cast(int, (v)), (ctrl), 0xf, 0xf, true))
__device__ __forceinline__ int t5_bucket(int n) {
    if (n < 16) return n;
    const int th[15] = {19, 21, 24, 27, 31, 35, 40, 46, 52, 59, 67, 77, 87, 99, 113};
    int b = 16;
#pragma unroll
    for (int i = 0; i < 15; ++i) b += (n >= th[i]) ? 1 : 0;
    return b;
}

struct Ptrs {
    const float *x, *ln_mix_g, *w_in, *conv_w, *conv_b, *w_gate_a, *b_gate_a, *w_gate_x, *b_gate_x, *lru_L, *q_norm_g, *k_norm_g, *sinks, *lru_out_g, *attn_out_g, *w_out, *ln_ffn_g, *w_query, *sub_keys, *expert_u, *expert_v, *rel_bias;
    float* out; unsigned char* ws;
};

__device__ __forceinline__ float row_to_bf16(const float* src, const float* g, bf16* dst, int lane) {
    float ss = 0.f;
#pragma unroll
    for (int j = 0; j < 4; ++j) {
        f32x4 v = *(const f32x4*)(src + 4 * lane + 256 * j);
        ss += (v.x * v.x + v.y * v.y) + (v.z * v.z + v.w * v.w);
        if (g) { const f32x4 gg = *(const f32x4*)(g + 4 * lane + 256 * j); v = v * gg; }
        u32x2 o; o.x = pk2(v.x, v.y); o.y = pk2(v.z, v.w);
        *(u32x2*)(dst + 4 * lane + 256 * j) = o;
    }
    return ss;
}
constexpr float FP8_SU = 256.0f, FP8_SV = 64.0f;
__device__ __forceinline__ void row_to_fp8(const float* src, const float* g, float scale, unsigned char* dst, int lane) {
    u32x4 o;
#pragma unroll
    for (int j = 0; j < 4; ++j) {
        f32x4 v = *(const f32x4*)(src + 16 * lane + 4 * j);
        if (g) { const f32x4 gg = *(const f32x4*)(g + 16 * lane + 4 * j); v = v * gg; }
        v = v * scale;
        int w = 0; w = __builtin_amdgcn_cvt_pk_fp8_f32(v.x, v.y, w, false); w = __builtin_amdgcn_cvt_pk_fp8_f32(v.z, v.w, w, true);
        o[j] = (unsigned)w;
    }
    *(u32x4*)(dst + 16 * lane) = o;
}
__device__ __forceinline__ void expert_rows4(const Ptrs& P, int r0, int lane);
constexpr size_t SLICE_BYTES = (size_t)NEXP * 128;
__device__ __forceinline__ void row_to_fp8_sliced(const float* src, const float* g, float scale, unsigned char* base, int e, int lane) {
    u32x4 o;
#pragma unroll
    for (int j = 0; j < 4; ++j) {
        f32x4 v = *(const f32x4*)(src + 16 * lane + 4 * j) * scale;
        if (g) v = v * *(const f32x4*)(g + 16 * lane + 4 * j);
        int w = 0; w = __builtin_amdgcn_cvt_pk_fp8_f32(v.x, v.y, w, false); w = __builtin_amdgcn_cvt_pk_fp8_f32(v.z, v.w, w, true);
        o[j] = (unsigned)w;
    }
    *(u32x4*)(base + (size_t)(lane >> 3) * SLICE_BYTES + (size_t)e * 128 + 16 * (lane & 7)) = o;
}
__device__ __forceinline__ float wave_max_u(float v) {
    v = fmaxf(v, DPP_F(v, 0xB1)); v = fmaxf(v, DPP_F(v, 0x4E)); v = fmaxf(v, DPP_F(v, 0x141)); v = fmaxf(v, DPP_F(v, 0x140));
    const int i = __builtin_bit_cast(int, v);
    return fmaxf(fmaxf(__builtin_bit_cast(float, __builtin_amdgcn_readlane(i, 0)), __builtin_bit_cast(float, __builtin_amdgcn_readlane(i, 16))),
                 fmaxf(__builtin_bit_cast(float, __builtin_amdgcn_readlane(i, 32)), __builtin_bit_cast(float, __builtin_amdgcn_readlane(i, 48))));
}
struct ExpRows {
    f32x4 v[4][4]; int r0;
    __device__ __forceinline__ void load(const Ptrs& P, int r0_, int lane_) {
        r0 = r0_; int lane = lane_; asm volatile("" : "+v"(lane));
        const bool isv = r0 >= NEXP; const int e0 = isv ? r0 - NEXP : r0;
        const float* src = (isv ? P.expert_v : P.expert_u) + (size_t)e0 * D + 16 * lane;
#pragma unroll
        for (int k = 0; k < 4; ++k)
#pragma unroll
            for (int j = 0; j < 4; ++j) v[k][j] = *(const f32x4*)(src + (size_t)k * D + 4 * j);
    }
    __device__ __forceinline__ void finish(const Ptrs& P, int lane_) {
        int lane = lane_; asm volatile("" : "+v"(lane));
        const bool isv = r0 >= NEXP; const int e0 = isv ? r0 - NEXP : r0;
        unsigned char* base = P.ws + (isv ? WS_EV : WS_EU) + (size_t)(lane >> 3) * SLICE_BYTES + 16 * (lane & 7);
        f32x4 g[4];
        if (!isv) {
#pragma unroll
            for (int j = 0; j < 4; ++j) g[j] = *(const f32x4*)(P.ln_ffn_g + 16 * lane + 4 * j); }
        float* scl = (float*)(P.ws + (isv ? WS_SVS : WS_SUS));
#pragma unroll
        for (int k = 0; k < 4; ++k) { float m = 0.f;
#pragma unroll
            for (int j = 0; j < 4; ++j) { if (!isv) v[k][j] = v[k][j] * g[j]; m = fmaxf(m, fmaxf(fmaxf(fabsf(v[k][j].x), fabsf(v[k][j].y)), fmaxf(fabsf(v[k][j].z), fabsf(v[k][j].w)))); }
            m = fmaxf(wave_max_u(m), 1e-30f);
            const float inv = 127.0f * __builtin_amdgcn_rcpf(m);
            if (lane == 0) scl[e0 + k] = m * (1.0f / 127.0f);
            u32x4 o;
#pragma unroll
            for (int j = 0; j < 4; ++j) { const int q0 = (int)rintf(v[k][j].x * inv), q1 = (int)rintf(v[k][j].y * inv), q2 = (int)rintf(v[k][j].z * inv), q3 = (int)rintf(v[k][j].w * inv);
                o[j] = (unsigned)(q0 & 0xff) | ((unsigned)(q1 & 0xff) << 8) | ((unsigned)(q2 & 0xff) << 16) | ((unsigned)q3 << 24); }
            *(u32x4*)(base + (size_t)(e0 + k) * 128) = o; }
    }
};
__device__ __forceinline__ void expert_rows4(const Ptrs& P, int r0, int lane) { ExpRows A; A.load(P, r0, lane); A.finish(P, lane); }
__device__ __forceinline__ void transpose_item(const float* W, int K, int N, const float* g0, const float* g1, int gsplit, bf16* WT, LAS float* scr, int item, int lane) {
    const int nblk = N / 32, kb = item / nblk, nb = item % nblk, k0 = 64 * kb, n0 = 32 * nb;
#pragma unroll
    for (int i = 0; i < 32; ++i) { const int kk = 2 * i + (lane >> 5); const int k = k0 + kk; const float gk = (k < gsplit) ? g0[k] : g1[k - gsplit];
        scr[kk * 33 + (lane & 31)] = W[(size_t)k * N + n0 + (lane & 31)] * gk; }
    asm volatile("s_waitcnt lgkmcnt(0)" ::: "memory");
    const int c = lane & 7;
#pragma unroll
    for (int j = 0; j < 4; ++j) { const int n = (lane >> 3) + 8 * j; const LAS float* s = scr + (8 * c) * 33 + n;
        u32x4 o; o.x = pk2(s[0 * 33], s[1 * 33]); o.y = pk2(s[2 * 33], s[3 * 33]); o.z = pk2(s[4 * 33], s[5 * 33]); o.w = pk2(s[6 * 33], s[7 * 33]);
        *(u32x4*)(WT + (size_t)(n0 + n) * K + k0 + 8 * c) = o; }
    asm volatile("s_waitcnt lgkmcnt(0)" ::: "memory");
}
__device__ __forceinline__ void p0_prep(const Ptrs& P, int gw, int NGW, int lane, LAS float* scr) {
    unsigned char* ws = P.ws;
    constexpr int I_IN = (D / 64) * (NIN / 32), I_OUT = (D / 64) * (D / 32), I_Q = (D / 64) * (NQ / 32);
    for (int it = gw; it < I_IN + I_OUT + I_Q; it += NGW) {
        int r = it;
        if (r < I_IN) { transpose_item(P.w_in, D, NIN, P.ln_mix_g, P.ln_mix_g, D, (bf16*)(ws + WS_WINT), scr, r, lane); continue; } r -= I_IN;
        if (r < I_OUT) { transpose_item(P.w_out, D, D, P.lru_out_g, P.attn_out_g, LRU_W, (bf16*)(ws + WS_WOUTT), scr, r, lane); continue; } r -= I_OUT;
        transpose_item(P.w_query, D, NQ, P.ln_ffn_g, P.ln_ffn_g, D, (bf16*)(ws + WS_WQT), scr, r, lane);
    }
    for (int r0 = gw * 4; r0 < T; r0 += NGW * 4) {
        f32x4 v[4][4];
#pragma unroll
        for (int k = 0; k < 4; ++k)
#pragma unroll
            for (int j = 0; j < 4; ++j) v[k][j] = *(const f32x4*)(P.x + (size_t)(r0 + k) * D + 4 * lane + 256 * j);
#pragma unroll
        for (int k = 0; k < 4; ++k) { float ss = 0.f;
#pragma unroll
            for (int j = 0; j < 4; ++j) ss += (v[k][j].x * v[k][j].x + v[k][j].y * v[k][j].y) + (v[k][j].z * v[k][j].z + v[k][j].w * v[k][j].w);
            const float r1 = __builtin_amdgcn_rsqf(wave_sum(ss) * (1.0f / D) + EPS);
            if (lane == 0) ((float*)(ws + WS_R1X))[r0 + k] = r1;
            bf16* dst = (bf16*)(ws + WS_XBF) + (size_t)(r0 + k) * D;
#pragma unroll
            for (int j = 0; j < 4; ++j) { u32x2 o; o.x = pk2(v[k][j].x * r1, v[k][j].y * r1); o.y = pk2(v[k][j].z * r1, v[k][j].w * r1); *(u32x2*)(dst + 4 * lane + 256 * j) = o; } }
    }
    for (int e = gw; e < 256; e += NGW) (void)row_to_bf16(P.sub_keys + (size_t)e * D, nullptr, (bf16*)(ws + WS_SKB) + (size_t)e * D, lane);
    for (int e = gw * 64 + lane; e < 2 * NBLK * BLK * BLK + NH * WIN; e += NGW * 64) {
        if (e < 2 * NBLK * BLK * BLK) { const int g = e / (NBLK * BLK * BLK), r = e % (NBLK * BLK * BLK), n = r / (BLK * BLK), j = (r / BLK) % BLK, i = r % BLK;
            const float* W = g ? P.w_gate_x : P.w_gate_a;
            ((bf16*)(ws + WS_WGT))[e] = (bf16)f2bf(W[(size_t)n * BLK * BLK + i * BLK + j]); }
        else { const int q = e - 2 * NBLK * BLK * BLK, h = q / WIN, rel = q % WIN;
            ((float*)(ws + WS_BL))[q] = P.rel_bias[t5_bucket(rel) * NH + h]; }
    }
}
namespace pg8 {
typedef unsigned short bf16_t;
constexpr int BM = 256, BK = 64, HALF = 128, HTB = HALF * BK * 2  , STAGE_BYTES = 8 * HTB, NXCD = 8, WGM = 4;
__host__ __device__ __forceinline__ int lds_byte(int r, int c) { const int st = (r >> 4) * 2 + (c >> 5), rr = r & 15, cc = c & 31, ob = rr * 64 + cc * 2; return st * 1024 + (ob ^ (((ob >> 9) & 1) << 5)); }
__host__ __device__ __forceinline__ void stage_rc(int b, int& R, int& C) { const int st = b / 1024, sb = b % 1024, swz = sb ^ (((sb >> 9) & 1) << 5); R = (st >> 1) * 16 + swz / 64; C = (st & 1) * 32 + (swz % 64) / 2; }
__host__ __device__ __forceinline__ int perm32(int rho) { const int n = rho >> 4, i = rho & 15; return 8 * (i >> 2) + 4 * n + (i & 3); }
struct Unit { int pm, pn; };
struct Gemm { const bf16_t* A; const bf16_t* Bt; int M, N, K; };
struct StaticOrder {
    int nM, nN, nwg, G, c;
    __host__ __device__ void init(int M, int N, int G_, int c_) { nM = M / BM; nN = N / BM; nwg = nM * nN; G = G_; c = c_; }
    __host__ __device__ bool next(int i, Unit& u) const {
        const long L = (long)i * G + c; if (L >= nwg) return false;
        int wgid = (int)L; { const int q = nwg / NXCD, r = nwg % NXCD, xcd = wgid % NXCD, off = wgid / NXCD; wgid = (xcd < r ? xcd * (q + 1) : r * (q + 1) + (xcd - r) * q) + off; }
        const int nig = WGM * nN, gid = wgid / nig, fm = gid * WGM, gsz = (nM - fm) < WGM ? (nM - fm) : WGM;
        u.pm = fm + ((wgid % nig) % gsz); u.pn = (wgid % nig) / gsz; return true;
    }
    __device__ __forceinline__ void a_ready(const Unit&) const {}
    __device__ __forceinline__ void done(const Unit&) const {}
};
struct OneUnit {
    Unit u;
    __device__ __forceinline__ bool next(int i, Unit& o) const { if (i != 0) return false; o = u; return true; }
    __device__ __forceinline__ void a_ready(const Unit&) const {}
    __device__ __forceinline__ void done(const Unit&) const {}
};
__device__ __forceinline__ unsigned cvt_pk_bf16(float lo, float hi) { unsigned r; asm volatile("v_cvt_pk_bf16_f32 %0, %1, %2" : "=v"(r) : "v"(lo), "v"(hi)); return r; }

struct EpiRowBf16 {
    static constexpr bool PERM = true, MID = false;
    bf16_t* O; int ldc; const float* rs;
    __device__ __forceinline__ void mid(f32x4 (&)[2][2][4][2], const Unit&, int, int, int, int) const {}
    __device__ __forceinline__ void operator()(const f32x4 (&acc)[2][2][4][2], const Unit& u, int wr, int wc, int fr, int fq) const {
        const int row0 = u.pm * BM + wr * 64 + fr, col0 = u.pn * BM + wc * 32 + 8 * fq;
#pragma unroll
        for (int ai = 0; ai < 2; ++ai)
#pragma unroll
            for (int m = 0; m < 4; ++m) { const int row = row0 + ai * HALF + m * 16; const float sc = rs ? rs[row] : 1.0f; bf16_t* rowp = O + (size_t)row * ldc + col0;
#pragma unroll
                for (int bj = 0; bj < 2; ++bj) { const f32x4 v0 = acc[ai][bj][m][0] * sc, v1 = acc[ai][bj][m][1] * sc;
                    u32x4 w; w.x = cvt_pk_bf16(v0[0], v0[1]); w.y = cvt_pk_bf16(v0[2], v0[3]); w.z = cvt_pk_bf16(v1[0], v1[1]); w.w = cvt_pk_bf16(v1[2], v1[3]);
                    *(u32x4*)(rowp + bj * HALF) = w; } }
    }
};
typedef float f32x2v __attribute__((ext_vector_type(2)));
struct EpiOut {
    static constexpr bool PERM = true, MID = true;
    const bf16_t* xbf; float* x1; bf16_t* x1bf; float* ssq2; const LAS f32x2v* rsl; const LAS float* rxl;
    __device__ __forceinline__ void mid(f32x4 (&acc)[2][2][4][2], const Unit&, int wr, int, int fr, int) const {
#pragma unroll
        for (int ai = 0; ai < 2; ++ai)
#pragma unroll
            for (int m = 0; m < 4; ++m) { const float ratio = rsl[ai * HALF + wr * 64 + m * 16 + fr].x;
#pragma unroll
                for (int bj = 0; bj < 2; ++bj)
#pragma unroll
                    for (int n = 0; n < 2; ++n) acc[ai][bj][m][n] = acc[ai][bj][m][n] * ratio; }
    }
    __device__ __forceinline__ void operator()(const f32x4 (&acc)[2][2][4][2], const Unit& u, int wr, int wc, int fr, int fq) const {
        const int col0 = u.pn * BM + wc * 32 + 8 * fq;
#pragma unroll
        for (int ai = 0; ai < 2; ++ai) {
            u32x2 xw[4][2][2];
#pragma unroll
            for (int m = 0; m < 4; ++m) { const size_t off = (size_t)(u.pm * BM + ai * HALF + wr * 64 + m * 16 + fr) * D + col0;
#pragma unroll
                for (int bj = 0; bj < 2; ++bj)
#pragma unroll
                    for (int n = 0; n < 2; ++n) xw[m][bj][n] = *(const u32x2*)(xbf + off + bj * HALF + n * 4); }
#pragma unroll
            for (int m = 0; m < 4; ++m) { const int r = ai * HALF + wr * 64 + m * 16 + fr; const float ratt = rsl[r].y, rx = rxl[r]; const int row = u.pm * BM + r; const size_t off = (size_t)row * D + col0; float ss = 0.f;
#pragma unroll
                for (int bj = 0; bj < 2; ++bj)
#pragma unroll
                    for (int n = 0; n < 2; ++n) { const u32x2 w2 = xw[m][bj][n]; const f32x4 xs = (f32x4){__builtin_bit_cast(float, w2.x << 16), __builtin_bit_cast(float, w2.x & 0xffff0000u), __builtin_bit_cast(float, w2.y << 16), __builtin_bit_cast(float, w2.y & 0xffff0000u)} * rx;
                        const f32x4 o = xs + acc[ai][bj][m][n] * ratt;
                        u32x2 w; w.x = cvt_pk_bf16(o[0], o[1]); w.y = cvt_pk_bf16(o[2], o[3]); *(u32x2*)(x1bf + off + bj * HALF + n * 4) = w;
                        ss += (o[0] * o[0] + o[1] * o[1]) + (o[2] * o[2] + o[3] * o[3]); }
                ss += __shfl_xor(ss, 16); ss += __shfl_xor(ss, 32);
                if (fq == 0) ssq2[(size_t)row * 16 + u.pn * 4 + wc] = ss; }
        }
    }
};

template <class Epi, class Sched, bool ALIGN_EPI = false, bool SP2 = false>
__device__ __forceinline__ void gemm_phase(LAS unsigned char* lds, const Gemm g, const Sched& S, const Epi& E) {
    const int tid = threadIdx.x, wid = __builtin_amdgcn_readfirstlane(tid >> 6), lane = tid & 63, wr = wid >> 2, wc = wid & 3, fr = lane & 15, fq = lane >> 4;
    const int K = g.K, nt = K / BK;
    unsigned voffA[2], voffB[2];
#pragma unroll
    for (int i = 0; i < 2; ++i) { int R, C; stage_rc(tid * 16 + i * 8192, R, C); const int Rb = Epi::PERM ? ((R & ~31) + perm32(R & 31)) : R;
        voffA[i] = (unsigned)(R * K + C) * 2u; voffB[i] = (unsigned)(Rb * K + C) * 2u; }
    const size_t kstep = (size_t)(BK * 2);
    const size_t hstep = (size_t)HALF * K * 2;
    const size_t tstep = 2 * hstep;
    const unsigned ldsw = (unsigned)wid * 1024u;
    const int aoff = lds_byte(wr * 64 + fr, fq * 8), boff = lds_byte(wc * 32 + fr, fq * 8);
#define PG8_SA(b, h) (((b) * 2 + (h)) * HTB)
#define PG8_SB(b, h) ((4 + (b) * 2 + (h)) * HTB)
#define PG8_STAGE(bufoff, gbase, voff) do { _Pragma("unroll") for (int _i = 0; _i < 2; ++_i) \
        __builtin_amdgcn_global_load_lds((const unsigned*)((const char*)(gbase) + (voff)[_i]), (LAS unsigned*)(lds + (bufoff) + ldsw + _i * 8192), 16, 0, 0); } while (0)
#define PG8_LDA(dst, b, h) do { _Pragma("unroll") for (int m = 0; m < 4; ++m) _Pragma("unroll") for (int k = 0; k < 2; ++k) dst[m][k] = *(const LAS bf16x8*)(lds + PG8_SA(b, h) + aoff + m * 2048 + k * 1024); } while (0)
#define PG8_LDB(dst, b, h) do { _Pragma("unroll") for (int n = 0; n < 2; ++n) _Pragma("unroll") for (int k = 0; k < 2; ++k) dst[n][k] = *(const LAS bf16x8*)(lds + PG8_SB(b, h) + boff + n * 2048 + k * 1024); } while (0)
#define PG8_MMA(ai, bj, At, Bt) do { __builtin_amdgcn_s_setprio(1); _Pragma("unroll") for (int m = 0; m < 4; ++m) _Pragma("unroll") for (int n = 0; n < 2; ++n) _Pragma("unroll") for (int k = 0; k < 2; ++k) \
        acc[ai][bj][m][n] = __builtin_amdgcn_mfma_f32_16x16x32_bf16(Bt[n][k], At[m][k], acc[ai][bj][m][n], 0, 0, 0); __builtin_amdgcn_s_setprio(0); } while (0)
#define PG8_WAIT_V(n) asm volatile("s_waitcnt vmcnt(" #n ")" ::: "memory")
#define PG8_WAIT_L(n) asm volatile("s_waitcnt lgkmcnt(" #n ")" ::: "memory")
#define PG8_BAR __builtin_amdgcn_s_barrier()
#define PG8_SCHED __builtin_amdgcn_sched_barrier(0)
    Unit cur, nxt; int ui = 0;
    if (!S.next(0, cur)) return;
    f32x4 acc[2][2][4][2];
#pragma unroll
    for (int a = 0; a < 2; ++a)
#pragma unroll
        for (int b = 0; b < 2; ++b)
#pragma unroll
            for (int m = 0; m < 4; ++m)
#pragma unroll
                for (int n = 0; n < 2; ++n) acc[a][b][m][n] = (f32x4){0.f, 0.f, 0.f, 0.f};
    bf16x8 At[4][2], B0[2][2], B1[2][2];
    const char* cA = (const char*)g.A + (size_t)cur.pm * tstep; const char* cB = (const char*)g.Bt + (size_t)cur.pn * tstep;
    S.a_ready(cur);
    if constexpr (SP2) {
        PG8_STAGE(PG8_SB(0, 0), cB, voffB); PG8_STAGE(PG8_SB(0, 1), cB + hstep, voffB); PG8_STAGE(PG8_SA(0, 0), cA, voffA); PG8_STAGE(PG8_SA(0, 1), cA + hstep, voffA);
        if (wr == 1) PG8_BAR;
        PG8_WAIT_V(2); PG8_BAR;
        PG8_STAGE(PG8_SB(1, 0), cB + kstep, voffB); PG8_STAGE(PG8_SA(1, 0), cA + kstep, voffA); PG8_STAGE(PG8_SB(1, 1), cB + hstep + kstep, voffB);
        PG8_WAIT_V(6); PG8_BAR;
    } else {
        PG8_STAGE(PG8_SB(0, 0), cB, voffB); PG8_STAGE(PG8_SA(0, 0), cA, voffA); PG8_STAGE(PG8_SB(0, 1), cB + hstep, voffB); PG8_STAGE(PG8_SA(0, 1), cA + hstep, voffA);
        if (wr == 1) PG8_BAR;
        PG8_WAIT_V(4); PG8_BAR;
        PG8_STAGE(PG8_SB(1, 0), cB + kstep, voffB); PG8_STAGE(PG8_SA(1, 0), cA + kstep, voffA); PG8_STAGE(PG8_SB(1, 1), cB + hstep + kstep, voffB);
        PG8_WAIT_V(6); PG8_BAR;
    }
    for (;;) {
        const bool has_next = S.next(ui + 1, nxt);
        const char* nA = has_next ? (const char*)g.A + (size_t)nxt.pm * tstep : cA; const char* nB = has_next ? (const char*)g.Bt + (size_t)nxt.pn * tstep : cB;
        for (int t = 0; t < nt; t += 2) {
            const bool last = (t == nt - 2);
            const char* a1 = cA + (size_t)(t + 1) * kstep;
            const char* a2 = last ? nA : cA + (size_t)(t + 2) * kstep; const char* b2 = last ? nB : cB + (size_t)(t + 2) * kstep;
            const char* a3 = a2 + kstep; const char* b3 = b2 + kstep;
            if (last && has_next) S.a_ready(nxt);
            if (Epi::MID && t == nt / 2) { E.mid(acc, cur, wr, wc, fr, fq); PG8_WAIT_L(0); PG8_SCHED; }
            if constexpr (SP2) {
            PG8_LDB(B0, 0, 0); PG8_LDB(B1, 0, 1); PG8_SCHED; PG8_LDA(At, 0, 0); PG8_STAGE(PG8_SA(1, 1), a1 + hstep, voffA);
            PG8_WAIT_V(8); PG8_WAIT_L(0); PG8_BAR; PG8_MMA(0, 0, At, B0); PG8_MMA(0, 1, At, B1); PG8_BAR; PG8_SCHED;
            PG8_LDA(At, 0, 1); PG8_STAGE(PG8_SB(0, 0), b2, voffB); PG8_STAGE(PG8_SB(0, 1), b2 + hstep, voffB); PG8_STAGE(PG8_SA(0, 0), a2, voffA);
            PG8_WAIT_V(8); PG8_WAIT_L(0); PG8_BAR; PG8_MMA(1, 0, At, B0); PG8_MMA(1, 1, At, B1); PG8_BAR; PG8_SCHED;
            PG8_LDB(B0, 1, 0); PG8_LDB(B1, 1, 1); PG8_SCHED; PG8_LDA(At, 1, 0); PG8_STAGE(PG8_SA(0, 1), a2 + hstep, voffA);
            PG8_WAIT_V(8); PG8_WAIT_L(0); PG8_BAR; PG8_MMA(0, 0, At, B0); PG8_MMA(0, 1, At, B1); PG8_BAR; PG8_SCHED;
            PG8_LDA(At, 1, 1); PG8_STAGE(PG8_SB(1, 0), b3, voffB); PG8_STAGE(PG8_SB(1, 1), b3 + hstep, voffB); PG8_STAGE(PG8_SA(1, 0), a3, voffA);
            PG8_WAIT_V(8); PG8_WAIT_L(0); PG8_BAR; PG8_MMA(1, 0, At, B0); PG8_MMA(1, 1, At, B1); PG8_BAR; PG8_SCHED;
            } else {
            PG8_LDB(B0, 0, 0); PG8_SCHED; PG8_LDA(At, 0, 0); PG8_STAGE(PG8_SA(1, 1), a1 + hstep, voffA);
            PG8_WAIT_L(8); PG8_BAR; PG8_WAIT_L(0); PG8_MMA(0, 0, At, B0); PG8_BAR; PG8_SCHED;
            PG8_LDB(B1, 0, 1); PG8_STAGE(PG8_SB(0, 0), b2, voffB);
            PG8_BAR; PG8_WAIT_L(0); PG8_MMA(0, 1, At, B1); PG8_BAR;
            PG8_LDA(At, 0, 1); PG8_STAGE(PG8_SA(0, 0), a2, voffA);
            PG8_BAR; PG8_WAIT_L(0); PG8_MMA(1, 0, At, B0); PG8_BAR; PG8_SCHED;
            PG8_STAGE(PG8_SB(0, 1), b2 + hstep, voffB);
            PG8_WAIT_V(6); PG8_BAR; PG8_MMA(1, 1, At, B1); PG8_BAR;
            PG8_LDB(B0, 1, 0); PG8_SCHED; PG8_LDA(At, 1, 0); PG8_STAGE(PG8_SA(0, 1), a2 + hstep, voffA);
            PG8_WAIT_L(8); PG8_BAR; PG8_WAIT_L(0); PG8_MMA(0, 0, At, B0); PG8_BAR; PG8_SCHED;
            PG8_LDB(B1, 1, 1); PG8_STAGE(PG8_SB(1, 0), b3, voffB);
            PG8_BAR; PG8_WAIT_L(0); PG8_MMA(0, 1, At, B1); PG8_BAR;
            PG8_LDA(At, 1, 1); PG8_STAGE(PG8_SA(1, 0), a3, voffA);
            PG8_BAR; PG8_WAIT_L(0); PG8_MMA(1, 0, At, B0); PG8_BAR; PG8_SCHED;
            PG8_STAGE(PG8_SB(1, 1), b3 + hstep, voffB);
            PG8_WAIT_V(6); PG8_BAR; PG8_MMA(1, 1, At, B1); PG8_BAR;
            }
        }
        if constexpr (ALIGN_EPI) { if (wr == 0) PG8_BAR; }
        E(acc, cur, wr, wc, fr, fq); S.done(cur);
        if (!has_next) break;
#pragma unroll
        for (int a = 0; a < 2; ++a)
#pragma unroll
            for (int b = 0; b < 2; ++b)
#pragma unroll
                for (int m = 0; m < 4; ++m)
#pragma unroll
                    for (int n = 0; n < 2; ++n) acc[a][b][m][n] = (f32x4){0.f, 0.f, 0.f, 0.f};
        cur = nxt; cA = nA; cB = nB; ++ui;
        if constexpr (ALIGN_EPI) { if (wr == 1) PG8_BAR; }
    }
    PG8_WAIT_V(0);
    if constexpr (!ALIGN_EPI) { if (wr == 0) PG8_BAR; }
    PG8_BAR;
#undef PG8_SA
#undef PG8_SB
#undef PG8_STAGE
#undef PG8_LDA
#undef PG8_LDB
#undef PG8_MMA
#undef PG8_WAIT_V
#undef PG8_WAIT_L
#undef PG8_BAR
#undef PG8_SCHED
}
}

#define XB_TMO      128
#define XB_XCNT(j)  (256  + 64 * (j))
#define XB_XSUB(j)  (1280 + 64 * (j))
#define XB_XGEN(j)  (2304 + 64 * (j))
#define XB_TOP      3328
#define XB_TOPGEN   3392
#define XCD_BAR_WORDS 3456
#define XB_SPIN_CAP (1u << 18)
__device__ __forceinline__ unsigned xb_ld(unsigned* p)              { return __hip_atomic_load(p, __ATOMIC_RELAXED, __HIP_MEMORY_SCOPE_AGENT); }
__device__ __forceinline__ unsigned xb_add(unsigned* p, unsigned v) { return __hip_atomic_fetch_add(p, v, __ATOMIC_RELAXED, __HIP_MEMORY_SCOPE_AGENT); }
__device__ __forceinline__ unsigned xb_xcc_id() { return (unsigned)__builtin_amdgcn_s_getreg((3 << 11) | 20) & 0xFu; }
#define XB_SPIN(cond, bar) do { unsigned _sp = 0; while (cond) { __builtin_amdgcn_s_sleep(1); \
    if ((++_sp & 255u) == 0u) { if (xb_ld(&(bar)[XB_TMO])) break; if (_sp > XB_SPIN_CAP) { atomicAdd(&(bar)[XB_TMO], 1u); break; } } } } while (0)
struct XcdBarrier { unsigned* bar; unsigned x; volatile LAS unsigned* st; };
__device__ __forceinline__ XcdBarrier xcd_barrier_post(unsigned* bar, volatile LAS unsigned* st) {
    XcdBarrier b; b.bar = bar; b.x = xb_xcc_id(); b.st = st;
    if (threadIdx.x == 0) (void)xb_add(&bar[XB_XCNT(b.x)], 1u);
    return b;
}
__device__ __forceinline__ void xcd_barrier_complete(unsigned* bar, unsigned x, unsigned& nloc, unsigned& nx) {
    const unsigned G = gridDim.x * gridDim.y * gridDim.z;
    unsigned sum, cnt, mine, sp = 0u;
    for (;;) {
        sum = 0u; cnt = 0u; mine = 0u;
#pragma unroll
        for (unsigned j = 0; j < 16; ++j) { const unsigned c = xb_ld(&bar[XB_XCNT(j)]); sum += c; cnt += (c > 0u) ? 1u : 0u; mine = (j == x) ? c : mine; }
        if (sum == G) break;
        __builtin_amdgcn_s_sleep(1);
        if ((++sp & 255u) == 0u) { if (xb_ld(&bar[XB_TMO])) break; if (sp > XB_SPIN_CAP) { atomicAdd(&bar[XB_TMO], 1u); break; } }
    }
    nloc = mine > 0u ? mine : 1u; nx = cnt > 0u ? cnt : 1u;
}
__device__ __forceinline__ void xcd_barrier(const XcdBarrier& b) {
    asm volatile("s_waitcnt vmcnt(0)" ::: "memory");
    __syncthreads();
    if (threadIdx.x == 0) {
        unsigned* bar = b.bar;
        __builtin_amdgcn_s_waitcnt(0);
        unsigned nloc = b.st[0], nx = b.st[1];
        if (nloc == 0u) { xcd_barrier_complete(bar, b.x, nloc, nx); b.st[0] = nloc; b.st[1] = nx; }
        const unsigned old = xb_add(&bar[XB_XSUB(b.x)], 1u);
        const unsigned gen = old / nloc;
        if (old + 1u == (gen + 1u) * nloc) {
            __builtin_amdgcn_fence(__ATOMIC_RELEASE, "agent");
            asm volatile("s_waitcnt vmcnt(0)" ::: "memory");
            const unsigned og = xb_add(&bar[XB_TOP], 1u);
            const unsigned tg = og / nx;
            if (og + 1u == (tg + 1u) * nx) xb_add(&bar[XB_TOPGEN], 1u);
            else XB_SPIN(xb_ld(&bar[XB_TOPGEN]) == tg, bar);
            __builtin_amdgcn_fence(__ATOMIC_ACQUIRE, "agent");
            xb_add(&bar[XB_XGEN(b.x)], 1u);
            asm volatile("s_waitcnt vmcnt(0)" ::: "memory");
        } else {
            XB_SPIN(xb_ld(&bar[XB_XGEN(b.x)]) == gen, bar);
            __builtin_amdgcn_fence(__ATOMIC_ACQUIRE, "agent");
            asm volatile("s_waitcnt vmcnt(0)" ::: "memory");
        }
    }
    __syncthreads();
}

constexpr int NWAVES = 8;
constexpr int RING_BYTES = 131072, MISC_OFF = RING_BYTES, RS_OFF = RING_BYTES + 512, LDS_BYTES = 147456;
constexpr int CW_BAR = 4096;
constexpr int CW_ATTQ = 64;

__device__ __forceinline__ float dpp_add(float v, float o) { return v + o; }
__device__ __forceinline__ float row16_sum(float v) {
    v += DPP_F(v, 0xB1); v += DPP_F(v, 0x4E); v += DPP_F(v, 0x141); v += DPP_F(v, 0x140); return v;
}
__device__ __forceinline__ float wave_sum_u(float v) {
    v = row16_sum(v);
    const int i = __builtin_bit_cast(int, v);
    return (__builtin_bit_cast(float, __builtin_amdgcn_readlane(i, 0)) + __builtin_bit_cast(float, __builtin_amdgcn_readlane(i, 16))) +
           (__builtin_bit_cast(float, __builtin_amdgcn_readlane(i, 32)) + __builtin_bit_cast(float, __builtin_amdgcn_readlane(i, 48)));
}
typedef __bf16 bf16x2_t __attribute__((ext_vector_type(2)));
__device__ __forceinline__ float dot2(unsigned a, unsigned b, float acc) { return __builtin_amdgcn_fdot2_f32_bf16(__builtin_bit_cast(bf16x2_t, a), __builtin_bit_cast(bf16x2_t, b), acc, false); }

__device__ __forceinline__ void unpack8(const u32x4 w, float (&f)[8]) {
#pragma unroll
    for (int i = 0; i < 4; ++i) { f[2 * i] = bflo(w[i]); f[2 * i + 1] = bfhi(w[i]); }
}
typedef float f32x2 __attribute__((ext_vector_type(2)));
constexpr int CW_QU = 8192, CW_QV = 8192 + 512;
template <int M> __device__ __forceinline__ float xor_lane(float v) {
    if (M < 32) return __builtin_bit_cast(float, __builtin_amdgcn_ds_swizzle(__builtin_bit_cast(int, v), (M << 10) | 0x1f));
    return __shfl_xor(v, M);
}
__device__ __forceinline__ float fsel(int m, float a, float b) { return __builtin_bit_cast(float, (__builtin_bit_cast(int, a) & m) | (__builtin_bit_cast(int, b) & ~m)); }
__device__ __forceinline__ void fp8x16_to_f32(const u32x4 w, float (&f)[16]) {
#pragma unroll
    for (int q = 0; q < 4; ++q) { const f32x2 lo = __builtin_amdgcn_cvt_pk_f32_fp8((int)w[q], false), hi = __builtin_amdgcn_cvt_pk_f32_fp8((int)w[q], true);
        f[4 * q] = lo.x; f[4 * q + 1] = lo.y; f[4 * q + 2] = hi.x; f[4 * q + 3] = hi.y; }
}
template <int WHICH> struct SliceTok {
    u32x4 vv[16]; f32x2 o; float r0, r1, wsc; int t, ia, ib, wd;
    __device__ __forceinline__ void idx(const Ptrs& P, int t_, int lane) { const unsigned short* ip = (const unsigned short*)(P.ws + WS_IDX16) + (size_t)t_ * 128; ia = ip[(unsigned)lane]; ib = ip[(unsigned)(64 + lane)]; }
    __device__ __forceinline__ void load(const Ptrs& P, int t_, int j, int lane) {
        t = t_;
        const unsigned char* ws = P.ws;
        const int sl = lane >> 3, p = lane & 7;
        const unsigned char* TAB = ws + (WHICH ? WS_EV : WS_EU) + (size_t)j * SLICE_BYTES;
        const int baddr = 4 * sl;
        if (WHICH == 1) { wd = ((const int*)(ws + WS_W))[(unsigned)(t * 32 + (lane & 31))]; wsc = ((const float*)(ws + WS_R1))[t];
            const int col = 128 * j + 16 * p + 8 * ((lane >> 5) & 1) + 4 * ((lane >> 4) & 1) + 2 * ((lane >> 3) & 1); { const unsigned xw = *(const unsigned*)((const bf16*)(ws + WS_X1BF) + (size_t)t * D + (unsigned)col); o = (f32x2){bflo(xw), bfhi(xw)}; } }
#pragma unroll
        for (int i = 0; i < 16; ++i) { const int e = __builtin_amdgcn_ds_bpermute(baddr + 32 * (i & 7), (i < 8) ? ia : ib); vv[i] = *(const u32x4*)(TAB + (unsigned)(e * 128 + 16 * p)); }
    }
    __device__ __forceinline__ void compute(int lane, const LAS unsigned char* xqp, float sx) {
        const int sl = lane >> 3;
        const int baddr = 4 * sl;
        if (WHICH == 0) {
            const i32x4 xq = *(const LAS i32x4*)xqp;
            int d[16];
#pragma unroll
            for (int i = 0; i < 16; ++i) { int a = 0;
#pragma unroll
                for (int q = 0; q < 4; ++q) a = __builtin_amdgcn_sdot4((int)vv[i][q], xq[q], a, false);
                d[i] = a; }
#pragma unroll
            for (int st = 0; st < 3; ++st) { const int M = 1 << st, n = 8 >> st; const int hm = (lane & M) ? -1 : 0;
#pragma unroll
                for (int i = 0; i < 8; ++i) if (i < n) { const int keep = (d[n + i] & hm) | (d[i] & ~hm), send = (d[i] & hm) | (d[n + i] & ~hm);
                    d[i] = keep + ((st == 0) ? DPP_I(send, 0xB1) : (st == 1) ? DPP_I(send, 0x4E) : __builtin_amdgcn_ds_swizzle(send, (4 << 10) | 0x1f)); } }
            r0 = (float)d[0] * sx; r1 = (float)d[1] * sx;
            (void)baddr;
        } else {
            int wq[4];
#pragma unroll
            for (int b = 0; b < 4; ++b) wq[b] = __builtin_amdgcn_ds_bpermute(16 * sl + 4 * b, wd);
            int acc[16];
#pragma unroll
            for (int c = 0; c < 16; ++c) acc[c] = 0;
#pragma unroll
            for (int b = 0; b < 4; ++b)
#pragma unroll
                for (int q = 0; q < 4; ++q) { const unsigned r0_ = vv[4 * b][q], r1_ = vv[4 * b + 1][q], r2_ = vv[4 * b + 2][q], r3_ = vv[4 * b + 3][q];
                    const unsigned t01l = __builtin_amdgcn_perm(r1_, r0_, 0x05010400u), t01h = __builtin_amdgcn_perm(r1_, r0_, 0x07030602u);
                    const unsigned t23l = __builtin_amdgcn_perm(r3_, r2_, 0x05010400u), t23h = __builtin_amdgcn_perm(r3_, r2_, 0x07030602u);
                    const unsigned c0 = __builtin_amdgcn_perm(t23l, t01l, 0x05040100u), c1 = __builtin_amdgcn_perm(t23l, t01l, 0x07060302u);
                    const unsigned c2 = __builtin_amdgcn_perm(t23h, t01h, 0x05040100u), c3 = __builtin_amdgcn_perm(t23h, t01h, 0x07060302u);
                    acc[4 * q] = __builtin_amdgcn_sdot4((int)c0, wq[b], acc[4 * q], false); acc[4 * q + 1] = __builtin_amdgcn_sdot4((int)c1, wq[b], acc[4 * q + 1], false);
                    acc[4 * q + 2] = __builtin_amdgcn_sdot4((int)c2, wq[b], acc[4 * q + 2], false); acc[4 * q + 3] = __builtin_amdgcn_sdot4((int)c3, wq[b], acc[4 * q + 3], false); }
#pragma unroll
            for (int st = 0; st < 3; ++st) { const int M = 32 >> st, n = 8 >> st; const int hm = (lane & M) ? -1 : 0;
#pragma unroll
                for (int i = 0; i < 8; ++i) if (i < n) { const int keep = (acc[n + i] & hm) | (acc[i] & ~hm), send = (acc[i] & hm) | (acc[n + i] & ~hm);
                    acc[i] = keep + ((st == 0) ? __shfl_xor(send, 32) : (st == 1) ? __builtin_amdgcn_ds_swizzle(send, (16 << 10) | 0x1f) : __builtin_amdgcn_ds_swizzle(send, (8 << 10) | 0x1f)); } }
            r0 = (float)acc[0] * wsc; r1 = (float)acc[1] * wsc;
        }
    }
    __device__ __forceinline__ void store(const Ptrs& P, int j, int lane) {
        const int sl = lane >> 3, p = lane & 7;
        if (WHICH == 0) { const int i0 = 8 * (lane & 1) + 4 * ((lane >> 1) & 1) + 2 * ((lane >> 2) & 1);
            float* pp = (float*)(P.ws + WS_PART) + ((size_t)j * T + t) * 128;
            pp[(unsigned)(8 * i0 + sl)] = r0; pp[(unsigned)(8 * i0 + 8 + sl)] = r1; }
        else { const int col = 128 * j + 16 * p + 8 * ((lane >> 5) & 1) + 4 * ((lane >> 4) & 1) + 2 * ((lane >> 3) & 1);
            f32x2 q = o; q.x += r0; q.y += r1; *(f32x2*)(P.out + (size_t)t * D + (unsigned)col) = q; }
    }
};
template <int WHICH> __device__ __forceinline__ void p6_sliced(const Ptrs& P, LAS unsigned char* lds, volatile LAS unsigned* MISC, unsigned* ctl, int tid, int lane, int wave) {
    const int my = (int)(xb_xcc_id() & 7u);
    LAS unsigned char* XQ = lds + wave * 1024;
    LAS float* SX = (LAS float*)(lds + 8192 + wave * 32);
    for (int off = 0; off < 8; ++off) {
        const int j = (my + off) & 7;
        unsigned* head = ctl + (WHICH ? CW_QV : CW_QU) + 64 * j;
        for (;;) {
            if (tid == 0) MISC[1] = atomicAdd(head, 1u);
            __syncthreads();
            const int blk = (int)MISC[1];
            __syncthreads();
            if (blk >= T / 64) break;
            const int t0 = blk * 64 + wave * 8;
            int la = lane; asm volatile("" : "+v"(la));
            SliceTok<WHICH> A, B;
            A.idx(P, t0, la); B.idx(P, t0 + 1, la);
            A.load(P, t0, j, la);
            if (WHICH == 0) {
                const bf16* xb = (const bf16*)(P.ws + WS_X1BF) + (size_t)(t0 + (la >> 3)) * D + (unsigned)(128 * j + 16 * (la & 7));
                const u32x4 xw0 = *(const u32x4*)xb, xw1 = *(const u32x4*)(xb + 8);
                float xf[16]; { float t8[8]; unpack8(xw0, t8);
#pragma unroll
                    for (int i = 0; i < 8; ++i) xf[i] = t8[i];
                    unpack8(xw1, t8);
#pragma unroll
                    for (int i = 0; i < 8; ++i) xf[8 + i] = t8[i]; }
                float mx = 0.f;
#pragma unroll
                for (int i = 0; i < 16; ++i) mx = fmaxf(mx, fabsf(xf[i]));
                mx = fmaxf(mx, DPP_F(mx, 0xB1)); mx = fmaxf(mx, DPP_F(mx, 0x4E)); mx = fmaxf(mx, DPP_F(mx, 0x141));
                mx = fmaxf(mx, 1e-30f);
                const float xinv = 127.0f * __builtin_amdgcn_rcpf(mx);
                i32x4 xq;
#pragma unroll
                for (int q = 0; q < 4; ++q) { const int q0 = (int)rintf(xf[4 * q] * xinv), q1 = (int)rintf(xf[4 * q + 1] * xinv), q2 = (int)rintf(xf[4 * q + 2] * xinv), q3 = (int)rintf(xf[4 * q + 3] * xinv);
                    xq[q] = (int)((unsigned)(q0 & 0xff) | ((unsigned)(q1 & 0xff) << 8) | ((unsigned)(q2 & 0xff) << 16) | ((unsigned)q3 << 24)); }
                *(LAS i32x4*)(XQ + 16 * la) = xq;
                if ((la & 7) == 0) SX[la >> 3] = mx * (1.0f / 127.0f);
            }
            const LAS unsigned char* xqp = XQ + 16 * (la & 7);
#pragma unroll
            for (int n = 0; n < 8; n += 2) {
                B.load(P, t0 + n + 1, j, la);
                if (n + 2 < 8) A.idx(P, t0 + n + 2, la);
                A.compute(la, xqp + 128 * n, (WHICH == 0) ? SX[n] : 0.f); A.store(P, j, la);
                if (n + 2 < 8) { A.load(P, t0 + n + 2, j, la); B.idx(P, t0 + n + 3, la); }
                B.compute(la, xqp + 128 * (n + 1), (WHICH == 0) ? SX[n + 1] : 0.f); B.store(P, j, la);
            }
        }
    }
}

__device__ __forceinline__ void p6_v2(const Ptrs& P, volatile LAS unsigned* MISC, unsigned* ctl, int tid, int lane, int wave) {
    const int my = (int)(xb_xcc_id() & 7u);
    const unsigned char* ws = P.ws;
    constexpr int PD = 6;
    for (int off = 0; off < 8; ++off) {
        const int j = (my + off) & 7;
        unsigned* head = ctl + CW_QV + 64 * j;
        const unsigned char* TAB = ws + WS_EV + (size_t)j * SLICE_BYTES;
        for (;;) {
            if (tid == 0) MISC[1] = atomicAdd(head, 1u);
            __syncthreads();
            const int blk = (int)MISC[1];
            __syncthreads();
            if (blk >= T / 64) break;
            int la = lane; asm volatile("" : "+v"(la));
            const int t = blk * 64 + wave * 8 + (la >> 3);
            const unsigned pb = 16u * (unsigned)(la & 7);
            const unsigned char* idp = ws + WS_IDX16 + (unsigned)(t * 256);
            const unsigned char* wp = ws + WS_W + (unsigned)(t * 128);
            u32x4 ids[16];
#pragma unroll
            for (int c = 0; c < 16; ++c) ids[c] = *(const u32x4*)(idp + 16 * c);
            u32x4 vv[PD + 1][4];
#define P6V_ISSUE(q_) do { _Pragma("unroll") for (int e_ = 0; e_ < 4; ++e_) { const int k_ = 4 * (q_) + e_; const unsigned word = ids[k_ >> 3][(k_ & 7) >> 1]; \
                const unsigned ex = (k_ & 1) ? (word >> 16) : (word & 0xffffu); vv[(q_) % (PD + 1)][e_] = *(const u32x4*)(TAB + (ex * 128u + pb)); } } while (0)
#pragma unroll
            for (int q = 0; q < PD; ++q) P6V_ISSUE(q);
            const u32x4 xr0 = *(const u32x4*)((const bf16*)(ws + WS_X1BF) + (size_t)t * D + (unsigned)(128 * j) + pb), xr1 = *(const u32x4*)((const bf16*)(ws + WS_X1BF) + (size_t)t * D + (unsigned)(128 * j) + pb + 8);
            const float wsc = ((const float*)(ws + WS_R1))[t];
            u32x4 wq[8];
#pragma unroll
            for (int c = 0; c < 8; ++c) wq[c] = *(const u32x4*)(wp + 16 * c);
            int acc[16];
#pragma unroll
            for (int c = 0; c < 16; ++c) acc[c] = 0;
#pragma unroll
            for (int q = 0; q < 32; ++q) {
                if (q + PD < 32) P6V_ISSUE(q + PD);
                const int wv = (int)wq[q >> 2][q & 3];
#pragma unroll
                for (int d = 0; d < 4; ++d) { const unsigned r0_ = vv[q % (PD + 1)][0][d], r1_ = vv[q % (PD + 1)][1][d], r2_ = vv[q % (PD + 1)][2][d], r3_ = vv[q % (PD + 1)][3][d];
                    const unsigned t01l = __builtin_amdgcn_perm(r1_, r0_, 0x05010400u), t01h = __builtin_amdgcn_perm(r1_, r0_, 0x07030602u);
                    const unsigned t23l = __builtin_amdgcn_perm(r3_, r2_, 0x05010400u), t23h = __builtin_amdgcn_perm(r3_, r2_, 0x07030602u);
                    const unsigned c0 = __builtin_amdgcn_perm(t23l, t01l, 0x05040100u), c1 = __builtin_amdgcn_perm(t23l, t01l, 0x07060302u);
                    const unsigned c2 = __builtin_amdgcn_perm(t23h, t01h, 0x05040100u), c3 = __builtin_amdgcn_perm(t23h, t01h, 0x07060302u);
                    acc[4 * d] = __builtin_amdgcn_sdot4((int)c0, wv, acc[4 * d], false); acc[4 * d + 1] = __builtin_amdgcn_sdot4((int)c1, wv, acc[4 * d + 1], false);
                    acc[4 * d + 2] = __builtin_amdgcn_sdot4((int)c2, wv, acc[4 * d + 2], false); acc[4 * d + 3] = __builtin_amdgcn_sdot4((int)c3, wv, acc[4 * d + 3], false); }
            }
#undef P6V_ISSUE
            float xf[16]; { float t8[8]; unpack8(xr0, t8);
#pragma unroll
                for (int i = 0; i < 8; ++i) xf[i] = t8[i];
                unpack8(xr1, t8);
#pragma unroll
                for (int i = 0; i < 8; ++i) xf[8 + i] = t8[i]; }
            float* op = P.out + (size_t)t * D + (unsigned)(128 * j) + pb;
#pragma unroll
            for (int c4 = 0; c4 < 4; ++c4) *(f32x4*)(op + 4 * c4) = (f32x4){xf[4 * c4] + (float)acc[4 * c4] * wsc, xf[4 * c4 + 1] + (float)acc[4 * c4 + 1] * wsc, xf[4 * c4 + 2] + (float)acc[4 * c4 + 2] * wsc, xf[4 * c4 + 3] + (float)acc[4 * c4 + 3] * wsc};
        }
    }
}

__device__ __forceinline__ void p6_v3(const Ptrs& P, LAS unsigned char* lds, int bx, int lane, int wave) {
    const unsigned char* ws = P.ws;
    constexpr int NB = 8;
    const int j = bx & 7, wi = (bx >> 3) * 8 + wave, T0 = wi * 64;
    const unsigned char* TAB = ws + WS_EV + (size_t)j * SLICE_BYTES;
    LAS unsigned char* buf = lds + wave * 6144;
    int la = lane; asm volatile("" : "+v"(la));
    const int g = la >> 3;
    const unsigned pb = 16u * (unsigned)(la & 7);
#define V3_FETCH(b_, r0_, r1_, r2_) do { const unsigned char* ip_ = ws + WS_IDX16 + (unsigned)((T0 + 8 * (b_)) * 256) + 16u * (unsigned)la; r0_ = *(const u32x4*)ip_; r1_ = *(const u32x4*)(ip_ + 1024); \
        r2_ = *(const u32x4*)(ws + WS_W + (unsigned)((T0 + 8 * (b_)) * 128) + 16u * (unsigned)la); } while (0)
#define V3_PARK(b_, r0_, r1_, r2_) do { LAS unsigned char* d_ = buf + ((b_) & 1) * 3072; *(LAS u32x4*)(d_ + 16 * la) = r0_; *(LAS u32x4*)(d_ + 1024 + 16 * la) = r1_; *(LAS u32x4*)(d_ + 2048 + 16 * la) = r2_; } while (0)
    u32x4 f0, f1, f2;
    V3_FETCH(0, f0, f1, f2); V3_PARK(0, f0, f1, f2);
    u32x4 V00, V01, V02, V03, V10, V11, V12, V13, V20, V21, V22, V23, V30, V31, V32, V33, V40, V41, V42, V43, V50, V51, V52, V53, V60, V61, V62, V63, V70, V71, V72, V73;
#define V3_ISSUE(S_, bsel_, tq_) do { const u32x2 e2_ = *(const LAS u32x2*)(buf + (bsel_) * 3072 + g * 256 + 8 * (tq_)); \
        V##S_##0 = *(const u32x4*)(TAB + ((e2_.x & 0xffffu) * 128u + pb)); V##S_##1 = *(const u32x4*)(TAB + ((e2_.x >> 16) * 128u + pb)); \
        V##S_##2 = *(const u32x4*)(TAB + ((e2_.y & 0xffffu) * 128u + pb)); V##S_##3 = *(const u32x4*)(TAB + ((e2_.y >> 16) * 128u + pb)); } while (0)
#define V3_MAC(S_, q_) do { const int wv = *(const LAS int*)(buf + bs * 3072 + 2048 + g * 128 + 4 * (q_)); \
        _Pragma("unroll") for (int d = 0; d < 4; ++d) { const unsigned r0_ = V##S_##0[d], r1_ = V##S_##1[d], r2_ = V##S_##2[d], r3_ = V##S_##3[d]; \
            const unsigned t01l = __builtin_amdgcn_perm(r1_, r0_, 0x05010400u), t01h = __builtin_amdgcn_perm(r1_, r0_, 0x07030602u); \
            const unsigned t23l = __builtin_amdgcn_perm(r3_, r2_, 0x05010400u), t23h = __builtin_amdgcn_perm(r3_, r2_, 0x07030602u); \
            const unsigned c0 = __builtin_amdgcn_perm(t23l, t01l, 0x05040100u), c1 = __builtin_amdgcn_perm(t23l, t01l, 0x07060302u); \
            const unsigned c2 = __builtin_amdgcn_perm(t23h, t01h, 0x05040100u), c3 = __builtin_amdgcn_perm(t23h, t01h, 0x07060302u); \
            acc[4 * d] = __builtin_amdgcn_sdot4((int)c0, wv, acc[4 * d], false); acc[4 * d + 1] = __builtin_amdgcn_sdot4((int)c1, wv, acc[4 * d + 1], false); \
            acc[4 * d + 2] = __builtin_amdgcn_sdot4((int)c2, wv, acc[4 * d + 2], false); acc[4 * d + 3] = __builtin_amdgcn_sdot4((int)c3, wv, acc[4 * d + 3], false); } } while (0)
    V3_ISSUE(0, 0, 0);
    V3_ISSUE(1, 0, 1);
    V3_ISSUE(2, 0, 2);
    V3_ISSUE(3, 0, 3);
    V3_ISSUE(4, 0, 4);
    V3_ISSUE(5, 0, 5);
#pragma unroll 1
    for (int b = 0; b < NB; ++b) {
        int acc[16];
#pragma unroll
        for (int c = 0; c < 16; ++c) acc[c] = 0;
        const int bs = b & 1, t = T0 + 8 * b + g;
        const bf16* xrp = (const bf16*)(ws + WS_X1BF) + (size_t)t * D + (unsigned)(128 * j) + pb;
        const u32x4 xr0 = *(const u32x4*)xrp, xr1 = *(const u32x4*)(xrp + 8);
        const float wsc = ((const float*)(ws + WS_R1))[t];
        V3_FETCH((b + 1) & 7, f0, f1, f2);
        V3_ISSUE(6, bs, 6); V3_MAC(0, 0);
        V3_ISSUE(7, bs, 7); V3_MAC(1, 1);
        V3_ISSUE(0, bs, 8); V3_MAC(2, 2);
        V3_ISSUE(1, bs, 9); V3_MAC(3, 3);
        V3_ISSUE(2, bs, 10); V3_MAC(4, 4);
        V3_ISSUE(3, bs, 11); V3_MAC(5, 5);
        V3_ISSUE(4, bs, 12); V3_MAC(6, 6);
        V3_ISSUE(5, bs, 13); V3_MAC(7, 7);
        V3_PARK(b + 1, f0, f1, f2);
        V3_ISSUE(6, bs, 14); V3_MAC(0, 8);
        V3_ISSUE(7, bs, 15); V3_MAC(1, 9);
        V3_ISSUE(0, bs, 16); V3_MAC(2, 10);
        V3_ISSUE(1, bs, 17); V3_MAC(3, 11);
        V3_ISSUE(2, bs, 18); V3_MAC(4, 12);
        V3_ISSUE(3, bs, 19); V3_MAC(5, 13);
        V3_ISSUE(4, bs, 20); V3_MAC(6, 14);
        V3_ISSUE(5, bs, 21); V3_MAC(7, 15);
        V3_ISSUE(6, bs, 22); V3_MAC(0, 16);
        V3_ISSUE(7, bs, 23); V3_MAC(1, 17);
        V3_ISSUE(0, bs, 24); V3_MAC(2, 18);
        V3_ISSUE(1, bs, 25); V3_MAC(3, 19);
        V3_ISSUE(2, bs, 26); V3_MAC(4, 20);
        V3_ISSUE(3, bs, 27); V3_MAC(5, 21);
        V3_ISSUE(4, bs, 28); V3_MAC(6, 22);
        V3_ISSUE(5, bs, 29); V3_MAC(7, 23);
        V3_ISSUE(6, bs, 30); V3_MAC(0, 24);
        V3_ISSUE(7, bs, 31); V3_MAC(1, 25);
        V3_ISSUE(0, bs ^ 1, 0); V3_MAC(2, 26);
        V3_ISSUE(1, bs ^ 1, 1); V3_MAC(3, 27);
        V3_ISSUE(2, bs ^ 1, 2); V3_MAC(4, 28);
        V3_ISSUE(3, bs ^ 1, 3); V3_MAC(5, 29);
        V3_ISSUE(4, bs ^ 1, 4); V3_MAC(6, 30);
        V3_ISSUE(5, bs ^ 1, 5); V3_MAC(7, 31);
        float xf[16]; { float t8[8]; unpack8(xr0, t8);
#pragma unroll
            for (int i = 0; i < 8; ++i) xf[i] = t8[i];
            unpack8(xr1, t8);
#pragma unroll
            for (int i = 0; i < 8; ++i) xf[8 + i] = t8[i]; }
        float* op = P.out + (size_t)t * D + (unsigned)(128 * j) + pb;
#pragma unroll
        for (int c4 = 0; c4 < 4; ++c4) { *(f32x4*)(op + 4 * c4) = (f32x4){xf[4 * c4] + (float)acc[4 * c4] * wsc, xf[4 * c4 + 1] + (float)acc[4 * c4 + 1] * wsc, xf[4 * c4 + 2] + (float)acc[4 * c4 + 2] * wsc, xf[4 * c4 + 3] + (float)acc[4 * c4 + 3] * wsc};
        }
    }
#undef V3_MAC
#undef V3_FETCH
#undef V3_PARK
#undef V3_ISSUE
}

__device__ __forceinline__ void p6_u3(const Ptrs& P, LAS unsigned char* lds, int bx, int lane, int wave) {
    const unsigned char* ws = P.ws;
    constexpr int NB = 8;
    const int j = bx & 7, wi = (bx >> 3) * 8 + wave, T0 = wi * 64;
    const unsigned char* TAB = ws + WS_EU + (size_t)j * SLICE_BYTES;
    LAS unsigned char* buf = lds + wave * 8192;
    int la = lane; asm volatile("" : "+v"(la));
    const int sl = la >> 3, pc = la & 7;
    const unsigned pb = 16u * (unsigned)pc;
    const int i0 = 8 * (la & 1) + 4 * ((la >> 1) & 1) + 2 * ((la >> 2) & 1);
#define U3_FETCH(b_) do { const unsigned char* ip_ = ws + WS_IDX16 + (unsigned)((T0 + 8 * (b_)) * 256) + 16u * (unsigned)la; f0 = *(const u32x4*)ip_; f1 = *(const u32x4*)(ip_ + 1024); \
        const bf16* xb_ = (const bf16*)(ws + WS_X1BF) + (size_t)(T0 + 8 * (b_) + (la >> 3)) * D + (unsigned)(128 * j + 16 * (la & 7)); x0 = *(const u32x4*)xb_; x1 = *(const u32x4*)(xb_ + 8); } while (0)
#define U3_PARK(b_) do { LAS unsigned char* d_ = buf + ((b_) & 1) * 4096; *(LAS u32x4*)(d_ + 16 * la) = f0; *(LAS u32x4*)(d_ + 1024 + 16 * la) = f1; \
        float xf[16]; { float t8[8]; unpack8(x0, t8); _Pragma("unroll") for (int i = 0; i < 8; ++i) xf[i] = t8[i]; unpack8(x1, t8); _Pragma("unroll") for (int i = 0; i < 8; ++i) xf[8 + i] = t8[i]; } \
        float mx = 0.f; _Pragma("unroll") for (int i = 0; i < 16; ++i) mx = fmaxf(mx, fabsf(xf[i])); \
        mx = fmaxf(mx, DPP_F(mx, 0xB1)); mx = fmaxf(mx, DPP_F(mx, 0x4E)); mx = fmaxf(mx, DPP_F(mx, 0x141)); mx = fmaxf(mx, 1e-30f); \
        const float xinv = 127.0f * __builtin_amdgcn_rcpf(mx); i32x4 xq_; \
        _Pragma("unroll") for (int q = 0; q < 4; ++q) { const int q0 = (int)rintf(xf[4 * q] * xinv), q1 = (int)rintf(xf[4 * q + 1] * xinv), q2 = (int)rintf(xf[4 * q + 2] * xinv), q3 = (int)rintf(xf[4 * q + 3] * xinv); \
            xq_[q] = (int)((unsigned)(q0 & 0xff) | ((unsigned)(q1 & 0xff) << 8) | ((unsigned)(q2 & 0xff) << 16) | ((unsigned)q3 << 24)); } \
        *(LAS i32x4*)(d_ + 2048 + 16 * la) = xq_; if ((la & 7) == 0) *(LAS float*)(d_ + 3072 + 4 * (la >> 3)) = mx * (1.0f / 127.0f); } while (0)
    u32x4 f0, f1, x0, x1;
    u32x4 A0, A1, A2, A3, A4, A5, A6, A7, A8, A9, A10, A11, A12, A13, A14, A15;
    u32x4 B0, B1, B2, B3, B4, B5, B6, B7, B8, B9, B10, B11, B12, B13, B14, B15;
    U3_FETCH(0); U3_PARK(0);
    { const LAS unsigned char* ip_ = buf + (0) * 4096 + 0 * 256 + 32 * sl; const u32x4 e0_ = *(const LAS u32x4*)ip_, e1_ = *(const LAS u32x4*)(ip_ + 16);
        A0 = *(const u32x4*)(TAB + ((e0_[0] & 0xffffu) * 128u + pb));
        A1 = *(const u32x4*)(TAB + ((e0_[0] >> 16) * 128u + pb));
        A2 = *(const u32x4*)(TAB + ((e0_[1] & 0xffffu) * 128u + pb));
        A3 = *(const u32x4*)(TAB + ((e0_[1] >> 16) * 128u + pb));
        A4 = *(const u32x4*)(TAB + ((e0_[2] & 0xffffu) * 128u + pb));
        A5 = *(const u32x4*)(TAB + ((e0_[2] >> 16) * 128u + pb));
        A6 = *(const u32x4*)(TAB + ((e0_[3] & 0xffffu) * 128u + pb));
        A7 = *(const u32x4*)(TAB + ((e0_[3] >> 16) * 128u + pb));
        A8 = *(const u32x4*)(TAB + ((e1_[0] & 0xffffu) * 128u + pb));
        A9 = *(const u32x4*)(TAB + ((e1_[0] >> 16) * 128u + pb));
        A10 = *(const u32x4*)(TAB + ((e1_[1] & 0xffffu) * 128u + pb));
        A11 = *(const u32x4*)(TAB + ((e1_[1] >> 16) * 128u + pb));
        A12 = *(const u32x4*)(TAB + ((e1_[2] & 0xffffu) * 128u + pb));
        A13 = *(const u32x4*)(TAB + ((e1_[2] >> 16) * 128u + pb));
        A14 = *(const u32x4*)(TAB + ((e1_[3] & 0xffffu) * 128u + pb));
        A15 = *(const u32x4*)(TAB + ((e1_[3] >> 16) * 128u + pb));
    }
#pragma unroll 1
    for (int b = 0; b < NB; ++b) {
        const int bs = b & 1;
        U3_FETCH((b + 1) & 7);
        { const LAS unsigned char* ip_ = buf + (bs) * 4096 + 1 * 256 + 32 * sl; const u32x4 e0_ = *(const LAS u32x4*)ip_, e1_ = *(const LAS u32x4*)(ip_ + 16);
            B0 = *(const u32x4*)(TAB + ((e0_[0] & 0xffffu) * 128u + pb));
            B1 = *(const u32x4*)(TAB + ((e0_[0] >> 16) * 128u + pb));
            B2 = *(const u32x4*)(TAB + ((e0_[1] & 0xffffu) * 128u + pb));
            B3 = *(const u32x4*)(TAB + ((e0_[1] >> 16) * 128u + pb));
            B4 = *(const u32x4*)(TAB + ((e0_[2] & 0xffffu) * 128u + pb));
            B5 = *(const u32x4*)(TAB + ((e0_[2] >> 16) * 128u + pb));
            B6 = *(const u32x4*)(TAB + ((e0_[3] & 0xffffu) * 128u + pb));
            B7 = *(const u32x4*)(TAB + ((e0_[3] >> 16) * 128u + pb));
            B8 = *(const u32x4*)(TAB + ((e1_[0] & 0xffffu) * 128u + pb));
            B9 = *(const u32x4*)(TAB + ((e1_[0] >> 16) * 128u + pb));
            B10 = *(const u32x4*)(TAB + ((e1_[1] & 0xffffu) * 128u + pb));
            B11 = *(const u32x4*)(TAB + ((e1_[1] >> 16) * 128u + pb));
            B12 = *(const u32x4*)(TAB + ((e1_[2] & 0xffffu) * 128u + pb));
            B13 = *(const u32x4*)(TAB + ((e1_[2] >> 16) * 128u + pb));
            B14 = *(const u32x4*)(TAB + ((e1_[3] & 0xffffu) * 128u + pb));
            B15 = *(const u32x4*)(TAB + ((e1_[3] >> 16) * 128u + pb));
        }
        { const i32x4 xq = *(const LAS i32x4*)(buf + bs * 4096 + 2048 + 0 * 128 + 16 * pc); const float sx = *(const LAS float*)(buf + bs * 4096 + 3072 + 4 * 0);
            int d[16];
            d[0] = __builtin_amdgcn_sdot4((int)A0[3], xq[3], __builtin_amdgcn_sdot4((int)A0[2], xq[2], __builtin_amdgcn_sdot4((int)A0[1], xq[1], __builtin_amdgcn_sdot4((int)A0[0], xq[0], 0, false), false), false), false);
            d[1] = __builtin_amdgcn_sdot4((int)A1[3], xq[3], __builtin_amdgcn_sdot4((int)A1[2], xq[2], __builtin_amdgcn_sdot4((int)A1[1], xq[1], __builtin_amdgcn_sdot4((int)A1[0], xq[0], 0, false), false), false), false);
            d[2] = __builtin_amdgcn_sdot4((int)A2[3], xq[3], __builtin_amdgcn_sdot4((int)A2[2], xq[2], __builtin_amdgcn_sdot4((int)A2[1], xq[1], __builtin_amdgcn_sdot4((int)A2[0], xq[0], 0, false), false), false), false);
            d[3] = __builtin_amdgcn_sdot4((int)A3[3], xq[3], __builtin_amdgcn_sdot4((int)A3[2], xq[2], __builtin_amdgcn_sdot4((int)A3[1], xq[1], __builtin_amdgcn_sdot4((int)A3[0], xq[0], 0, false), false), false), false);
            d[4] = __builtin_amdgcn_sdot4((int)A4[3], xq[3], __builtin_amdgcn_sdot4((int)A4[2], xq[2], __builtin_amdgcn_sdot4((int)A4[1], xq[1], __builtin_amdgcn_sdot4((int)A4[0], xq[0], 0, false), false), false), false);
            d[5] = __builtin_amdgcn_sdot4((int)A5[3], xq[3], __builtin_amdgcn_sdot4((int)A5[2], xq[2], __builtin_amdgcn_sdot4((int)A5[1], xq[1], __builtin_amdgcn_sdot4((int)A5[0], xq[0], 0, false), false), false), false);
            d[6] = __builtin_amdgcn_sdot4((int)A6[3], xq[3], __builtin_amdgcn_sdot4((int)A6[2], xq[2], __builtin_amdgcn_sdot4((int)A6[1], xq[1], __builtin_amdgcn_sdot4((int)A6[0], xq[0], 0, false), false), false), false);
            d[7] = __builtin_amdgcn_sdot4((int)A7[3], xq[3], __builtin_amdgcn_sdot4((int)A7[2], xq[2], __builtin_amdgcn_sdot4((int)A7[1], xq[1], __builtin_amdgcn_sdot4((int)A7[0], xq[0], 0, false), false), false), false);
            d[8] = __builtin_amdgcn_sdot4((int)A8[3], xq[3], __builtin_amdgcn_sdot4((int)A8[2], xq[2], __builtin_amdgcn_sdot4((int)A8[1], xq[1], __builtin_amdgcn_sdot4((int)A8[0], xq[0], 0, false), false), false), false);
            d[9] = __builtin_amdgcn_sdot4((int)A9[3], xq[3], __builtin_amdgcn_sdot4((int)A9[2], xq[2], __builtin_amdgcn_sdot4((int)A9[1], xq[1], __builtin_amdgcn_sdot4((int)A9[0], xq[0], 0, false), false), false), false);
            d[10] = __builtin_amdgcn_sdot4((int)A10[3], xq[3], __builtin_amdgcn_sdot4((int)A10[2], xq[2], __builtin_amdgcn_sdot4((int)A10[1], xq[1], __builtin_amdgcn_sdot4((int)A10[0], xq[0], 0, false), false), false), false);
            d[11] = __builtin_amdgcn_sdot4((int)A11[3], xq[3], __builtin_amdgcn_sdot4((int)A11[2], xq[2], __builtin_amdgcn_sdot4((int)A11[1], xq[1], __builtin_amdgcn_sdot4((int)A11[0], xq[0], 0, false), false), false), false);
            d[12] = __builtin_amdgcn_sdot4((int)A12[3], xq[3], __builtin_amdgcn_sdot4((int)A12[2], xq[2], __builtin_amdgcn_sdot4((int)A12[1], xq[1], __builtin_amdgcn_sdot4((int)A12[0], xq[0], 0, false), false), false), false);
            d[13] = __builtin_amdgcn_sdot4((int)A13[3], xq[3], __builtin_amdgcn_sdot4((int)A13[2], xq[2], __builtin_amdgcn_sdot4((int)A13[1], xq[1], __builtin_amdgcn_sdot4((int)A13[0], xq[0], 0, false), false), false), false);
            d[14] = __builtin_amdgcn_sdot4((int)A14[3], xq[3], __builtin_amdgcn_sdot4((int)A14[2], xq[2], __builtin_amdgcn_sdot4((int)A14[1], xq[1], __builtin_amdgcn_sdot4((int)A14[0], xq[0], 0, false), false), false), false);
            d[15] = __builtin_amdgcn_sdot4((int)A15[3], xq[3], __builtin_amdgcn_sdot4((int)A15[2], xq[2], __builtin_amdgcn_sdot4((int)A15[1], xq[1], __builtin_amdgcn_sdot4((int)A15[0], xq[0], 0, false), false), false), false);
            _Pragma("unroll") for (int st = 0; st < 3; ++st) { const int M = 1 << st, nn = 8 >> st; const int hm = (la & M) ? -1 : 0;
                _Pragma("unroll") for (int i = 0; i < 8; ++i) if (i < nn) { const int keep = (d[nn + i] & hm) | (d[i] & ~hm), send = (d[i] & hm) | (d[nn + i] & ~hm);
                    d[i] = keep + ((st == 0) ? DPP_I(send, 0xB1) : (st == 1) ? DPP_I(send, 0x4E) : __builtin_amdgcn_ds_swizzle(send, (4 << 10) | 0x1f)); } }
            float* pp = (float*)(P.ws + WS_PART) + ((size_t)j * T + (unsigned)(T0 + 8 * b + 0)) * 128;
            *(f32x2*)(pp + (unsigned)(16 * sl + i0)) = (f32x2){(float)d[0] * sx, (float)d[1] * sx}; }
        { const LAS unsigned char* ip_ = buf + (bs) * 4096 + 2 * 256 + 32 * sl; const u32x4 e0_ = *(const LAS u32x4*)ip_, e1_ = *(const LAS u32x4*)(ip_ + 16);
            A0 = *(const u32x4*)(TAB + ((e0_[0] & 0xffffu) * 128u + pb));
            A1 = *(const u32x4*)(TAB + ((e0_[0] >> 16) * 128u + pb));
            A2 = *(const u32x4*)(TAB + ((e0_[1] & 0xffffu) * 128u + pb));
            A3 = *(const u32x4*)(TAB + ((e0_[1] >> 16) * 128u + pb));
            A4 = *(const u32x4*)(TAB + ((e0_[2] & 0xffffu) * 128u + pb));
            A5 = *(const u32x4*)(TAB + ((e0_[2] >> 16) * 128u + pb));
            A6 = *(const u32x4*)(TAB + ((e0_[3] & 0xffffu) * 128u + pb));
            A7 = *(const u32x4*)(TAB + ((e0_[3] >> 16) * 128u + pb));
            A8 = *(const u32x4*)(TAB + ((e1_[0] & 0xffffu) * 128u + pb));
            A9 = *(const u32x4*)(TAB + ((e1_[0] >> 16) * 128u + pb));
            A10 = *(const u32x4*)(TAB + ((e1_[1] & 0xffffu) * 128u + pb));
            A11 = *(const u32x4*)(TAB + ((e1_[1] >> 16) * 128u + pb));
            A12 = *(const u32x4*)(TAB + ((e1_[2] & 0xffffu) * 128u + pb));
            A13 = *(const u32x4*)(TAB + ((e1_[2] >> 16) * 128u + pb));
            A14 = *(const u32x4*)(TAB + ((e1_[3] & 0xffffu) * 128u + pb));
            A15 = *(const u32x4*)(TAB + ((e1_[3] >> 16) * 128u + pb));
        }
        { const i32x4 xq = *(const LAS i32x4*)(buf + bs * 4096 + 2048 + 1 * 128 + 16 * pc); const float sx = *(const LAS float*)(buf + bs * 4096 + 3072 + 4 * 1);
            int d[16];
            d[0] = __builtin_amdgcn_sdot4((int)B0[3], xq[3], __builtin_amdgcn_sdot4((int)B0[2], xq[2], __builtin_amdgcn_sdot4((int)B0[1], xq[1], __builtin_amdgcn_sdot4((int)B0[0], xq[0], 0, false), false), false), false);
            d[1] = __builtin_amdgcn_sdot4((int)B1[3], xq[3], __builtin_amdgcn_sdot4((int)B1[2], xq[2], __builtin_amdgcn_sdot4((int)B1[1], xq[1], __builtin_amdgcn_sdot4((int)B1[0], xq[0], 0, false), false), false), false);
            d[2] = __builtin_amdgcn_sdot4((int)B2[3], xq[3], __builtin_amdgcn_sdot4((int)B2[2], xq[2], __builtin_amdgcn_sdot4((int)B2[1], xq[1], __builtin_amdgcn_sdot4((int)B2[0], xq[0], 0, false), false), false), false);
            d[3] = __builtin_amdgcn_sdot4((int)B3[3], xq[3], __builtin_amdgcn_sdot4((int)B3[2], xq[2], __builtin_amdgcn_sdot4((int)B3[1], xq[1], __builtin_amdgcn_sdot4((int)B3[0], xq[0], 0, false), false), false), false);
            d[4] = __builtin_amdgcn_sdot4((int)B4[3], xq[3], __builtin_amdgcn_sdot4((int)B4[2], xq[2], __builtin_amdgcn_sdot4((int)B4[1], xq[1], __builtin_amdgcn_sdot4((int)B4[0], xq[0], 0, false), false), false), false);
            d[5] = __builtin_amdgcn_sdot4((int)B5[3], xq[3], __builtin_amdgcn_sdot4((int)B5[2], xq[2], __builtin_amdgcn_sdot4((int)B5[1], xq[1], __builtin_amdgcn_sdot4((int)B5[0], xq[0], 0, false), false), false), false);
            d[6] = __builtin_amdgcn_sdot4((int)B6[3], xq[3], __builtin_amdgcn_sdot4((int)B6[2], xq[2], __builtin_amdgcn_sdot4((int)B6[1], xq[1], __builtin_amdgcn_sdot4((int)B6[0], xq[0], 0, false), false), false), false);
            d[7] = __builtin_amdgcn_sdot4((int)B7[3], xq[3], __builtin_amdgcn_sdot4((int)B7[2], xq[2], __builtin_amdgcn_sdot4((int)B7[1], xq[1], __builtin_amdgcn_sdot4((int)B7[0], xq[0], 0, false), false), false), false);
            d[8] = __builtin_amdgcn_sdot4((int)B8[3], xq[3], __builtin_amdgcn_sdot4((int)B8[2], xq[2], __builtin_amdgcn_sdot4((int)B8[1], xq[1], __builtin_amdgcn_sdot4((int)B8[0], xq[0], 0, false), false), false), false);
            d[9] = __builtin_amdgcn_sdot4((int)B9[3], xq[3], __builtin_amdgcn_sdot4((int)B9[2], xq[2], __builtin_amdgcn_sdot4((int)B9[1], xq[1], __builtin_amdgcn_sdot4((int)B9[0], xq[0], 0, false), false), false), false);
            d[10] = __builtin_amdgcn_sdot4((int)B10[3], xq[3], __builtin_amdgcn_sdot4((int)B10[2], xq[2], __builtin_amdgcn_sdot4((int)B10[1], xq[1], __builtin_amdgcn_sdot4((int)B10[0], xq[0], 0, false), false), false), false);
            d[11] = __builtin_amdgcn_sdot4((int)B11[3], xq[3], __builtin_amdgcn_sdot4((int)B11[2], xq[2], __builtin_amdgcn_sdot4((int)B11[1], xq[1], __builtin_amdgcn_sdot4((int)B11[0], xq[0], 0, false), false), false), false);
            d[12] = __builtin_amdgcn_sdot4((int)B12[3], xq[3], __builtin_amdgcn_sdot4((int)B12[2], xq[2], __builtin_amdgcn_sdot4((int)B12[1], xq[1], __builtin_amdgcn_sdot4((int)B12[0], xq[0], 0, false), false), false), false);
            d[13] = __builtin_amdgcn_sdot4((int)B13[3], xq[3], __builtin_amdgcn_sdot4((int)B13[2], xq[2], __builtin_amdgcn_sdot4((int)B13[1], xq[1], __builtin_amdgcn_sdot4((int)B13[0], xq[0], 0, false), false), false), false);
            d[14] = __builtin_amdgcn_sdot4((int)B14[3], xq[3], __builtin_amdgcn_sdot4((int)B14[2], xq[2], __builtin_amdgcn_sdot4((int)B14[1], xq[1], __builtin_amdgcn_sdot4((int)B14[0], xq[0], 0, false), false), false), false);
            d[15] = __builtin_amdgcn_sdot4((int)B15[3], xq[3], __builtin_amdgcn_sdot4((int)B15[2], xq[2], __builtin_amdgcn_sdot4((int)B15[1], xq[1], __builtin_amdgcn_sdot4((int)B15[0], xq[0], 0, false), false), false), false);
            _Pragma("unroll") for (int st = 0; st < 3; ++st) { const int M = 1 << st, nn = 8 >> st; const int hm = (la & M) ? -1 : 0;
                _Pragma("unroll") for (int i = 0; i < 8; ++i) if (i < nn) { const int keep = (d[nn + i] & hm) | (d[i] & ~hm), send = (d[i] & hm) | (d[nn + i] & ~hm);
                    d[i] = keep + ((st == 0) ? DPP_I(send, 0xB1) : (st == 1) ? DPP_I(send, 0x4E) : __builtin_amdgcn_ds_swizzle(send, (4 << 10) | 0x1f)); } }
            float* pp = (float*)(P.ws + WS_PART) + ((size_t)j * T + (unsigned)(T0 + 8 * b + 1)) * 128;
            *(f32x2*)(pp + (unsigned)(16 * sl + i0)) = (f32x2){(float)d[0] * sx, (float)d[1] * sx}; }
        U3_PARK(b + 1);
        { const LAS unsigned char* ip_ = buf + (bs) * 4096 + 3 * 256 + 32 * sl; const u32x4 e0_ = *(const LAS u32x4*)ip_, e1_ = *(const LAS u32x4*)(ip_ + 16);
            B0 = *(const u32x4*)(TAB + ((e0_[0] & 0xffffu) * 128u + pb));
            B1 = *(const u32x4*)(TAB + ((e0_[0] >> 16) * 128u + pb));
            B2 = *(const u32x4*)(TAB + ((e0_[1] & 0xffffu) * 128u + pb));
            B3 = *(const u32x4*)(TAB + ((e0_[1] >> 16) * 128u + pb));
            B4 = *(const u32x4*)(TAB + ((e0_[2] & 0xffffu) * 128u + pb));
            B5 = *(const u32x4*)(TAB + ((e0_[2] >> 16) * 128u + pb));
            B6 = *(const u32x4*)(TAB + ((e0_[3] & 0xffffu) * 128u + pb));
            B7 = *(const u32x4*)(TAB + ((e0_[3] >> 16) * 128u + pb));
            B8 = *(const u32x4*)(TAB + ((e1_[0] & 0xffffu) * 128u + pb));
            B9 = *(const u32x4*)(TAB + ((e1_[0] >> 16) * 128u + pb));
            B10 = *(const u32x4*)(TAB + ((e1_[1] & 0xffffu) * 128u + pb));
            B11 = *(const u32x4*)(TAB + ((e1_[1] >> 16) * 128u + pb));
            B12 = *(const u32x4*)(TAB + ((e1_[2] & 0xffffu) * 128u + pb));
            B13 = *(const u32x4*)(TAB + ((e1_[2] >> 16) * 128u + pb));
            B14 = *(const u32x4*)(TAB + ((e1_[3] & 0xffffu) * 128u + pb));
            B15 = *(const u32x4*)(TAB + ((e1_[3] >> 16) * 128u + pb));
        }
        { const i32x4 xq = *(const LAS i32x4*)(buf + bs * 4096 + 2048 + 2 * 128 + 16 * pc); const float sx = *(const LAS float*)(buf + bs * 4096 + 3072 + 4 * 2);
            int d[16];
            d[0] = __builtin_amdgcn_sdot4((int)A0[3], xq[3], __builtin_amdgcn_sdot4((int)A0[2], xq[2], __builtin_amdgcn_sdot4((int)A0[1], xq[1], __builtin_amdgcn_sdot4((int)A0[0], xq[0], 0, false), false), false), false);
            d[1] = __builtin_amdgcn_sdot4((int)A1[3], xq[3], __builtin_amdgcn_sdot4((int)A1[2], xq[2], __builtin_amdgcn_sdot4((int)A1[1], xq[1], __builtin_amdgcn_sdot4((int)A1[0], xq[0], 0, false), false), false), false);
            d[2] = __builtin_amdgcn_sdot4((int)A2[3], xq[3], __builtin_amdgcn_sdot4((int)A2[2], xq[2], __builtin_amdgcn_sdot4((int)A2[1], xq[1], __builtin_amdgcn_sdot4((int)A2[0], xq[0], 0, false), false), false), false);
            d[3] = __builtin_amdgcn_sdot4((int)A3[3], xq[3], __builtin_amdgcn_sdot4((int)A3[2], xq[2], __builtin_amdgcn_sdot4((int)A3[1], xq[1], __builtin_amdgcn_sdot4((int)A3[0], xq[0], 0, false), false), false), false);
            d[4] = __builtin_amdgcn_sdot4((int)A4[3], xq[3], __builtin_amdgcn_sdot4((int)A4[2], xq[2], __builtin_amdgcn_sdot4((int)A4[1], xq[1], __builtin_amdgcn_sdot4((int)A4[0], xq[0], 0, false), false), false), false);
            d[5] = __builtin_amdgcn_sdot4((int)A5[3], xq[3], __builtin_amdgcn_sdot4((int)A5[2], xq[2], __builtin_amdgcn_sdot4((int)A5[1], xq[1], __builtin_amdgcn_sdot4((int)A5[0], xq[0], 0, false), false), false), false);
            d[6] = __builtin_amdgcn_sdot4((int)A6[3], xq[3], __builtin_amdgcn_sdot4((int)A6[2], xq[2], __builtin_amdgcn_sdot4((int)A6[1], xq[1], __builtin_amdgcn_sdot4((int)A6[0], xq[0], 0, false), false), false), false);
            d[7] = __builtin_amdgcn_sdot4((int)A7[3], xq[3], __builtin_amdgcn_sdot4((int)A7[2], xq[2], __builtin_amdgcn_sdot4((int)A7[1], xq[1], __builtin_amdgcn_sdot4((int)A7[0], xq[0], 0, false), false), false), false);
            d[8] = __builtin_amdgcn_sdot4((int)A8[3], xq[3], __builtin_amdgcn_sdot4((int)A8[2], xq[2], __builtin_amdgcn_sdot4((int)A8[1], xq[1], __builtin_amdgcn_sdot4((int)A8[0], xq[0], 0, false), false), false), false);
            d[9] = __builtin_amdgcn_sdot4((int)A9[3], xq[3], __builtin_amdgcn_sdot4((int)A9[2], xq[2], __builtin_amdgcn_sdot4((int)A9[1], xq[1], __builtin_amdgcn_sdot4((int)A9[0], xq[0], 0, false), false), false), false);
            d[10] = __builtin_amdgcn_sdot4((int)A10[3], xq[3], __builtin_amdgcn_sdot4((int)A10[2], xq[2], __builtin_amdgcn_sdot4((int)A10[1], xq[1], __builtin_amdgcn_sdot4((int)A10[0], xq[0], 0, false), false), false), false);
            d[11] = __builtin_amdgcn_sdot4((int)A11[3], xq[3], __builtin_amdgcn_sdot4((int)A11[2], xq[2], __builtin_amdgcn_sdot4((int)A11[1], xq[1], __builtin_amdgcn_sdot4((int)A11[0], xq[0], 0, false), false), false), false);
            d[12] = __builtin_amdgcn_sdot4((int)A12[3], xq[3], __builtin_amdgcn_sdot4((int)A12[2], xq[2], __builtin_amdgcn_sdot4((int)A12[1], xq[1], __builtin_amdgcn_sdot4((int)A12[0], xq[0], 0, false), false), false), false);
            d[13] = __builtin_amdgcn_sdot4((int)A13[3], xq[3], __builtin_amdgcn_sdot4((int)A13[2], xq[2], __builtin_amdgcn_sdot4((int)A13[1], xq[1], __builtin_amdgcn_sdot4((int)A13[0], xq[0], 0, false), false), false), false);
            d[14] = __builtin_amdgcn_sdot4((int)A14[3], xq[3], __builtin_amdgcn_sdot4((int)A14[2], xq[2], __builtin_amdgcn_sdot4((int)A14[1], xq[1], __builtin_amdgcn_sdot4((int)A14[0], xq[0], 0, false), false), false), false);
            d[15] = __builtin_amdgcn_sdot4((int)A15[3], xq[3], __builtin_amdgcn_sdot4((int)A15[2], xq[2], __builtin_amdgcn_sdot4((int)A15[1], xq[1], __builtin_amdgcn_sdot4((int)A15[0], xq[0], 0, false), false), false), false);
            _Pragma("unroll") for (int st = 0; st < 3; ++st) { const int M = 1 << st, nn = 8 >> st; const int hm = (la & M) ? -1 : 0;
                _Pragma("unroll") for (int i = 0; i < 8; ++i) if (i < nn) { const int keep = (d[nn + i] & hm) | (d[i] & ~hm), send = (d[i] & hm) | (d[nn + i] & ~hm);
                    d[i] = keep + ((st == 0) ? DPP_I(send, 0xB1) : (st == 1) ? DPP_I(send, 0x4E) : __builtin_amdgcn_ds_swizzle(send, (4 << 10) | 0x1f)); } }
            float* pp = (float*)(P.ws + WS_PART) + ((size_t)j * T + (unsigned)(T0 + 8 * b + 2)) * 128;
            *(f32x2*)(pp + (unsigned)(16 * sl + i0)) = (f32x2){(float)d[0] * sx, (float)d[1] * sx}; }
        { const LAS unsigned char* ip_ = buf + (bs) * 4096 + 4 * 256 + 32 * sl; const u32x4 e0_ = *(const LAS u32x4*)ip_, e1_ = *(const LAS u32x4*)(ip_ + 16);
            A0 = *(const u32x4*)(TAB + ((e0_[0] & 0xffffu) * 128u + pb));
            A1 = *(const u32x4*)(TAB + ((e0_[0] >> 16) * 128u + pb));
            A2 = *(const u32x4*)(TAB + ((e0_[1] & 0xffffu) * 128u + pb));
            A3 = *(const u32x4*)(TAB + ((e0_[1] >> 16) * 128u + pb));
            A4 = *(const u32x4*)(TAB + ((e0_[2] & 0xffffu) * 128u + pb));
            A5 = *(const u32x4*)(TAB + ((e0_[2] >> 16) * 128u + pb));
            A6 = *(const u32x4*)(TAB + ((e0_[3] & 0xffffu) * 128u + pb));
            A7 = *(const u32x4*)(TAB + ((e0_[3] >> 16) * 128u + pb));
            A8 = *(const u32x4*)(TAB + ((e1_[0] & 0xffffu) * 128u + pb));
            A9 = *(const u32x4*)(TAB + ((e1_[0] >> 16) * 128u + pb));
            A10 = *(const u32x4*)(TAB + ((e1_[1] & 0xffffu) * 128u + pb));
            A11 = *(const u32x4*)(TAB + ((e1_[1] >> 16) * 128u + pb));
            A12 = *(const u32x4*)(TAB + ((e1_[2] & 0xffffu) * 128u + pb));
            A13 = *(const u32x4*)(TAB + ((e1_[2] >> 16) * 128u + pb));
            A14 = *(const u32x4*)(TAB + ((e1_[3] & 0xffffu) * 128u + pb));
            A15 = *(const u32x4*)(TAB + ((e1_[3] >> 16) * 128u + pb));
        }
        { const i32x4 xq = *(const LAS i32x4*)(buf + bs * 4096 + 2048 + 3 * 128 + 16 * pc); const float sx = *(const LAS float*)(buf + bs * 4096 + 3072 + 4 * 3);
            int d[16];
            d[0] = __builtin_amdgcn_sdot4((int)B0[3], xq[3], __builtin_amdgcn_sdot4((int)B0[2], xq[2], __builtin_amdgcn_sdot4((int)B0[1], xq[1], __builtin_amdgcn_sdot4((int)B0[0], xq[0], 0, false), false), false), false);
            d[1] = __builtin_amdgcn_sdot4((int)B1[3], xq[3], __builtin_amdgcn_sdot4((int)B1[2], xq[2], __builtin_amdgcn_sdot4((int)B1[1], xq[1], __builtin_amdgcn_sdot4((int)B1[0], xq[0], 0, false), false), false), false);
            d[2] = __builtin_amdgcn_sdot4((int)B2[3], xq[3], __builtin_amdgcn_sdot4((int)B2[2], xq[2], __builtin_amdgcn_sdot4((int)B2[1], xq[1], __builtin_amdgcn_sdot4((int)B2[0], xq[0], 0, false), false), false), false);
            d[3] = __builtin_amdgcn_sdot4((int)B3[3], xq[3], __builtin_amdgcn_sdot4((int)B3[2], xq[2], __builtin_amdgcn_sdot4((int)B3[1], xq[1], __builtin_amdgcn_sdot4((int)B3[0], xq[0], 0, false), false), false), false);
            d[4] = __builtin_amdgcn_sdot4((int)B4[3], xq[3], __builtin_amdgcn_sdot4((int)B4[2], xq[2], __builtin_amdgcn_sdot4((int)B4[1], xq[1], __builtin_amdgcn_sdot4((int)B4[0], xq[0], 0, false), false), false), false);
            d[5] = __builtin_amdgcn_sdot4((int)B5[3], xq[3], __builtin_amdgcn_sdot4((int)B5[2], xq[2], __builtin_amdgcn_sdot4((int)B5[1], xq[1], __builtin_amdgcn_sdot4((int)B5[0], xq[0], 0, false), false), false), false);
            d[6] = __builtin_amdgcn_sdot4((int)B6[3], xq[3], __builtin_amdgcn_sdot4((int)B6[2], xq[2], __builtin_amdgcn_sdot4((int)B6[1], xq[1], __builtin_amdgcn_sdot4((int)B6[0], xq[0], 0, false), false), false), false);
            d[7] = __builtin_amdgcn_sdot4((int)B7[3], xq[3], __builtin_amdgcn_sdot4((int)B7[2], xq[2], __builtin_amdgcn_sdot4((int)B7[1], xq[1], __builtin_amdgcn_sdot4((int)B7[0], xq[0], 0, false), false), false), false);
            d[8] = __builtin_amdgcn_sdot4((int)B8[3], xq[3], __builtin_amdgcn_sdot4((int)B8[2], xq[2], __builtin_amdgcn_sdot4((int)B8[1], xq[1], __builtin_amdgcn_sdot4((int)B8[0], xq[0], 0, false), false), false), false);
            d[9] = __builtin_amdgcn_sdot4((int)B9[3], xq[3], __builtin_amdgcn_sdot4((int)B9[2], xq[2], __builtin_amdgcn_sdot4((int)B9[1], xq[1], __builtin_amdgcn_sdot4((int)B9[0], xq[0], 0, false), false), false), false);
            d[10] = __builtin_amdgcn_sdot4((int)B10[3], xq[3], __builtin_amdgcn_sdot4((int)B10[2], xq[2], __builtin_amdgcn_sdot4((int)B10[1], xq[1], __builtin_amdgcn_sdot4((int)B10[0], xq[0], 0, false), false), false), false);
            d[11] = __builtin_amdgcn_sdot4((int)B11[3], xq[3], __builtin_amdgcn_sdot4((int)B11[2], xq[2], __builtin_amdgcn_sdot4((int)B11[1], xq[1], __builtin_amdgcn_sdot4((int)B11[0], xq[0], 0, false), false), false), false);
            d[12] = __builtin_amdgcn_sdot4((int)B12[3], xq[3], __builtin_amdgcn_sdot4((int)B12[2], xq[2], __builtin_amdgcn_sdot4((int)B12[1], xq[1], __builtin_amdgcn_sdot4((int)B12[0], xq[0], 0, false), false), false), false);
            d[13] = __builtin_amdgcn_sdot4((int)B13[3], xq[3], __builtin_amdgcn_sdot4((int)B13[2], xq[2], __builtin_amdgcn_sdot4((int)B13[1], xq[1], __builtin_amdgcn_sdot4((int)B13[0], xq[0], 0, false), false), false), false);
            d[14] = __builtin_amdgcn_sdot4((int)B14[3], xq[3], __builtin_amdgcn_sdot4((int)B14[2], xq[2], __builtin_amdgcn_sdot4((int)B14[1], xq[1], __builtin_amdgcn_sdot4((int)B14[0], xq[0], 0, false), false), false), false);
            d[15] = __builtin_amdgcn_sdot4((int)B15[3], xq[3], __builtin_amdgcn_sdot4((int)B15[2], xq[2], __builtin_amdgcn_sdot4((int)B15[1], xq[1], __builtin_amdgcn_sdot4((int)B15[0], xq[0], 0, false), false), false), false);
            _Pragma("unroll") for (int st = 0; st < 3; ++st) { const int M = 1 << st, nn = 8 >> st; const int hm = (la & M) ? -1 : 0;
                _Pragma("unroll") for (int i = 0; i < 8; ++i) if (i < nn) { const int keep = (d[nn + i] & hm) | (d[i] & ~hm), send = (d[i] & hm) | (d[nn + i] & ~hm);
                    d[i] = keep + ((st == 0) ? DPP_I(send, 0xB1) : (st == 1) ? DPP_I(send, 0x4E) : __builtin_amdgcn_ds_swizzle(send, (4 << 10) | 0x1f)); } }
            float* pp = (float*)(P.ws + WS_PART) + ((size_t)j * T + (unsigned)(T0 + 8 * b + 3)) * 128;
            *(f32x2*)(pp + (unsigned)(16 * sl + i0)) = (f32x2){(float)d[0] * sx, (float)d[1] * sx}; }
        { const LAS unsigned char* ip_ = buf + (bs) * 4096 + 5 * 256 + 32 * sl; const u32x4 e0_ = *(const LAS u32x4*)ip_, e1_ = *(const LAS u32x4*)(ip_ + 16);
            B0 = *(const u32x4*)(TAB + ((e0_[0] & 0xffffu) * 128u + pb));
            B1 = *(const u32x4*)(TAB + ((e0_[0] >> 16) * 128u + pb));
            B2 = *(const u32x4*)(TAB + ((e0_[1] & 0xffffu) * 128u + pb));
            B3 = *(const u32x4*)(TAB + ((e0_[1] >> 16) * 128u + pb));
            B4 = *(const u32x4*)(TAB + ((e0_[2] & 0xffffu) * 128u + pb));
            B5 = *(const u32x4*)(TAB + ((e0_[2] >> 16) * 128u + pb));
            B6 = *(const u32x4*)(TAB + ((e0_[3] & 0xffffu) * 128u + pb));
            B7 = *(const u32x4*)(TAB + ((e0_[3] >> 16) * 128u + pb));
            B8 = *(const u32x4*)(TAB + ((e1_[0] & 0xffffu) * 128u + pb));
            B9 = *(const u32x4*)(TAB + ((e1_[0] >> 16) * 128u + pb));
            B10 = *(const u32x4*)(TAB + ((e1_[1] & 0xffffu) * 128u + pb));
            B11 = *(const u32x4*)(TAB + ((e1_[1] >> 16) * 128u + pb));
            B12 = *(const u32x4*)(TAB + ((e1_[2] & 0xffffu) * 128u + pb));
            B13 = *(const u32x4*)(TAB + ((e1_[2] >> 16) * 128u + pb));
            B14 = *(const u32x4*)(TAB + ((e1_[3] & 0xffffu) * 128u + pb));
            B15 = *(const u32x4*)(TAB + ((e1_[3] >> 16) * 128u + pb));
        }
        { const i32x4 xq = *(const LAS i32x4*)(buf + bs * 4096 + 2048 + 4 * 128 + 16 * pc); const float sx = *(const LAS float*)(buf + bs * 4096 + 3072 + 4 * 4);
            int d[16];
            d[0] = __builtin_amdgcn_sdot4((int)A0[3], xq[3], __builtin_amdgcn_sdot4((int)A0[2], xq[2], __builtin_amdgcn_sdot4((int)A0[1], xq[1], __builtin_amdgcn_sdot4((int)A0[0], xq[0], 0, false), false), false), false);
            d[1] = __builtin_amdgcn_sdot4((int)A1[3], xq[3], __builtin_amdgcn_sdot4((int)A1[2], xq[2], __builtin_amdgcn_sdot4((int)A1[1], xq[1], __builtin_amdgcn_sdot4((int)A1[0], xq[0], 0, false), false), false), false);
            d[2] = __builtin_amdgcn_sdot4((int)A2[3], xq[3], __builtin_amdgcn_sdot4((int)A2[2], xq[2], __builtin_amdgcn_sdot4((int)A2[1], xq[1], __builtin_amdgcn_sdot4((int)A2[0], xq[0], 0, false), false), false), false);
            d[3] = __builtin_amdgcn_sdot4((int)A3[3], xq[3], __builtin_amdgcn_sdot4((int)A3[2], xq[2], __builtin_amdgcn_sdot4((int)A3[1], xq[1], __builtin_amdgcn_sdot4((int)A3[0], xq[0], 0, false), false), false), false);
            d[4] = __builtin_amdgcn_sdot4((int)A4[3], xq[3], __builtin_amdgcn_sdot4((int)A4[2], xq[2], __builtin_amdgcn_sdot4((int)A4[1], xq[1], __builtin_amdgcn_sdot4((int)A4[0], xq[0], 0, false), false), false), false);
            d[5] = __builtin_amdgcn_sdot4((int)A5[3], xq[3], __builtin_amdgcn_sdot4((int)A5[2], xq[2], __builtin_amdgcn_sdot4((int)A5[1], xq[1], __builtin_amdgcn_sdot4((int)A5[0], xq[0], 0, false), false), false), false);
            d[6] = __builtin_amdgcn_sdot4((int)A6[3], xq[3], __builtin_amdgcn_sdot4((int)A6[2], xq[2], __builtin_amdgcn_sdot4((int)A6[1], xq[1], __builtin_amdgcn_sdot4((int)A6[0], xq[0], 0, false), false), false), false);
            d[7] = __builtin_amdgcn_sdot4((int)A7[3], xq[3], __builtin_amdgcn_sdot4((int)A7[2], xq[2], __builtin_amdgcn_sdot4((int)A7[1], xq[1], __builtin_amdgcn_sdot4((int)A7[0], xq[0], 0, false), false), false), false);
            d[8] = __builtin_amdgcn_sdot4((int)A8[3], xq[3], __builtin_amdgcn_sdot4((int)A8[2], xq[2], __builtin_amdgcn_sdot4((int)A8[1], xq[1], __builtin_amdgcn_sdot4((int)A8[0], xq[0], 0, false), false), false), false);
            d[9] = __builtin_amdgcn_sdot4((int)A9[3], xq[3], __builtin_amdgcn_sdot4((int)A9[2], xq[2], __builtin_amdgcn_sdot4((int)A9[1], xq[1], __builtin_amdgcn_sdot4((int)A9[0], xq[0], 0, false), false), false), false);
            d[10] = __builtin_amdgcn_sdot4((int)A10[3], xq[3], __builtin_amdgcn_sdot4((int)A10[2], xq[2], __builtin_amdgcn_sdot4((int)A10[1], xq[1], __builtin_amdgcn_sdot4((int)A10[0], xq[0], 0, false), false), false), false);
            d[11] = __builtin_amdgcn_sdot4((int)A11[3], xq[3], __builtin_amdgcn_sdot4((int)A11[2], xq[2], __builtin_amdgcn_sdot4((int)A11[1], xq[1], __builtin_amdgcn_sdot4((int)A11[0], xq[0], 0, false), false), false), false);
            d[12] = __builtin_amdgcn_sdot4((int)A12[3], xq[3], __builtin_amdgcn_sdot4((int)A12[2], xq[2], __builtin_amdgcn_sdot4((int)A12[1], xq[1], __builtin_amdgcn_sdot4((int)A12[0], xq[0], 0, false), false), false), false);
            d[13] = __builtin_amdgcn_sdot4((int)A13[3], xq[3], __builtin_amdgcn_sdot4((int)A13[2], xq[2], __builtin_amdgcn_sdot4((int)A13[1], xq[1], __builtin_amdgcn_sdot4((int)A13[0], xq[0], 0, false), false), false), false);
            d[14] = __builtin_amdgcn_sdot4((int)A14[3], xq[3], __builtin_amdgcn_sdot4((int)A14[2], xq[2], __builtin_amdgcn_sdot4((int)A14[1], xq[1], __builtin_amdgcn_sdot4((int)A14[0], xq[0], 0, false), false), false), false);
            d[15] = __builtin_amdgcn_sdot4((int)A15[3], xq[3], __builtin_amdgcn_sdot4((int)A15[2], xq[2], __builtin_amdgcn_sdot4((int)A15[1], xq[1], __builtin_amdgcn_sdot4((int)A15[0], xq[0], 0, false), false), false), false);
            _Pragma("unroll") for (int st = 0; st < 3; ++st) { const int M = 1 << st, nn = 8 >> st; const int hm = (la & M) ? -1 : 0;
                _Pragma("unroll") for (int i = 0; i < 8; ++i) if (i < nn) { const int keep = (d[nn + i] & hm) | (d[i] & ~hm), send = (d[i] & hm) | (d[nn + i] & ~hm);
                    d[i] = keep + ((st == 0) ? DPP_I(send, 0xB1) : (st == 1) ? DPP_I(send, 0x4E) : __builtin_amdgcn_ds_swizzle(send, (4 << 10) | 0x1f)); } }
            float* pp = (float*)(P.ws + WS_PART) + ((size_t)j * T + (unsigned)(T0 + 8 * b + 4)) * 128;
            *(f32x2*)(pp + (unsigned)(16 * sl + i0)) = (f32x2){(float)d[0] * sx, (float)d[1] * sx}; }
        { const LAS unsigned char* ip_ = buf + (bs) * 4096 + 6 * 256 + 32 * sl; const u32x4 e0_ = *(const LAS u32x4*)ip_, e1_ = *(const LAS u32x4*)(ip_ + 16);
            A0 = *(const u32x4*)(TAB + ((e0_[0] & 0xffffu) * 128u + pb));
            A1 = *(const u32x4*)(TAB + ((e0_[0] >> 16) * 128u + pb));
            A2 = *(const u32x4*)(TAB + ((e0_[1] & 0xffffu) * 128u + pb));
            A3 = *(const u32x4*)(TAB + ((e0_[1] >> 16) * 128u + pb));
            A4 = *(const u32x4*)(TAB + ((e0_[2] & 0xffffu) * 128u + pb));
            A5 = *(const u32x4*)(TAB + ((e0_[2] >> 16) * 128u + pb));
            A6 = *(const u32x4*)(TAB + ((e0_[3] & 0xffffu) * 128u + pb));
            A7 = *(const u32x4*)(TAB + ((e0_[3] >> 16) * 128u + pb));
            A8 = *(const u32x4*)(TAB + ((e1_[0] & 0xffffu) * 128u + pb));
            A9 = *(const u32x4*)(TAB + ((e1_[0] >> 16) * 128u + pb));
            A10 = *(const u32x4*)(TAB + ((e1_[1] & 0xffffu) * 128u + pb));
            A11 = *(const u32x4*)(TAB + ((e1_[1] >> 16) * 128u + pb));
            A12 = *(const u32x4*)(TAB + ((e1_[2] & 0xffffu) * 128u + pb));
            A13 = *(const u32x4*)(TAB + ((e1_[2] >> 16) * 128u + pb));
            A14 = *(const u32x4*)(TAB + ((e1_[3] & 0xffffu) * 128u + pb));
            A15 = *(const u32x4*)(TAB + ((e1_[3] >> 16) * 128u + pb));
        }
        { const i32x4 xq = *(const LAS i32x4*)(buf + bs * 4096 + 2048 + 5 * 128 + 16 * pc); const float sx = *(const LAS float*)(buf + bs * 4096 + 3072 + 4 * 5);
            int d[16];
            d[0] = __builtin_amdgcn_sdot4((int)B0[3], xq[3], __builtin_amdgcn_sdot4((int)B0[2], xq[2], __builtin_amdgcn_sdot4((int)B0[1], xq[1], __builtin_amdgcn_sdot4((int)B0[0], xq[0], 0, false), false), false), false);
            d[1] = __builtin_amdgcn_sdot4((int)B1[3], xq[3], __builtin_amdgcn_sdot4((int)B1[2], xq[2], __builtin_amdgcn_sdot4((int)B1[1], xq[1], __builtin_amdgcn_sdot4((int)B1[0], xq[0], 0, false), false), false), false);
            d[2] = __builtin_amdgcn_sdot4((int)B2[3], xq[3], __builtin_amdgcn_sdot4((int)B2[2], xq[2], __builtin_amdgcn_sdot4((int)B2[1], xq[1], __builtin_amdgcn_sdot4((int)B2[0], xq[0], 0, false), false), false), false);
            d[3] = __builtin_amdgcn_sdot4((int)B3[3], xq[3], __builtin_amdgcn_sdot4((int)B3[2], xq[2], __builtin_amdgcn_sdot4((int)B3[1], xq[1], __builtin_amdgcn_sdot4((int)B3[0], xq[0], 0, false), false), false), false);
            d[4] = __builtin_amdgcn_sdot4((int)B4[3], xq[3], __builtin_amdgcn_sdot4((int)B4[2], xq[2], __builtin_amdgcn_sdot4((int)B4[1], xq[1], __builtin_amdgcn_sdot4((int)B4[0], xq[0], 0, false), false), false), false);
            d[5] = __builtin_amdgcn_sdot4((int)B5[3], xq[3], __builtin_amdgcn_sdot4((int)B5[2], xq[2], __builtin_amdgcn_sdot4((int)B5[1], xq[1], __builtin_amdgcn_sdot4((int)B5[0], xq[0], 0, false), false), false), false);
            d[6] = __builtin_amdgcn_sdot4((int)B6[3], xq[3], __builtin_amdgcn_sdot4((int)B6[2], xq[2], __builtin_amdgcn_sdot4((int)B6[1], xq[1], __builtin_amdgcn_sdot4((int)B6[0], xq[0], 0, false), false), false), false);
            d[7] = __builtin_amdgcn_sdot4((int)B7[3], xq[3], __builtin_amdgcn_sdot4((int)B7[2], xq[2], __builtin_amdgcn_sdot4((int)B7[1], xq[1], __builtin_amdgcn_sdot4((int)B7[0], xq[0], 0, false), false), false), false);
            d[8] = __builtin_amdgcn_sdot4((int)B8[3], xq[3], __builtin_amdgcn_sdot4((int)B8[2], xq[2], __builtin_amdgcn_sdot4((int)B8[1], xq[1], __builtin_amdgcn_sdot4((int)B8[0], xq[0], 0, false), false), false), false);
            d[9] = __builtin_amdgcn_sdot4((int)B9[3], xq[3], __builtin_amdgcn_sdot4((int)B9[2], xq[2], __builtin_amdgcn_sdot4((int)B9[1], xq[1], __builtin_amdgcn_sdot4((int)B9[0], xq[0], 0, false), false), false), false);
            d[10] = __builtin_amdgcn_sdot4((int)B10[3], xq[3], __builtin_amdgcn_sdot4((int)B10[2], xq[2], __builtin_amdgcn_sdot4((int)B10[1], xq[1], __builtin_amdgcn_sdot4((int)B10[0], xq[0], 0, false), false), false), false);
            d[11] = __builtin_amdgcn_sdot4((int)B11[3], xq[3], __builtin_amdgcn_sdot4((int)B11[2], xq[2], __builtin_amdgcn_sdot4((int)B11[1], xq[1], __builtin_amdgcn_sdot4((int)B11[0], xq[0], 0, false), false), false), false);
            d[12] = __builtin_amdgcn_sdot4((int)B12[3], xq[3], __builtin_amdgcn_sdot4((int)B12[2], xq[2], __builtin_amdgcn_sdot4((int)B12[1], xq[1], __builtin_amdgcn_sdot4((int)B12[0], xq[0], 0, false), false), false), false);
            d[13] = __builtin_amdgcn_sdot4((int)B13[3], xq[3], __builtin_amdgcn_sdot4((int)B13[2], xq[2], __builtin_amdgcn_sdot4((int)B13[1], xq[1], __builtin_amdgcn_sdot4((int)B13[0], xq[0], 0, false), false), false), false);
            d[14] = __builtin_amdgcn_sdot4((int)B14[3], xq[3], __builtin_amdgcn_sdot4((int)B14[2], xq[2], __builtin_amdgcn_sdot4((int)B14[1], xq[1], __builtin_amdgcn_sdot4((int)B14[0], xq[0], 0, false), false), false), false);
            d[15] = __builtin_amdgcn_sdot4((int)B15[3], xq[3], __builtin_amdgcn_sdot4((int)B15[2], xq[2], __builtin_amdgcn_sdot4((int)B15[1], xq[1], __builtin_amdgcn_sdot4((int)B15[0], xq[0], 0, false), false), false), false);
            _Pragma("unroll") for (int st = 0; st < 3; ++st) { const int M = 1 << st, nn = 8 >> st; const int hm = (la & M) ? -1 : 0;
                _Pragma("unroll") for (int i = 0; i < 8; ++i) if (i < nn) { const int keep = (d[nn + i] & hm) | (d[i] & ~hm), send = (d[i] & hm) | (d[nn + i] & ~hm);
                    d[i] = keep + ((st == 0) ? DPP_I(send, 0xB1) : (st == 1) ? DPP_I(send, 0x4E) : __builtin_amdgcn_ds_swizzle(send, (4 << 10) | 0x1f)); } }
            float* pp = (float*)(P.ws + WS_PART) + ((size_t)j * T + (unsigned)(T0 + 8 * b + 5)) * 128;
            *(f32x2*)(pp + (unsigned)(16 * sl + i0)) = (f32x2){(float)d[0] * sx, (float)d[1] * sx}; }
        { const LAS unsigned char* ip_ = buf + (bs) * 4096 + 7 * 256 + 32 * sl; const u32x4 e0_ = *(const LAS u32x4*)ip_, e1_ = *(const LAS u32x4*)(ip_ + 16);
            B0 = *(const u32x4*)(TAB + ((e0_[0] & 0xffffu) * 128u + pb));
            B1 = *(const u32x4*)(TAB + ((e0_[0] >> 16) * 128u + pb));
            B2 = *(const u32x4*)(TAB + ((e0_[1] & 0xffffu) * 128u + pb));
            B3 = *(const u32x4*)(TAB + ((e0_[1] >> 16) * 128u + pb));
            B4 = *(const u32x4*)(TAB + ((e0_[2] & 0xffffu) * 128u + pb));
            B5 = *(const u32x4*)(TAB + ((e0_[2] >> 16) * 128u + pb));
            B6 = *(const u32x4*)(TAB + ((e0_[3] & 0xffffu) * 128u + pb));
            B7 = *(const u32x4*)(TAB + ((e0_[3] >> 16) * 128u + pb));
            B8 = *(const u32x4*)(TAB + ((e1_[0] & 0xffffu) * 128u + pb));
            B9 = *(const u32x4*)(TAB + ((e1_[0] >> 16) * 128u + pb));
            B10 = *(const u32x4*)(TAB + ((e1_[1] & 0xffffu) * 128u + pb));
            B11 = *(const u32x4*)(TAB + ((e1_[1] >> 16) * 128u + pb));
            B12 = *(const u32x4*)(TAB + ((e1_[2] & 0xffffu) * 128u + pb));
            B13 = *(const u32x4*)(TAB + ((e1_[2] >> 16) * 128u + pb));
            B14 = *(const u32x4*)(TAB + ((e1_[3] & 0xffffu) * 128u + pb));
            B15 = *(const u32x4*)(TAB + ((e1_[3] >> 16) * 128u + pb));
        }
        { const i32x4 xq = *(const LAS i32x4*)(buf + bs * 4096 + 2048 + 6 * 128 + 16 * pc); const float sx = *(const LAS float*)(buf + bs * 4096 + 3072 + 4 * 6);
            int d[16];
            d[0] = __builtin_amdgcn_sdot4((int)A0[3], xq[3], __builtin_amdgcn_sdot4((int)A0[2], xq[2], __builtin_amdgcn_sdot4((int)A0[1], xq[1], __builtin_amdgcn_sdot4((int)A0[0], xq[0], 0, false), false), false), false);
            d[1] = __builtin_amdgcn_sdot4((int)A1[3], xq[3], __builtin_amdgcn_sdot4((int)A1[2], xq[2], __builtin_amdgcn_sdot4((int)A1[1], xq[1], __builtin_amdgcn_sdot4((int)A1[0], xq[0], 0, false), false), false), false);
            d[2] = __builtin_amdgcn_sdot4((int)A2[3], xq[3], __builtin_amdgcn_sdot4((int)A2[2], xq[2], __builtin_amdgcn_sdot4((int)A2[1], xq[1], __builtin_amdgcn_sdot4((int)A2[0], xq[0], 0, false), false), false), false);
            d[3] = __builtin_amdgcn_sdot4((int)A3[3], xq[3], __builtin_amdgcn_sdot4((int)A3[2], xq[2], __builtin_amdgcn_sdot4((int)A3[1], xq[1], __builtin_amdgcn_sdot4((int)A3[0], xq[0], 0, false), false), false), false);
            d[4] = __builtin_amdgcn_sdot4((int)A4[3], xq[3], __builtin_amdgcn_sdot4((int)A4[2], xq[2], __builtin_amdgcn_sdot4((int)A4[1], xq[1], __builtin_amdgcn_sdot4((int)A4[0], xq[0], 0, false), false), false), false);
            d[5] = __builtin_amdgcn_sdot4((int)A5[3], xq[3], __builtin_amdgcn_sdot4((int)A5[2], xq[2], __builtin_amdgcn_sdot4((int)A5[1], xq[1], __builtin_amdgcn_sdot4((int)A5[0], xq[0], 0, false), false), false), false);
            d[6] = __builtin_amdgcn_sdot4((int)A6[3], xq[3], __builtin_amdgcn_sdot4((int)A6[2], xq[2], __builtin_amdgcn_sdot4((int)A6[1], xq[1], __builtin_amdgcn_sdot4((int)A6[0], xq[0], 0, false), false), false), false);
            d[7] = __builtin_amdgcn_sdot4((int)A7[3], xq[3], __builtin_amdgcn_sdot4((int)A7[2], xq[2], __builtin_amdgcn_sdot4((int)A7[1], xq[1], __builtin_amdgcn_sdot4((int)A7[0], xq[0], 0, false), false), false), false);
            d[8] = __builtin_amdgcn_sdot4((int)A8[3], xq[3], __builtin_amdgcn_sdot4((int)A8[2], xq[2], __builtin_amdgcn_sdot4((int)A8[1], xq[1], __builtin_amdgcn_sdot4((int)A8[0], xq[0], 0, false), false), false), false);
            d[9] = __builtin_amdgcn_sdot4((int)A9[3], xq[3], __builtin_amdgcn_sdot4((int)A9[2], xq[2], __builtin_amdgcn_sdot4((int)A9[1], xq[1], __builtin_amdgcn_sdot4((int)A9[0], xq[0], 0, false), false), false), false);
            d[10] = __builtin_amdgcn_sdot4((int)A10[3], xq[3], __builtin_amdgcn_sdot4((int)A10[2], xq[2], __builtin_amdgcn_sdot4((int)A10[1], xq[1], __builtin_amdgcn_sdot4((int)A10[0], xq[0], 0, false), false), false), false);
            d[11] = __builtin_amdgcn_sdot4((int)A11[3], xq[3], __builtin_amdgcn_sdot4((int)A11[2], xq[2], __builtin_amdgcn_sdot4((int)A11[1], xq[1], __builtin_amdgcn_sdot4((int)A11[0], xq[0], 0, false), false), false), false);
            d[12] = __builtin_amdgcn_sdot4((int)A12[3], xq[3], __builtin_amdgcn_sdot4((int)A12[2], xq[2], __builtin_amdgcn_sdot4((int)A12[1], xq[1], __builtin_amdgcn_sdot4((int)A12[0], xq[0], 0, false), false), false), false);
            d[13] = __builtin_amdgcn_sdot4((int)A13[3], xq[3], __builtin_amdgcn_sdot4((int)A13[2], xq[2], __builtin_amdgcn_sdot4((int)A13[1], xq[1], __builtin_amdgcn_sdot4((int)A13[0], xq[0], 0, false), false), false), false);
            d[14] = __builtin_amdgcn_sdot4((int)A14[3], xq[3], __builtin_amdgcn_sdot4((int)A14[2], xq[2], __builtin_amdgcn_sdot4((int)A14[1], xq[1], __builtin_amdgcn_sdot4((int)A14[0], xq[0], 0, false), false), false), false);
            d[15] = __builtin_amdgcn_sdot4((int)A15[3], xq[3], __builtin_amdgcn_sdot4((int)A15[2], xq[2], __builtin_amdgcn_sdot4((int)A15[1], xq[1], __builtin_amdgcn_sdot4((int)A15[0], xq[0], 0, false), false), false), false);
            _Pragma("unroll") for (int st = 0; st < 3; ++st) { const int M = 1 << st, nn = 8 >> st; const int hm = (la & M) ? -1 : 0;
                _Pragma("unroll") for (int i = 0; i < 8; ++i) if (i < nn) { const int keep = (d[nn + i] & hm) | (d[i] & ~hm), send = (d[i] & hm) | (d[nn + i] & ~hm);
                    d[i] = keep + ((st == 0) ? DPP_I(send, 0xB1) : (st == 1) ? DPP_I(send, 0x4E) : __builtin_amdgcn_ds_swizzle(send, (4 << 10) | 0x1f)); } }
            float* pp = (float*)(P.ws + WS_PART) + ((size_t)j * T + (unsigned)(T0 + 8 * b + 6)) * 128;
            *(f32x2*)(pp + (unsigned)(16 * sl + i0)) = (f32x2){(float)d[0] * sx, (float)d[1] * sx}; }
        { const LAS unsigned char* ip_ = buf + (bs ^ 1) * 4096 + 0 * 256 + 32 * sl; const u32x4 e0_ = *(const LAS u32x4*)ip_, e1_ = *(const LAS u32x4*)(ip_ + 16);
            A0 = *(const u32x4*)(TAB + ((e0_[0] & 0xffffu) * 128u + pb));
            A1 = *(const u32x4*)(TAB + ((e0_[0] >> 16) * 128u + pb));
            A2 = *(const u32x4*)(TAB + ((e0_[1] & 0xffffu) * 128u + pb));
            A3 = *(const u32x4*)(TAB + ((e0_[1] >> 16) * 128u + pb));
            A4 = *(const u32x4*)(TAB + ((e0_[2] & 0xffffu) * 128u + pb));
            A5 = *(const u32x4*)(TAB + ((e0_[2] >> 16) * 128u + pb));
            A6 = *(const u32x4*)(TAB + ((e0_[3] & 0xffffu) * 128u + pb));
            A7 = *(const u32x4*)(TAB + ((e0_[3] >> 16) * 128u + pb));
            A8 = *(const u32x4*)(TAB + ((e1_[0] & 0xffffu) * 128u + pb));
            A9 = *(const u32x4*)(TAB + ((e1_[0] >> 16) * 128u + pb));
            A10 = *(const u32x4*)(TAB + ((e1_[1] & 0xffffu) * 128u + pb));
            A11 = *(const u32x4*)(TAB + ((e1_[1] >> 16) * 128u + pb));
            A12 = *(const u32x4*)(TAB + ((e1_[2] & 0xffffu) * 128u + pb));
            A13 = *(const u32x4*)(TAB + ((e1_[2] >> 16) * 128u + pb));
            A14 = *(const u32x4*)(TAB + ((e1_[3] & 0xffffu) * 128u + pb));
            A15 = *(const u32x4*)(TAB + ((e1_[3] >> 16) * 128u + pb));
        }
        { const i32x4 xq = *(const LAS i32x4*)(buf + bs * 4096 + 2048 + 7 * 128 + 16 * pc); const float sx = *(const LAS float*)(buf + bs * 4096 + 3072 + 4 * 7);
            int d[16];
            d[0] = __builtin_amdgcn_sdot4((int)B0[3], xq[3], __builtin_amdgcn_sdot4((int)B0[2], xq[2], __builtin_amdgcn_sdot4((int)B0[1], xq[1], __builtin_amdgcn_sdot4((int)B0[0], xq[0], 0, false), false), false), false);
            d[1] = __builtin_amdgcn_sdot4((int)B1[3], xq[3], __builtin_amdgcn_sdot4((int)B1[2], xq[2], __builtin_amdgcn_sdot4((int)B1[1], xq[1], __builtin_amdgcn_sdot4((int)B1[0], xq[0], 0, false), false), false), false);
            d[2] = __builtin_amdgcn_sdot4((int)B2[3], xq[3], __builtin_amdgcn_sdot4((int)B2[2], xq[2], __builtin_amdgcn_sdot4((int)B2[1], xq[1], __builtin_amdgcn_sdot4((int)B2[0], xq[0], 0, false), false), false), false);
            d[3] = __builtin_amdgcn_sdot4((int)B3[3], xq[3], __builtin_amdgcn_sdot4((int)B3[2], xq[2], __builtin_amdgcn_sdot4((int)B3[1], xq[1], __builtin_amdgcn_sdot4((int)B3[0], xq[0], 0, false), false), false), false);
            d[4] = __builtin_amdgcn_sdot4((int)B4[3], xq[3], __builtin_amdgcn_sdot4((int)B4[2], xq[2], __builtin_amdgcn_sdot4((int)B4[1], xq[1], __builtin_amdgcn_sdot4((int)B4[0], xq[0], 0, false), false), false), false);
            d[5] = __builtin_amdgcn_sdot4((int)B5[3], xq[3], __builtin_amdgcn_sdot4((int)B5[2], xq[2], __builtin_amdgcn_sdot4((int)B5[1], xq[1], __builtin_amdgcn_sdot4((int)B5[0], xq[0], 0, false), false), false), false);
            d[6] = __builtin_amdgcn_sdot4((int)B6[3], xq[3], __builtin_amdgcn_sdot4((int)B6[2], xq[2], __builtin_amdgcn_sdot4((int)B6[1], xq[1], __builtin_amdgcn_sdot4((int)B6[0], xq[0], 0, false), false), false), false);
            d[7] = __builtin_amdgcn_sdot4((int)B7[3], xq[3], __builtin_amdgcn_sdot4((int)B7[2], xq[2], __builtin_amdgcn_sdot4((int)B7[1], xq[1], __builtin_amdgcn_sdot4((int)B7[0], xq[0], 0, false), false), false), false);
            d[8] = __builtin_amdgcn_sdot4((int)B8[3], xq[3], __builtin_amdgcn_sdot4((int)B8[2], xq[2], __builtin_amdgcn_sdot4((int)B8[1], xq[1], __builtin_amdgcn_sdot4((int)B8[0], xq[0], 0, false), false), false), false);
            d[9] = __builtin_amdgcn_sdot4((int)B9[3], xq[3], __builtin_amdgcn_sdot4((int)B9[2], xq[2], __builtin_amdgcn_sdot4((int)B9[1], xq[1], __builtin_amdgcn_sdot4((int)B9[0], xq[0], 0, false), false), false), false);
            d[10] = __builtin_amdgcn_sdot4((int)B10[3], xq[3], __builtin_amdgcn_sdot4((int)B10[2], xq[2], __builtin_amdgcn_sdot4((int)B10[1], xq[1], __builtin_amdgcn_sdot4((int)B10[0], xq[0], 0, false), false), false), false);
            d[11] = __builtin_amdgcn_sdot4((int)B11[3], xq[3], __builtin_amdgcn_sdot4((int)B11[2], xq[2], __builtin_amdgcn_sdot4((int)B11[1], xq[1], __builtin_amdgcn_sdot4((int)B11[0], xq[0], 0, false), false), false), false);
            d[12] = __builtin_amdgcn_sdot4((int)B12[3], xq[3], __builtin_amdgcn_sdot4((int)B12[2], xq[2], __builtin_amdgcn_sdot4((int)B12[1], xq[1], __builtin_amdgcn_sdot4((int)B12[0], xq[0], 0, false), false), false), false);
            d[13] = __builtin_amdgcn_sdot4((int)B13[3], xq[3], __builtin_amdgcn_sdot4((int)B13[2], xq[2], __builtin_amdgcn_sdot4((int)B13[1], xq[1], __builtin_amdgcn_sdot4((int)B13[0], xq[0], 0, false), false), false), false);
            d[14] = __builtin_amdgcn_sdot4((int)B14[3], xq[3], __builtin_amdgcn_sdot4((int)B14[2], xq[2], __builtin_amdgcn_sdot4((int)B14[1], xq[1], __builtin_amdgcn_sdot4((int)B14[0], xq[0], 0, false), false), false), false);
            d[15] = __builtin_amdgcn_sdot4((int)B15[3], xq[3], __builtin_amdgcn_sdot4((int)B15[2], xq[2], __builtin_amdgcn_sdot4((int)B15[1], xq[1], __builtin_amdgcn_sdot4((int)B15[0], xq[0], 0, false), false), false), false);
            _Pragma("unroll") for (int st = 0; st < 3; ++st) { const int M = 1 << st, nn = 8 >> st; const int hm = (la & M) ? -1 : 0;
                _Pragma("unroll") for (int i = 0; i < 8; ++i) if (i < nn) { const int keep = (d[nn + i] & hm) | (d[i] & ~hm), send = (d[i] & hm) | (d[nn + i] & ~hm);
                    d[i] = keep + ((st == 0) ? DPP_I(send, 0xB1) : (st == 1) ? DPP_I(send, 0x4E) : __builtin_amdgcn_ds_swizzle(send, (4 << 10) | 0x1f)); } }
            float* pp = (float*)(P.ws + WS_PART) + ((size_t)j * T + (unsigned)(T0 + 8 * b + 7)) * 128;
            *(f32x2*)(pp + (unsigned)(16 * sl + i0)) = (f32x2){(float)d[0] * sx, (float)d[1] * sx}; }
    }
#undef U3_FETCH
#undef U3_PARK
}
__device__ __forceinline__ void p6_combine(const Ptrs& P, int gtid, int nthreads) {
    const unsigned char* ws = P.ws;
    for (int i = gtid; i < T * 128 / 4; i += nthreads) {
        const int t = i >> 5;
        f32x4 a = *(const f32x4*)((const float*)(ws + WS_PART) + (size_t)i * 4);
#pragma unroll
        for (int j = 1; j < 8; ++j) a += *(const f32x4*)((const float*)(ws + WS_PART) + ((size_t)j * T * 128) + (size_t)i * 4);
        const float r2u = ((const float*)(ws + WS_R2))[t];
        const f32x4 g = *(const f32x4*)((const float*)(ws + WS_GW) + (size_t)i * 4);
        const u32x2 e2 = *(const u32x2*)((const unsigned short*)(ws + WS_IDX16) + (size_t)i * 4); const int4 ei = make_int4((int)(e2.x & 0xffffu), (int)(e2.x >> 16), (int)(e2.y & 0xffffu), (int)(e2.y >> 16));
        const float* sus = (const float*)(ws + WS_SUS); const float* svs = (const float*)(ws + WS_SVS);
        f32x4 w; w.x = svs[ei.x] * g.x * gelu_tanh(r2u * sus[ei.x] * a.x); w.y = svs[ei.y] * g.y * gelu_tanh(r2u * sus[ei.y] * a.y); w.z = svs[ei.z] * g.z * gelu_tanh(r2u * sus[ei.z] * a.z); w.w = svs[ei.w] * g.w * gelu_tanh(r2u * sus[ei.w] * a.w);
        float mx = fmaxf(fmaxf(fabsf(w.x), fabsf(w.y)), fmaxf(fabsf(w.z), fabsf(w.w)));
        mx = fmaxf(mx, DPP_F(mx, 0xB1)); mx = fmaxf(mx, DPP_F(mx, 0x4E)); mx = fmaxf(mx, DPP_F(mx, 0x141)); mx = fmaxf(mx, DPP_F(mx, 0x140)); mx = fmaxf(mx, xor_lane<16>(mx));
        mx = fmaxf(mx, 1e-30f);
        const float inv = 127.0f * __builtin_amdgcn_rcpf(mx);
        const int m = i & 31;
        ((unsigned*)(P.ws + WS_W))[i] = (unsigned)((int)rintf(w.x * inv) & 0xff) | ((unsigned)((int)rintf(w.y * inv) & 0xff) << 8) | ((unsigned)((int)rintf(w.z * inv) & 0xff) << 16) | ((unsigned)(int)rintf(w.w * inv) << 24);
        if (m == 0) ((float*)(P.ws + WS_R1))[t] = mx * (1.0f / 127.0f);
    }
}

typedef float f32x16 __attribute__((ext_vector_type(16)));
#define MFMA32(a, b, c) __builtin_amdgcn_mfma_f32_32x32x16_bf16((a), (b), (c), 0, 0, 0)
__device__ __forceinline__ int crow(int reg, int h) { return (reg & 3) + 8 * (reg >> 2) + 4 * h; }
__device__ __forceinline__ unsigned pkbf(float lo, float hi) { const bf16x2_t v = {(__bf16)lo, (__bf16)hi}; return __builtin_bit_cast(unsigned, v); }

constexpr int KL_STRIDE = 72, VT_STRIDE = 196;
constexpr int KL_OFF = 0, VT_OFF = 192 * KL_STRIDE * 2, BIASL_OFF = VT_OFF + 64 * VT_STRIDE * 2;
__device__ __forceinline__ void attn_item(const Ptrs& P, LAS unsigned char* lds, int item, int tid, int lane, int wave) {
    const unsigned char* ws = P.ws;
    const bf16* proj = (const bf16*)(ws + WS_PROJ);
    const int kvh = item & 1, qb = (item >> 1) & 31, b = item >> 6;
    const int tb = b * SEQ, p0 = qb * 64;
    LAS bf16* KL = (LAS bf16*)(lds + KL_OFF); LAS bf16* VT = (LAS bf16*)(lds + VT_OFF); LAS float* BIASL = (LAS float*)(lds + BIASL_OFF);
#pragma unroll
    for (int i = 0; i < 3; ++i) {
        const int p = tid + 512 * i, key = p >> 3, ch = p & 7, kpos = p0 - 128 + key;
        u32x4 kw = (u32x4){0u, 0u, 0u, 0u}, vw = (u32x4){0u, 0u, 0u, 0u};
        if (kpos >= 0) { const bf16* src = proj + (size_t)(tb + kpos) * NIN + kvh * HD + 8 * ch; kw = *(const u32x4*)(src + C_K); vw = *(const u32x4*)(src + C_V); }
        float kf[8]; unpack8(kw, kf);
        float ss = 0.f;
#pragma unroll
        for (int j = 0; j < 8; ++j) ss += kf[j] * kf[j];
        ss += DPP_F(ss, 0xB1); ss += DPP_F(ss, 0x4E); ss += DPP_F(ss, 0x141);
        const float rinv = __builtin_amdgcn_rsqf(ss * (1.0f / HD) + EPS);
        const f32x4 g0 = *(const f32x4*)(P.k_norm_g + 8 * ch), g1 = *(const f32x4*)(P.k_norm_g + 8 * ch + 4);
        u32x4 o; o.x = pkbf(kf[0] * rinv * g0.x, kf[1] * rinv * g0.y); o.y = pkbf(kf[2] * rinv * g0.z, kf[3] * rinv * g0.w);
        o.z = pkbf(kf[4] * rinv * g1.x, kf[5] * rinv * g1.y); o.w = pkbf(kf[6] * rinv * g1.z, kf[7] * rinv * g1.w);
        *(LAS u32x4*)(KL + key * KL_STRIDE + 8 * ch) = o;
#pragma unroll
        for (int j = 0; j < 4; ++j) { VT[(8 * ch + 2 * j) * VT_STRIDE + key] = (bf16)(vw[j] & 0xffffu); VT[(8 * ch + 2 * j + 1) * VT_STRIDE + key] = (bf16)(vw[j] >> 16); }
    }
    for (int e = tid; e < 4 * 192; e += 512) { const int gg = e / 192, rel = e % 192 - 32;
        BIASL[e] = (rel >= 0 && rel < WIN) ? ((const float*)(ws + WS_BL))[(kvh * 4 + gg) * WIN + rel] : -1.0e30f; }
    __syncthreads();
    const int g = wave >> 1, a = wave & 1, head = kvh * 4 + g, q = lane & 31, hh = lane >> 5;
    const int tq = tb + p0 + 32 * a + q;
    bf16x8 Bq[4];
    {
        float qf[4][8]; float ss = 0.f;
#pragma unroll
        for (int s = 0; s < 4; ++s) { const u32x4 w = *(const u32x4*)(proj + (size_t)tq * NIN + C_Q + head * HD + 16 * s + 8 * hh); unpack8(w, qf[s]);
#pragma unroll
            for (int j = 0; j < 8; ++j) ss += qf[s][j] * qf[s][j]; }
        ss += __shfl_xor(ss, 32);
        const float rinv = 0.125f * __builtin_amdgcn_rsqf(ss * (1.0f / HD) + EPS);
#pragma unroll
        for (int s = 0; s < 4; ++s) { const f32x4 g0 = *(const f32x4*)(P.q_norm_g + 16 * s + 8 * hh), g1 = *(const f32x4*)(P.q_norm_g + 16 * s + 8 * hh + 4);
            u32x4 o; o.x = pkbf(qf[s][0] * rinv * g0.x, qf[s][1] * rinv * g0.y); o.y = pkbf(qf[s][2] * rinv * g0.z, qf[s][3] * rinv * g0.w);
            o.z = pkbf(qf[s][4] * rinv * g1.x, qf[s][5] * rinv * g1.y); o.w = pkbf(qf[s][6] * rinv * g1.z, qf[s][7] * rinv * g1.w);
            Bq[s] = __builtin_bit_cast(bf16x8, o); }
    }
    f32x16 sc[5];
#pragma unroll
    for (int c = 0; c < 5; ++c) {
#pragma unroll
        for (int r = 0; r < 16; ++r) sc[c][r] = 0.f;
#pragma unroll
        for (int s = 0; s < 4; ++s) { const bf16x8 A = *(const LAS bf16x8*)(KL + (32 * (a + c) + q) * KL_STRIDE + 16 * s + 8 * hh); sc[c] = MFMA32(A, Bq[s], sc[c]); }
    }
    const float sink = P.sinks[head];
    float m = sink;
    const LAS float* bias_base = BIASL + g * 192 + q + 160 - 4 * hh;
    const int kneg = p0 - 128 + 32 * a + 4 * hh;
#pragma unroll
    for (int c = 0; c < 5; ++c)
#pragma unroll
        for (int r = 0; r < 16; ++r) { const int kw0 = 32 * c + (r & 3) + 8 * (r >> 2);
            const float bv = bias_base[-kw0];
            float v = sc[c][r] + bv; v = (kneg + kw0 >= 0) ? v : -1.0e30f; sc[c][r] = v; m = fmaxf(m, v); }
    m = fmaxf(m, __shfl_xor(m, 32));
    float l = 0.f;
#pragma unroll
    for (int c = 0; c < 5; ++c)
#pragma unroll
        for (int r = 0; r < 16; ++r) { const float p = __expf(sc[c][r] - m); sc[c][r] = p; l += p; }
    l += __shfl_xor(l, 32);
    const float inv = 1.0f / (l + __expf(sink - m));
    f32x16 oacc[2];
#pragma unroll
    for (int dt = 0; dt < 2; ++dt)
#pragma unroll
        for (int r = 0; r < 16; ++r) oacc[dt][r] = 0.f;
#pragma unroll
    for (int c = 0; c < 5; ++c)
#pragma unroll
        for (int s2 = 0; s2 < 2; ++s2) {
            u32x4 pw; pw.x = pkbf(sc[c][8 * s2 + 0], sc[c][8 * s2 + 1]); pw.y = pkbf(sc[c][8 * s2 + 2], sc[c][8 * s2 + 3]); pw.z = pkbf(sc[c][8 * s2 + 4], sc[c][8 * s2 + 5]); pw.w = pkbf(sc[c][8 * s2 + 6], sc[c][8 * s2 + 7]);
            const bf16x8 Pb = __builtin_bit_cast(bf16x8, pw);
            const int kb = 32 * (a + c) + 16 * s2 + 4 * hh;
#pragma unroll
            for (int dt = 0; dt < 2; ++dt) { const LAS bf16* vr = VT + (32 * dt + q) * VT_STRIDE + kb;
                const u32x2 lo = *(const LAS u32x2*)vr, hi = *(const LAS u32x2*)(vr + 8);
                const bf16x8 Av = __builtin_bit_cast(bf16x8, (u32x4){lo.x, lo.y, hi.x, hi.y});
                oacc[dt] = MFMA32(Av, Pb, oacc[dt]); }
        }
    float ss = 0.f;
    bf16* orow = (bf16*)(ws + WS_MIX) + (size_t)tq * D + LRU_W + head * HD + 4 * hh;
#pragma unroll
    for (int dt = 0; dt < 2; ++dt)
#pragma unroll
        for (int r4 = 0; r4 < 4; ++r4) { const float o0 = oacc[dt][4 * r4] * inv, o1 = oacc[dt][4 * r4 + 1] * inv, o2 = oacc[dt][4 * r4 + 2] * inv, o3 = oacc[dt][4 * r4 + 3] * inv;
            ss += (o0 * o0 + o1 * o1) + (o2 * o2 + o3 * o3);
            u32x2 w; w.x = pkbf(o0, o1); w.y = pkbf(o2, o3); *(u32x2*)(orow + 32 * dt + 8 * r4) = w; }
    ss += __shfl_xor(ss, 32);
    if (hh == 0) ((float*)(ws + WS_SSQA))[(size_t)tq * 8 + head] = ss;
    __syncthreads();
}

__device__ __forceinline__ void bar4(volatile LAS unsigned* cnt, unsigned& target, int lane) {
    asm volatile("s_waitcnt vmcnt(0) lgkmcnt(0)" ::: "memory");
    target += 4u;
    if (lane == 0) (void)__hip_atomic_fetch_add((LAS unsigned*)cnt, 1u, __ATOMIC_RELAXED, __HIP_MEMORY_SCOPE_WORKGROUP);
    while (*cnt < target) __builtin_amdgcn_s_sleep(1);
    asm volatile("" ::: "memory");
}
__device__ __forceinline__ void attn_item4(const Ptrs& P, LAS unsigned char* lds, int item, int tid, int lane, int wave, volatile LAS unsigned* bcnt, unsigned& btgt) {
    const unsigned char* ws = P.ws;
    const bf16* proj = (const bf16*)(ws + WS_PROJ);
    const int kvh = item & 1, qb = (item >> 1) & 31, b = item >> 6;
    const int tb = b * SEQ, p0 = qb * 64;
    LAS bf16* KL = (LAS bf16*)(lds + KL_OFF); LAS bf16* VT = (LAS bf16*)(lds + VT_OFF); LAS float* BIASL = (LAS float*)(lds + BIASL_OFF);
#pragma unroll
    for (int i = 0; i < 6; ++i) {
        const int p = tid + 256 * i, key = p >> 3, ch = p & 7, kpos = p0 - 128 + key;
        u32x4 kw = (u32x4){0u, 0u, 0u, 0u}, vw = (u32x4){0u, 0u, 0u, 0u};
        if (kpos >= 0) { const bf16* src = proj + (size_t)(tb + kpos) * NIN + kvh * HD + 8 * ch; kw = *(const u32x4*)(src + C_K); vw = *(const u32x4*)(src + C_V); }
        float kf[8]; unpack8(kw, kf);
        float ss = 0.f;
#pragma unroll
        for (int j = 0; j < 8; ++j) ss += kf[j] * kf[j];
        ss += DPP_F(ss, 0xB1); ss += DPP_F(ss, 0x4E); ss += DPP_F(ss, 0x141);
        const float rinv = __builtin_amdgcn_rsqf(ss * (1.0f / HD) + EPS);
        const f32x4 g0 = *(const f32x4*)(P.k_norm_g + 8 * ch), g1 = *(const f32x4*)(P.k_norm_g + 8 * ch + 4);
        u32x4 o; o.x = pkbf(kf[0] * rinv * g0.x, kf[1] * rinv * g0.y); o.y = pkbf(kf[2] * rinv * g0.z, kf[3] * rinv * g0.w);
        o.z = pkbf(kf[4] * rinv * g1.x, kf[5] * rinv * g1.y); o.w = pkbf(kf[6] * rinv * g1.z, kf[7] * rinv * g1.w);
        *(LAS u32x4*)(KL + key * KL_STRIDE + 8 * ch) = o;
#pragma unroll
        for (int j = 0; j < 4; ++j) { VT[(8 * ch + 2 * j) * VT_STRIDE + key] = (bf16)(vw[j] & 0xffffu); VT[(8 * ch + 2 * j + 1) * VT_STRIDE + key] = (bf16)(vw[j] >> 16); }
    }
    for (int e = tid; e < 4 * 192; e += 256) { const int gg = e / 192, rel = e % 192 - 32;
        BIASL[e] = (rel >= 0 && rel < WIN) ? ((const float*)(ws + WS_BL))[(kvh * 4 + gg) * WIN + rel] : -1.0e30f; }
    bar4(bcnt, btgt, lane);
#pragma unroll 1
    for (int a = 0; a < 2; ++a) {
    const int g = wave, head = kvh * 4 + g, q = lane & 31, hh = lane >> 5;
    const int tq = tb + p0 + 32 * a + q;
    bf16x8 Bq[4];
    {
        float qf[4][8]; float ss = 0.f;
#pragma unroll
        for (int s = 0; s < 4; ++s) { const u32x4 w = *(const u32x4*)(proj + (size_t)tq * NIN + C_Q + head * HD + 16 * s + 8 * hh); unpack8(w, qf[s]);
#pragma unroll
            for (int j = 0; j < 8; ++j) ss += qf[s][j] * qf[s][j]; }
        ss += __shfl_xor(ss, 32);
        const float rinv = 0.125f * __builtin_amdgcn_rsqf(ss * (1.0f / HD) + EPS);
#pragma unroll
        for (int s = 0; s < 4; ++s) { const f32x4 g0 = *(const f32x4*)(P.q_norm_g + 16 * s + 8 * hh), g1 = *(const f32x4*)(P.q_norm_g + 16 * s + 8 * hh + 4);
            u32x4 o; o.x = pkbf(qf[s][0] * rinv * g0.x, qf[s][1] * rinv * g0.y); o.y = pkbf(qf[s][2] * rinv * g0.z, qf[s][3] * rinv * g0.w);
            o.z = pkbf(qf[s][4] * rinv * g1.x, qf[s][5] * rinv * g1.y); o.w = pkbf(qf[s][6] * rinv * g1.z, qf[s][7] * rinv * g1.w);
            Bq[s] = __builtin_bit_cast(bf16x8, o); }
    }
    f32x16 sc[5];
#pragma unroll
    for (int c = 0; c < 5; ++c) {
#pragma unroll
        for (int r = 0; r < 16; ++r) sc[c][r] = 0.f;
#pragma unroll
        for (int s = 0; s < 4; ++s) { const bf16x8 A = *(const LAS bf16x8*)(KL + (32 * (a + c) + q) * KL_STRIDE + 16 * s + 8 * hh); sc[c] = MFMA32(A, Bq[s], sc[c]); }
    }
    const float sink = P.sinks[head];
    float m = sink;
    const LAS float* bias_base = BIASL + g * 192 + q + 160 - 4 * hh;
    const int kneg = p0 - 128 + 32 * a + 4 * hh;
#pragma unroll
    for (int c = 0; c < 5; ++c)
#pragma unroll
        for (int r = 0; r < 16; ++r) { const int kw0 = 32 * c + (r & 3) + 8 * (r >> 2);
            const float bv = bias_base[-kw0];
            float v = sc[c][r] + bv; v = (kneg + kw0 >= 0) ? v : -1.0e30f; sc[c][r] = v; m = fmaxf(m, v); }
    m = fmaxf(m, __shfl_xor(m, 32));
    float l = 0.f;
#pragma unroll
    for (int c = 0; c < 5; ++c)
#pragma unroll
        for (int r = 0; r < 16; ++r) { const float p = __expf(sc[c][r] - m); sc[c][r] = p; l += p; }
    l += __shfl_xor(l, 32);
    const float inv = 1.0f / (l + __expf(sink - m));
    f32x16 oacc[2];
#pragma unroll
    for (int dt = 0; dt < 2; ++dt)
#pragma unroll
        for (int r = 0; r < 16; ++r) oacc[dt][r] = 0.f;
#pragma unroll
    for (int c = 0; c < 5; ++c)
#pragma unroll
        for (int s2 = 0; s2 < 2; ++s2) {
            u32x4 pw; pw.x = pkbf(sc[c][8 * s2 + 0], sc[c][8 * s2 + 1]); pw.y = pkbf(sc[c][8 * s2 + 2], sc[c][8 * s2 + 3]); pw.z = pkbf(sc[c][8 * s2 + 4], sc[c][8 * s2 + 5]); pw.w = pkbf(sc[c][8 * s2 + 6], sc[c][8 * s2 + 7]);
            const bf16x8 Pb = __builtin_bit_cast(bf16x8, pw);
            const int kb = 32 * (a + c) + 16 * s2 + 4 * hh;
#pragma unroll
            for (int dt = 0; dt < 2; ++dt) { const LAS bf16* vr = VT + (32 * dt + q) * VT_STRIDE + kb;
                const u32x2 lo = *(const LAS u32x2*)vr, hi = *(const LAS u32x2*)(vr + 8);
                const bf16x8 Av = __builtin_bit_cast(bf16x8, (u32x4){lo.x, lo.y, hi.x, hi.y});
                oacc[dt] = MFMA32(Av, Pb, oacc[dt]); }
        }
    float ss = 0.f;
    bf16* orow = (bf16*)(ws + WS_MIX) + (size_t)tq * D + LRU_W + head * HD + 4 * hh;
#pragma unroll
    for (int dt = 0; dt < 2; ++dt)
#pragma unroll
        for (int r4 = 0; r4 < 4; ++r4) { const float o0 = oacc[dt][4 * r4] * inv, o1 = oacc[dt][4 * r4 + 1] * inv, o2 = oacc[dt][4 * r4 + 2] * inv, o3 = oacc[dt][4 * r4 + 3] * inv;
            ss += (o0 * o0 + o1 * o1) + (o2 * o2 + o3 * o3);
            u32x2 w; w.x = pkbf(o0, o1); w.y = pkbf(o2, o3); *(u32x2*)(orow + 32 * dt + 8 * r4) = w; }
    ss += __shfl_xor(ss, 32);
    if (hh == 0) ((float*)(ws + WS_SSQA))[(size_t)tq * 8 + head] = ss;
    }
    bar4(bcnt, btgt, lane);
}

constexpr int LR_XB = 0, LR_XCF = 17408, LR_XCB = 33792, LR_LA = 43008, LR_LB = 59392, LR_XG = 75776, LR_GB = 92160, LR_TOT = 108544, LR_H0 = 112640, LR_CW = 113152, LR_PAR = 114432, LR_ASEG = 115200  ;
constexpr int XCB_STRIDE = 72;
constexpr size_t WS_AGG = 14 * MiB + 512 * 1024;
constexpr size_t WS_HLAC = 80 * MiB;
template <int MODE> __device__ __forceinline__ void lru_seg(const Ptrs& P, LAS unsigned char* lds, int item, int tid, int lane, int wave) {
    unsigned char* ws = P.ws;
    const bf16* proj = (const bf16*)(ws + WS_PROJ);
    const int n = item & 7, seg = (item >> 3) & 7, b = item >> 6, tb = b * SEQ, s0 = seg * 256;
    LAS float* XB = (LAS float*)(lds + LR_XB); LAS float* XCF = (LAS float*)(lds + LR_XCF); LAS bf16* XCB = (LAS bf16*)(lds + LR_XCB);
    LAS float* LA = (LAS float*)(lds + LR_LA); LAS float* LB = (LAS float*)(lds + LR_LB); LAS float* XG = (LAS float*)(lds + LR_XG); LAS float* GBL = (LAS float*)(lds + LR_GB);
    LAS float* TOT = (LAS float*)(lds + LR_TOT); LAS float* H0 = (LAS float*)(lds + LR_H0); LAS float* CW = (LAS float*)(lds + LR_CW); LAS float* PAR = (LAS float*)(lds + LR_PAR); LAS float* ASEG = (LAS float*)(lds + LR_ASEG);
    float* agg = (float*)(ws + WS_AGG) + (size_t)((b * NBLK + n) * 8) * 128;
    if (tid < 64) { const int c = n * BLK + tid;
#pragma unroll
        for (int k = 0; k < 4; ++k) CW[k * 64 + tid] = P.conv_w[k * LRU_W + c];
        CW[4 * 64 + tid] = P.conv_b[c];
        PAR[tid] = P.b_gate_a[c]; PAR[64 + tid] = P.b_gate_x[c]; PAR[128 + tid] = log1pf(expf(-P.lru_L[c]));
        float h = 0.f;
        if (MODE) for (int sp = 0; sp < seg; ++sp) h = agg[sp * 128 + tid] * h + agg[sp * 128 + 64 + tid];
        H0[tid] = h; ASEG[tid] = 1.f; ASEG[64 + tid] = 1.f; }
    const int gsel = wave >> 2, tm = (wave >> 1) & 1, tn = wave & 1, jl = lane & 31, hh = lane >> 5;
    bf16x8 Bg[4];
#pragma unroll
    for (int s = 0; s < 4; ++s) Bg[s] = *(const bf16x8*)((const bf16*)(ws + WS_WGT) + ((size_t)(gsel * NBLK + n) * BLK + 32 * tn + jl) * BLK + 16 * s + 8 * hh);
    const int prow = tid >> 3, pch = tid & 7;
    u32x4 pxa, pxb = (u32x4){0u, 0u, 0u, 0u}, pg = (u32x4){0u, 0u, 0u, 0u};
#define LRU_PREFETCH(t0_) do { const int sp_ = (t0_) - 3 + prow; pxa = (u32x4){0u, 0u, 0u, 0u}; \
        if (sp_ >= 0) pxa = *(const u32x4*)(proj + (size_t)(tb + sp_) * NIN + C_XB + n * BLK + 8 * pch); \
        if (tid < 24) pxb = *(const u32x4*)(proj + (size_t)(tb + (t0_) - 3 + 64 + prow) * NIN + C_XB + n * BLK + 8 * pch); \
        if (MODE) pg = *(const u32x4*)(proj + (size_t)(tb + (t0_) + prow) * NIN + C_GB + n * BLK + 8 * pch); } while (0)
    LRU_PREFETCH(s0);
    __syncthreads();
    const int jc = 32 * tn + jl;
    const float gbias = PAR[gsel * 64 + jc], sp8 = -8.0f * PAR[128 + jc];
#pragma unroll 1
    for (int ck = 0; ck < 4; ++ck) {
        const int t0 = s0 + ck * 64, par = ck & 1;
        { float f[8]; unpack8(pxa, f);
            *(LAS f32x4*)(XB + prow * 64 + 8 * pch) = (f32x4){f[0], f[1], f[2], f[3]}; *(LAS f32x4*)(XB + prow * 64 + 8 * pch + 4) = (f32x4){f[4], f[5], f[6], f[7]};
            if (tid < 24) { unpack8(pxb, f); *(LAS f32x4*)(XB + (64 + prow) * 64 + 8 * pch) = (f32x4){f[0], f[1], f[2], f[3]}; *(LAS f32x4*)(XB + (64 + prow) * 64 + 8 * pch + 4) = (f32x4){f[4], f[5], f[6], f[7]}; }
            if (MODE) { unpack8(pg, f);
#pragma unroll
                for (int q = 0; q < 8; ++q) f[q] = gelu_tanh(f[q]);
                *(LAS f32x4*)(GBL + prow * 64 + 8 * pch) = (f32x4){f[0], f[1], f[2], f[3]}; *(LAS f32x4*)(GBL + prow * 64 + 8 * pch + 4) = (f32x4){f[4], f[5], f[6], f[7]}; } }
        if (ck < 3) LRU_PREFETCH(t0 + 64);
        __syncthreads();
        { const int t = tid >> 3, c0 = 8 * (tid & 7); float xc[8];
#pragma unroll
            for (int i = 0; i < 8; ++i) { const int c = c0 + i; float v = CW[4 * 64 + c];
#pragma unroll
                for (int k = 0; k < 4; ++k) v += CW[k * 64 + c] * XB[(t + k) * 64 + c];
                xc[i] = v; }
            *(LAS f32x4*)(XCF + t * 64 + c0) = (f32x4){xc[0], xc[1], xc[2], xc[3]}; *(LAS f32x4*)(XCF + t * 64 + c0 + 4) = (f32x4){xc[4], xc[5], xc[6], xc[7]};
            u32x4 o; o.x = pkbf(xc[0], xc[1]); o.y = pkbf(xc[2], xc[3]); o.z = pkbf(xc[4], xc[5]); o.w = pkbf(xc[6], xc[7]);
            *(LAS u32x4*)(XCB + t * XCB_STRIDE + c0) = o; }
        __syncthreads();
        { f32x16 z;
#pragma unroll
            for (int r = 0; r < 16; ++r) z[r] = 0.f;
#pragma unroll
            for (int s = 0; s < 4; ++s) { const bf16x8 A = *(const LAS bf16x8*)(XCB + (32 * tm + jl) * XCB_STRIDE + 16 * s + 8 * hh); z = MFMA32(A, Bg[s], z); }
            if (gsel == 0) {
#pragma unroll
                for (int r = 0; r < 16; ++r) { const int tt = 32 * tm + crow(r, hh); const float rg = sigmoidf(z[r] + gbias);
                    const float la = sp8 * rg, aa = __expf(la), x2 = 2.0f * la;
                    const float om = -x2 * (1.0f + x2 * (0.5f + x2 * (0.16666667f + x2 * (0.041666668f + x2 * (0.0083333338f + x2 * 0.0013888889f)))));
                    LA[tt * 64 + jc] = aa; LB[tt * 64 + jc] = __builtin_amdgcn_sqrtf(om); }
            } else {
#pragma unroll
                for (int r = 0; r < 16; ++r) { const int tt = 32 * tm + crow(r, hh); XG[tt * 64 + jc] = sigmoidf(z[r] + gbias) * XCF[tt * 64 + jc]; }
            } }
        __syncthreads();
        float Ac[8], Hl[8];
        { float A = 1.f, H = 0.f;
#pragma unroll
            for (int i = 0; i < 8; ++i) { const int t = 8 * wave + i; const float av = LA[t * 64 + lane], bv = LB[t * 64 + lane] * XG[t * 64 + lane]; H = av * H + bv; A = A * av; Ac[i] = A; Hl[i] = H; }
            TOT[(wave * 64 + lane) * 2] = A; TOT[(wave * 64 + lane) * 2 + 1] = H; }
        __syncthreads();
        { float cin = H0[par * 64 + lane], ain = ASEG[par * 64 + lane];
            for (int s = 0; s < wave; ++s) { const float ta = TOT[(s * 64 + lane) * 2]; cin = ta * cin + TOT[(s * 64 + lane) * 2 + 1]; ain *= ta; }
            if (wave == 7) { const float ta = TOT[(7 * 64 + lane) * 2]; H0[(par ^ 1) * 64 + lane] = ta * cin + TOT[(7 * 64 + lane) * 2 + 1]; ASEG[(par ^ 1) * 64 + lane] = ain * ta; }
            if (!MODE) {
                unsigned* hl = (unsigned*)(ws + WS_HLAC) + (size_t)(tb + t0 + 8 * wave) * LRU_W + n * BLK + lane;
#pragma unroll
                for (int i = 0; i < 8; ++i) hl[(size_t)i * LRU_W] = pkbf(Hl[i] + Ac[i] * cin, Ac[i] * ain);
            } else {
#pragma unroll
                for (int i = 0; i < 8; ++i) { const int t = 8 * wave + i; const float h = Hl[i] + Ac[i] * cin; const float y = h * GBL[t * 64 + lane];
                    const size_t tok = (size_t)(tb + t0 + t);
                    ((bf16*)(ws + WS_MIX))[tok * D + n * BLK + lane] = (bf16)f2bf(y);
                    const float ss = wave_sum_u(y * y);
                    if (lane == 0) ((float*)(ws + WS_SSQL))[tok * 8 + n] = ss; } } }
        __syncthreads();
    }
#undef LRU_PREFETCH
    if (!MODE && tid < 64) { agg[seg * 128 + tid] = ASEG[tid]; agg[seg * 128 + 64 + tid] = H0[tid]; }
    __syncthreads();
}

constexpr size_t WS_AGG16 = 14 * MiB + 512 * 1024;
__device__ __forceinline__ void lru_wave_task(const Ptrs& P, LAS float* cwl, int task, int lane) {
    unsigned char* ws = P.ws;
    const bf16* proj = (const bf16*)(ws + WS_PROJ);
    const int nt = task & 1, hs = (task >> 1) & 15, n = (task >> 5) & 7, b = task >> 8, tb = b * SEQ, s0 = hs * 128;
    for (int e = lane; e < 5 * 64; e += 64) { const int k = e >> 6, c = e & 63; cwl[e] = (k < 4) ? P.conv_w[k * LRU_W + n * BLK + c] : P.conv_b[n * BLK + c]; }
    const int jl = lane & 31, hh = lane >> 5, jc = 32 * nt + jl, cg = n * BLK + jc;
    const bf16* wga = (const bf16*)(ws + WS_WGT) + ((size_t)(0 * NBLK + n) * BLK + jc) * BLK + 8 * hh;
    const bf16* wgx = (const bf16*)(ws + WS_WGT) + ((size_t)(1 * NBLK + n) * BLK + jc) * BLK + 8 * hh;
    const float ba = P.b_gate_a[cg], bxg = P.b_gate_x[cg], sp8 = -8.0f * log1pf(expf(-P.lru_L[cg]));
    float cin = 0.f, ain = 1.f;
    LAS bf16* xbl = (LAS bf16*)(cwl + 5 * 64);
    u32x4 pr[5];
#define LRU_PREF(ti_) do { _Pragma("unroll") for (int i = 0; i < 5; ++i) { const int p = lane + 64 * i, row = p >> 3, ch = p & 7, pos = s0 + 32 * (ti_) - 3 + row; pr[i] = (u32x4){0u, 0u, 0u, 0u}; \
        if (p < 35 * 8 && pos >= 0 && (ti_) < 4) pr[i] = *(const u32x4*)(proj + (size_t)(tb + pos) * NIN + C_XB + n * BLK + 8 * ch); } } while (0)
    LRU_PREF(0);
    bf16x8 Ba = *(const bf16x8*)wga, Bx = *(const bf16x8*)wgx;
#pragma unroll 1
    for (int ti = 0; ti < 4; ++ti) {
        const int t0 = s0 + 32 * ti;
#pragma unroll
        for (int i = 0; i < 5; ++i) { const int p = lane + 64 * i; if (p < 35 * 8) *(LAS u32x4*)(xbl + (p >> 3) * 72 + 8 * (p & 7)) = pr[i]; }
        LRU_PREF(ti + 1);
        f32x16 za, zx, zc;
#pragma unroll
        for (int r = 0; r < 16; ++r) { za[r] = 0.f; zx[r] = 0.f; zc[r] = 0.f; }
#pragma unroll
        for (int s = 0; s < 4; ++s) { const int ch0 = 16 * s + 8 * hh;
            const bf16x8 Ban = *(const bf16x8*)(wga + 16 * ((s + 1) & 3)), Bxn = *(const bf16x8*)(wgx + 16 * ((s + 1) & 3));
            float xc[8];
            { const f32x4 b0 = *(const LAS f32x4*)(cwl + 4 * 64 + ch0), b1 = *(const LAS f32x4*)(cwl + 4 * 64 + ch0 + 4);
              xc[0] = b0.x; xc[1] = b0.y; xc[2] = b0.z; xc[3] = b0.w; xc[4] = b1.x; xc[5] = b1.y; xc[6] = b1.z; xc[7] = b1.w; }
#pragma unroll
            for (int tap = 0; tap < 4; ++tap) { const f32x4 w0 = *(const LAS f32x4*)(cwl + tap * 64 + ch0), w1 = *(const LAS f32x4*)(cwl + tap * 64 + ch0 + 4);
                float xf[8]; unpack8(*(const LAS u32x4*)(xbl + (jl + tap) * 72 + ch0), xf);
                xc[0] += w0.x * xf[0]; xc[1] += w0.y * xf[1]; xc[2] += w0.z * xf[2]; xc[3] += w0.w * xf[3]; xc[4] += w1.x * xf[4]; xc[5] += w1.y * xf[5]; xc[6] += w1.z * xf[6]; xc[7] += w1.w * xf[7]; }
            u32x4 o; o.x = pkbf(xc[0], xc[1]); o.y = pkbf(xc[2], xc[3]); o.z = pkbf(xc[4], xc[5]); o.w = pkbf(xc[6], xc[7]);
            const bf16x8 Af = __builtin_bit_cast(bf16x8, o);
            u32x4 idw;
#pragma unroll
            for (int w = 0; w < 4; ++w) { const int k0 = 16 * s + 8 * hh + 2 * w; idw[w] = (k0 == jc ? 0x3F80u : 0u) | (k0 + 1 == jc ? 0x3F800000u : 0u); }
            za = MFMA32(Af, Ba, za); zx = MFMA32(Af, Bx, zx); zc = MFMA32(Af, __builtin_bit_cast(bf16x8, idw), zc);
            Ba = Ban; Bx = Bxn;
            __builtin_amdgcn_sched_barrier(0); }
        float av[16], bv[16];
#pragma unroll
        for (int r = 0; r < 16; ++r) { const float zar = za[r], zxr = zx[r], zcr = zc[r];
            const float rg = sigmoidf(zar + ba), ig = sigmoidf(zxr + bxg), la = sp8 * rg, x2 = 2.0f * la;
            const float om = -x2 * (1.0f + x2 * (0.5f + x2 * (0.16666667f + x2 * (0.041666668f + x2 * (0.0083333338f + x2 * 0.0013888889f)))));
            av[r] = __expf(la); bv[r] = __builtin_amdgcn_sqrtf(om) * ig * zcr; }
        float RA[4], RH[4];
#pragma unroll
        for (int q = 0; q < 4; ++q) { float A = 1.f, H = 0.f;
#pragma unroll
            for (int i = 0; i < 4; ++i) { const int r = 4 * q + i; H = av[r] * H + bv[r]; A = A * av[r]; av[r] = A; bv[r] = H; }
            RA[q] = A; RH[q] = H; }
        const int hm = hh ? -1 : 0;
        float cH[4], cA[4];
#pragma unroll
        for (int q = 0; q < 4; ++q) { const float pa = __shfl_xor(RA[q], 32), ph = __shfl_xor(RH[q], 32);
            const float r0a = fsel(hm, pa, RA[q]), r0h = fsel(hm, ph, RH[q]), r1a = fsel(hm, RA[q], pa), r1h = fsel(hm, RH[q], ph);
            const float mid = r0a * cin + r0h, amid = ain * r0a;
            cH[q] = fsel(hm, mid, cin); cA[q] = fsel(hm, amid, ain);
            cin = r1a * mid + r1h; ain = amid * r1a; }
        unsigned* hl = (unsigned*)(ws + WS_HLAC) + (size_t)(tb + t0 + 4 * hh) * LRU_W + cg;
#pragma unroll
        for (int r = 0; r < 16; ++r) { const int q = r >> 2; hl[(size_t)((r & 3) + 8 * q) * LRU_W] = pkbf(bv[r] + av[r] * cH[q], av[r] * cA[q]); }
    }
#undef LRU_PREF
    if (hh == 0) { float* agg = (float*)(ws + WS_AGG16) + (size_t)((b * NBLK + n) * 16 + hs) * 128; agg[jc] = ain; agg[64 + jc] = cin; }
}

__device__ __forceinline__ void p2_mixer_a(const Ptrs& P, LAS unsigned char* lds, volatile LAS unsigned* MISC, unsigned* ctl, int tid, int lane, int wave, int gw, int NGW) {
    if (wave < 4) {
        unsigned btgt = 0u;
        for (int item = (int)blockIdx.x; item < BATCH * 32 * NKV; item += (int)gridDim.x) attn_item4(P, lds, item, tid, lane, wave, MISC + 24, btgt);
    } else {
        const int lw = (gw >> 3) * 4 + (wave - 4), NLW = NGW / 2;
        for (int task = lw; task < BATCH * NBLK * 16 * 2; task += NLW) lru_wave_task(P, (LAS float*)(lds + 65536 + (wave - 4) * 8192), task, lane);
    }
}
__device__ __forceinline__ void p2_mixer_b(const Ptrs& P, LAS unsigned char* lds, int bx, int G, int tid, int lane, int wave) {
    unsigned char* ws = P.ws;
    LAS float* CAR = (LAS float*)lds;
    for (int item = bx; item < BATCH * 8 * 4; item += G) {
        const int q = item & 3, seg = (item >> 2) & 7, b = item >> 5;
        { const int c = tid, n = c >> 6, j = c & 63, hs = 2 * seg + (q >> 1); const float* agg = (const float*)(ws + WS_AGG16) + (size_t)((b * NBLK + n) * 16) * 128;
            float h = 0.f;
            for (int sp = 0; sp < hs; ++sp) h = agg[sp * 128 + j] * h + agg[sp * 128 + 64 + j];
            CAR[c] = h; }
        __syncthreads();
        const f32x4 c0 = *(const LAS f32x4*)(CAR + 8 * lane), c1 = *(const LAS f32x4*)(CAR + 8 * lane + 4);
        const float car[8] = {c0.x, c0.y, c0.z, c0.w, c1.x, c1.y, c1.z, c1.w};
        const int tok0 = b * SEQ + seg * 256 + q * 64 + wave * 8;
        u32x4 H0[8], H1[8], G4[8];
#pragma unroll
        for (int i = 0; i < 8; ++i) { const size_t tok = (size_t)(tok0 + i);
            const unsigned* hl = (const unsigned*)(ws + WS_HLAC) + tok * LRU_W + 8 * lane;
            H0[i] = *(const u32x4*)hl; H1[i] = *(const u32x4*)(hl + 4);
            G4[i] = *(const u32x4*)((const bf16*)(ws + WS_PROJ) + tok * NIN + C_GB + 8 * lane); }
#pragma unroll
        for (int i = 0; i < 8; ++i) { const size_t tok = (size_t)(tok0 + i);
            const u32x4 h0 = H0[i], h1 = H1[i];
            float gf[8]; unpack8(G4[i], gf);
            const unsigned hw[8] = {h0.x, h0.y, h0.z, h0.w, h1.x, h1.y, h1.z, h1.w};
            float y[8], ss = 0.f;
#pragma unroll
            for (int k = 0; k < 8; ++k) { y[k] = (bflo(hw[k]) + bfhi(hw[k]) * car[k]) * gelu_tanh(gf[k]); ss += y[k] * y[k]; }
            u32x4 o; o.x = pkbf(y[0], y[1]); o.y = pkbf(y[2], y[3]); o.z = pkbf(y[4], y[5]); o.w = pkbf(y[6], y[7]);
            *(u32x4*)((bf16*)(ws + WS_MIX) + tok * D + 8 * lane) = o;
            ss += DPP_F(ss, 0xB1); ss += DPP_F(ss, 0x4E); ss += DPP_F(ss, 0x141);
            if ((lane & 7) == 0) ((float*)(ws + WS_SSQL))[tok * 8 + (lane >> 3)] = ss; }
        __syncthreads();
    }
}

template <int N> __device__ __forceinline__ void bitonic_sort_desc(int (&v)[N]) {
#pragma unroll
    for (int k = 2; k <= N; k <<= 1)
#pragma unroll
        for (int j = k >> 1; j > 0; j >>= 1)
#pragma unroll
            for (int i = 0; i < N; ++i) { const int l = i ^ j; if (l > i) { const bool desc = ((i & k) == 0); const int hi = max(v[i], v[l]), lo = min(v[i], v[l]); v[i] = desc ? hi : lo; v[l] = desc ? lo : hi; } }
}
__device__ __forceinline__ void sort16_desc(int (&a)[16]) {
#define CE(i, j) { const int hi_ = max(a[i], a[j]), lo_ = min(a[i], a[j]); a[i] = hi_; a[j] = lo_; }
    CE(0,13) CE(1,12) CE(2,15) CE(3,14) CE(4,8) CE(5,6) CE(7,11) CE(9,10) CE(0,5) CE(1,7) CE(2,9) CE(3,4) CE(6,13) CE(8,14) CE(10,15) CE(11,12) CE(0,1) CE(2,3) CE(4,5) CE(6,8) CE(7,9) CE(10,11) CE(12,13) CE(14,15) CE(0,2) CE(1,3) CE(4,10) CE(5,11) CE(6,7) CE(8,9) CE(12,14) CE(13,15) CE(1,2) CE(3,12) CE(4,6) CE(5,7) CE(8,10) CE(9,11) CE(13,14) CE(1,4) CE(2,6) CE(5,8) CE(7,10) CE(9,13) CE(11,14) CE(2,4) CE(3,6) CE(9,12) CE(11,13) CE(3,5) CE(6,8) CE(7,9) CE(10,12) CE(3,4) CE(5,6) CE(7,8) CE(9,10) CE(11,12) CE(6,7) CE(8,9)
#undef CE
}
__device__ __forceinline__ void merge_top16(int (&a)[16], const int (&b)[16]) {
#pragma unroll
    for (int i = 0; i < 16; ++i) a[i] = max(a[i], b[15 - i]);
#pragma unroll
    for (int j = 8; j > 0; j >>= 1)
#pragma unroll
        for (int i = 0; i < 16; ++i) { const int l = i ^ j; if (l > i) { const int hi = max(a[i], a[l]), lo = min(a[i], a[l]); a[i] = hi; a[l] = lo; } }
}
__device__ __forceinline__ int f2key(unsigned bits) { const int b = (int)bits; return b ^ ((b >> 31) & 0x7fffffff); }
struct CandTab { int i[64], j[64], n; constexpr CandTab() : i{}, j{}, n(0) { for (int a = 0; a < 16; ++a) for (int b = 0; b < 16; ++b) if ((a + 1) * (b + 1) <= 16) { i[n] = a; j[n] = b; ++n; } } };
constexpr int SKL_STRIDE = 136;
constexpr int SKL_BYTES = 256 * SKL_STRIDE * 2;
__device__ __forceinline__ void p5_topk(const Ptrs& P, LAS unsigned char* lds, const pg8::StaticOrder& S, int tid, int lane, int wave, int gw, int NGW) {
    const unsigned char* ws = P.ws;
    constexpr CandTab CT;
    static_assert(CT.n <= 64, "candidate table");
    const bf16* Q = (const bf16*)(ws + WS_Q); const bf16* SK = (const bf16*)(ws + WS_SKB);
    LAS bf16* SKL = (LAS bf16*)lds;
    LAS unsigned char* ib = lds + SKL_BYTES + (wave * 64 + lane) * 32;
    const int tl = lane & 31, hh = lane >> 5;
    const bool conv = wave >= 4;
    const int NCW = NGW / 2;
    int cvn = (gw >> 3) * 4 + (wave & 3);
#pragma unroll 1
    for (int round = 0; ; ++round) {
        pg8::Unit u; if (!S.next(round, u)) break;
        const int h = u.pn;
#pragma unroll
        for (int i = 0; i < 8; ++i) { const int p = tid + 512 * i, row = p >> 4, ch = p & 15;
            const u32x4 w = *(const u32x4*)(SK + ((size_t)(h * 2) * NKEYS + row) * DHALF + 8 * ch); *(LAS u32x4*)(SKL + row * SKL_STRIDE + 8 * ch) = w; }
        __syncthreads();
        if (conv) {
            constexpr int NGRP = 2 * NEXP / 4;
            ExpRows EA, EB;
            EA.load(P, 4 * min(cvn, NGRP - 1), lane); EB.load(P, 4 * min(cvn + NCW, NGRP - 1), lane);
            EA.finish(P, lane); EA.load(P, 4 * min(cvn + 2 * NCW, NGRP - 1), lane);
            EB.finish(P, lane); EB.load(P, 4 * min(cvn + 3 * NCW, NGRP - 1), lane);
            EA.finish(P, lane); EB.finish(P, lane);
            cvn += 4 * NCW;
        } else
#pragma unroll 1
        for (int sub = 0; sub < 2; ++sub) {
        const int tg = u.pm * 8 + wave + 4 * sub;
        const int t = tg * 32 + tl;
        float r2;
        { const float* sp = (const float*)(ws + WS_SSQ2) + (size_t)t * 16; const f32x4 s0 = *(const f32x4*)sp, s1 = *(const f32x4*)(sp + 4), s2 = *(const f32x4*)(sp + 8), s3 = *(const f32x4*)(sp + 12);
            const float ss = (((s0.x + s0.y) + (s0.z + s0.w)) + ((s1.x + s1.y) + (s1.z + s1.w))) + (((s2.x + s2.y) + (s2.z + s2.w)) + ((s3.x + s3.y) + (s3.z + s3.w)));
            r2 = __builtin_amdgcn_rsqf(ss * (1.0f / D) + EPS); if (h == 0 && hh == 0) ((float*)(ws + WS_R2))[t] = r2; }
        int KS[2][16];
#pragma unroll
        for (int c = 0; c < 2; ++c) {
            f32x16 acc[4];
#pragma unroll
            for (int kt = 0; kt < 4; ++kt)
#pragma unroll
                for (int r = 0; r < 16; ++r) acc[kt][r] = 0.f;
            int hq2 = hh; asm volatile("" : "+v"(hq2));
            const bf16* qrow = Q + (unsigned)(t * NQ + h * DQ + c * DHALF + 8 * hq2);
            bf16x8 Bf[8];
#pragma unroll
            for (int s = 0; s < 8; ++s) Bf[s] = *(const bf16x8*)(qrow + 16 * s);
            const LAS bf16* krow = SKL + (c * NKEYS + tl) * SKL_STRIDE + 8 * hh;
#pragma unroll
            for (int s = 0; s < 8; ++s)
#pragma unroll
                for (int kt = 0; kt < 4; ++kt) { const bf16x8 Af = *(const LAS bf16x8*)(krow + kt * 32 * SKL_STRIDE + 16 * s); acc[kt] = MFMA32(Af, Bf[s], acc[kt]); }
            int kk[4][16];
#pragma unroll
            for (int kt = 0; kt < 4; ++kt) {
#pragma unroll
                for (int r = 0; r < 16; ++r) { const float av = acc[kt][r];
                    kk[kt][r] = f2key((__float_as_uint(av) & ~0x7Fu) | (unsigned)(32 * kt + crow(r, hh))); }
                sort16_desc(kk[kt]); }
            merge_top16(kk[0], kk[1]); merge_top16(kk[2], kk[3]); merge_top16(kk[0], kk[2]);
            int pp[16];
#pragma unroll
            for (int i = 0; i < 16; ++i) pp[i] = __shfl_xor(kk[0][i], 32);
            merge_top16(kk[0], pp);
#pragma unroll
            for (int i = 0; i < 16; ++i) KS[c][i] = kk[0][i];
        }
        float fa[16], fb[16];
        { unsigned wa[4], wb[4];
#pragma unroll
            for (int i = 0; i < 4; ++i) { wa[i] = 0u; wb[i] = 0u; }
#pragma unroll
            for (int i = 0; i < 16; ++i) { const unsigned ua = (unsigned)f2key((unsigned)KS[0][i]), ub = (unsigned)f2key((unsigned)KS[1][i]);
                fa[i] = __builtin_bit_cast(float, ua & ~0x7Fu); fb[i] = __builtin_bit_cast(float, ub & ~0x7Fu);
                wa[i >> 2] |= (ua & 0x7Fu) << (8 * (i & 3)); wb[i >> 2] |= (ub & 0x7Fu) << (8 * (i & 3)); }
            *(LAS u32x4*)ib = (u32x4){wa[0], wa[1], wa[2], wa[3]}; *(LAS u32x4*)(ib + 16) = (u32x4){wb[0], wb[1], wb[2], wb[3]}; }
        int cv[4][16];
#pragma unroll
        for (int q = 0; q < 64; ++q) {
            if (q < CT.n) { const float sum = fa[CT.i[q]] + fb[CT.j[q]]; cv[q >> 4][q & 15] = f2key((__builtin_bit_cast(unsigned, sum) & ~0xFFu) | (unsigned)(CT.i[q] * 16 + CT.j[q])); }
            else cv[q >> 4][q & 15] = (int)0x80000000;
        }
#pragma unroll
        for (int gq = 0; gq < 4; ++gq) sort16_desc(cv[gq]);
        merge_top16(cv[0], cv[1]); merge_top16(cv[2], cv[3]); merge_top16(cv[0], cv[2]);
        asm volatile("s_waitcnt lgkmcnt(0)" ::: "memory");
        int ex[16]; float gv[16]; float den = 0.f; float v0 = 0.f;
#pragma unroll
        for (int k = 0; k < 16; ++k) { const unsigned ub = (unsigned)f2key((unsigned)cv[0][k]); const float val = __builtin_bit_cast(float, ub & ~0xFFu); const unsigned ij = ub & 0xFFu;
            if (k == 0) v0 = val;
            const int n1 = ib[ij >> 4], n2 = ib[16 + (ij & 15u)];
            ex[k] = n1 * NKEYS + n2; gv[k] = __expf(r2 * (val - v0)); den += gv[k]; }
        const float rden = 1.0f / den;
        int hq = hh; asm volatile("" : "+v"(hq));
        float* gp = (float*)(ws + WS_GW) + (unsigned)(t * 128 + h * 16 + 8 * hq);
        int e8[8]; float g8[8];
#pragma unroll
        for (int k = 0; k < 8; ++k) { const int msk = -hh;
            e8[k] = (ex[8 + k] & msk) | (ex[k] & ~msk);
            g8[k] = __builtin_bit_cast(float, (__builtin_bit_cast(int, gv[8 + k]) & msk) | (__builtin_bit_cast(int, gv[k]) & ~msk)) * rden; }
        *(u32x4*)((unsigned short*)(ws + WS_IDX16) + (unsigned)(t * 128 + h * 16 + 8 * hq)) = (u32x4){(unsigned)e8[0] | ((unsigned)e8[1] << 16), (unsigned)e8[2] | ((unsigned)e8[3] << 16), (unsigned)e8[4] | ((unsigned)e8[5] << 16), (unsigned)e8[6] | ((unsigned)e8[7] << 16)};
        *(f32x4*)gp = (f32x4){g8[0], g8[1], g8[2], g8[3]}; *(f32x4*)(gp + 4) = (f32x4){g8[4], g8[5], g8[6], g8[7]};
        }
        __syncthreads();
    }
    if (conv) for (; cvn < 2 * NEXP / 4; cvn += NCW) expert_rows4(P, 4 * cvn, lane);
}

struct Args { Ptrs P; int ph_lo, ph_hi, li, pad; };
constexpr int NPH = 9;
__global__ void __launch_bounds__(NWAVES * 64, 2) fwd(Args a) {
    extern __shared__ __attribute__((aligned(16))) unsigned char lds_raw[];
    LAS unsigned char* lds = (LAS unsigned char*)lds_raw;
    volatile LAS unsigned* MISC = (volatile LAS unsigned*)(lds + MISC_OFF);
    const Ptrs& P = a.P;
    unsigned char* ws = P.ws;
    const int tid = threadIdx.x, lane = tid & 63, wave = __builtin_amdgcn_readfirstlane(tid >> 6);
    const int G = gridDim.x, bx = blockIdx.x, vcu = (G % 8 == 0) ? (bx % 8) * (G / 8) + bx / 8 : bx;
    if (tid < 32) MISC[tid] = 0u;
    __syncthreads();
    unsigned* ctl = (unsigned*)(ws + WS_CTL);
    XcdBarrier bar = xcd_barrier_post(ctl + CW_BAR + a.li * XCD_BAR_WORDS, MISC + 8);
    const int lo = a.ph_lo, hi = a.ph_hi;
#define IN(k) (lo <= (k) && (k) < hi)
#define SEAM(k) do { if (IN(k) && IN((k) + 1)) xcd_barrier(bar); } while (0)
    const int gw = vcu * NWAVES + wave, NGW = G * NWAVES;

    if (IN(0)) { p0_prep(P, gw, NGW, lane, (LAS float*)(lds + wave * 16384)); }
    SEAM(0);
    if (IN(1)) { {
        pg8::Gemm g{(const bf16*)(ws + WS_XBF), (const bf16*)(ws + WS_WINT), T, NIN, D}; pg8::StaticOrder S; S.init(T, NIN, G, bx);
        pg8::EpiRowBf16 E{(bf16*)(ws + WS_PROJ), NIN, nullptr};
        pg8::gemm_phase<pg8::EpiRowBf16, pg8::StaticOrder, true, true>(lds, g, S, E);
    } }
    SEAM(1);
    if (IN(2)) { p2_mixer_a(P, lds, MISC, ctl, tid, lane, wave, gw, NGW); xcd_barrier(bar); p2_mixer_b(P, lds, bx, G, tid, lane, wave); }
    SEAM(2);
    if (IN(3)) {
        pg8::Gemm g{(const bf16*)(ws + WS_MIX), (const bf16*)(ws + WS_WOUTT), T, D, D}; pg8::StaticOrder S; S.init(T, D, G, bx);
        LAS pg8::f32x2v* rsl = (LAS pg8::f32x2v*)(lds + RS_OFF); LAS float* rxl = (LAS float*)(lds + RS_OFF + 2048);
        pg8::Unit u;
        for (int round = 0; S.next(round, u); ++round) {
            if (tid < 256) { const int row = u.pm * 256 + tid; const float* sl = (const float*)(ws + WS_SSQL) + (size_t)row * 8; const float* sa = (const float*)(ws + WS_SSQA) + (size_t)row * 8;
                const f32x4 l0 = *(const f32x4*)sl, l1 = *(const f32x4*)(sl + 4), a0 = *(const f32x4*)sa, a1 = *(const f32x4*)(sa + 4);
                const float sL = ((l0.x + l0.y) + (l0.z + l0.w)) + ((l1.x + l1.y) + (l1.z + l1.w)), sA = ((a0.x + a0.y) + (a0.z + a0.w)) + ((a1.x + a1.y) + (a1.z + a1.w));
                const float rl = __builtin_amdgcn_rsqf(sL * (1.0f / LRU_W) + EPS), ra = __builtin_amdgcn_rsqf(sA * (1.0f / ATT_W) + EPS);
                rsl[tid] = (pg8::f32x2v){rl * __builtin_amdgcn_rcpf(ra), ra}; rxl[tid] = __builtin_amdgcn_rcpf(((const float*)(ws + WS_R1X))[row]); }
            __syncthreads();
            pg8::OneUnit S1{u};
            pg8::EpiOut E{(const bf16*)(ws + WS_XBF), P.out, (bf16*)(ws + WS_X1BF), (float*)(ws + WS_SSQ2), rsl, rxl};
            pg8::gemm_phase<pg8::EpiOut, pg8::OneUnit, false, true>(lds, g, S1, E);
            __syncthreads();
        }
    }
    SEAM(3);
    if (IN(4)) { {
        pg8::Gemm g{(const bf16*)(ws + WS_X1BF), (const bf16*)(ws + WS_WQT), T, NQ, D}; pg8::StaticOrder S; S.init(T, NQ, G, bx);
        pg8::EpiRowBf16 E{(bf16*)(ws + WS_Q), NQ, nullptr};
        pg8::gemm_phase<pg8::EpiRowBf16, pg8::StaticOrder, true, true>(lds, g, S, E);
    } }
    if (IN(5)) { pg8::StaticOrder S; S.init(T, NQ, G, bx); p5_topk(P, lds, S, tid, lane, wave, gw, NGW); }
    SEAM(5);
    if (IN(6)) { if (G == 256) p6_u3(P, lds, bx, lane, wave); else p6_sliced<0>(P, lds, MISC, ctl, tid, lane, wave); }
    SEAM(6);
    if (IN(7)) { p6_combine(P, bx * (NWAVES * 64) + tid, G * NWAVES * 64); }
    SEAM(7);
    if (IN(8)) { if (G == 256) p6_v3(P, lds, bx, lane, wave); else p6_v2(P, MISC, ctl, tid, lane, wave); }
#undef IN
#undef SEAM
}

extern "C" void kernel_launch(void* const* d_in, const int* in_sizes, int n_in, void* d_out, int out_size, void* d_ws, size_t ws_size, hipStream_t stream) {
    static int grid = 0;
    if (grid == 0) {
        if (n_in != 22 || out_size != T * D || ws_size < WS_END) { fprintf(stderr, "kernel_launch: unexpected shapes (n_in %d, out %d, ws %zu)\n", n_in, out_size, ws_size); grid = -1; return; }
        int dev = 0, cus = 0, per_cu = 0;
        if (hipGetDevice(&dev) != hipSuccess || hipDeviceGetAttribute(&cus, hipDeviceAttributeMultiprocessorCount, dev) != hipSuccess) { grid = -1; return; }
        if (hipFuncSetAttribute((const void*)fwd, hipFuncAttributeMaxDynamicSharedMemorySize, LDS_BYTES) != hipSuccess) { fprintf(stderr, "kernel_launch: hipFuncSetAttribute failed\n"); grid = -1; return; }
        if (hipOccupancyMaxActiveBlocksPerMultiprocessor(&per_cu, (const void*)fwd, NWAVES * 64, LDS_BYTES) != hipSuccess || per_cu < 1) fprintf(stderr, "kernel_launch: occupancy query says %d\n", per_cu);
        (void)hipGetLastError();
        grid = cus;
        if (grid != 256) fprintf(stderr, "kernel_launch: %d CUs (built for 256)\n", grid);
    }
    if (grid < 0) return;
    Ptrs P{};
    const float** pp = (const float**)&P;
    for (int i = 0; i < 22; ++i) pp[i] = (const float*)d_in[i];
    P.out = (float*)d_out; P.ws = (unsigned char*)d_ws;
    unsigned char* ws = P.ws;
    (void)hipMemsetAsync(ws + WS_CTL, 0, CTL_BYTES, stream);
    Args a{}; a.P = P;
    int li = 0;
#define FWD(lo_, hi_) do { a.ph_lo = (lo_); a.ph_hi = (hi_); a.li = li++; hipLaunchKernelGGL(fwd, dim3(grid), dim3(NWAVES * 64), LDS_BYTES, stream, a); } while (0)
    FWD(0, NPH);
}
```

```cpp
#include <hip/hip_runtime.h>
#include <cstdio>
#include <cstdint>

#define LAS __attribute__((address_space(3)))
typedef unsigned short bf16;
typedef short bf16x8 __attribute__((ext_vector_type(8)));
typedef float f32x4 __attribute__((ext_vector_type(4)));
typedef unsigned u32x4 __attribute__((ext_vector_type(4)));
typedef unsigned u32x2 __attribute__((ext_vector_type(2)));

constexpr int D = 1024, BATCH = 8, SEQ = 2048, T = BATCH * SEQ;
constexpr int LRU_W = 512, NBLK = 8, BLK = 64;
constexpr int NH = 8, NKV = 2, HD = 64, ATT_W = 512, KV_W = 128, WIN = 128;
constexpr int PH = 8, NKEYS = 128, DQ = 256, DHALF = 128, TOPK = 16, NEXP = NKEYS * NKEYS;
constexpr int NIN = 1792, NQ = PH * DQ;
constexpr int C_XB = 0, C_GB = 512, C_Q = 1024, C_K = 1536, C_V = 1664;
constexpr float EPS = 1e-6f;

constexpr size_t MiB = 1u << 20;
constexpr size_t WS_CTL = 0, CTL_BYTES = 1 * MiB;
constexpr size_t WS_WINT = 1 * MiB;
constexpr size_t WS_WOUTT = 5 * MiB;
constexpr size_t WS_WQT = 7 * MiB;
constexpr size_t WS_SKB = 11 * MiB;
constexpr size_t WS_WGT = 11 * MiB + 512 * 1024;
constexpr size_t WS_BL = 11 * MiB + 768 * 1024;
constexpr size_t WS_SUS = 11 * MiB + 832 * 1024;
constexpr size_t WS_SVS = 11 * MiB + 896 * 1024;
constexpr size_t WS_R1 = 12 * MiB;
constexpr size_t WS_R1X = 12 * MiB + 64 * 1024;
constexpr size_t WS_R2 = 12 * MiB + 256 * 1024;
constexpr size_t WS_SSQL = 12 * MiB + 512 * 1024;
constexpr size_t WS_SSQA = 13 * MiB;
constexpr size_t WS_SSQ2 = 13 * MiB + 512 * 1024;
constexpr size_t WS_EU = 16 * MiB;
constexpr size_t WS_EV = 48 * MiB;
constexpr size_t WS_X1BF = 80 * MiB;
constexpr size_t WS_MIX = 112 * MiB;
constexpr size_t WS_IDX = 144 * MiB;
constexpr size_t WS_GW = 152 * MiB;
constexpr size_t WS_XBF = 160 * MiB;
constexpr size_t WS_PROJ = 192 * MiB;
constexpr size_t WS_Q = 160 * MiB;
constexpr size_t WS_IDX16 = 240 * MiB;
constexpr size_t WS_W = 232 * MiB;
constexpr size_t WS_PART = 160 * MiB;
constexpr size_t WS_END = 248 * MiB;

__device__ __forceinline__ unsigned f2bf(float f) { unsigned u = __builtin_bit_cast(unsigned, f); return (u + 0x7fffu + ((u >> 16) & 1u)) >> 16; }
__device__ __forceinline__ unsigned pk2(float lo, float hi) { return f2bf(lo) | (f2bf(hi) << 16); }
__device__ __forceinline__ float bf2f(unsigned short b) { return __builtin_bit_cast(float, ((unsigned)b) << 16); }
__device__ __forceinline__ float bflo(unsigned w) { return __builtin_bit_cast(float, w << 16); }
__device__ __forceinline__ float bfhi(unsigned w) { return __builtin_bit_cast(float, w & 0xffff0000u); }
__device__ __forceinline__ float wave_sum(float v) {
#pragma unroll
    for (int o = 1; o < 64; o <<= 1) v += __shfl_xor(v, o);
    return v;
}
__device__ __forceinline__ float gelu_tanh(float x) {
    const float u = 0.7978845608028654f * (x + 0.044715f * x * x * x);
    return x * __builtin_amdgcn_rcpf(1.0f + __expf(-2.0f * u));
}
__device__ __forceinline__ float sigmoidf(float z) { return __builtin_amdgcn_rcpf(1.0f + __expf(-z)); }
typedef int i32x4 __attribute__((ext_vector_type(4)));
#define DPP_I(v, ctrl) __builtin_amdgcn_update_dpp(0, (v), (ctrl), 0xf, 0xf, true)
#define DPP_F(v, ctrl) __builtin_bit_cast(float, __builtin_amdgcn_update_dpp(0, __builtin_bit_cast(int, (v)), (ctrl), 0xf, 0xf, true))
__device__ __forceinline__ int t5_bucket(int n) {
    if (n < 16) return n;
    const int th[15] = {19, 21, 24, 27, 31, 35, 40, 46, 52, 59, 67, 77, 87, 99, 113};
    int b = 16;
#pragma unroll
    for (int i = 0; i < 15; ++i) b += (n >= th[i]) ? 1 : 0;
    return b;
}

struct Ptrs {
    const float *x, *ln_mix_g, *w_in, *conv_w, *conv_b, *w_gate_a, *b_gate_a, *w_gate_x, *b_gate_x, *lru_L, *q_norm_g, *k_norm_g, *sinks, *lru_out_g, *attn_out_g, *w_out, *ln_ffn_g, *w_query, *sub_keys, *expert_u, *expert_v, *rel_bias;
    float* out; unsigned char* ws;
};

__device__ __forceinline__ float row_to_bf16(const float* src, const float* g, bf16* dst, int lane) {
    float ss = 0.f;
#pragma unroll
    for (int j = 0; j < 4; ++j) {
        f32x4 v = *(const f32x4*)(src + 4 * lane + 256 * j);
        ss += (v.x * v.x + v.y * v.y) + (v.z * v.z + v.w * v.w);
        if (g) { const f32x4 gg = *(const f32x4*)(g + 4 * lane + 256 * j); v = v * gg; }
        u32x2 o; o.x = pk2(v.x, v.y); o.y = pk2(v.z, v.w);
        *(u32x2*)(dst + 4 * lane + 256 * j) = o;
    }
    return ss;
}
constexpr float FP8_SU = 256.0f, FP8_SV = 64.0f;
__device__ __forceinline__ void row_to_fp8(const float* src, const float* g, float scale, unsigned char* dst, int lane) {
    u32x4 o;
#pragma unroll
    for (int j = 0; j < 4; ++j) {
        f32x4 v = *(const f32x4*)(src + 16 * lane + 4 * j);
        if (g) { const f32x4 gg = *(const f32x4*)(g + 16 * lane + 4 * j); v = v * gg; }
        v = v * scale;
        int w = 0; w = __builtin_amdgcn_cvt_pk_fp8_f32(v.x, v.y, w, false); w = __builtin_amdgcn_cvt_pk_fp8_f32(v.z, v.w, w, true);
        o[j] = (unsigned)w;
    }
    *(u32x4*)(dst + 16 * lane) = o;
}
__device__ __forceinline__ void expert_rows4(const Ptrs& P, int r0, int lane);
constexpr size_t SLICE_BYTES = (size_t)NEXP * 128;
__device__ __forceinline__ void row_to_fp8_sliced(const float* src, const float* g, float scale, unsigned char* base, int e, int lane) {
    u32x4 o;
#pragma unroll
    for (int j = 0; j < 4; ++j) {
        f32x4 v = *(const f32x4*)(src + 16 * lane + 4 * j) * scale;
        if (g) v = v * *(const f32x4*)(g + 16 * lane + 4 * j);
        int w = 0; w = __builtin_amdgcn_cvt_pk_fp8_f32(v.x, v.y, w, false); w = __builtin_amdgcn_cvt_pk_fp8_f32(v.z, v.w, w, true);
        o[j] = (unsigned)w;
    }
    *(u32x4*)(base + (size_t)(lane >> 3) * SLICE_BYTES + (size_t)e * 128 + 16 * (lane & 7)) = o;
}
__device__ __forceinline__ float wave_max_u(float v) {
    v = fmaxf(v, DPP_F(v, 0xB1)); v = fmaxf(v, DPP_F(v, 0x4E)); v = fmaxf(v, DPP_F(v, 0x141)); v = fmaxf(v, DPP_F(v, 0x140));
    const int i = __builtin_bit_cast(int, v);
    return fmaxf(fmaxf(__builtin_bit_cast(float, __builtin_amdgcn_readlane(i, 0)), __builtin_bit_cast(float, __builtin_amdgcn_readlane(i, 16))),
                 fmaxf(__builtin_bit_cast(float, __builtin_amdgcn_readlane(i, 32)), __builtin_bit_cast(float, __builtin_amdgcn_readlane(i, 48))));
}
struct ExpRows {
    f32x4 v[4][4]; int r0;
    __device__ __forceinline__ void load(const Ptrs& P, int r0_, int lane_) {
        r0 = r0_; int lane = lane_; asm volatile("" : "+v"(lane));
        const bool isv = r0 >= NEXP; const int e0 = isv ? r0 - NEXP : r0;
        const float* src = (isv ? P.expert_v : P.expert_u) + (size_t)e0 * D + 16 * lane;
#pragma unroll
        for (int k = 0; k < 4; ++k)
#pragma unroll
            for (int j = 0; j < 4; ++j) v[k][j] = *(const f32x4*)(src + (size_t)k * D + 4 * j);
    }
    __device__ __forceinline__ void finish(const Ptrs& P, int lane_) {
        int lane = lane_; asm volatile("" : "+v"(lane));
        const bool isv = r0 >= NEXP; const int e0 = isv ? r0 - NEXP : r0;
        unsigned char* base = P.ws + (isv ? WS_EV : WS_EU) + (size_t)(lane >> 3) * SLICE_BYTES + 16 * (lane & 7);
        f32x4 g[4];
        if (!isv) {
#pragma unroll
            for (int j = 0; j < 4; ++j) g[j] = *(const f32x4*)(P.ln_ffn_g + 16 * lane + 4 * j); }
        float* scl = (float*)(P.ws + (isv ? WS_SVS : WS_SUS));
#pragma unroll
        for (int k = 0; k < 4; ++k) { float m = 0.f;
#pragma unroll
            for (int j = 0; j < 4; ++j) { if (!isv) v[k][j] = v[k][j] * g[j]; m = fmaxf(m, fmaxf(fmaxf(fabsf(v[k][j].x), fabsf(v[k][j].y)), fmaxf(fabsf(v[k][j].z), fabsf(v[k][j].w)))); }
            m = fmaxf(wave_max_u(m), 1e-30f);
            const float inv = 127.0f * __builtin_amdgcn_rcpf(m);
            if (lane == 0) scl[e0 + k] = m * (1.0f / 127.0f);
            u32x4 o;
#pragma unroll
            for (int j = 0; j < 4; ++j) { const int q0 = (int)rintf(v[k][j].x * inv), q1 = (int)rintf(v[k][j].y * inv), q2 = (int)rintf(v[k][j].z * inv), q3 = (int)rintf(v[k][j].w * inv);
                o[j] = (unsigned)(q0 & 0xff) | ((unsigned)(q1 & 0xff) << 8) | ((unsigned)(q2 & 0xff) << 16) | ((unsigned)q3 << 24); }
            *(u32x4*)(base + (size_t)(e0 + k) * 128) = o; }
    }
};
__device__ __forceinline__ void expert_rows4(const Ptrs& P, int r0, int lane) { ExpRows A; A.load(P, r0, lane); A.finish(P, lane); }
__device__ __forceinline__ void transpose_item(const float* W, int K, int N, const float* g0, const float* g1, int gsplit, bf16* WT, LAS float* scr, int item, int lane) {
    const int nblk = N / 32, kb = item / nblk, nb = item % nblk, k0 = 64 * kb, n0 = 32 * nb;
#pragma unroll
    for (int i = 0; i < 32; ++i) { const int kk = 2 * i + (lane >> 5); const int k = k0 + kk; const float gk = (k < gsplit) ? g0[k] : g1[k - gsplit];
        scr[kk * 33 + (lane & 31)] = W[(size_t)k * N + n0 + (lane & 31)] * gk; }
    asm volatile("s_waitcnt lgkmcnt(0)" ::: "memory");
    const int c = lane & 7;
#pragma unroll
    for (int j = 0; j < 4; ++j) { const int n = (lane >> 3) + 8 * j; const LAS float* s = scr + (8 * c) * 33 + n;
        u32x4 o; o.x = pk2(s[0 * 33], s[1 * 33]); o.y = pk2(s[2 * 33], s[3 * 33]); o.z = pk2(s[4 * 33], s[5 * 33]); o.w = pk2(s[6 * 33], s[7 * 33]);
        *(u32x4*)(WT + (size_t)(n0 + n) * K + k0 + 8 * c) = o; }
    asm volatile("s_waitcnt lgkmcnt(0)" ::: "memory");
}
__device__ __forceinline__ void p0_prep(const Ptrs& P, int gw, int NGW, int lane, LAS float* scr) {
    unsigned char* ws = P.ws;
    constexpr int I_IN = (D / 64) * (NIN / 32), I_OUT = (D / 64) * (D / 32), I_Q = (D / 64) * (NQ / 32);
    for (int it = gw; it < I_IN + I_OUT + I_Q; it += NGW) {
        int r = it;
        if (r < I_IN) { transpose_item(P.w_in, D, NIN, P.ln_mix_g, P.ln_mix_g, D, (bf16*)(ws + WS_WINT), scr, r, lane); continue; } r -= I_IN;
        if (r < I_OUT) { transpose_item(P.w_out, D, D, P.lru_out_g, P.attn_out_g, LRU_W, (bf16*)(ws + WS_WOUTT), scr, r, lane); continue; } r -= I_OUT;
        transpose_item(P.w_query, D, NQ, P.ln_ffn_g, P.ln_ffn_g, D, (bf16*)(ws + WS_WQT), scr, r, lane);
    }
    for (int r0 = gw * 4; r0 < T; r0 += NGW * 4) {
        f32x4 v[4][4];
#pragma unroll
        for (int k = 0; k < 4; ++k)
#pragma unroll
            for (int j = 0; j < 4; ++j) v[k][j] = *(const f32x4*)(P.x + (size_t)(r0 + k) * D + 4 * lane + 256 * j);
#pragma unroll
        for (int k = 0; k < 4; ++k) { float ss = 0.f;
#pragma unroll
            for (int j = 0; j < 4; ++j) ss += (v[k][j].x * v[k][j].x + v[k][j].y * v[k][j].y) + (v[k][j].z * v[k][j].z + v[k][j].w * v[k][j].w);
            const float r1 = __builtin_amdgcn_rsqf(wave_sum(ss) * (1.0f / D) + EPS);
            if (lane == 0) ((float*)(ws + WS_R1X))[r0 + k] = r1;
            bf16* dst = (bf16*)(ws + WS_XBF) + (size_t)(r0 + k) * D;
#pragma unroll
            for (int j = 0; j < 4; ++j) { u32x2 o; o.x = pk2(v[k][j].x * r1, v[k][j].y * r1); o.y = pk2(v[k][j].z * r1, v[k][j].w * r1); *(u32x2*)(dst + 4 * lane + 256 * j) = o; } }
    }
    for (int e = gw; e < 256; e += NGW) (void)row_to_bf16(P.sub_keys + (size_t)e * D, nullptr, (bf16*)(ws + WS_SKB) + (size_t)e * D, lane);
    for (int e = gw * 64 + lane; e < 2 * NBLK * BLK * BLK + NH * WIN; e += NGW * 64) {
        if (e < 2 * NBLK * BLK * BLK) { const int g = e / (NBLK * BLK * BLK), r = e % (NBLK * BLK * BLK), n = r / (BLK * BLK), j = (r / BLK) % BLK, i = r % BLK;
            const float* W = g ? P.w_gate_x : P.w_gate_a;
            ((bf16*)(ws + WS_WGT))[e] = (bf16)f2bf(W[(size_t)n * BLK * BLK + i * BLK + j]); }
        else { const int q = e - 2 * NBLK * BLK * BLK, h = q / WIN, rel = q % WIN;
            ((float*)(ws + WS_BL))[q] = P.rel_bias[t5_bucket(rel) * NH + h]; }
    }
}
namespace pg8 {
typedef unsigned short bf16_t;
constexpr int BM = 256, BK = 64, HALF = 128, HTB = HALF * BK * 2  , STAGE_BYTES = 8 * HTB, NXCD = 8, WGM = 2;
__host__ __device__ __forceinline__ int lds_byte(int r, int c) { const int st = (r >> 4) * 2 + (c >> 5), rr = r & 15, cc = c & 31, ob = rr * 64 + cc * 2; return st * 1024 + (ob ^ (((ob >> 9) & 1) << 5)); }
__host__ __device__ __forceinline__ void stage_rc(int b, int& R, int& C) { const int st = b / 1024, sb = b % 1024, swz = sb ^ (((sb >> 9) & 1) << 5); R = (st >> 1) * 16 + swz / 64; C = (st & 1) * 32 + (swz % 64) / 2; }
__host__ __device__ __forceinline__ int perm32(int rho) { const int n = rho >> 4, i = rho & 15; return 8 * (i >> 2) + 4 * n + (i & 3); }
struct Unit { int pm, pn; };
struct Gemm { const bf16_t* A; const bf16_t* Bt; int M, N, K; };
struct StaticOrder {
    int nM, nN, nwg, G, c;
    __host__ __device__ void init(int M, int N, int G_, int c_) { nM = M / BM; nN = N / BM; nwg = nM * nN; G = G_; c = c_; }
    __host__ __device__ bool next(int i, Unit& u) const {
        const long L = (long)i * G + c; if (L >= nwg) return false;
        int wgid = (int)L; { const int q = nwg / NXCD, r = nwg % NXCD, xcd = wgid % NXCD, off = wgid / NXCD; wgid = (xcd < r ? xcd * (q + 1) : r * (q + 1) + (xcd - r) * q) + off; }
        const int nig = WGM * nN, gid = wgid / nig, fm = gid * WGM, gsz = (nM - fm) < WGM ? (nM - fm) : WGM;
        u.pm = fm + ((wgid % nig) % gsz); u.pn = (wgid % nig) / gsz; return true;
    }
    __device__ __forceinline__ void a_ready(const Unit&) const {}
    __device__ __forceinline__ void done(const Unit&) const {}
};
struct OneUnit {
    Unit u;
    __device__ __forceinline__ bool next(int i, Unit& o) const { if (i != 0) return false; o = u; return true; }
    __device__ __forceinline__ void a_ready(const Unit&) const {}
    __device__ __forceinline__ void done(const Unit&) const {}
};
__device__ __forceinline__ unsigned cvt_pk_bf16(float lo, float hi) { unsigned r; asm volatile("v_cvt_pk_bf16_f32 %0, %1, %2" : "=v"(r) : "v"(lo), "v"(hi)); return r; }

struct EpiRowBf16 {
    static constexpr bool PERM = true, MID = false;
    bf16_t* O; int ldc; const float* rs;
    __device__ __forceinline__ void mid(f32x4 (&)[2][2][4][2], const Unit&, int, int, int, int) const {}
    __device__ __forceinline__ void operator()(const f32x4 (&acc)[2][2][4][2], const Unit& u, int wr, int wc, int fr, int fq) const {
        const int row0 = u.pm * BM + wr * 64 + fr, col0 = u.pn * BM + wc * 32 + 8 * fq;
#pragma unroll
        for (int ai = 0; ai < 2; ++ai)
#pragma unroll
            for (int m = 0; m < 4; ++m) { const int row = row0 + ai * HALF + m * 16; const float sc = rs ? rs[row] : 1.0f; bf16_t* rowp = O + (size_t)row * ldc + col0;
#pragma unroll
                for (int bj = 0; bj < 2; ++bj) { const f32x4 v0 = acc[ai][bj][m][0] * sc, v1 = acc[ai][bj][m][1] * sc;
                    u32x4 w; w.x = cvt_pk_bf16(v0[0], v0[1]); w.y = cvt_pk_bf16(v0[2], v0[3]); w.z = cvt_pk_bf16(v1[0], v1[1]); w.w = cvt_pk_bf16(v1[2], v1[3]);
                    *(u32x4*)(rowp + bj * HALF) = w; } }
    }
};
typedef float f32x2v __attribute__((ext_vector_type(2)));
struct EpiOut {
    static constexpr bool PERM = true, MID = true;
    const bf16_t* xbf; float* x1; bf16_t* x1bf; float* ssq2; const LAS f32x2v* rsl; const LAS float* rxl;
    __device__ __forceinline__ void mid(f32x4 (&acc)[2][2][4][2], const Unit&, int wr, int, int fr, int) const {
#pragma unroll
        for (int ai = 0; ai < 2; ++ai)
#pragma unroll
            for (int m = 0; m < 4; ++m) { const float ratio = rsl[ai * HALF + wr * 64 + m * 16 + fr].x;
#pragma unroll
                for (int bj = 0; bj < 2; ++bj)
#pragma unroll
                    for (int n = 0; n < 2; ++n) acc[ai][bj][m][n] = acc[ai][bj][m][n] * ratio; }
    }
    __device__ __forceinline__ void operator()(const f32x4 (&acc)[2][2][4][2], const Unit& u, int wr, int wc, int fr, int fq) const {
        const int col0 = u.pn * BM + wc * 32 + 8 * fq;
#pragma unroll
        for (int ai = 0; ai < 2; ++ai) {
            u32x2 xw[4][2][2];
#pragma unroll
            for (int m = 0; m < 4; ++m) { const size_t off = (size_t)(u.pm * BM + ai * HALF + wr * 64 + m * 16 + fr) * D + col0;
#pragma unroll
                for (int bj = 0; bj < 2; ++bj)
#pragma unroll
                    for (int n = 0; n < 2; ++n) xw[m][bj][n] = *(const u32x2*)(xbf + off + bj * HALF + n * 4); }
#pragma unroll
            for (int m = 0; m < 4; ++m) { const int r = ai * HALF + wr * 64 + m * 16 + fr; const float ratt = rsl[r].y, rx = rxl[r]; const int row = u.pm * BM + r; const size_t off = (size_t)row * D + col0; float ss = 0.f;
#pragma unroll
                for (int bj = 0; bj < 2; ++bj)
#pragma unroll
                    for (int n = 0; n < 2; ++n) { const u32x2 w2 = xw[m][bj][n]; const f32x4 xs = (f32x4){__builtin_bit_cast(float, w2.x << 16), __builtin_bit_cast(float, w2.x & 0xffff0000u), __builtin_bit_cast(float, w2.y << 16), __builtin_bit_cast(float, w2.y & 0xffff0000u)} * rx;
                        const f32x4 o = xs + acc[ai][bj][m][n] * ratt;
                        u32x2 w; w.x = cvt_pk_bf16(o[0], o[1]); w.y = cvt_pk_bf16(o[2], o[3]); *(u32x2*)(x1bf + off + bj * HALF + n * 4) = w;
                        ss += (o[0] * o[0] + o[1] * o[1]) + (o[2] * o[2] + o[3] * o[3]); }
                ss += __shfl_xor(ss, 16); ss += __shfl_xor(ss, 32);
                if (fq == 0) ssq2[(size_t)row * 16 + u.pn * 4 + wc] = ss; }
        }
    }
};

template <class Epi, class Sched, bool ALIGN_EPI = false, bool SP2 = false>
__device__ __forceinline__ void gemm_phase(LAS unsigned char* lds, const Gemm g, const Sched& S, const Epi& E) {
    const int tid = threadIdx.x, wid = __builtin_amdgcn_readfirstlane(tid >> 6), lane = tid & 63, wr = wid >> 2, wc = wid & 3, fr = lane & 15, fq = lane >> 4;
    const int K = g.K, nt = K / BK;
    unsigned voffA[2], voffB[2];
#pragma unroll
    for (int i = 0; i < 2; ++i) { int R, C; stage_rc(tid * 16 + i * 8192, R, C); const int Rb = Epi::PERM ? ((R & ~31) + perm32(R & 31)) : R;
        voffA[i] = (unsigned)(R * K + C) * 2u; voffB[i] = (unsigned)(Rb * K + C) * 2u; }
    const size_t kstep = (size_t)(BK * 2);
    const size_t hstep = (size_t)HALF * K * 2;
    const size_t tstep = 2 * hstep;
    const unsigned ldsw = (unsigned)wid * 1024u;
    const int aoff = lds_byte(wr * 64 + fr, fq * 8), boff = lds_byte(wc * 32 + fr, fq * 8);
#define PG8_SA(b, h) (((b) * 2 + (h)) * HTB)
#define PG8_SB(b, h) ((4 + (b) * 2 + (h)) * HTB)
#define PG8_STAGE(bufoff, gbase, voff) do { _Pragma("unroll") for (int _i = 0; _i < 2; ++_i) \
        __builtin_amdgcn_global_load_lds((const unsigned*)((const char*)(gbase) + (voff)[_i]), (LAS unsigned*)(lds + (bufoff) + ldsw + _i * 8192), 16, 0, 0); } while (0)
#define PG8_LDA(dst, b, h) do { _Pragma("unroll") for (int m = 0; m < 4; ++m) _Pragma("unroll") for (int k = 0; k < 2; ++k) dst[m][k] = *(const LAS bf16x8*)(lds + PG8_SA(b, h) + aoff + m * 2048 + k * 1024); } while (0)
#define PG8_LDB(dst, b, h) do { _Pragma("unroll") for (int n = 0; n < 2; ++n) _Pragma("unroll") for (int k = 0; k < 2; ++k) dst[n][k] = *(const LAS bf16x8*)(lds + PG8_SB(b, h) + boff + n * 2048 + k * 1024); } while (0)
#define PG8_MMA(ai, bj, At, Bt) do { __builtin_amdgcn_s_setprio(1); _Pragma("unroll") for (int m = 0; m < 4; ++m) _Pragma("unroll") for (int n = 0; n < 2; ++n) _Pragma("unroll") for (int k = 0; k < 2; ++k) \
        acc[ai][bj][m][n] = __builtin_amdgcn_mfma_f32_16x16x32_bf16(Bt[n][k], At[m][k], acc[ai][bj][m][n], 0, 0, 0); __builtin_amdgcn_s_setprio(0); } while (0)
#define PG8_WAIT_V(n) asm volatile("s_waitcnt vmcnt(" #n ")" ::: "memory")
#define PG8_WAIT_L(n) asm volatile("s_waitcnt lgkmcnt(" #n ")" ::: "memory")
#define PG8_BAR __builtin_amdgcn_s_barrier()
#define PG8_SCHED __builtin_amdgcn_sched_barrier(0)
    Unit cur, nxt; int ui = 0;
    if (!S.next(0, cur)) return;
    f32x4 acc[2][2][4][2];
#pragma unroll
    for (int a = 0; a < 2; ++a)
#pragma unroll
        for (int b = 0; b < 2; ++b)
#pragma unroll
            for (int m = 0; m < 4; ++m)
#pragma unroll
                for (int n = 0; n < 2; ++n) acc[a][b][m][n] = (f32x4){0.f, 0.f, 0.f, 0.f};
    bf16x8 At[4][2], B0[2][2], B1[2][2];
    const char* cA = (const char*)g.A + (size_t)cur.pm * tstep; const char* cB = (const char*)g.Bt + (size_t)cur.pn * tstep;
    S.a_ready(cur);
    if constexpr (SP2) {
        PG8_STAGE(PG8_SB(0, 0), cB, voffB); PG8_STAGE(PG8_SB(0, 1), cB + hstep, voffB); PG8_STAGE(PG8_SA(0, 0), cA, voffA); PG8_STAGE(PG8_SA(0, 1), cA + hstep, voffA);
        if (wr == 1) PG8_BAR;
        PG8_WAIT_V(2); PG8_BAR;
        PG8_STAGE(PG8_SB(1, 0), cB + kstep, voffB); PG8_STAGE(PG8_SA(1, 0), cA + kstep, voffA); PG8_STAGE(PG8_SB(1, 1), cB + hstep + kstep, voffB);
        PG8_WAIT_V(6); PG8_BAR;
    } else {
        PG8_STAGE(PG8_SB(0, 0), cB, voffB); PG8_STAGE(PG8_SA(0, 0), cA, voffA); PG8_STAGE(PG8_SB(0, 1), cB + hstep, voffB); PG8_STAGE(PG8_SA(0, 1), cA + hstep, voffA);
        if (wr == 1) PG8_BAR;
        PG8_WAIT_V(4); PG8_BAR;
        PG8_STAGE(PG8_SB(1, 0), cB + kstep, voffB); PG8_STAGE(PG8_SA(1, 0), cA + kstep, voffA); PG8_STAGE(PG8_SB(1, 1), cB + hstep + kstep, voffB);
        PG8_WAIT_V(6); PG8_BAR;
    }
    for (;;) {
        const bool has_next = S.next(ui + 1, nxt);
        const char* nA = has_next ? (const char*)g.A + (size_t)nxt.pm * tstep : cA; const char* nB = has_next ? (const char*)g.Bt + (size_t)nxt.pn * tstep : cB;
        for (int t = 0; t < nt; t += 2) {
            const bool last = (t == nt - 2);
            const char* a1 = cA + (size_t)(t + 1) * kstep;
            const char* a2 = last ? nA : cA + (size_t)(t + 2) * kstep; const char* b2 = last ? nB : cB + (size_t)(t + 2) * kstep;
            const char* a3 = a2 + kstep; const char* b3 = b2 + kstep;
            if (last && has_next) S.a_ready(nxt);
            if (Epi::MID && t == nt / 2) { E.mid(acc, cur, wr, wc, fr, fq); PG8_WAIT_L(0); PG8_SCHED; }
            if constexpr (SP2) {
            PG8_LDB(B0, 0, 0); PG8_LDB(B1, 0, 1); PG8_SCHED; PG8_LDA(At, 0, 0); PG8_STAGE(PG8_SA(1, 1), a1 + hstep, voffA);
            PG8_WAIT_V(8); PG8_WAIT_L(0); PG8_BAR; PG8_MMA(0, 0, At, B0); PG8_MMA(0, 1, At, B1); PG8_BAR; PG8_SCHED;
            PG8_LDA(At, 0, 1); PG8_STAGE(PG8_SB(0, 0), b2, voffB); PG8_STAGE(PG8_SB(0, 1), b2 + hstep, voffB); PG8_STAGE(PG8_SA(0, 0), a2, voffA);
            PG8_WAIT_V(8); PG8_WAIT_L(0); PG8_BAR; PG8_MMA(1, 0, At, B0); PG8_MMA(1, 1, At, B1); PG8_BAR; PG8_SCHED;
            PG8_LDB(B0, 1, 0); PG8_LDB(B1, 1, 1); PG8_SCHED; PG8_LDA(At, 1, 0); PG8_STAGE(PG8_SA(0, 1), a2 + hstep, voffA);
            PG8_WAIT_V(8); PG8_WAIT_L(0); PG8_BAR; PG8_MMA(0, 0, At, B0); PG8_MMA(0, 1, At, B1); PG8_BAR; PG8_SCHED;
            PG8_LDA(At, 1, 1); PG8_STAGE(PG8_SB(1, 0), b3, voffB); PG8_STAGE(PG8_SB(1, 1), b3 + hstep, voffB); PG8_STAGE(PG8_SA(1, 0), a3, voffA);
            PG8_WAIT_V(8); PG8_WAIT_L(0); PG8_BAR; PG8_MMA(1, 0, At, B0); PG8_MMA(1, 1, At, B1); PG8_BAR; PG8_SCHED;
            } else {
            PG8_LDB(B0, 0, 0); PG8_SCHED; PG8_LDA(At, 0, 0); PG8_STAGE(PG8_SA(1, 1), a1 + hstep, voffA);
            PG8_WAIT_L(8); PG8_BAR; PG8_WAIT_L(0); PG8_MMA(0, 0, At, B0); PG8_BAR; PG8_SCHED;
            PG8_LDB(B1, 0, 1); PG8_STAGE(PG8_SB(0, 0), b2, voffB);
            PG8_BAR; PG8_WAIT_L(0); PG8_MMA(0, 1, At, B1); PG8_BAR;
            PG8_LDA(At, 0, 1); PG8_STAGE(PG8_SA(0, 0), a2, voffA);
            PG8_BAR; PG8_WAIT_L(0); PG8_MMA(1, 0, At, B0); PG8_BAR; PG8_SCHED;
            PG8_STAGE(PG8_SB(0, 1), b2 + hstep, voffB);
            PG8_WAIT_V(6); PG8_BAR; PG8_MMA(1, 1, At, B1); PG8_BAR;
            PG8_LDB(B0, 1, 0); PG8_SCHED; PG8_LDA(At, 1, 0); PG8_STAGE(PG8_SA(0, 1), a2 + hstep, voffA);
            PG8_WAIT_L(8); PG8_BAR; PG8_WAIT_L(0); PG8_MMA(0, 0, At, B0); PG8_BAR; PG8_SCHED;
            PG8_LDB(B1, 1, 1); PG8_STAGE(PG8_SB(1, 0), b3, voffB);
            PG8_BAR; PG8_WAIT_L(0); PG8_MMA(0, 1, At, B1); PG8_BAR;
            PG8_LDA(At, 1, 1); PG8_STAGE(PG8_SA(1, 0), a3, voffA);
            PG8_BAR; PG8_WAIT_L(0); PG8_MMA(1, 0, At, B0); PG8_BAR; PG8_SCHED;
            PG8_STAGE(PG8_SB(1, 1), b3 + hstep, voffB);
            PG8_WAIT_V(6); PG8_BAR; PG8_MMA(1, 1, At, B1); PG8_BAR;
            }
        }
        if constexpr (ALIGN_EPI) { if (wr == 0) PG8_BAR; }
        E(acc, cur, wr, wc, fr, fq); S.done(cur);
        if (!has_next) break;
#pragma unroll
        for (int a = 0; a < 2; ++a)
#pragma unroll
            for (int b = 0; b < 2; ++b)
#pragma unroll
                for (int m = 0; m < 4; ++m)
#pragma unroll
                    for (int n = 0; n < 2; ++n) acc[a][b][m][n] = (f32x4){0.f, 0.f, 0.f, 0.f};
        cur = nxt; cA = nA; cB = nB; ++ui;
        if constexpr (ALIGN_EPI) { if (wr == 1) PG8_BAR; }
    }
    PG8_WAIT_V(0);
    if constexpr (!ALIGN_EPI) { if (wr == 0) PG8_BAR; }
    PG8_BAR;
#undef PG8_SA
#undef PG8_SB
#undef PG8_STAGE
#undef PG8_LDA
#undef PG8_LDB
#undef PG8_MMA
#undef PG8_WAIT_V
#undef PG8_WAIT_L
#undef PG8_BAR
#undef PG8_SCHED
}
}

#define XB_TMO      128
#define XB_XCNT(j)  (256  + 64 * (j))
#define XB_XSUB(j)  (1280 + 64 * (j))
#define XB_XGEN(j)  (2304 + 64 * (j))
#define XB_TOP      3328
#define XB_TOPGEN   3392
#define XCD_BAR_WORDS 3456
#define XB_SPIN_CAP (1u << 18)
__device__ __forceinline__ unsigned xb_ld(unsigned* p)              { return __hip_atomic_load(p, __ATOMIC_RELAXED, __HIP_MEMORY_SCOPE_AGENT); }
__device__ __forceinline__ unsigned xb_add(unsigned* p, unsigned v) { return __hip_atomic_fetch_add(p, v, __ATOMIC_RELAXED, __HIP_MEMORY_SCOPE_AGENT); }
__device__ __forceinline__ unsigned xb_xcc_id() { return (unsigned)__builtin_amdgcn_s_getreg((3 << 11) | 20) & 0xFu; }
#define XB_SPIN(cond, bar) do { unsigned _sp = 0; while (cond) { __builtin_amdgcn_s_sleep(1); \
    if ((++_sp & 255u) == 0u) { if (xb_ld(&(bar)[XB_TMO])) break; if (_sp > XB_SPIN_CAP) { atomicAdd(&(bar)[XB_TMO], 1u); break; } } } } while (0)
struct XcdBarrier { unsigned* bar; unsigned x; volatile LAS unsigned* st; };
__device__ __forceinline__ XcdBarrier xcd_barrier_post(unsigned* bar, volatile LAS unsigned* st) {
    XcdBarrier b; b.bar = bar; b.x = xb_xcc_id(); b.st = st;
    if (threadIdx.x == 0) (void)xb_add(&bar[XB_XCNT(b.x)], 1u);
    return b;
}
__device__ __forceinline__ void xcd_barrier_complete(unsigned* bar, unsigned x, unsigned& nloc, unsigned& nx) {
    const unsigned G = gridDim.x * gridDim.y * gridDim.z;
    unsigned sum, cnt, mine, sp = 0u;
    for (;;) {
        sum = 0u; cnt = 0u; mine = 0u;
#pragma unroll
        for (unsigned j = 0; j < 16; ++j) { const unsigned c = xb_ld(&bar[XB_XCNT(j)]); sum += c; cnt += (c > 0u) ? 1u : 0u; mine = (j == x) ? c : mine; }
        if (sum == G) break;
        __builtin_amdgcn_s_sleep(1);
        if ((++sp & 255u) == 0u) { if (xb_ld(&bar[XB_TMO])) break; if (sp > XB_SPIN_CAP) { atomicAdd(&bar[XB_TMO], 1u); break; } }
    }
    nloc = mine > 0u ? mine : 1u; nx = cnt > 0u ? cnt : 1u;
}
__device__ __forceinline__ void xcd_barrier(const XcdBarrier& b) {
    asm volatile("s_waitcnt vmcnt(0)" ::: "memory");
    __syncthreads();
    if (threadIdx.x == 0) {
        unsigned* bar = b.bar;
        __builtin_amdgcn_s_waitcnt(0);
        unsigned nloc = b.st[0], nx = b.st[1];
        if (nloc == 0u) { xcd_barrier_complete(bar, b.x, nloc, nx); b.st[0] = nloc; b.st[1] = nx; }
        const unsigned old = xb_add(&bar[XB_XSUB(b.x)], 1u);
        const unsigned gen = old / nloc;
        if (old + 1u == (gen + 1u) * nloc) {
            __builtin_amdgcn_fence(__ATOMIC_RELEASE, "agent");
            asm volatile("s_waitcnt vmcnt(0)" ::: "memory");
            const unsigned og = xb_add(&bar[XB_TOP], 1u);
            const unsigned tg = og / nx;
            if (og + 1u == (tg + 1u) * nx) xb_add(&bar[XB_TOPGEN], 1u);
            else XB_SPIN(xb_ld(&bar[XB_TOPGEN]) == tg, bar);
            __builtin_amdgcn_fence(__ATOMIC_ACQUIRE, "agent");
            xb_add(&bar[XB_XGEN(b.x)], 1u);
            asm volatile("s_waitcnt vmcnt(0)" ::: "memory");
        } else {
            XB_SPIN(xb_ld(&bar[XB_XGEN(b.x)]) == gen, bar);
            __builtin_amdgcn_fence(__ATOMIC_ACQUIRE, "agent");
            asm volatile("s_waitcnt vmcnt(0)" ::: "memory");
        }
    }
    __syncthreads();
}

constexpr int NWAVES = 8;
constexpr int RING_BYTES = 131072, MISC_OFF = RING_BYTES, RS_OFF = RING_BYTES + 512, LDS_BYTES = 147456;
constexpr int CW_BAR = 4096;
constexpr int CW_ATTQ = 64;

__device__ __forceinline__ float dpp_add(float v, float o) { return v + o; }
__device__ __forceinline__ float row16_sum(float v) {
    v += DPP_F(v, 0xB1); v += DPP_F(v, 0x4E); v += DPP_F(v, 0x141); v += DPP_F(v, 0x140); return v;
}
__device__ __forceinline__ float wave_sum_u(float v) {
    v = row16_sum(v);
    const int i = __builtin_bit_cast(int, v);
    return (__builtin_bit_cast(float, __builtin_amdgcn_readlane(i, 0)) + __builtin_bit_cast(float, __builtin_amdgcn_readlane(i, 16))) +
           (__builtin_bit_cast(float, __builtin_amdgcn_readlane(i, 32)) + __builtin_bit_cast(float, __builtin_amdgcn_readlane(i, 48)));
}
typedef __bf16 bf16x2_t __attribute__((ext_vector_type(2)));
__device__ __forceinline__ float dot2(unsigned a, unsigned b, float acc) { return __builtin_amdgcn_fdot2_f32_bf16(__builtin_bit_cast(bf16x2_t, a), __builtin_bit_cast(bf16x2_t, b), acc, false); }

__device__ __forceinline__ void unpack8(const u32x4 w, float (&f)[8]) {
#pragma unroll
    for (int i = 0; i < 4; ++i) { f[2 * i] = bflo(w[i]); f[2 * i + 1] = bfhi(w[i]); }
}
typedef float f32x2 __attribute__((ext_vector_type(2)));
constexpr int CW_QU = 8192, CW_QV = 8192 + 512;
template <int M> __device__ __forceinline__ float xor_lane(float v) {
    if (M < 32) return __builtin_bit_cast(float, __builtin_amdgcn_ds_swizzle(__builtin_bit_cast(int, v), (M << 10) | 0x1f));
    return __shfl_xor(v, M);
}
__device__ __forceinline__ float fsel(int m, float a, float b) { return __builtin_bit_cast(float, (__builtin_bit_cast(int, a) & m) | (__builtin_bit_cast(int, b) & ~m)); }
__device__ __forceinline__ void fp8x16_to_f32(const u32x4 w, float (&f)[16]) {
#pragma unroll
    for (int q = 0; q < 4; ++q) { const f32x2 lo = __builtin_amdgcn_cvt_pk_f32_fp8((int)w[q], false), hi = __builtin_amdgcn_cvt_pk_f32_fp8((int)w[q], true);
        f[4 * q] = lo.x; f[4 * q + 1] = lo.y; f[4 * q + 2] = hi.x; f[4 * q + 3] = hi.y; }
}
template <int WHICH> struct SliceTok {
    u32x4 vv[16]; f32x2 o; float r0, r1, wsc; int t, ia, ib, wd;
    __device__ __forceinline__ void idx(const Ptrs& P, int t_, int lane) { const unsigned short* ip = (const unsigned short*)(P.ws + WS_IDX16) + (size_t)t_ * 128; ia = ip[(unsigned)lane]; ib = ip[(unsigned)(64 + lane)]; }
    __device__ __forceinline__ void load(const Ptrs& P, int t_, int j, int lane) {
        t = t_;
        const unsigned char* ws = P.ws;
        const int sl = lane >> 3, p = lane & 7;
        const unsigned char* TAB = ws + (WHICH ? WS_EV : WS_EU) + (size_t)j * SLICE_BYTES;
        const int baddr = 4 * sl;
        if (WHICH == 1) { wd = ((const int*)(ws + WS_W))[(unsigned)(t * 32 + (lane & 31))]; wsc = ((const float*)(ws + WS_R1))[t];
            const int col = 128 * j + 16 * p + 8 * ((lane >> 5) & 1) + 4 * ((lane >> 4) & 1) + 2 * ((lane >> 3) & 1); { const unsigned xw = *(const unsigned*)((const bf16*)(ws + WS_X1BF) + (size_t)t * D + (unsigned)col); o = (f32x2){bflo(xw), bfhi(xw)}; } }
#pragma unroll
        for (int i = 0; i < 16; ++i) { const int e = __builtin_amdgcn_ds_bpermute(baddr + 32 * (i & 7), (i < 8) ? ia : ib); vv[i] = *(const u32x4*)(TAB + (unsigned)(e * 128 + 16 * p)); }
    }
    __device__ __forceinline__ void compute(int lane, const LAS unsigned char* xqp, float sx) {
        const int sl = lane >> 3;
        const int baddr = 4 * sl;
        if (WHICH == 0) {
            const i32x4 xq = *(const LAS i32x4*)xqp;
            int d[16];
#pragma unroll
            for (int i = 0; i < 16; ++i) { int a = 0;
#pragma unroll
                for (int q = 0; q < 4; ++q) a = __builtin_amdgcn_sdot4((int)vv[i][q], xq[q], a, false);
                d[i] = a; }
#pragma unroll
            for (int st = 0; st < 3; ++st) { const int M = 1 << st, n = 8 >> st; const int hm = (lane & M) ? -1 : 0;
#pragma unroll
                for (int i = 0; i < 8; ++i) if (i < n) { const int keep = (d[n + i] & hm) | (d[i] & ~hm), send = (d[i] & hm) | (d[n + i] & ~hm);
                    d[i] = keep + ((st == 0) ? DPP_I(send, 0xB1) : (st == 1) ? DPP_I(send, 0x4E) : __builtin_amdgcn_ds_swizzle(send, (4 << 10) | 0x1f)); } }
            r0 = (float)d[0] * sx; r1 = (float)d[1] * sx;
            (void)baddr;
        } else {
            int wq[4];
#pragma unroll
            for (int b = 0; b < 4; ++b) wq[b] = __builtin_amdgcn_ds_bpermute(16 * sl + 4 * b, wd);
            int acc[16];
#pragma unroll
            for (int c = 0; c < 16; ++c) acc[c] = 0;
#pragma unroll
            for (int b = 0; b < 4; ++b)
#pragma unroll
                for (int q = 0; q < 4; ++q) { const unsigned r0_ = vv[4 * b][q], r1_ = vv[4 * b + 1][q], r2_ = vv[4 * b + 2][q], r3_ = vv[4 * b + 3][q];
                    const unsigned t01l = __builtin_amdgcn_perm(r1_, r0_, 0x05010400u), t01h = __builtin_amdgcn_perm(r1_, r0_, 0x07030602u);
                    const unsigned t23l = __builtin_amdgcn_perm(r3_, r2_, 0x05010400u), t23h = __builtin_amdgcn_perm(r3_, r2_, 0x07030602u);
                    const unsigned c0 = __builtin_amdgcn_perm(t23l, t01l, 0x05040100u), c1 = __builtin_amdgcn_perm(t23l, t01l, 0x07060302u);
                    const unsigned c2 = __builtin_amdgcn_perm(t23h, t01h, 0x05040100u), c3 = __builtin_amdgcn_perm(t23h, t01h, 0x07060302u);
                    acc[4 * q] = __builtin_amdgcn_sdot4((int)c0, wq[b], acc[4 * q], false); acc[4 * q + 1] = __builtin_amdgcn_sdot4((int)c1, wq[b], acc[4 * q + 1], false);
                    acc[4 * q + 2] = __builtin_amdgcn_sdot4((int)c2, wq[b], acc[4 * q + 2], false); acc[4 * q + 3] = __builtin_amdgcn_sdot4((int)c3, wq[b], acc[4 * q + 3], false); }
#pragma unroll
            for (int st = 0; st < 3; ++st) { const int M = 32 >> st, n = 8 >> st; const int hm = (lane & M) ? -1 : 0;
#pragma unroll
                for (int i = 0; i < 8; ++i) if (i < n) { const int keep = (acc[n + i] & hm) | (acc[i] & ~hm), send = (acc[i] & hm) | (acc[n + i] & ~hm);
                    acc[i] = keep + ((st == 0) ? __shfl_xor(send, 32) : (st == 1) ? __builtin_amdgcn_ds_swizzle(send, (16 << 10) | 0x1f) : __builtin_amdgcn_ds_swizzle(send, (8 << 10) | 0x1f)); } }
            r0 = (float)acc[0] * wsc; r1 = (float)acc[1] * wsc;
        }
    }
    __device__ __forceinline__ void store(const Ptrs& P, int j, int lane) {
        const int sl = lane >> 3, p = lane & 7;
        if (WHICH == 0) { const int i0 = 8 * (lane & 1) + 4 * ((lane >> 1) & 1) + 2 * ((lane >> 2) & 1);
            float* pp = (float*)(P.ws + WS_PART) + ((size_t)j * T + t) * 128;
            pp[(unsigned)(8 * i0 + sl)] = r0; pp[(unsigned)(8 * i0 + 8 + sl)] = r1; }
        else { const int col = 128 * j + 16 * p + 8 * ((lane >> 5) & 1) + 4 * ((lane >> 4) & 1) + 2 * ((lane >> 3) & 1);
            f32x2 q = o; q.x += r0; q.y += r1; *(f32x2*)(P.out + (size_t)t * D + (unsigned)col) = q; }
    }
};
template <int WHICH> __device__ __forceinline__ void p6_sliced(const Ptrs& P, LAS unsigned char* lds, volatile LAS unsigned* MISC, unsigned* ctl, int tid, int lane, int wave) {
    const int my = (int)(xb_xcc_id() & 7u);
    LAS unsigned char* XQ = lds + wave * 1024;
    LAS float* SX = (LAS float*)(lds + 8192 + wave * 32);
    for (int off = 0; off < 8; ++off) {
        const int j = (my + off) & 7;
        unsigned* head = ctl + (WHICH ? CW_QV : CW_QU) + 64 * j;
        for (;;) {
            if (tid == 0) MISC[1] = atomicAdd(head, 1u);
            __syncthreads();
            const int blk = (int)MISC[1];
            __syncthreads();
            if (blk >= T / 64) break;
            const int t0 = blk * 64 + wave * 8;
            int la = lane; asm volatile("" : "+v"(la));
            SliceTok<WHICH> A, B;
            A.idx(P, t0, la); B.idx(P, t0 + 1, la);
            A.load(P, t0, j, la);
            if (WHICH == 0) {
                const bf16* xb = (const bf16*)(P.ws + WS_X1BF) + (size_t)(t0 + (la >> 3)) * D + (unsigned)(128 * j + 16 * (la & 7));
                const u32x4 xw0 = *(const u32x4*)xb, xw1 = *(const u32x4*)(xb + 8);
                float xf[16]; { float t8[8]; unpack8(xw0, t8);
#pragma unroll
                    for (int i = 0; i < 8; ++i) xf[i] = t8[i];
                    unpack8(xw1, t8);
#pragma unroll
                    for (int i = 0; i < 8; ++i) xf[8 + i] = t8[i]; }
                float mx = 0.f;
#pragma unroll
                for (int i = 0; i < 16; ++i) mx = fmaxf(mx, fabsf(xf[i]));
                mx = fmaxf(mx, DPP_F(mx, 0xB1)); mx = fmaxf(mx, DPP_F(mx, 0x4E)); mx = fmaxf(mx, DPP_F(mx, 0x141));
                mx = fmaxf(mx, 1e-30f);
                const float xinv = 127.0f * __builtin_amdgcn_rcpf(mx);
                i32x4 xq;
#pragma unroll
                for (int q = 0; q < 4; ++q) { const int q0 = (int)rintf(xf[4 * q] * xinv), q1 = (int)rintf(xf[4 * q + 1] * xinv), q2 = (int)rintf(xf[4 * q + 2] * xinv), q3 = (int)rintf(xf[4 * q + 3] * xinv);
                    xq[q] = (int)((unsigned)(q0 & 0xff) | ((unsigned)(q1 & 0xff) << 8) | ((unsigned)(q2 & 0xff) << 16) | ((unsigned)q3 << 24)); }
                *(LAS i32x4*)(XQ + 16 * la) = xq;
                if ((la & 7) == 0) SX[la >> 3] = mx * (1.0f / 127.0f);
            }
            const LAS unsigned char* xqp = XQ + 16 * (la & 7);
#pragma unroll
            for (int n = 0; n < 8; n += 2) {
                B.load(P, t0 + n + 1, j, la);
                if (n + 2 < 8) A.idx(P, t0 + n + 2, la);
                A.compute(la, xqp + 128 * n, (WHICH == 0) ? SX[n] : 0.f); A.store(P, j, la);
                if (n + 2 < 8) { A.load(P, t0 + n + 2, j, la); B.idx(P, t0 + n + 3, la); }
                B.compute(la, xqp + 128 * (n + 1), (WHICH == 0) ? SX[n + 1] : 0.f); B.store(P, j, la);
            }
        }
    }
}

__device__ __forceinline__ void p6_v2(const Ptrs& P, volatile LAS unsigned* MISC, unsigned* ctl, int tid, int lane, int wave) {
    const int my = (int)(xb_xcc_id() & 7u);
    const unsigned char* ws = P.ws;
    constexpr int PD = 6;
    for (int off = 0; off < 8; ++off) {
        const int j = (my + off) & 7;
        unsigned* head = ctl + CW_QV + 64 * j;
        const unsigned char* TAB = ws + WS_EV + (size_t)j * SLICE_BYTES;
        for (;;) {
            if (tid == 0) MISC[1] = atomicAdd(head, 1u);
            __syncthreads();
            const int blk = (int)MISC[1];
            __syncthreads();
            if (blk >= T / 64) break;
            int la = lane; asm volatile("" : "+v"(la));
            const int t = blk * 64 + wave * 8 + (la >> 3);
            const unsigned pb = 16u * (unsigned)(la & 7);
            const unsigned char* idp = ws + WS_IDX16 + (unsigned)(t * 256);
            const unsigned char* wp = ws + WS_W + (unsigned)(t * 128);
            u32x4 ids[16];
#pragma unroll
            for (int c = 0; c < 16; ++c) ids[c] = *(const u32x4*)(idp + 16 * c);
            u32x4 vv[PD + 1][4];
#define P6V_ISSUE(q_) do { _Pragma("unroll") for (int e_ = 0; e_ < 4; ++e_) { const int k_ = 4 * (q_) + e_; const unsigned word = ids[k_ >> 3][(k_ & 7) >> 1]; \
                const unsigned ex = (k_ & 1) ? (word >> 16) : (word & 0xffffu); vv[(q_) % (PD + 1)][e_] = *(const u32x4*)(TAB + (ex * 128u + pb)); } } while (0)
#pragma unroll
            for (int q = 0; q < PD; ++q) P6V_ISSUE(q);
            const u32x4 xr0 = *(const u32x4*)((const bf16*)(ws + WS_X1BF) + (size_t)t * D + (unsigned)(128 * j) + pb), xr1 = *(const u32x4*)((const bf16*)(ws + WS_X1BF) + (size_t)t * D + (unsigned)(128 * j) + pb + 8);
            const float wsc = ((const float*)(ws + WS_R1))[t];
            u32x4 wq[8];
#pragma unroll
            for (int c = 0; c < 8; ++c) wq[c] = *(const u32x4*)(wp + 16 * c);
            int acc[16];
#pragma unroll
            for (int c = 0; c < 16; ++c) acc[c] = 0;
#pragma unroll
            for (int q = 0; q < 32; ++q) {
                if (q + PD < 32) P6V_ISSUE(q + PD);
                const int wv = (int)wq[q >> 2][q & 3];
#pragma unroll
                for (int d = 0; d < 4; ++d) { const unsigned r0_ = vv[q % (PD + 1)][0][d], r1_ = vv[q % (PD + 1)][1][d], r2_ = vv[q % (PD + 1)][2][d], r3_ = vv[q % (PD + 1)][3][d];
                    const unsigned t01l = __builtin_amdgcn_perm(r1_, r0_, 0x05010400u), t01h = __builtin_amdgcn_perm(r1_, r0_, 0x07030602u);
                    const unsigned t23l = __builtin_amdgcn_perm(r3_, r2_, 0x05010400u), t23h = __builtin_amdgcn_perm(r3_, r2_, 0x07030602u);
                    const unsigned c0 = __builtin_amdgcn_perm(t23l, t01l, 0x05040100u), c1 = __builtin_amdgcn_perm(t23l, t01l, 0x07060302u);
                    const unsigned c2 = __builtin_amdgcn_perm(t23h, t01h, 0x05040100u), c3 = __builtin_amdgcn_perm(t23h, t01h, 0x07060302u);
                    acc[4 * d] = __builtin_amdgcn_sdot4((int)c0, wv, acc[4 * d], false); acc[4 * d + 1] = __builtin_amdgcn_sdot4((int)c1, wv, acc[4 * d + 1], false);
                    acc[4 * d + 2] = __builtin_amdgcn_sdot4((int)c2, wv, acc[4 * d + 2], false); acc[4 * d + 3] = __builtin_amdgcn_sdot4((int)c3, wv, acc[4 * d + 3], false); }
            }
#undef P6V_ISSUE
            float xf[16]; { float t8[8]; unpack8(xr0, t8);
#pragma unroll
                for (int i = 0; i < 8; ++i) xf[i] = t8[i];
                unpack8(xr1, t8);
#pragma unroll
                for (int i = 0; i < 8; ++i) xf[8 + i] = t8[i]; }
            float* op = P.out + (size_t)t * D + (unsigned)(128 * j) + pb;
#pragma unroll
            for (int c4 = 0; c4 < 4; ++c4) *(f32x4*)(op + 4 * c4) = (f32x4){xf[4 * c4] + (float)acc[4 * c4] * wsc, xf[4 * c4 + 1] + (float)acc[4 * c4 + 1] * wsc, xf[4 * c4 + 2] + (float)acc[4 * c4 + 2] * wsc, xf[4 * c4 + 3] + (float)acc[4 * c4 + 3] * wsc};
        }
    }
}

__device__ __forceinline__ void p6_v3(const Ptrs& P, LAS unsigned char* lds, int bx, int lane, int wave) {
    const unsigned char* ws = P.ws;
    constexpr int NB = 8;
    const int j = bx & 7, wi = (bx >> 3) * 8 + wave, T0 = wi * 64;
    const unsigned char* TAB = ws + WS_EV + (size_t)j * SLICE_BYTES;
    LAS unsigned char* buf = lds + wave * 6144;
    int la = lane; asm volatile("" : "+v"(la));
    const int g = la >> 3;
    const unsigned pb = 16u * (unsigned)(la & 7);
#define V3_FETCH(b_, r0_, r1_, r2_) do { const unsigned char* ip_ = ws + WS_IDX16 + (unsigned)((T0 + 8 * (b_)) * 256) + 16u * (unsigned)la; r0_ = *(const u32x4*)ip_; r1_ = *(const u32x4*)(ip_ + 1024); \
        r2_ = *(const u32x4*)(ws + WS_W + (unsigned)((T0 + 8 * (b_)) * 128) + 16u * (unsigned)la); } while (0)
#define V3_PARK(b_, r0_, r1_, r2_) do { LAS unsigned char* d_ = buf + ((b_) & 1) * 3072; *(LAS u32x4*)(d_ + 16 * la) = r0_; *(LAS u32x4*)(d_ + 1024 + 16 * la) = r1_; *(LAS u32x4*)(d_ + 2048 + 16 * la) = r2_; } while (0)
    u32x4 f0, f1, f2;
    V3_FETCH(0, f0, f1, f2); V3_PARK(0, f0, f1, f2);
    u32x4 V00, V01, V02, V03, V10, V11, V12, V13, V20, V21, V22, V23, V30, V31, V32, V33, V40, V41, V42, V43, V50, V51, V52, V53, V60, V61, V62, V63, V70, V71, V72, V73;
#define V3_ISSUE(S_, bsel_, tq_) do { const u32x2 e2_ = *(const LAS u32x2*)(buf + (bsel_) * 3072 + g * 256 + 8 * (tq_)); \
        V##S_##0 = *(const u32x4*)(TAB + ((e2_.x & 0xffffu) * 128u + pb)); V##S_##1 = *(const u32x4*)(TAB + ((e2_.x >> 16) * 128u + pb)); \
        V##S_##2 = *(const u32x4*)(TAB + ((e2_.y & 0xffffu) * 128u + pb)); V##S_##3 = *(const u32x4*)(TAB + ((e2_.y >> 16) * 128u + pb)); } while (0)
#define V3_MAC(S_, q_) do { const int wv = *(const LAS int*)(buf + bs * 3072 + 2048 + g * 128 + 4 * (q_)); \
        _Pragma("unroll") for (int d = 0; d < 4; ++d) { const unsigned r0_ = V##S_##0[d], r1_ = V##S_##1[d], r2_ = V##S_##2[d], r3_ = V##S_##3[d]; \
            const unsigned t01l = __builtin_amdgcn_perm(r1_, r0_, 0x05010400u), t01h = __builtin_amdgcn_perm(r1_, r0_, 0x07030602u); \
            const unsigned t23l = __builtin_amdgcn_perm(r3_, r2_, 0x05010400u), t23h = __builtin_amdgcn_perm(r3_, r2_, 0x07030602u); \
            const unsigned c0 = __builtin_amdgcn_perm(t23l, t01l, 0x05040100u), c1 = __builtin_amdgcn_perm(t23l, t01l, 0x07060302u); \
            const unsigned c2 = __builtin_amdgcn_perm(t23h, t01h, 0x05040100u), c3 = __builtin_amdgcn_perm(t23h, t01h, 0x07060302u); \
            acc[4 * d] = __builtin_amdgcn_sdot4((int)c0, wv, acc[4 * d], false); acc[4 * d + 1] = __builtin_amdgcn_sdot4((int)c1, wv, acc[4 * d + 1], false); \
            acc[4 * d + 2] = __builtin_amdgcn_sdot4((int)c2, wv, acc[4 * d + 2], false); acc[4 * d + 3] = __builtin_amdgcn_sdot4((int)c3, wv, acc[4 * d + 3], false); } } while (0)
    V3_ISSUE(0, 0, 0);
    V3_ISSUE(1, 0, 1);
    V3_ISSUE(2, 0, 2);
    V3_ISSUE(3, 0, 3);
    V3_ISSUE(4, 0, 4);
    V3_ISSUE(5, 0, 5);
#pragma unroll 1
    for (int b = 0; b < NB; ++b) {
        int acc[16];
#pragma unroll
        for (int c = 0; c < 16; ++c) acc[c] = 0;
        const int bs = b & 1, t = T0 + 8 * b + g;
        const bf16* xrp = (const bf16*)(ws + WS_X1BF) + (size_t)t * D + (unsigned)(128 * j) + pb;
        const u32x4 xr0 = *(const u32x4*)xrp, xr1 = *(const u32x4*)(xrp + 8);
        const float wsc = ((const float*)(ws + WS_R1))[t];
        V3_FETCH((b + 1) & 7, f0, f1, f2);
        V3_ISSUE(6, bs, 6); V3_MAC(0, 0);
        V3_ISSUE(7, bs, 7); V3_MAC(1, 1);
        V3_ISSUE(0, bs, 8); V3_MAC(2, 2);
        V3_ISSUE(1, bs, 9); V3_MAC(3, 3);
        V3_ISSUE(2, bs, 10); V3_MAC(4, 4);
        V3_ISSUE(3, bs, 11); V3_MAC(5, 5);
        V3_ISSUE(4, bs, 12); V3_MAC(6, 6);
        V3_ISSUE(5, bs, 13); V3_MAC(7, 7);
        V3_PARK(b + 1, f0, f1, f2);
        V3_ISSUE(6, bs, 14); V3_MAC(0, 8);
        V3_ISSUE(7, bs, 15); V3_MAC(1, 9);
        V3_ISSUE(0, bs, 16); V3_MAC(2, 10);
        V3_ISSUE(1, bs, 17); V3_MAC(3, 11);
        V3_ISSUE(2, bs, 18); V3_MAC(4, 12);
        V3_ISSUE(3, bs, 19); V3_MAC(5, 13);
        V3_ISSUE(4, bs, 20); V3_MAC(6, 14);
        V3_ISSUE(5, bs, 21); V3_MAC(7, 15);
        V3_ISSUE(6, bs, 22); V3_MAC(0, 16);
        V3_ISSUE(7, bs, 23); V3_MAC(1, 17);
        V3_ISSUE(0, bs, 24); V3_MAC(2, 18);
        V3_ISSUE(1, bs, 25); V3_MAC(3, 19);
        V3_ISSUE(2, bs, 26); V3_MAC(4, 20);
        V3_ISSUE(3, bs, 27); V3_MAC(5, 21);
        V3_ISSUE(4, bs, 28); V3_MAC(6, 22);
        V3_ISSUE(5, bs, 29); V3_MAC(7, 23);
        V3_ISSUE(6, bs, 30); V3_MAC(0, 24);
        V3_ISSUE(7, bs, 31); V3_MAC(1, 25);
        V3_ISSUE(0, bs ^ 1, 0); V3_MAC(2, 26);
        V3_ISSUE(1, bs ^ 1, 1); V3_MAC(3, 27);
        V3_ISSUE(2, bs ^ 1, 2); V3_MAC(4, 28);
        V3_ISSUE(3, bs ^ 1, 3); V3_MAC(5, 29);
        V3_ISSUE(4, bs ^ 1, 4); V3_MAC(6, 30);
        V3_ISSUE(5, bs ^ 1, 5); V3_MAC(7, 31);
        float xf[16]; { float t8[8]; unpack8(xr0, t8);
#pragma unroll
            for (int i = 0; i < 8; ++i) xf[i] = t8[i];
            unpack8(xr1, t8);
#pragma unroll
            for (int i = 0; i < 8; ++i) xf[8 + i] = t8[i]; }
        float* op = P.out + (size_t)t * D + (unsigned)(128 * j) + pb;
#pragma unroll
        for (int c4 = 0; c4 < 4; ++c4) { *(f32x4*)(op + 4 * c4) = (f32x4){xf[4 * c4] + (float)acc[4 * c4] * wsc, xf[4 * c4 + 1] + (float)acc[4 * c4 + 1] * wsc, xf[4 * c4 + 2] + (float)acc[4 * c4 + 2] * wsc, xf[4 * c4 + 3] + (float)acc[4 * c4 + 3] * wsc};
        }
    }
#undef V3_MAC
#undef V3_FETCH
#undef V3_PARK
#undef V3_ISSUE
}

__device__ __forceinline__ void p6_u3(const Ptrs& P, LAS unsigned char* lds, int bx, int lane, int wave) {
    const unsigned char* ws = P.ws;
    constexpr int NB = 8;
    const int j = bx & 7, wi = (bx >> 3) * 8 + wave, T0 = wi * 64;
    const unsigned char* TAB = ws + WS_EU + (size_t)j * SLICE_BYTES;
    LAS unsigned char* buf = lds + wave * 8192;
    int la = lane; asm volatile("" : "+v"(la));
    const int sl = la >> 3, pc = la & 7;
    const unsigned pb = 16u * (unsigned)pc;
    const int i0 = 8 * (la & 1) + 4 * ((la >> 1) & 1) + 2 * ((la >> 2) & 1);
#define U3_FETCH(b_) do { const unsigned char* ip_ = ws + WS_IDX16 + (unsigned)((T0 + 8 * (b_)) * 256) + 16u * (unsigned)la; f0 = *(const u32x4*)ip_; f1 = *(const u32x4*)(ip_ + 1024); \
        const bf16* xb_ = (const bf16*)(ws + WS_X1BF) + (size_t)(T0 + 8 * (b_) + (la >> 3)) * D + (unsigned)(128 * j + 16 * (la & 7)); x0 = *(const u32x4*)xb_; x1 = *(const u32x4*)(xb_ + 8); } while (0)
#define U3_PARK(b_) do { LAS unsigned char* d_ = buf + ((b_) & 1) * 4096; *(LAS u32x4*)(d_ + 16 * la) = f0; *(LAS u32x4*)(d_ + 1024 + 16 * la) = f1; \
        float xf[16]; { float t8[8]; unpack8(x0, t8); _Pragma("unroll") for (int i = 0; i < 8; ++i) xf[i] = t8[i]; unpack8(x1, t8); _Pragma("unroll") for (int i = 0; i < 8; ++i) xf[8 + i] = t8[i]; } \
        float mx = 0.f; _Pragma("unroll") for (int i = 0; i < 16; ++i) mx = fmaxf(mx, fabsf(xf[i])); \
        mx = fmaxf(mx, DPP_F(mx, 0xB1)); mx = fmaxf(mx, DPP_F(mx, 0x4E)); mx = fmaxf(mx, DPP_F(mx, 0x141)); mx = fmaxf(mx, 1e-30f); \
        const float xinv = 127.0f * __builtin_amdgcn_rcpf(mx); i32x4 xq_; \
        _Pragma("unroll") for (int q = 0; q < 4; ++q) { const int q0 = (int)rintf(xf[4 * q] * xinv), q1 = (int)rintf(xf[4 * q + 1] * xinv), q2 = (int)rintf(xf[4 * q + 2] * xinv), q3 = (int)rintf(xf[4 * q + 3] * xinv); \
            xq_[q] = (int)((unsigned)(q0 & 0xff) | ((unsigned)(q1 & 0xff) << 8) | ((unsigned)(q2 & 0xff) << 16) | ((unsigned)q3 << 24)); } \
        *(LAS i32x4*)(d_ + 2048 + 16 * la) = xq_; if ((la & 7) == 0) *(LAS float*)(d_ + 3072 + 4 * (la >> 3)) = mx * (1.0f / 127.0f); } while (0)
    u32x4 f0, f1, x0, x1;
    u32x4 A0, A1, A2, A3, A4, A5, A6, A7, A8, A9, A10, A11, A12, A13, A14, A15;
    u32x4 B0, B1, B2, B3, B4, B5, B6, B7, B8, B9, B10, B11, B12, B13, B14, B15;
    U3_FETCH(0); U3_PARK(0);
    { const LAS unsigned char* ip_ = buf + (0) * 4096 + 0 * 256 + 32 * sl; const u32x4 e0_ = *(const LAS u32x4*)ip_, e1_ = *(const LAS u32x4*)(ip_ + 16);
        A0 = *(const u32x4*)(TAB + ((e0_[0] & 0xffffu) * 128u + pb));
        A1 = *(const u32x4*)(TAB + ((e0_[0] >> 16) * 128u + pb));
        A2 = *(const u32x4*)(TAB + ((e0_[1] & 0xffffu) * 128u + pb));
        A3 = *(const u32x4*)(TAB + ((e0_[1] >> 16) * 128u + pb));
        A4 = *(const u32x4*)(TAB + ((e0_[2] & 0xffffu) * 128u + pb));
        A5 = *(const u32x4*)(TAB + ((e0_[2] >> 16) * 128u + pb));
        A6 = *(const u32x4*)(TAB + ((e0_[3] & 0xffffu) * 128u + pb));
        A7 = *(const u32x4*)(TAB + ((e0_[3] >> 16) * 128u + pb));
        A8 = *(const u32x4*)(TAB + ((e1_[0] & 0xffffu) * 128u + pb));
        A9 = *(const u32x4*)(TAB + ((e1_[0] >> 16) * 128u + pb));
        A10 = *(const u32x4*)(TAB + ((e1_[1] & 0xffffu) * 128u + pb));
        A11 = *(const u32x4*)(TAB + ((e1_[1] >> 16) * 128u + pb));
        A12 = *(const u32x4*)(TAB + ((e1_[2] & 0xffffu) * 128u + pb));
        A13 = *(const u32x4*)(TAB + ((e1_[2] >> 16) * 128u + pb));
        A14 = *(const u32x4*)(TAB + ((e1_[3] & 0xffffu) * 128u + pb));
        A15 = *(const u32x4*)(TAB + ((e1_[3] >> 16) * 128u + pb));
    }
#pragma unroll 1
    for (int b = 0; b < NB; ++b) {
        const int bs = b & 1;
        U3_FETCH((b + 1) & 7);
        { const LAS unsigned char* ip_ = buf + (bs) * 4096 + 1 * 256 + 32 * sl; const u32x4 e0_ = *(const LAS u32x4*)ip_, e1_ = *(const LAS u32x4*)(ip_ + 16);
            B0 = *(const u32x4*)(TAB + ((e0_[0] & 0xffffu) * 128u + pb));
            B1 = *(const u32x4*)(TAB + ((e0_[0] >> 16) * 128u + pb));
            B2 = *(const u32x4*)(TAB + ((e0_[1] & 0xffffu) * 128u + pb));
            B3 = *(const u32x4*)(TAB + ((e0_[1] >> 16) * 128u + pb));
            B4 = *(const u32x4*)(TAB + ((e0_[2] & 0xffffu) * 128u + pb));
            B5 = *(const u32x4*)(TAB + ((e0_[2] >> 16) * 128u + pb));
            B6 = *(const u32x4*)(TAB + ((e0_[3] & 0xffffu) * 128u + pb));
            B7 = *(const u32x4*)(TAB + ((e0_[3] >> 16) * 128u + pb));
            B8 = *(const u32x4*)(TAB + ((e1_[0] & 0xffffu) * 128u + pb));
            B9 = *(const u32x4*)(TAB + ((e1_[0] >> 16) * 128u + pb));
            B10 = *(const u32x4*)(TAB + ((e1_[1] & 0xffffu) * 128u + pb));
            B11 = *(const u32x4*)(TAB + ((e1_[1] >> 16) * 128u + pb));
            B12 = *(const u32x4*)(TAB + ((e1_[2] & 0xffffu) * 128u + pb));
            B13 = *(const u32x4*)(TAB + ((e1_[2] >> 16) * 128u + pb));
            B14 = *(const u32x4*)(TAB + ((e1_[3] & 0xffffu) * 128u + pb));
            B15 = *(const u32x4*)(TAB + ((e1_[3] >> 16) * 128u + pb));
        }
        { const i32x4 xq = *(const LAS i32x4*)(buf + bs * 4096 + 2048 + 0 * 128 + 16 * pc); const float sx = *(const LAS float*)(buf + bs * 4096 + 3072 + 4 * 0);
            int d[16];
            d[0] = __builtin_amdgcn_sdot4((int)A0[3], xq[3], __builtin_amdgcn_sdot4((int)A0[2], xq[2], __builtin_amdgcn_sdot4((int)A0[1], xq[1], __builtin_amdgcn_sdot4((int)A0[0], xq[0], 0, false), false), false), false);
            d[1] = __builtin_amdgcn_sdot4((int)A1[3], xq[3], __builtin_amdgcn_sdot4((int)A1[2], xq[2], __builtin_amdgcn_sdot4((int)A1[1], xq[1], __builtin_amdgcn_sdot4((int)A1[0], xq[0], 0, false), false), false), false);
            d[2] = __builtin_amdgcn_sdot4((int)A2[3], xq[3], __builtin_amdgcn_sdot4((int)A2[2], xq[2], __builtin_amdgcn_sdot4((int)A2[1], xq[1], __builtin_amdgcn_sdot4((int)A2[0], xq[0], 0, false), false), false), false);
            d[3] = __builtin_amdgcn_sdot4((int)A3[3], xq[3], __builtin_amdgcn_sdot4((int)A3[2], xq[2], __builtin_amdgcn_sdot4((int)A3[1], xq[1], __builtin_amdgcn_sdot4((int)A3[0], xq[0], 0, false), false), false), false);
            d[4] = __builtin_amdgcn_sdot4((int)A4[3], xq[3], __builtin_amdgcn_sdot4((int)A4[2], xq[2], __builtin_amdgcn_sdot4((int)A4[1], xq[1], __builtin_amdgcn_sdot4((int)A4[0], xq[0], 0, false), false), false), false);
            d[5] = __builtin_amdgcn_sdot4((int)A5[3], xq[3], __builtin_amdgcn_sdot4((int)A5[2], xq[2], __builtin_amdgcn_sdot4((int)A5[1], xq[1], __builtin_amdgcn_sdot4((int)A5[0], xq[0], 0, false), false), false), false);
            d[6] = __builtin_amdgcn_sdot4((int)A6[3], xq[3], __builtin_amdgcn_sdot4((int)A6[2], xq[2], __builtin_amdgcn_sdot4((int)A6[1], xq[1], __builtin_amdgcn_sdot4((int)A6[0], xq[0], 0, false), false), false), false);
            d[7] = __builtin_amdgcn_sdot4((int)A7[3], xq[3], __builtin_amdgcn_sdot4((int)A7[2], xq[2], __builtin_amdgcn_sdot4((int)A7[1], xq[1], __builtin_amdgcn_sdot4((int)A7[0], xq[0], 0, false), false), false), false);
            d[8] = __builtin_amdgcn_sdot4((int)A8[3], xq[3], __builtin_amdgcn_sdot4((int)A8[2], xq[2], __builtin_amdgcn_sdot4((int)A8[1], xq[1], __builtin_amdgcn_sdot4((int)A8[0], xq[0], 0, false), false), false), false);
            d[9] = __builtin_amdgcn_sdot4((int)A9[3], xq[3], __builtin_amdgcn_sdot4((int)A9[2], xq[2], __builtin_amdgcn_sdot4((int)A9[1], xq[1], __builtin_amdgcn_sdot4((int)A9[0], xq[0], 0, false), false), false), false);
            d[10] = __builtin_amdgcn_sdot4((int)A10[3], xq[3], __builtin_amdgcn_sdot4((int)A10[2], xq[2], __builtin_amdgcn_sdot4((int)A10[1], xq[1], __builtin_amdgcn_sdot4((int)A10[0], xq[0], 0, false), false), false), false);
            d[11] = __builtin_amdgcn_sdot4((int)A11[3], xq[3], __builtin_amdgcn_sdot4((int)A11[2], xq[2], __builtin_amdgcn_sdot4((int)A11[1], xq[1], __builtin_amdgcn_sdot4((int)A11[0], xq[0], 0, false), false), false), false);
            d[12] = __builtin_amdgcn_sdot4((int)A12[3], xq[3], __builtin_amdgcn_sdot4((int)A12[2], xq[2], __builtin_amdgcn_sdot4((int)A12[1], xq[1], __builtin_amdgcn_sdot4((int)A12[0], xq[0], 0, false), false), false), false);
            d[13] = __builtin_amdgcn_sdot4((int)A13[3], xq[3], __builtin_amdgcn_sdot4((int)A13[2], xq[2], __builtin_amdgcn_sdot4((int)A13[1], xq[1], __builtin_amdgcn_sdot4((int)A13[0], xq[0], 0, false), false), false), false);
            d[14] = __builtin_amdgcn_sdot4((int)A14[3], xq[3], __builtin_amdgcn_sdot4((int)A14[2], xq[2], __builtin_amdgcn_sdot4((int)A14[1], xq[1], __builtin_amdgcn_sdot4((int)A14[0], xq[0], 0, false), false), false), false);
            d[15] = __builtin_amdgcn_sdot4((int)A15[3], xq[3], __builtin_amdgcn_sdot4((int)A15[2], xq[2], __builtin_amdgcn_sdot4((int)A15[1], xq[1], __builtin_amdgcn_sdot4((int)A15[0], xq[0], 0, false), false), false), false);
            _Pragma("unroll") for (int st = 0; st < 3; ++st) { const int M = 1 << st, nn = 8 >> st; const int hm = (la & M) ? -1 : 0;
                _Pragma("unroll") for (int i = 0; i < 8; ++i) if (i < nn) { const int keep = (d[nn + i] & hm) | (d[i] & ~hm), send = (d[i] & hm) | (d[nn + i] & ~hm);
                    d[i] = keep + ((st == 0) ? DPP_I(send, 0xB1) : (st == 1) ? DPP_I(send, 0x4E) : __builtin_amdgcn_ds_swizzle(send, (4 << 10) | 0x1f)); } }
            float* pp = (float*)(P.ws + WS_PART) + ((size_t)j * T + (unsigned)(T0 + 8 * b + 0)) * 128;
            *(f32x2*)(pp + (unsigned)(16 * sl + i0)) = (f32x2){(float)d[0] * sx, (float)d[1] * sx}; }
        { const LAS unsigned char* ip_ = buf + (bs) * 4096 + 2 * 256 + 32 * sl; const u32x4 e0_ = *(const LAS u32x4*)ip_, e1_ = *(const LAS u32x4*)(ip_ + 16);
            A0 = *(const u32x4*)(TAB + ((e0_[0] & 0xffffu) * 128u + pb));
            A1 = *(const u32x4*)(TAB + ((e0_[0] >> 16) * 128u + pb));
            A2 = *(const u32x4*)(TAB + ((e0_[1] & 0xffffu) * 128u + pb));
            A3 = *(const u32x4*)(TAB + ((e0_[1] >> 16) * 128u + pb));
            A4 = *(const u32x4*)(TAB + ((e0_[2] & 0xffffu) * 128u + pb));
            A5 = *(const u32x4*)(TAB + ((e0_[2] >> 16) * 128u + pb));
            A6 = *(const u32x4*)(TAB + ((e0_[3] & 0xffffu) * 128u + pb));
            A7 = *(const u32x4*)(TAB + ((e0_[3] >> 16) * 128u + pb));
            A8 = *(const u32x4*)(TAB + ((e1_[0] & 0xffffu) * 128u + pb));
            A9 = *(const u32x4*)(TAB + ((e1_[0] >> 16) * 128u + pb));
            A10 = *(const u32x4*)(TAB + ((e1_[1] & 0xffffu) * 128u + pb));
            A11 = *(const u32x4*)(TAB + ((e1_[1] >> 16) * 128u + pb));
            A12 = *(const u32x4*)(TAB + ((e1_[2] & 0xffffu) * 128u + pb));
            A13 = *(const u32x4*)(TAB + ((e1_[2] >> 16) * 128u + pb));
            A14 = *(const u32x4*)(TAB + ((e1_[3] & 0xffffu) * 128u + pb));
            A15 = *(const u32x4*)(TAB + ((e1_[3] >> 16) * 128u + pb));
        }
        { const i32x4 xq = *(const LAS i32x4*)(buf + bs * 4096 + 2048 + 1 * 128 + 16 * pc); const float sx = *(const LAS float*)(buf + bs * 4096 + 3072 + 4 * 1);
            int d[16];
            d[0] = __builtin_amdgcn_sdot4((int)B0[3], xq[3], __builtin_amdgcn_sdot4((int)B0[2], xq[2], __builtin_amdgcn_sdot4((int)B0[1], xq[1], __builtin_amdgcn_sdot4((int)B0[0], xq[0], 0, false), false), false), false);
            d[1] = __builtin_amdgcn_sdot4((int)B1[3], xq[3], __builtin_amdgcn_sdot4((int)B1[2], xq[2], __builtin_amdgcn_sdot4((int)B1[1], xq[1], __builtin_amdgcn_sdot4((int)B1[0], xq[0], 0, false), false), false), false);
            d[2] = __builtin_amdgcn_sdot4((int)B2[3], xq[3], __builtin_amdgcn_sdot4((int)B2[2], xq[2], __builtin_amdgcn_sdot4((int)B2[1], xq[1], __builtin_amdgcn_sdot4((int)B2[0], xq[0], 0, false), false), false), false);
            d[3] = __builtin_amdgcn_sdot4((int)B3[3], xq[3], __builtin_amdgcn_sdot4((int)B3[2], xq[2], __builtin_amdgcn_sdot4((int)B3[1], xq[1], __builtin_amdgcn_sdot4((int)B3[0], xq[0], 0, false), false), false), false);
            d[4] = __builtin_amdgcn_sdot4((int)B4[3], xq[3], __builtin_amdgcn_sdot4((int)B4[2], xq[2], __builtin_amdgcn_sdot4((int)B4[1], xq[1], __builtin_amdgcn_sdot4((int)B4[0], xq[0], 0, false), false), false), false);
            d[5] = __builtin_amdgcn_sdot4((int)B5[3], xq[3], __builtin_amdgcn_sdot4((int)B5[2], xq[2], __builtin_amdgcn_sdot4((int)B5[1], xq[1], __builtin_amdgcn_sdot4((int)B5[0], xq[0], 0, false), false), false), false);
            d[6] = __builtin_amdgcn_sdot4((int)B6[3], xq[3], __builtin_amdgcn_sdot4((int)B6[2], xq[2], __builtin_amdgcn_sdot4((int)B6[1], xq[1], __builtin_amdgcn_sdot4((int)B6[0], xq[0], 0, false), false), false), false);
            d[7] = __builtin_amdgcn_sdot4((int)B7[3], xq[3], __builtin_amdgcn_sdot4((int)B7[2], xq[2], __builtin_amdgcn_sdot4((int)B7[1], xq[1], __builtin_amdgcn_sdot4((int)B7[0], xq[0], 0, false), false), false), false);
            d[8] = __builtin_amdgcn_sdot4((int)B8[3], xq[3], __builtin_amdgcn_sdot4((int)B8[2], xq[2], __builtin_amdgcn_sdot4((int)B8[1], xq[1], __builtin_amdgcn_sdot4((int)B8[0], xq[0], 0, false), false), false), false);
            d[9] = __builtin_amdgcn_sdot4((int)B9[3], xq[3], __builtin_amdgcn_sdot4((int)B9[2], xq[2], __builtin_amdgcn_sdot4((int)B9[1], xq[1], __builtin_amdgcn_sdot4((int)B9[0], xq[0], 0, false), false), false), false);
            d[10] = __builtin_amdgcn_sdot4((int)B10[3], xq[3], __builtin_amdgcn_sdot4((int)B10[2], xq[2], __builtin_amdgcn_sdot4((int)B10[1], xq[1], __builtin_amdgcn_sdot4((int)B10[0], xq[0], 0, false), false), false), false);
            d[11] = __builtin_amdgcn_sdot4((int)B11[3], xq[3], __builtin_amdgcn_sdot4((int)B11[2], xq[2], __builtin_amdgcn_sdot4((int)B11[1], xq[1], __builtin_amdgcn_sdot4((int)B11[0], xq[0], 0, false), false), false), false);
            d[12] = __builtin_amdgcn_sdot4((int)B12[3], xq[3], __builtin_amdgcn_sdot4((int)B12[2], xq[2], __builtin_amdgcn_sdot4((int)B12[1], xq[1], __builtin_amdgcn_sdot4((int)B12[0], xq[0], 0, false), false), false), false);
            d[13] = __builtin_amdgcn_sdot4((int)B13[3], xq[3], __builtin_amdgcn_sdot4((int)B13[2], xq[2], __builtin_amdgcn_sdot4((int)B13[1], xq[1], __builtin_amdgcn_sdot4((int)B13[0], xq[0], 0, false), false), false), false);
            d[14] = __builtin_amdgcn_sdot4((int)B14[3], xq[3], __builtin_amdgcn_sdot4((int)B14[2], xq[2], __builtin_amdgcn_sdot4((int)B14[1], xq[1], __builtin_amdgcn_sdot4((int)B14[0], xq[0], 0, false), false), false), false);
            d[15] = __builtin_amdgcn_sdot4((int)B15[3], xq[3], __builtin_amdgcn_sdot4((int)B15[2], xq[2], __builtin_amdgcn_sdot4((int)B15[1], xq[1], __builtin_amdgcn_sdot4((int)B15[0], xq[0], 0, false), false), false), false);
            _Pragma("unroll") for (int st = 0; st < 3; ++st) { const int M = 1 << st, nn = 8 >> st; const int hm = (la & M) ? -1 : 0;
                _Pragma("unroll") for (int i = 0; i < 8; ++i) if (i < nn) { const int keep = (d[nn + i] & hm) | (d[i] & ~hm), send = (d[i] & hm) | (d[nn + i] & ~hm);
                    d[i] = keep + ((st == 0) ? DPP_I(send, 0xB1) : (st == 1) ? DPP_I(send, 0x4E) : __builtin_amdgcn_ds_swizzle(send, (4 << 10) | 0x1f)); } }
            float* pp = (float*)(P.ws + WS_PART) + ((size_t)j * T + (unsigned)(T0 + 8 * b + 1)) * 128;
            *(f32x2*)(pp + (unsigned)(16 * sl + i0)) = (f32x2){(float)d[0] * sx, (float)d[1] * sx}; }
        U3_PARK(b + 1);
        { const LAS unsigned char* ip_ = buf + (bs) * 4096 + 3 * 256 + 32 * sl; const u32x4 e0_ = *(const LAS u32x4*)ip_, e1_ = *(const LAS u32x4*)(ip_ + 16);
            B0 = *(const u32x4*)(TAB + ((e0_[0] & 0xffffu) * 128u + pb));
            B1 = *(const u32x4*)(TAB + ((e0_[0] >> 16) * 128u + pb));
            B2 = *(const u32x4*)(TAB + ((e0_[1] & 0xffffu) * 128u + pb));
            B3 = *(const u32x4*)(TAB + ((e0_[1] >> 16) * 128u + pb));
            B4 = *(const u32x4*)(TAB + ((e0_[2] & 0xffffu) * 128u + pb));
            B5 = *(const u32x4*)(TAB + ((e0_[2] >> 16) * 128u + pb));
            B6 = *(const u32x4*)(TAB + ((e0_[3] & 0xffffu) * 128u + pb));
            B7 = *(const u32x4*)(TAB + ((e0_[3] >> 16) * 128u + pb));
            B8 = *(const u32x4*)(TAB + ((e1_[0] & 0xffffu) * 128u + pb));
            B9 = *(const u32x4*)(TAB + ((e1_[0] >> 16) * 128u + pb));
            B10 = *(const u32x4*)(TAB + ((e1_[1] & 0xffffu) * 128u + pb));
            B11 = *(const u32x4*)(TAB + ((e1_[1] >> 16) * 128u + pb));
            B12 = *(const u32x4*)(TAB + ((e1_[2] & 0xffffu) * 128u + pb));
            B13 = *(const u32x4*)(TAB + ((e1_[2] >> 16) * 128u + pb));
            B14 = *(const u32x4*)(TAB + ((e1_[3] & 0xffffu) * 128u + pb));
            B15 = *(const u32x4*)(TAB + ((e1_[3] >> 16) * 128u + pb));
        }
        { const i32x4 xq = *(const LAS i32x4*)(buf + bs * 4096 + 2048 + 2 * 128 + 16 * pc); const float sx = *(const LAS float*)(buf + bs * 4096 + 3072 + 4 * 2);
            int d[16];
            d[0] = __builtin_amdgcn_sdot4((int)A0[3], xq[3], __builtin_amdgcn_sdot4((int)A0[2], xq[2], __builtin_amdgcn_sdot4((int)A0[1], xq[1], __builtin_amdgcn_sdot4((int)A0[0], xq[0], 0, false), false), false), false);
            d[1] = __builtin_amdgcn_sdot4((int)A1[3], xq[3], __builtin_amdgcn_sdot4((int)A1[2], xq[2], __builtin_amdgcn_sdot4((int)A1[1], xq[1], __builtin_amdgcn_sdot4((int)A1[0], xq[0], 0, false), false), false), false);
            d[2] = __builtin_amdgcn_sdot4((int)A2[3], xq[3], __builtin_amdgcn_sdot4((int)A2[2], xq[2], __builtin_amdgcn_sdot4((int)A2[1], xq[1], __builtin_amdgcn_sdot4((int)A2[0], xq[0], 0, false), false), false), false);
            d[3] = __builtin_amdgcn_sdot4((int)A3[3], xq[3], __builtin_amdgcn_sdot4((int)A3[2], xq[2], __builtin_amdgcn_sdot4((int)A3[1], xq[1], __builtin_amdgcn_sdot4((int)A3[0], xq[0], 0, false), false), false), false);
            d[4] = __builtin_amdgcn_sdot4((int)A4[3], xq[3], __builtin_amdgcn_sdot4((int)A4[2], xq[2], __builtin_amdgcn_sdot4((int)A4[1], xq[1], __builtin_amdgcn_sdot4((int)A4[0], xq[0], 0, false), false), false), false);
            d[5] = __builtin_amdgcn_sdot4((int)A5[3], xq[3], __builtin_amdgcn_sdot4((int)A5[2], xq[2], __builtin_amdgcn_sdot4((int)A5[1], xq[1], __builtin_amdgcn_sdot4((int)A5[0], xq[0], 0, false), false), false), false);
            d[6] = __builtin_amdgcn_sdot4((int)A6[3], xq[3], __builtin_amdgcn_sdot4((int)A6[2], xq[2], __builtin_amdgcn_sdot4((int)A6[1], xq[1], __builtin_amdgcn_sdot4((int)A6[0], xq[0], 0, false), false), false), false);
            d[7] = __builtin_amdgcn_sdot4((int)A7[3], xq[3], __builtin_amdgcn_sdot4((int)A7[2], xq[2], __builtin_amdgcn_sdot4((int)A7[1], xq[1], __builtin_amdgcn_sdot4((int)A7[0], xq[0], 0, false), false), false), false);
            d[8] = __builtin_amdgcn_sdot4((int)A8[3], xq[3], __builtin_amdgcn_sdot4((int)A8[2], xq[2], __builtin_amdgcn_sdot4((int)A8[1], xq[1], __builtin_amdgcn_sdot4((int)A8[0], xq[0], 0, false), false), false), false);
            d[9] = __builtin_amdgcn_sdot4((int)A9[3], xq[3], __builtin_amdgcn_sdot4((int)A9[2], xq[2], __builtin_amdgcn_sdot4((int)A9[1], xq[1], __builtin_amdgcn_sdot4((int)A9[0], xq[0], 0, false), false), false), false);
            d[10] = __builtin_amdgcn_sdot4((int)A10[3], xq[3], __builtin_amdgcn_sdot4((int)A10[2], xq[2], __builtin_amdgcn_sdot4((int)A10[1], xq[1], __builtin_amdgcn_sdot4((int)A10[0], xq[0], 0, false), false), false), false);
            d[11] = __builtin_amdgcn_sdot4((int)A11[3], xq[3], __builtin_amdgcn_sdot4((int)A11[2], xq[2], __builtin_amdgcn_sdot4((int)A11[1], xq[1], __builtin_amdgcn_sdot4((int)A11[0], xq[0], 0, false), false), false), false);
            d[12] = __builtin_amdgcn_sdot4((int)A12[3], xq[3], __builtin_amdgcn_sdot4((int)A12[2], xq[2], __builtin_amdgcn_sdot4((int)A12[1], xq[1], __builtin_amdgcn_sdot4((int)A12[0], xq[0], 0, false), false), false), false);
            d[13] = __builtin_amdgcn_sdot4((int)A13[3], xq[3], __builtin_amdgcn_sdot4((int)A13[2], xq[2], __builtin_amdgcn_sdot4((int)A13[1], xq[1], __builtin_amdgcn_sdot4((int)A13[0], xq[0], 0, false), false), false), false);
            d[14] = __builtin_amdgcn_sdot4((int)A14[3], xq[3], __builtin_amdgcn_sdot4((int)A14[2], xq[2], __builtin_amdgcn_sdot4((int)A14[1], xq[1], __builtin_amdgcn_sdot4((int)A14[0], xq[0], 0, false), false), false), false);
            d[15] = __builtin_amdgcn_sdot4((int)A15[3], xq[3], __builtin_amdgcn_sdot4((int)A15[2], xq[2], __builtin_amdgcn_sdot4((int)A15[1], xq[1], __builtin_amdgcn_sdot4((int)A15[0], xq[0], 0, false), false), false), false);
            _Pragma("unroll") for (int st = 0; st < 3; ++st) { const int M = 1 << st, nn = 8 >> st; const int hm = (la & M) ? -1 : 0;
                _Pragma("unroll") for (int i = 0; i < 8; ++i) if (i < nn) { const int keep = (d[nn + i] & hm) | (d[i] & ~hm), send = (d[i] & hm) | (d[nn + i] & ~hm);
                    d[i] = keep + ((st == 0) ? DPP_I(send, 0xB1) : (st == 1) ? DPP_I(send, 0x4E) : __builtin_amdgcn_ds_swizzle(send, (4 << 10) | 0x1f)); } }
            float* pp = (float*)(P.ws + WS_PART) + ((size_t)j * T + (unsigned)(T0 + 8 * b + 2)) * 128;
            *(f32x2*)(pp + (unsigned)(16 * sl + i0)) = (f32x2){(float)d[0] * sx, (float)d[1] * sx}; }
        { const LAS unsigned char* ip_ = buf + (bs) * 4096 + 4 * 256 + 32 * sl; const u32x4 e0_ = *(const LAS u32x4*)ip_, e1_ = *(const LAS u32x4*)(ip_ + 16);
            A0 = *(const u32x4*)(TAB + ((e0_[0] & 0xffffu) * 128u + pb));
            A1 = *(const u32x4*)(TAB + ((e0_[0] >> 16) * 128u + pb));
            A2 = *(const u32x4*)(TAB + ((e0_[1] & 0xffffu) * 128u + pb));
            A3 = *(const u32x4*)(TAB + ((e0_[1] >> 16) * 128u + pb));
            A4 = *(const u32x4*)(TAB + ((e0_[2] & 0xffffu) * 128u + pb));
            A5 = *(const u32x4*)(TAB + ((e0_[2] >> 16) * 128u + pb));
            A6 = *(const u32x4*)(TAB + ((e0_[3] & 0xffffu) * 128u + pb));
            A7 = *(const u32x4*)(TAB + ((e0_[3] >> 16) * 128u + pb));
            A8 = *(const u32x4*)(TAB + ((e1_[0] & 0xffffu) * 128u + pb));
            A9 = *(const u32x4*)(TAB + ((e1_[0] >> 16) * 128u + pb));
            A10 = *(const u32x4*)(TAB + ((e1_[1] & 0xffffu) * 128u + pb));
            A11 = *(const u32x4*)(TAB + ((e1_[1] >> 16) * 128u + pb));
            A12 = *(const u32x4*)(TAB + ((e1_[2] & 0xffffu) * 128u + pb));
            A13 = *(const u32x4*)(TAB + ((e1_[2] >> 16) * 128u + pb));
            A14 = *(const u32x4*)(TAB + ((e1_[3] & 0xffffu) * 128u + pb));
            A15 = *(const u32x4*)(TAB + ((e1_[3] >> 16) * 128u + pb));
        }
        { const i32x4 xq = *(const LAS i32x4*)(buf + bs * 4096 + 2048 + 3 * 128 + 16 * pc); const float sx = *(const LAS float*)(buf + bs * 4096 + 3072 + 4 * 3);
            int d[16];
            d[0] = __builtin_amdgcn_sdot4((int)B0[3], xq[3], __builtin_amdgcn_sdot4((int)B0[2], xq[2], __builtin_amdgcn_sdot4((int)B0[1], xq[1], __builtin_amdgcn_sdot4((int)B0[0], xq[0], 0, false), false), false), false);
            d[1] = __builtin_amdgcn_sdot4((int)B1[3], xq[3], __builtin_amdgcn_sdot4((int)B1[2], xq[2], __builtin_amdgcn_sdot4((int)B1[1], xq[1], __builtin_amdgcn_sdot4((int)B1[0], xq[0], 0, false), false), false), false);
            d[2] = __builtin_amdgcn_sdot4((int)B2[3], xq[3], __builtin_amdgcn_sdot4((int)B2[2], xq[2], __builtin_amdgcn_sdot4((int)B2[1], xq[1], __builtin_amdgcn_sdot4((int)B2[0], xq[0], 0, false), false), false), false);
            d[3] = __builtin_amdgcn_sdot4((int)B3[3], xq[3], __builtin_amdgcn_sdot4((int)B3[2], xq[2], __builtin_amdgcn_sdot4((int)B3[1], xq[1], __builtin_amdgcn_sdot4((int)B3[0], xq[0], 0, false), false), false), false);
            d[4] = __builtin_amdgcn_sdot4((int)B4[3], xq[3], __builtin_amdgcn_sdot4((int)B4[2], xq[2], __builtin_amdgcn_sdot4((int)B4[1], xq[1], __builtin_amdgcn_sdot4((int)B4[0], xq[0], 0, false), false), false), false);
            d[5] = __builtin_amdgcn_sdot4((int)B5[3], xq[3], __builtin_amdgcn_sdot4((int)B5[2], xq[2], __builtin_amdgcn_sdot4((int)B5[1], xq[1], __builtin_amdgcn_sdot4((int)B5[0], xq[0], 0, false), false), false), false);
            d[6] = __builtin_amdgcn_sdot4((int)B6[3], xq[3], __builtin_amdgcn_sdot4((int)B6[2], xq[2], __builtin_amdgcn_sdot4((int)B6[1], xq[1], __builtin_amdgcn_sdot4((int)B6[0], xq[0], 0, false), false), false), false);
            d[7] = __builtin_amdgcn_sdot4((int)B7[3], xq[3], __builtin_amdgcn_sdot4((int)B7[2], xq[2], __builtin_amdgcn_sdot4((int)B7[1], xq[1], __builtin_amdgcn_sdot4((int)B7[0], xq[0], 0, false), false), false), false);
            d[8] = __builtin_amdgcn_sdot4((int)B8[3], xq[3], __builtin_amdgcn_sdot4((int)B8[2], xq[2], __builtin_amdgcn_sdot4((int)B8[1], xq[1], __builtin_amdgcn_sdot4((int)B8[0], xq[0], 0, false), false), false), false);
            d[9] = __builtin_amdgcn_sdot4((int)B9[3], xq[3], __builtin_amdgcn_sdot4((int)B9[2], xq[2], __builtin_amdgcn_sdot4((int)B9[1], xq[1], __builtin_amdgcn_sdot4((int)B9[0], xq[0], 0, false), false), false), false);
            d[10] = __builtin_amdgcn_sdot4((int)B10[3], xq[3], __builtin_amdgcn_sdot4((int)B10[2], xq[2], __builtin_amdgcn_sdot4((int)B10[1], xq[1], __builtin_amdgcn_sdot4((int)B10[0], xq[0], 0, false), false), false), false);
            d[11] = __builtin_amdgcn_sdot4((int)B11[3], xq[3], __builtin_amdgcn_sdot4((int)B11[2], xq[2], __builtin_amdgcn_sdot4((int)B11[1], xq[1], __builtin_amdgcn_sdot4((int)B11[0], xq[0], 0, false), false), false), false);
            d[12] = __builtin_amdgcn_sdot4((int)B12[3], xq[3], __builtin_amdgcn_sdot4((int)B12[2], xq[2], __builtin_amdgcn_sdot4((int)B12[1], xq[1], __builtin_amdgcn_sdot4((int)B12[0], xq[0], 0, false), false), false), false);
            d[13] = __builtin_amdgcn_sdot4((int)B13[3], xq[3], __builtin_amdgcn_sdot4((int)B13[2], xq[2], __builtin_amdgcn_sdot4((int)B13[1], xq[1], __builtin_amdgcn_sdot4((int)B13[0], xq[0], 0, false), false), false), false);
            d[14] = __builtin_amdgcn_sdot4((int)B14[3], xq[3], __builtin_amdgcn_sdot4((int)B14[2], xq[2], __builtin_amdgcn_sdot4((int)B14[1], xq[1], __builtin_amdgcn_sdot4((int)B14[0], xq[0], 0, false), false), false), false);
            d[15] = __builtin_amdgcn_sdot4((int)B15[3], xq[3], __builtin_amdgcn_sdot4((int)B15[2], xq[2], __builtin_amdgcn_sdot4((int)B15[1], xq[1], __builtin_amdgcn_sdot4((int)B15[0], xq[0], 0, false), false), false), false);
            _Pragma("unroll") for (int st = 0; st < 3; ++st) { const int M = 1 << st, nn = 8 >> st; const int hm = (la & M) ? -1 : 0;
                _Pragma("unroll") for (int i = 0; i < 8; ++i) if (i < nn) { const int keep = (d[nn + i] & hm) | (d[i] & ~hm), send = (d[i] & hm) | (d[nn + i] & ~hm);
                    d[i] = keep + ((st == 0) ? DPP_I(send, 0xB1) : (st == 1) ? DPP_I(send, 0x4E) : __builtin_amdgcn_ds_swizzle(send, (4 << 10) | 0x1f)); } }
            float* pp = (float*)(P.ws + WS_PART) + ((size_t)j * T + (unsigned)(T0 + 8 * b + 3)) * 128;
            *(f32x2*)(pp + (unsigned)(16 * sl + i0)) = (f32x2){(float)d[0] * sx, (float)d[1] * sx}; }
        { const LAS unsigned char* ip_ = buf + (bs) * 4096 + 5 * 256 + 32 * sl; const u32x4 e0_ = *(const LAS u32x4*)ip_, e1_ = *(const LAS u32x4*)(ip_ + 16);
            B0 = *(const u32x4*)(TAB + ((e0_[0] & 0xffffu) * 128u + pb));
            B1 = *(const u32x4*)(TAB + ((e0_[0] >> 16) * 128u + pb));
            B2 = *(const u32x4*)(TAB + ((e0_[1] & 0xffffu) * 128u + pb));
            B3 = *(const u32x4*)(TAB + ((e0_[1] >> 16) * 128u + pb));
            B4 = *(const u32x4*)(TAB + ((e0_[2] & 0xffffu) * 128u + pb));
            B5 = *(const u32x4*)(TAB + ((e0_[2] >> 16) * 128u + pb));
            B6 = *(const u32x4*)(TAB + ((e0_[3] & 0xffffu) * 128u + pb));
            B7 = *(const u32x4*)(TAB + ((e0_[3] >> 16) * 128u + pb));
            B8 = *(const u32x4*)(TAB + ((e1_[0] & 0xffffu) * 128u + pb));
            B9 = *(const u32x4*)(TAB + ((e1_[0] >> 16) * 128u + pb));
            B10 = *(const u32x4*)(TAB + ((e1_[1] & 0xffffu) * 128u + pb));
            B11 = *(const u32x4*)(TAB + ((e1_[1] >> 16) * 128u + pb));
            B12 = *(const u32x4*)(TAB + ((e1_[2] & 0xffffu) * 128u + pb));
            B13 = *(const u32x4*)(TAB + ((e1_[2] >> 16) * 128u + pb));
            B14 = *(const u32x4*)(TAB + ((e1_[3] & 0xffffu) * 128u + pb));
            B15 = *(const u32x4*)(TAB + ((e1_[3] >> 16) * 128u + pb));
        }
        { const i32x4 xq = *(const LAS i32x4*)(buf + bs * 4096 + 2048 + 4 * 128 + 16 * pc); const float sx = *(const LAS float*)(buf + bs * 4096 + 3072 + 4 * 4);
            int d[16];
            d[0] = __builtin_amdgcn_sdot4((int)A0[3], xq[3], __builtin_amdgcn_sdot4((int)A0[2], xq[2], __builtin_amdgcn_sdot4((int)A0[1], xq[1], __builtin_amdgcn_sdot4((int)A0[0], xq[0], 0, false), false), false), false);
            d[1] = __builtin_amdgcn_sdot4((int)A1[3], xq[3], __builtin_amdgcn_sdot4((int)A1[2], xq[2], __builtin_amdgcn_sdot4((int)A1[1], xq[1], __builtin_amdgcn_sdot4((int)A1[0], xq[0], 0, false), false), false), false);
            d[2] = __builtin_amdgcn_sdot4((int)A2[3], xq[3], __builtin_amdgcn_sdot4((int)A2[2], xq[2], __builtin_amdgcn_sdot4((int)A2[1], xq[1], __builtin_amdgcn_sdot4((int)A2[0], xq[0], 0, false), false), false), false);
            d[3] = __builtin_amdgcn_sdot4((int)A3[3], xq[3], __builtin_amdgcn_sdot4((int)A3[2], xq[2], __builtin_amdgcn_sdot4((int)A3[1], xq[1], __builtin_amdgcn_sdot4((int)A3[0], xq[0], 0, false), false), false), false);
            d[4] = __builtin_amdgcn_sdot4((int)A4[3], xq[3], __builtin_amdgcn_sdot4((int)A4[2], xq[2], __builtin_amdgcn_sdot4((int)A4[1], xq[1], __builtin_amdgcn_sdot4((int)A4[0], xq[0], 0, false), false), false), false);
            d[5] = __builtin_amdgcn_sdot4((int)A5[3], xq[3], __builtin_amdgcn_sdot4((int)A5[2], xq[2], __builtin_amdgcn_sdot4((int)A5[1], xq[1], __builtin_amdgcn_sdot4((int)A5[0], xq[0], 0, false), false), false), false);
            d[6] = __builtin_amdgcn_sdot4((int)A6[3], xq[3], __builtin_amdgcn_sdot4((int)A6[2], xq[2], __builtin_amdgcn_sdot4((int)A6[1], xq[1], __builtin_amdgcn_sdot4((int)A6[0], xq[0], 0, false), false), false), false);
            d[7] = __builtin_amdgcn_sdot4((int)A7[3], xq[3], __builtin_amdgcn_sdot4((int)A7[2], xq[2], __builtin_amdgcn_sdot4((int)A7[1], xq[1], __builtin_amdgcn_sdot4((int)A7[0], xq[0], 0, false), false), false), false);
            d[8] = __builtin_amdgcn_sdot4((int)A8[3], xq[3], __builtin_amdgcn_sdot4((int)A8[2], xq[2], __builtin_amdgcn_sdot4((int)A8[1], xq[1], __builtin_amdgcn_sdot4((int)A8[0], xq[0], 0, false), false), false), false);
            d[9] = __builtin_amdgcn_sdot4((int)A9[3], xq[3], __builtin_amdgcn_sdot4((int)A9[2], xq[2], __builtin_amdgcn_sdot4((int)A9[1], xq[1], __builtin_amdgcn_sdot4((int)A9[0], xq[0], 0, false), false), false), false);
            d[10] = __builtin_amdgcn_sdot4((int)A10[3], xq[3], __builtin_amdgcn_sdot4((int)A10[2], xq[2], __builtin_amdgcn_sdot4((int)A10[1], xq[1], __builtin_amdgcn_sdot4((int)A10[0], xq[0], 0, false), false), false), false);
            d[11] = __builtin_amdgcn_sdot4((int)A11[3], xq[3], __builtin_amdgcn_sdot4((int)A11[2], xq[2], __builtin_amdgcn_sdot4((int)A11[1], xq[1], __builtin_amdgcn_sdot4((int)A11[0], xq[0], 0, false), false), false), false);
            d[12] = __builtin_amdgcn_sdot4((int)A12[3], xq[3], __builtin_amdgcn_sdot4((int)A12[2], xq[2], __builtin_amdgcn_sdot4((int)A12[1], xq[1], __builtin_amdgcn_sdot4((int)A12[0], xq[0], 0, false), false), false), false);
            d[13] = __builtin_amdgcn_sdot4((int)A13[3], xq[3], __builtin_amdgcn_sdot4((int)A13[2], xq[2], __builtin_amdgcn_sdot4((int)A13[1], xq[1], __builtin_amdgcn_sdot4((int)A13[0], xq[0], 0, false), false), false), false);
            d[14] = __builtin_amdgcn_sdot4((int)A14[3], xq[3], __builtin_amdgcn_sdot4((int)A14[2], xq[2], __builtin_amdgcn_sdot4((int)A14[1], xq[1], __builtin_amdgcn_sdot4((int)A14[0], xq[0], 0, false), false), false), false);
            d[15] = __builtin_amdgcn_sdot4((int)A15[3], xq[3], __builtin_amdgcn_sdot4((int)A15[2], xq[2], __builtin_amdgcn_sdot4((int)A15[1], xq[1], __builtin_amdgcn_sdot4((int)A15[0], xq[0], 0, false), false), false), false);
            _Pragma("unroll") for (int st = 0; st < 3; ++st) { const int M = 1 << st, nn = 8 >> st; const int hm = (la & M) ? -1 : 0;
                _Pragma("unroll") for (int i = 0; i < 8; ++i) if (i < nn) { const int keep = (d[nn + i] & hm) | (d[i] & ~hm), send = (d[i] & hm) | (d[nn + i] & ~hm);
                    d[i] = keep + ((st == 0) ? DPP_I(send, 0xB1) : (st == 1) ? DPP_I(send, 0x4E) : __builtin_amdgcn_ds_swizzle(send, (4 << 10) | 0x1f)); } }
            float* pp = (float*)(P.ws + WS_PART) + ((size_t)j * T + (unsigned)(T0 + 8 * b + 4)) * 128;
            *(f32x2*)(pp + (unsigned)(16 * sl + i0)) = (f32x2){(float)d[0] * sx, (float)d[1] * sx}; }
        { const LAS unsigned char* ip_ = buf + (bs) * 4096 + 6 * 256 + 32 * sl; const u32x4 e0_ = *(const LAS u32x4*)ip_, e1_ = *(const LAS u32x4*)(ip_ + 16);
            A0 = *(const u32x4*)(TAB + ((e0_[0] & 0xffffu) * 128u + pb));
            A1 = *(const u32x4*)(TAB + ((e0_[0] >> 16) * 128u + pb));
            A2 = *(const u32x4*)(TAB + ((e0_[1] & 0xffffu) * 128u + pb));
            A3 = *(const u32x4*)(TAB + ((e0_[1] >> 16) * 128u + pb));
            A4 = *(const u32x4*)(TAB + ((e0_[2] & 0xffffu) * 128u + pb));
            A5 = *(const u32x4*)(TAB + ((e0_[2] >> 16) * 128u + pb));
            A6 = *(const u32x4*)(TAB + ((e0_[3] & 0xffffu) * 128u + pb));
            A7 = *(const u32x4*)(TAB + ((e0_[3] >> 16) * 128u + pb));
            A8 = *(const u32x4*)(TAB + ((e1_[0] & 0xffffu) * 128u + pb));
            A9 = *(const u32x4*)(TAB + ((e1_[0] >> 16) * 128u + pb));
            A10 = *(const u32x4*)(TAB + ((e1_[1] & 0xffffu) * 128u + pb));
            A11 = *(const u32x4*)(TAB + ((e1_[1] >> 16) * 128u + pb));
            A12 = *(const u32x4*)(TAB + ((e1_[2] & 0xffffu) * 128u + pb));
            A13 = *(const u32x4*)(TAB + ((e1_[2] >> 16) * 128u + pb));
            A14 = *(const u32x4*)(TAB + ((e1_[3] & 0xffffu) * 128u + pb));
            A15 = *(const u32x4*)(TAB + ((e1_[3] >> 16) * 128u + pb));
        }
        { const i32x4 xq = *(const LAS i32x4*)(buf + bs * 4096 + 2048 + 5 * 128 + 16 * pc); const float sx = *(const LAS float*)(buf + bs * 4096 + 3072 + 4 * 5);
            int d[16];
            d[0] = __builtin_amdgcn_sdot4((int)B0[3], xq[3], __builtin_amdgcn_sdot4((int)B0[2], xq[2], __builtin_amdgcn_sdot4((int)B0[1], xq[1], __builtin_amdgcn_sdot4((int)B0[0], xq[0], 0, false), false), false), false);
            d[1] = __builtin_amdgcn_sdot4((int)B1[3], xq[3], __builtin_amdgcn_sdot4((int)B1[2], xq[2], __builtin_amdgcn_sdot4((int)B1[1], xq[1], __builtin_amdgcn_sdot4((int)B1[0], xq[0], 0, false), false), false), false);
            d[2] = __builtin_amdgcn_sdot4((int)B2[3], xq[3], __builtin_amdgcn_sdot4((int)B2[2], xq[2], __builtin_amdgcn_sdot4((int)B2[1], xq[1], __builtin_amdgcn_sdot4((int)B2[0], xq[0], 0, false), false), false), false);
            d[3] = __builtin_amdgcn_sdot4((int)B3[3], xq[3], __builtin_amdgcn_sdot4((int)B3[2], xq[2], __builtin_amdgcn_sdot4((int)B3[1], xq[1], __builtin_amdgcn_sdot4((int)B3[0], xq[0], 0, false), false), false), false);
            d[4] = __builtin_amdgcn_sdot4((int)B4[3], xq[3], __builtin_amdgcn_sdot4((int)B4[2], xq[2], __builtin_amdgcn_sdot4((int)B4[1], xq[1], __builtin_amdgcn_sdot4((int)B4[0], xq[0], 0, false), false), false), false);
            d[5] = __builtin_amdgcn_sdot4((int)B5[3], xq[3], __builtin_amdgcn_sdot4((int)B5[2], xq[2], __builtin_amdgcn_sdot4((int)B5[1], xq[1], __builtin_amdgcn_sdot4((int)B5[0], xq[0], 0, false), false), false), false);
            d[6] = __builtin_amdgcn_sdot4((int)B6[3], xq[3], __builtin_amdgcn_sdot4((int)B6[2], xq[2], __builtin_amdgcn_sdot4((int)B6[1], xq[1], __builtin_amdgcn_sdot4((int)B6[0], xq[0], 0, false), false), false), false);
            d[7] = __builtin_amdgcn_sdot4((int)B7[3], xq[3], __builtin_amdgcn_sdot4((int)B7[2], xq[2], __builtin_amdgcn_sdot4((int)B7[1], xq[1], __builtin_amdgcn_sdot4((int)B7[0], xq[0], 0, false), false), false), false);
            d[8] = __builtin_amdgcn_sdot4((int)B8[3], xq[3], __builtin_amdgcn_sdot4((int)B8[2], xq[2], __builtin_amdgcn_sdot4((int)B8[1], xq[1], __builtin_amdgcn_sdot4((int)B8[0], xq[0], 0, false), false), false), false);
            d[9] = __builtin_amdgcn_sdot4((int)B9[3], xq[3], __builtin_amdgcn_sdot4((int)B9[2], xq[2], __builtin_amdgcn_sdot4((int)B9[1], xq[1], __builtin_amdgcn_sdot4((int)B9[0], xq[0], 0, false), false), false), false);
            d[10] = __builtin_amdgcn_sdot4((int)B10[3], xq[3], __builtin_amdgcn_sdot4((int)B10[2], xq[2], __builtin_amdgcn_sdot4((int)B10[1], xq[1], __builtin_amdgcn_sdot4((int)B10[0], xq[0], 0, false), false), false), false);
            d[11] = __builtin_amdgcn_sdot4((int)B11[3], xq[3], __builtin_amdgcn_sdot4((int)B11[2], xq[2], __builtin_amdgcn_sdot4((int)B11[1], xq[1], __builtin_amdgcn_sdot4((int)B11[0], xq[0], 0, false), false), false), false);
            d[12] = __builtin_amdgcn_sdot4((int)B12[3], xq[3], __builtin_amdgcn_sdot4((int)B12[2], xq[2], __builtin_amdgcn_sdot4((int)B12[1], xq[1], __builtin_amdgcn_sdot4((int)B12[0], xq[0], 0, false), false), false), false);
            d[13] = __builtin_amdgcn_sdot4((int)B13[3], xq[3], __builtin_amdgcn_sdot4((int)B13[2], xq[2], __builtin_amdgcn_sdot4((int)B13[1], xq[1], __builtin_amdgcn_sdot4((int)B13[0], xq[0], 0, false), false), false), false);
            d[14] = __builtin_amdgcn_sdot4((int)B14[3], xq[3], __builtin_amdgcn_sdot4((int)B14[2], xq[2], __builtin_amdgcn_sdot4((int)B14[1], xq[1], __builtin_amdgcn_sdot4((int)B14[0], xq[0], 0, false), false), false), false);
            d[15] = __builtin_amdgcn_sdot4((int)B15[3], xq[3], __builtin_amdgcn_sdot4((int)B15[2], xq[2], __builtin_amdgcn_sdot4((int)B15[1], xq[1], __builtin_amdgcn_sdot4((int)B15[0], xq[0], 0, false), false), false), false);
            _Pragma("unroll") for (int st = 0; st < 3; ++st) { const int M = 1 << st, nn = 8 >> st; const int hm = (la & M) ? -1 : 0;
                _Pragma("unroll") for (int i = 0; i < 8; ++i) if (i < nn) { const int keep = (d[nn + i] & hm) | (d[i] & ~hm), send = (d[i] & hm) | (d[nn + i] & ~hm);
                    d[i] = keep + ((st == 0) ? DPP_I(send, 0xB1) : (st == 1) ? DPP_I(send, 0x4E) : __builtin_amdgcn_ds_swizzle(send, (4 << 10) | 0x1f)); } }
            float* pp = (float*)(P.ws + WS_PART) + ((size_t)j * T + (unsigned)(T0 + 8 * b + 5)) * 128;
            *(f32x2*)(pp + (unsigned)(16 * sl + i0)) = (f32x2){(float)d[0] * sx, (float)d[1] * sx}; }
        { const LAS unsigned char* ip_ = buf + (bs) * 4096 + 7 * 256 + 32 * sl; const u32x4 e0_ = *(const LAS u32x4*)ip_, e1_ = *(const LAS u32x4*)(ip_ + 16);
            B0 = *(const u32x4*)(TAB + ((e0_[0] & 0xffffu) * 128u + pb));
            B1 = *(const u32x4*)(TAB + ((e0_[0] >> 16) * 128u + pb));
            B2 = *(const u32x4*)(TAB + ((e0_[1] & 0xffffu) * 128u + pb));
            B3 = *(const u32x4*)(TAB + ((e0_[1] >> 16) * 128u + pb));
            B4 = *(const u32x4*)(TAB + ((e0_[2] & 0xffffu) * 128u + pb));
            B5 = *(const u32x4*)(TAB + ((e0_[2] >> 16) * 128u + pb));
            B6 = *(const u32x4*)(TAB + ((e0_[3] & 0xffffu) * 128u + pb));
            B7 = *(const u32x4*)(TAB + ((e0_[3] >> 16) * 128u + pb));
            B8 = *(const u32x4*)(TAB + ((e1_[0] & 0xffffu) * 128u + pb));
            B9 = *(const u32x4*)(TAB + ((e1_[0] >> 16) * 128u + pb));
            B10 = *(const u32x4*)(TAB + ((e1_[1] & 0xffffu) * 128u + pb));
            B11 = *(const u32x4*)(TAB + ((e1_[1] >> 16) * 128u + pb));
            B12 = *(const u32x4*)(TAB + ((e1_[2] & 0xffffu) * 128u + pb));
            B13 = *(const u32x4*)(TAB + ((e1_[2] >> 16) * 128u + pb));
            B14 = *(const u32x4*)(TAB + ((e1_[3] & 0xffffu) * 128u + pb));
            B15 = *(const u32x4*)(TAB + ((e1_[3] >> 16) * 128u + pb));
        }
        { const i32x4 xq = *(const LAS i32x4*)(buf + bs * 4096 + 2048 + 6 * 128 + 16 * pc); const float sx = *(const LAS float*)(buf + bs * 4096 + 3072 + 4 * 6);
            int d[16];
            d[0] = __builtin_amdgcn_sdot4((int)A0[3], xq[3], __builtin_amdgcn_sdot4((int)A0[2], xq[2], __builtin_amdgcn_sdot4((int)A0[1], xq[1], __builtin_amdgcn_sdot4((int)A0[0], xq[0], 0, false), false), false), false);
            d[1] = __builtin_amdgcn_sdot4((int)A1[3], xq[3], __builtin_amdgcn_sdot4((int)A1[2], xq[2], __builtin_amdgcn_sdot4((int)A1[1], xq[1], __builtin_amdgcn_sdot4((int)A1[0], xq[0], 0, false), false), false), false);
            d[2] = __builtin_amdgcn_sdot4((int)A2[3], xq[3], __builtin_amdgcn_sdot4((int)A2[2], xq[2], __builtin_amdgcn_sdot4((int)A2[1], xq[1], __builtin_amdgcn_sdot4((int)A2[0], xq[0], 0, false), false), false), false);
            d[3] = __builtin_amdgcn_sdot4((int)A3[3], xq[3], __builtin_amdgcn_sdot4((int)A3[2], xq[2], __builtin_amdgcn_sdot4((int)A3[1], xq[1], __builtin_amdgcn_sdot4((int)A3[0], xq[0], 0, false), false), false), false);
            d[4] = __builtin_amdgcn_sdot4((int)A4[3], xq[3], __builtin_amdgcn_sdot4((int)A4[2], xq[2], __builtin_amdgcn_sdot4((int)A4[1], xq[1], __builtin_amdgcn_sdot4((int)A4[0], xq[0], 0, false), false), false), false);
            d[5] = __builtin_amdgcn_sdot4((int)A5[3], xq[3], __builtin_amdgcn_sdot4((int)A5[2], xq[2], __builtin_amdgcn_sdot4((int)A5[1], xq[1], __builtin_amdgcn_sdot4((int)A5[0], xq[0], 0, false), false), false), false);
            d[6] = __builtin_amdgcn_sdot4((int)A6[3], xq[3], __builtin_amdgcn_sdot4((int)A6[2], xq[2], __builtin_amdgcn_sdot4((int)A6[1], xq[1], __builtin_amdgcn_sdot4((int)A6[0], xq[0], 0, false), false), false), false);
            d[7] = __builtin_amdgcn_sdot4((int)A7[3], xq[3], __builtin_amdgcn_sdot4((int)A7[2], xq[2], __builtin_amdgcn_sdot4((int)A7[1], xq[1], __builtin_amdgcn_sdot4((int)A7[0], xq[0], 0, false), false), false), false);
            d[8] = __builtin_amdgcn_sdot4((int)A8[3], xq[3], __builtin_amdgcn_sdot4((int)A8[2], xq[2], __builtin_amdgcn_sdot4((int)A8[1], xq[1], __builtin_amdgcn_sdot4((int)A8[0], xq[0], 0, false), false), false), false);
            d[9] = __builtin_amdgcn_sdot4((int)A9[3], xq[3], __builtin_amdgcn_sdot4((int)A9[2], xq[2], __builtin_amdgcn_sdot4((int)A9[1], xq[1], __builtin_amdgcn_sdot4((int)A9[0], xq[0], 0, false), false), false), false);
            d[10] = __builtin_amdgcn_sdot4((int)A10[3], xq[3], __builtin_amdgcn_sdot4((int)A10[2], xq[2], __builtin_amdgcn_sdot4((int)A10[1], xq[1], __builtin_amdgcn_sdot4((int)A10[0], xq[0], 0, false), false), false), false);
            d[11] = __builtin_amdgcn_sdot4((int)A11[3], xq[3], __builtin_amdgcn_sdot4((int)A11[2], xq[2], __builtin_amdgcn_sdot4((int)A11[1], xq[1], __builtin_amdgcn_sdot4((int)A11[0], xq[0], 0, false), false), false), false);
            d[12] = __builtin_amdgcn_sdot4((int)A12[3], xq[3], __builtin_amdgcn_sdot4((int)A12[2], xq[2], __builtin_amdgcn_sdot4((int)A12[1], xq[1], __builtin_amdgcn_sdot4((int)A12[0], xq[0], 0, false), false), false), false);
            d[13] = __builtin_amdgcn_sdot4((int)A13[3], xq[3], __builtin_amdgcn_sdot4((int)A13[2], xq[2], __builtin_amdgcn_sdot4((int)A13[1], xq[1], __builtin_amdgcn_sdot4((int)A13[0], xq[0], 0, false), false), false), false);
            d[14] = __builtin_amdgcn_sdot4((int)A14[3], xq[3], __builtin_amdgcn_sdot4((int)A14[2], xq[2], __builtin_amdgcn_sdot4((int)A14[1], xq[1], __builtin_amdgcn_sdot4((int)A14[0], xq[0], 0, false), false), false), false);
            d[15] = __builtin_amdgcn_sdot4((int)A15[3], xq[3], __builtin_amdgcn_sdot4((int)A15[2], xq[2], __builtin_amdgcn_sdot4((int)A15[1], xq[1], __builtin_amdgcn_sdot4((int)A15[0], xq[0], 0, false), false), false), false);
            _Pragma("unroll") for (int st = 0; st < 3; ++st) { const int M = 1 << st, nn = 8 >> st; const int hm = (la & M) ? -1 : 0;
                _Pragma("unroll") for (int i = 0; i < 8; ++i) if (i < nn) { const int keep = (d[nn + i] & hm) | (d[i] & ~hm), send = (d[i] & hm) | (d[nn + i] & ~hm);
                    d[i] = keep + ((st == 0) ? DPP_I(send, 0xB1) : (st == 1) ? DPP_I(send, 0x4E) : __builtin_amdgcn_ds_swizzle(send, (4 << 10) | 0x1f)); } }
            float* pp = (float*)(P.ws + WS_PART) + ((size_t)j * T + (unsigned)(T0 + 8 * b + 6)) * 128;
            *(f32x2*)(pp + (unsigned)(16 * sl + i0)) = (f32x2){(float)d[0] * sx, (float)d[1] * sx}; }
        { const LAS unsigned char* ip_ = buf + (bs ^ 1) * 4096 + 0 * 256 + 32 * sl; const u32x4 e0_ = *(const LAS u32x4*)ip_, e1_ = *(const LAS u32x4*)(ip_ + 16);
            A0 = *(const u32x4*)(TAB + ((e0_[0] & 0xffffu) * 128u + pb));
            A1 = *(const u32x4*)(TAB + ((e0_[0] >> 16) * 128u + pb));
            A2 = *(const u32x4*)(TAB + ((e0_[1] & 0xffffu) * 128u + pb));
            A3 = *(const u32x4*)(TAB + ((e0_[1] >> 16) * 128u + pb));
            A4 = *(const u32x4*)(TAB + ((e0_[2] & 0xffffu) * 128u + pb));
            A5 = *(const u32x4*)(TAB + ((e0_[2] >> 16) * 128u + pb));
            A6 = *(const u32x4*)(TAB + ((e0_[3] & 0xffffu) * 128u + pb));
            A7 = *(const u32x4*)(TAB + ((e0_[3] >> 16) * 128u + pb));
            A8 = *(const u32x4*)(TAB + ((e1_[0] & 0xffffu) * 128u + pb));
            A9 = *(const u32x4*)(TAB + ((e1_[0] >> 16) * 128u + pb));
            A10 = *(const u32x4*)(TAB + ((e1_[1] & 0xffffu) * 128u + pb));
            A11 = *(const u32x4*)(TAB + ((e1_[1] >> 16) * 128u + pb));
            A12 = *(const u32x4*)(TAB + ((e1_[2] & 0xffffu) * 128u + pb));
            A13 = *(const u32x4*)(TAB + ((e1_[2] >> 16) * 128u + pb));
            A14 = *(const u32x4*)(TAB + ((e1_[3] & 0xffffu) * 128u + pb));
            A15 = *(const u32x4*)(TAB + ((e1_[3] >> 16) * 128u + pb));
        }
        { const i32x4 xq = *(const LAS i32x4*)(buf + bs * 4096 + 2048 + 7 * 128 + 16 * pc); const float sx = *(const LAS float*)(buf + bs * 4096 + 3072 + 4 * 7);
            int d[16];
            d[0] = __builtin_amdgcn_sdot4((int)B0[3], xq[3], __builtin_amdgcn_sdot4((int)B0[2], xq[2], __builtin_amdgcn_sdot4((int)B0[1], xq[1], __builtin_amdgcn_sdot4((int)B0[0], xq[0], 0, false), false), false), false);
            d[1] = __builtin_amdgcn_sdot4((int)B1[3], xq[3], __builtin_amdgcn_sdot4((int)B1[2], xq[2], __builtin_amdgcn_sdot4((int)B1[1], xq[1], __builtin_amdgcn_sdot4((int)B1[0], xq[0], 0, false), false), false), false);
            d[2] = __builtin_amdgcn_sdot4((int)B2[3], xq[3], __builtin_amdgcn_sdot4((int)B2[2], xq[2], __builtin_amdgcn_sdot4((int)B2[1], xq[1], __builtin_amdgcn_sdot4((int)B2[0], xq[0], 0, false), false), false), false);
            d[3] = __builtin_amdgcn_sdot4((int)B3[3], xq[3], __builtin_amdgcn_sdot4((int)B3[2], xq[2], __builtin_amdgcn_sdot4((int)B3[1], xq[1], __builtin_amdgcn_sdot4((int)B3[0], xq[0], 0, false), false), false), false);
            d[4] = __builtin_amdgcn_sdot4((int)B4[3], xq[3], __builtin_amdgcn_sdot4((int)B4[2], xq[2], __builtin_amdgcn_sdot4((int)B4[1], xq[1], __builtin_amdgcn_sdot4((int)B4[0], xq[0], 0, false), false), false), false);
            d[5] = __builtin_amdgcn_sdot4((int)B5[3], xq[3], __builtin_amdgcn_sdot4((int)B5[2], xq[2], __builtin_amdgcn_sdot4((int)B5[1], xq[1], __builtin_amdgcn_sdot4((int)B5[0], xq[0], 0, false), false), false), false);
            d[6] = __builtin_amdgcn_sdot4((int)B6[3], xq[3], __builtin_amdgcn_sdot4((int)B6[2], xq[2], __builtin_amdgcn_sdot4((int)B6[1], xq[1], __builtin_amdgcn_sdot4((int)B6[0], xq[0], 0, false), false), false), false);
            d[7] = __builtin_amdgcn_sdot4((int)B7[3], xq[3], __builtin_amdgcn_sdot4((int)B7[2], xq[2], __builtin_amdgcn_sdot4((int)B7[1], xq[1], __builtin_amdgcn_sdot4((int)B7[0], xq[0], 0, false), false), false), false);
            d[8] = __builtin_amdgcn_sdot4((int)B8[3], xq[3], __builtin_amdgcn_sdot4((int)B8[2], xq[2], __builtin_amdgcn_sdot4((int)B8[1], xq[1], __builtin_amdgcn_sdot4((int)B8[0], xq[0], 0, false), false), false), false);
            d[9] = __builtin_amdgcn_sdot4((int)B9[3], xq[3], __builtin_amdgcn_sdot4((int)B9[2], xq[2], __builtin_amdgcn_sdot4((int)B9[1], xq[1], __builtin_amdgcn_sdot4((int)B9[0], xq[0], 0, false), false), false), false);
            d[10] = __builtin_amdgcn_sdot4((int)B10[3], xq[3], __builtin_amdgcn_sdot4((int)B10[2], xq[2], __builtin_amdgcn_sdot4((int)B10[1], xq[1], __builtin_amdgcn_sdot4((int)B10[0], xq[0], 0, false), false), false), false);
            d[11] = __builtin_amdgcn_sdot4((int)B11[3], xq[3], __builtin_amdgcn_sdot4((int)B11[2], xq[2], __builtin_amdgcn_sdot4((int)B11[1], xq[1], __builtin_amdgcn_sdot4((int)B11[0], xq[0], 0, false), false), false), false);
            d[12] = __builtin_amdgcn_sdot4((int)B12[3], xq[3], __builtin_amdgcn_sdot4((int)B12[2], xq[2], __builtin_amdgcn_sdot4((int)B12[1], xq[1], __builtin_amdgcn_sdot4((int)B12[0], xq[0], 0, false), false), false), false);
            d[13] = __builtin_amdgcn_sdot4((int)B13[3], xq[3], __builtin_amdgcn_sdot4((int)B13[2], xq[2], __builtin_amdgcn_sdot4((int)B13[1], xq[1], __builtin_amdgcn_sdot4((int)B13[0], xq[0], 0, false), false), false), false);
            d[14] = __builtin_amdgcn_sdot4((int)B14[3], xq[3], __builtin_amdgcn_sdot4((int)B14[2], xq[2], __builtin_amdgcn_sdot4((int)B14[1], xq[1], __builtin_amdgcn_sdot4((int)B14[0], xq[0], 0, false), false), false), false);
            d[15] = __builtin_amdgcn_sdot4((int)B15[3], xq[3], __builtin_amdgcn_sdot4((int)B15[2], xq[2], __builtin_amdgcn_sdot4((int)B15[1], xq[1], __builtin_amdgcn_sdot4((int)B15[0], xq[0], 0, false), false), false), false);
            _Pragma("unroll") for (int st = 0; st < 3; ++st) { const int M = 1 << st, nn = 8 >> st; const int hm = (la & M) ? -1 : 0;
                _Pragma("unroll") for (int i = 0; i < 8; ++i) if (i < nn) { const int keep = (d[nn + i] & hm) | (d[i] & ~hm), send = (d[i] & hm) | (d[nn + i] & ~hm);
                    d[i] = keep + ((st == 0) ? DPP_I(send, 0xB1) : (st == 1) ? DPP_I(send, 0x4E) : __builtin_amdgcn_ds_swizzle(send, (4 << 10) | 0x1f)); } }
            float* pp = (float*)(P.ws + WS_PART) + ((size_t)j * T + (unsigned)(T0 + 8 * b + 7)) * 128;
            *(f32x2*)(pp + (unsigned)(16 * sl + i0)) = (f32x2){(float)d[0] * sx, (float)d[1] * sx}; }
    }
#undef U3_FETCH
#undef U3_PARK
}
__device__ __forceinline__ void p6_combine(const Ptrs& P, int gtid, int nthreads) {
    const unsigned char* ws = P.ws;
    for (int i = gtid; i < T * 128 / 4; i += nthreads) {
        const int t = i >> 5;
        f32x4 a = *(const f32x4*)((const float*)(ws + WS_PART) + (size_t)i * 4);
#pragma unroll
        for (int j = 1; j < 8; ++j) a += *(const f32x4*)((const float*)(ws + WS_PART) + ((size_t)j * T * 128) + (size_t)i * 4);
        const float r2u = ((const float*)(ws + WS_R2))[t];
        const f32x4 g = *(const f32x4*)((const float*)(ws + WS_GW) + (size_t)i * 4);
        const u32x2 e2 = *(const u32x2*)((const unsigned short*)(ws + WS_IDX16) + (size_t)i * 4); const int4 ei = make_int4((int)(e2.x & 0xffffu), (int)(e2.x >> 16), (int)(e2.y & 0xffffu), (int)(e2.y >> 16));
        const float* sus = (const float*)(ws + WS_SUS); const float* svs = (const float*)(ws + WS_SVS);
        f32x4 w; w.x = svs[ei.x] * g.x * gelu_tanh(r2u * sus[ei.x] * a.x); w.y = svs[ei.y] * g.y * gelu_tanh(r2u * sus[ei.y] * a.y); w.z = svs[ei.z] * g.z * gelu_tanh(r2u * sus[ei.z] * a.z); w.w = svs[ei.w] * g.w * gelu_tanh(r2u * sus[ei.w] * a.w);
        float mx = fmaxf(fmaxf(fabsf(w.x), fabsf(w.y)), fmaxf(fabsf(w.z), fabsf(w.w)));
        mx = fmaxf(mx, DPP_F(mx, 0xB1)); mx = fmaxf(mx, DPP_F(mx, 0x4E)); mx = fmaxf(mx, DPP_F(mx, 0x141)); mx = fmaxf(mx, DPP_F(mx, 0x140)); mx = fmaxf(mx, xor_lane<16>(mx));
        mx = fmaxf(mx, 1e-30f);
        const float inv = 127.0f * __builtin_amdgcn_rcpf(mx);
        const int m = i & 31;
        ((unsigned*)(P.ws + WS_W))[i] = (unsigned)((int)rintf(w.x * inv) & 0xff) | ((unsigned)((int)rintf(w.y * inv) & 0xff) << 8) | ((unsigned)((int)rintf(w.z * inv) & 0xff) << 16) | ((unsigned)(int)rintf(w.w * inv) << 24);
        if (m == 0) ((float*)(P.ws + WS_R1))[t] = mx * (1.0f / 127.0f);
    }
}

typedef float f32x16 __attribute__((ext_vector_type(16)));
#define MFMA32(a, b, c) __builtin_amdgcn_mfma_f32_32x32x16_bf16((a), (b), (c), 0, 0, 0)
__device__ __forceinline__ int crow(int reg, int h) { return (reg & 3) + 8 * (reg >> 2) + 4 * h; }
__device__ __forceinline__ unsigned pkbf(float lo, float hi) { const bf16x2_t v = {(__bf16)lo, (__bf16)hi}; return __builtin_bit_cast(unsigned, v); }

constexpr int KL_STRIDE = 72, VT_STRIDE = 196;
constexpr int KL_OFF = 0, VT_OFF = 192 * KL_STRIDE * 2, BIASL_OFF = VT_OFF + 64 * VT_STRIDE * 2;
__device__ __forceinline__ void attn_item(const Ptrs& P, LAS unsigned char* lds, int item, int tid, int lane, int wave) {
    const unsigned char* ws = P.ws;
    const bf16* proj = (const bf16*)(ws + WS_PROJ);
    const int kvh = item & 1, qb = (item >> 1) & 31, b = item >> 6;
    const int tb = b * SEQ, p0 = qb * 64;
    LAS bf16* KL = (LAS bf16*)(lds + KL_OFF); LAS bf16* VT = (LAS bf16*)(lds + VT_OFF); LAS float* BIASL = (LAS float*)(lds + BIASL_OFF);
#pragma unroll
    for (int i = 0; i < 3; ++i) {
        const int p = tid + 512 * i, key = p >> 3, ch = p & 7, kpos = p0 - 128 + key;
        u32x4 kw = (u32x4){0u, 0u, 0u, 0u}, vw = (u32x4){0u, 0u, 0u, 0u};
        if (kpos >= 0) { const bf16* src = proj + (size_t)(tb + kpos) * NIN + kvh * HD + 8 * ch; kw = *(const u32x4*)(src + C_K); vw = *(const u32x4*)(src + C_V); }
        float kf[8]; unpack8(kw, kf);
        float ss = 0.f;
#pragma unroll
        for (int j = 0; j < 8; ++j) ss += kf[j] * kf[j];
        ss += DPP_F(ss, 0xB1); ss += DPP_F(ss, 0x4E); ss += DPP_F(ss, 0x141);
        const float rinv = __builtin_amdgcn_rsqf(ss * (1.0f / HD) + EPS);
        const f32x4 g0 = *(const f32x4*)(P.k_norm_g + 8 * ch), g1 = *(const f32x4*)(P.k_norm_g + 8 * ch + 4);
        u32x4 o; o.x = pkbf(kf[0] * rinv * g0.x, kf[1] * rinv * g0.y); o.y = pkbf(kf[2] * rinv * g0.z, kf[3] * rinv * g0.w);
        o.z = pkbf(kf[4] * rinv * g1.x, kf[5] * rinv * g1.y); o.w = pkbf(kf[6] * rinv * g1.z, kf[7] * rinv * g1.w);
        *(LAS u32x4*)(KL + key * KL_STRIDE + 8 * ch) = o;
#pragma unroll
        for (int j = 0; j < 4; ++j) { VT[(8 * ch + 2 * j) * VT_STRIDE + key] = (bf16)(vw[j] & 0xffffu); VT[(8 * ch + 2 * j + 1) * VT_STRIDE + key] = (bf16)(vw[j] >> 16); }
    }
    for (int e = tid; e < 4 * 192; e += 512) { const int gg = e / 192, rel = e % 192 - 32;
        BIASL[e] = (rel >= 0 && rel < WIN) ? ((const float*)(ws + WS_BL))[(kvh * 4 + gg) * WIN + rel] : -1.0e30f; }
    __syncthreads();
    const int g = wave >> 1, a = wave & 1, head = kvh * 4 + g, q = lane & 31, hh = lane >> 5;
    const int tq = tb + p0 + 32 * a + q;
    bf16x8 Bq[4];
    {
        float qf[4][8]; float ss = 0.f;
#pragma unroll
        for (int s = 0; s < 4; ++s) { const u32x4 w = *(const u32x4*)(proj + (size_t)tq * NIN + C_Q + head * HD + 16 * s + 8 * hh); unpack8(w, qf[s]);
#pragma unroll
            for (int j = 0; j < 8; ++j) ss += qf[s][j] * qf[s][j]; }
        ss += __shfl_xor(ss, 32);
        const float rinv = 0.125f * __builtin_amdgcn_rsqf(ss * (1.0f / HD) + EPS);
#pragma unroll
        for (int s = 0; s < 4; ++s) { const f32x4 g0 = *(const f32x4*)(P.q_norm_g + 16 * s + 8 * hh), g1 = *(const f32x4*)(P.q_norm_g + 16 * s + 8 * hh + 4);
            u32x4 o; o.x = pkbf(qf[s][0] * rinv * g0.x, qf[s][1] * rinv * g0.y); o.y = pkbf(qf[s][2] * rinv * g0.z, qf[s][3] * rinv * g0.w);
            o.z = pkbf(qf[s][4] * rinv * g1.x, qf[s][5] * rinv * g1.y); o.w = pkbf(qf[s][6] * rinv * g1.z, qf[s][7] * rinv * g1.w);
            Bq[s] = __builtin_bit_cast(bf16x8, o); }
    }
    f32x16 sc[5];
#pragma unroll
    for (int c = 0; c < 5; ++c) {
#pragma unroll
        for (int r = 0; r < 16; ++r) sc[c][r] = 0.f;
#pragma unroll
        for (int s = 0; s < 4; ++s) { const bf16x8 A = *(const LAS bf16x8*)(KL + (32 * (a + c) + q) * KL_STRIDE + 16 * s + 8 * hh); sc[c] = MFMA32(A, Bq[s], sc[c]); }
    }
    const float sink = P.sinks[head];
    float m = sink;
    const LAS float* bias_base = BIASL + g * 192 + q + 160 - 4 * hh;
    const int kneg = p0 - 128 + 32 * a + 4 * hh;
#pragma unroll
    for (int c = 0; c < 5; ++c)
#pragma unroll
        for (int r = 0; r < 16; ++r) { const int kw0 = 32 * c + (r & 3) + 8 * (r >> 2);
            const float bv = bias_base[-kw0];
            float v = sc[c][r] + bv; v = (kneg + kw0 >= 0) ? v : -1.0e30f; sc[c][r] = v; m = fmaxf(m, v); }
    m = fmaxf(m, __shfl_xor(m, 32));
    float l = 0.f;
#pragma unroll
    for (int c = 0; c < 5; ++c)
#pragma unroll
        for (int r = 0; r < 16; ++r) { const float p = __expf(sc[c][r] - m); sc[c][r] = p; l += p; }
    l += __shfl_xor(l, 32);
    const float inv = 1.0f / (l + __expf(sink - m));
    f32x16 oacc[2];
#pragma unroll
    for (int dt = 0; dt < 2; ++dt)
#pragma unroll
        for (int r = 0; r < 16; ++r) oacc[dt][r] = 0.f;
#pragma unroll
    for (int c = 0; c < 5; ++c)
#pragma unroll
        for (int s2 = 0; s2 < 2; ++s2) {
            u32x4 pw; pw.x = pkbf(sc[c][8 * s2 + 0], sc[c][8 * s2 + 1]); pw.y = pkbf(sc[c][8 * s2 + 2], sc[c][8 * s2 + 3]); pw.z = pkbf(sc[c][8 * s2 + 4], sc[c][8 * s2 + 5]); pw.w = pkbf(sc[c][8 * s2 + 6], sc[c][8 * s2 + 7]);
            const bf16x8 Pb = __builtin_bit_cast(bf16x8, pw);
            const int kb = 32 * (a + c) + 16 * s2 + 4 * hh;
#pragma unroll
            for (int dt = 0; dt < 2; ++dt) { const LAS bf16* vr = VT + (32 * dt + q) * VT_STRIDE + kb;
                const u32x2 lo = *(const LAS u32x2*)vr, hi = *(const LAS u32x2*)(vr + 8);
                const bf16x8 Av = __builtin_bit_cast(bf16x8, (u32x4){lo.x, lo.y, hi.x, hi.y});
                oacc[dt] = MFMA32(Av, Pb, oacc[dt]); }
        }
    float ss = 0.f;
    bf16* orow = (bf16*)(ws + WS_MIX) + (size_t)tq * D + LRU_W + head * HD + 4 * hh;
#pragma unroll
    for (int dt = 0; dt < 2; ++dt)
#pragma unroll
        for (int r4 = 0; r4 < 4; ++r4) { const float o0 = oacc[dt][4 * r4] * inv, o1 = oacc[dt][4 * r4 + 1] * inv, o2 = oacc[dt][4 * r4 + 2] * inv, o3 = oacc[dt][4 * r4 + 3] * inv;
            ss += (o0 * o0 + o1 * o1) + (o2 * o2 + o3 * o3);
            u32x2 w; w.x = pkbf(o0, o1); w.y = pkbf(o2, o3); *(u32x2*)(orow + 32 * dt + 8 * r4) = w; }
    ss += __shfl_xor(ss, 32);
    if (hh == 0) ((float*)(ws + WS_SSQA))[(size_t)tq * 8 + head] = ss;
    __syncthreads();
}

__device__ __forceinline__ void bar4(volatile LAS unsigned* cnt, unsigned& target, int lane) {
    asm volatile("s_waitcnt vmcnt(0) lgkmcnt(0)" ::: "memory");
    target += 4u;
    if (lane == 0) (void)__hip_atomic_fetch_add((LAS unsigned*)cnt, 1u, __ATOMIC_RELAXED, __HIP_MEMORY_SCOPE_WORKGROUP);
    while (*cnt < target) __builtin_amdgcn_s_sleep(1);
    asm volatile("" ::: "memory");
}
__device__ __forceinline__ void attn_item4(const Ptrs& P, LAS unsigned char* lds, int item, int tid, int lane, int wave, volatile LAS unsigned* bcnt, unsigned& btgt) {
    const unsigned char* ws = P.ws;
    const bf16* proj = (const bf16*)(ws + WS_PROJ);
    const int kvh = item & 1, qb = (item >> 1) & 31, b = item >> 6;
    const int tb = b * SEQ, p0 = qb * 64;
    LAS bf16* KL = (LAS bf16*)(lds + KL_OFF); LAS bf16* VT = (LAS bf16*)(lds + VT_OFF); LAS float* BIASL = (LAS float*)(lds + BIASL_OFF);
#pragma unroll
    for (int i = 0; i < 6; ++i) {
        const int p = tid + 256 * i, key = p >> 3, ch = p & 7, kpos = p0 - 128 + key;
        u32x4 kw = (u32x4){0u, 0u, 0u, 0u}, vw = (u32x4){0u, 0u, 0u, 0u};
        if (kpos >= 0) { const bf16* src = proj + (size_t)(tb + kpos) * NIN + kvh * HD + 8 * ch; kw = *(const u32x4*)(src + C_K); vw = *(const u32x4*)(src + C_V); }
        float kf[8]; unpack8(kw, kf);
        float ss = 0.f;
#pragma unroll
        for (int j = 0; j < 8; ++j) ss += kf[j] * kf[j];
        ss += DPP_F(ss, 0xB1); ss += DPP_F(ss, 0x4E); ss += DPP_F(ss, 0x141);
        const float rinv = __builtin_amdgcn_rsqf(ss * (1.0f / HD) + EPS);
        const f32x4 g0 = *(const f32x4*)(P.k_norm_g + 8 * ch), g1 = *(const f32x4*)(P.k_norm_g + 8 * ch + 4);
        u32x4 o; o.x = pkbf(kf[0] * rinv * g0.x, kf[1] * rinv * g0.y); o.y = pkbf(kf[2] * rinv * g0.z, kf[3] * rinv * g0.w);
        o.z = pkbf(kf[4] * rinv * g1.x, kf[5] * rinv * g1.y); o.w = pkbf(kf[6] * rinv * g1.z, kf[7] * rinv * g1.w);
        *(LAS u32x4*)(KL + key * KL_STRIDE + 8 * ch) = o;
#pragma unroll
        for (int j = 0; j < 4; ++j) { VT[(8 * ch + 2 * j) * VT_STRIDE + key] = (bf16)(vw[j] & 0xffffu); VT[(8 * ch + 2 * j + 1) * VT_STRIDE + key] = (bf16)(vw[j] >> 16); }
    }
    for (int e = tid; e < 4 * 192; e += 256) { const int gg = e / 192, rel = e % 192 - 32;
        BIASL[e] = (rel >= 0 && rel < WIN) ? ((const float*)(ws + WS_BL))[(kvh * 4 + gg) * WIN + rel] : -1.0e30f; }
    bar4(bcnt, btgt, lane);
#pragma unroll 1
    for (int a = 0; a < 2; ++a) {
    const int g = wave, head = kvh * 4 + g, q = lane & 31, hh = lane >> 5;
    const int tq = tb + p0 + 32 * a + q;
    bf16x8 Bq[4];
    {
        float qf[4][8]; float ss = 0.f;
#pragma unroll
        for (int s = 0; s < 4; ++s) { const u32x4 w = *(const u32x4*)(proj + (size_t)tq * NIN + C_Q + head * HD + 16 * s + 8 * hh); unpack8(w, qf[s]);
#pragma unroll
            for (int j = 0; j < 8; ++j) ss += qf[s][j] * qf[s][j]; }
        ss += __shfl_xor(ss, 32);
        const float rinv = 0.125f * __builtin_amdgcn_rsqf(ss * (1.0f / HD) + EPS);
#pragma unroll
        for (int s = 0; s < 4; ++s) { const f32x4 g0 = *(const f32x4*)(P.q_norm_g + 16 * s + 8 * hh), g1 = *(const f32x4*)(P.q_norm_g + 16 * s + 8 * hh + 4);
            u32x4 o; o.x = pkbf(qf[s][0] * rinv * g0.x, qf[s][1] * rinv * g0.y); o.y = pkbf(qf[s][2] * rinv * g0.z, qf[s][3] * rinv * g0.w);
            o.z = pkbf(qf[s][4] * rinv * g1.x, qf[s][5] * rinv * g1.y); o.w = pkbf(qf[s][6] * rinv * g1.z, qf[s][7] * rinv * g1.w);
            Bq[s] = __builtin_bit_cast(bf16x8, o); }
    }
    f32x16 sc[5];
#pragma unroll
    for (int c = 0; c < 5; ++c) {
#pragma unroll
        for (int r = 0; r < 16; ++r) sc[c][r] = 0.f;
#pragma unroll
        for (int s = 0; s < 4; ++s) { const bf16x8 A = *(const LAS bf16x8*)(KL + (32 * (a + c) + q) * KL_STRIDE + 16 * s + 8 * hh); sc[c] = MFMA32(A, Bq[s], sc[c]); }
    }
    const float sink = P.sinks[head];
    float m = sink;
    const LAS float* bias_base = BIASL + g * 192 + q + 160 - 4 * hh;
    const int kneg = p0 - 128 + 32 * a + 4 * hh;
#pragma unroll
    for (int c = 0; c < 5; ++c)
#pragma unroll
        for (int r = 0; r < 16; ++r) { const int kw0 = 32 * c + (r & 3) + 8 * (r >> 2);
            const float bv = bias_base[-kw0];
            float v = sc[c][r] + bv; v = (kneg + kw0 >= 0) ? v : -1.0e30f; sc[c][r] = v; m = fmaxf(m, v); }
    m = fmaxf(m, __shfl_xor(m, 32));
    float l = 0.f;
#pragma unroll
    for (int c = 0; c < 5; ++c)
#pragma unroll
        for (int r = 0; r < 16; ++r) { const float p = __expf(sc[c][r] - m); sc[c][r] = p; l += p; }
    l += __shfl_xor(l, 32);
    const float inv = 1.0f / (l + __expf(sink - m));
    f32x16 oacc[2];
#pragma unroll
    for (int dt = 0; dt < 2; ++dt)
#pragma unroll
        for (int r = 0; r < 16; ++r) oacc[dt][r] = 0.f;
#pragma unroll
    for (int c = 0; c < 5; ++c)
#pragma unroll
        for (int s2 = 0; s2 < 2; ++s2) {
            u32x4 pw; pw.x = pkbf(sc[c][8 * s2 + 0], sc[c][8 * s2 + 1]); pw.y = pkbf(sc[c][8 * s2 + 2], sc[c][8 * s2 + 3]); pw.z = pkbf(sc[c][8 * s2 + 4], sc[c][8 * s2 + 5]); pw.w = pkbf(sc[c][8 * s2 + 6], sc[c][8 * s2 + 7]);
            const bf16x8 Pb = __builtin_bit_cast(bf16x8, pw);
            const int kb = 32 * (a + c) + 16 * s2 + 4 * hh;
#pragma unroll
            for (int dt = 0; dt < 2; ++dt) { const LAS bf16* vr = VT + (32 * dt + q) * VT_STRIDE + kb;
                const u32x2 lo = *(const LAS u32x2*)vr, hi = *(const LAS u32x2*)(vr + 8);
                const bf16x8 Av = __builtin_bit_cast(bf16x8, (u32x4){lo.x, lo.y, hi.x, hi.y});
                oacc[dt] = MFMA32(Av, Pb, oacc[dt]); }
        }
    float ss = 0.f;
    bf16* orow = (bf16*)(ws + WS_MIX) + (size_t)tq * D + LRU_W + head * HD + 4 * hh;
#pragma unroll
    for (int dt = 0; dt < 2; ++dt)
#pragma unroll
        for (int r4 = 0; r4 < 4; ++r4) { const float o0 = oacc[dt][4 * r4] * inv, o1 = oacc[dt][4 * r4 + 1] * inv, o2 = oacc[dt][4 * r4 + 2] * inv, o3 = oacc[dt][4 * r4 + 3] * inv;
            ss += (o0 * o0 + o1 * o1) + (o2 * o2 + o3 * o3);
            u32x2 w; w.x = pkbf(o0, o1); w.y = pkbf(o2, o3); *(u32x2*)(orow + 32 * dt + 8 * r4) = w; }
    ss += __shfl_xor(ss, 32);
    if (hh == 0) ((float*)(ws + WS_SSQA))[(size_t)tq * 8 + head] = ss;
    }
    bar4(bcnt, btgt, lane);
}

constexpr int LR_XB = 0, LR_XCF = 17408, LR_XCB = 33792, LR_LA = 43008, LR_LB = 59392, LR_XG = 75776, LR_GB = 92160, LR_TOT = 108544, LR_H0 = 112640, LR_CW = 113152, LR_PAR = 114432, LR_ASEG = 115200  ;
constexpr int XCB_STRIDE = 72;
constexpr size_t WS_AGG = 14 * MiB + 512 * 1024;
constexpr size_t WS_HLAC = 80 * MiB;
template <int MODE> __device__ __forceinline__ void lru_seg(const Ptrs& P, LAS unsigned char* lds, int item, int tid, int lane, int wave) {
    unsigned char* ws = P.ws;
    const bf16* proj = (const bf16*)(ws + WS_PROJ);
    const int n = item & 7, seg = (item >> 3) & 7, b = item >> 6, tb = b * SEQ, s0 = seg * 256;
    LAS float* XB = (LAS float*)(lds + LR_XB); LAS float* XCF = (LAS float*)(lds + LR_XCF); LAS bf16* XCB = (LAS bf16*)(lds + LR_XCB);
    LAS float* LA = (LAS float*)(lds + LR_LA); LAS float* LB = (LAS float*)(lds + LR_LB); LAS float* XG = (LAS float*)(lds + LR_XG); LAS float* GBL = (LAS float*)(lds + LR_GB);
    LAS float* TOT = (LAS float*)(lds + LR_TOT); LAS float* H0 = (LAS float*)(lds + LR_H0); LAS float* CW = (LAS float*)(lds + LR_CW); LAS float* PAR = (LAS float*)(lds + LR_PAR); LAS float* ASEG = (LAS float*)(lds + LR_ASEG);
    float* agg = (float*)(ws + WS_AGG) + (size_t)((b * NBLK + n) * 8) * 128;
    if (tid < 64) { const int c = n * BLK + tid;
#pragma unroll
        for (int k = 0; k < 4; ++k) CW[k * 64 + tid] = P.conv_w[k * LRU_W + c];
        CW[4 * 64 + tid] = P.conv_b[c];
        PAR[tid] = P.b_gate_a[c]; PAR[64 + tid] = P.b_gate_x[c]; PAR[128 + tid] = log1pf(expf(-P.lru_L[c]));
        float h = 0.f;
        if (MODE) for (int sp = 0; sp < seg; ++sp) h = agg[sp * 128 + tid] * h + agg[sp * 128 + 64 + tid];
        H0[tid] = h; ASEG[tid] = 1.f; ASEG[64 + tid] = 1.f; }
    const int gsel = wave >> 2, tm = (wave >> 1) & 1, tn = wave & 1, jl = lane & 31, hh = lane >> 5;
    bf16x8 Bg[4];
#pragma unroll
    for (int s = 0; s < 4; ++s) Bg[s] = *(const bf16x8*)((const bf16*)(ws + WS_WGT) + ((size_t)(gsel * NBLK + n) * BLK + 32 * tn + jl) * BLK + 16 * s + 8 * hh);
    const int prow = tid >> 3, pch = tid & 7;
    u32x4 pxa, pxb = (u32x4){0u, 0u, 0u, 0u}, pg = (u32x4){0u, 0u, 0u, 0u};
#define LRU_PREFETCH(t0_) do { const int sp_ = (t0_) - 3 + prow; pxa = (u32x4){0u, 0u, 0u, 0u}; \
        if (sp_ >= 0) pxa = *(const u32x4*)(proj + (size_t)(tb + sp_) * NIN + C_XB + n * BLK + 8 * pch); \
        if (tid < 24) pxb = *(const u32x4*)(proj + (size_t)(tb + (t0_) - 3 + 64 + prow) * NIN + C_XB + n * BLK + 8 * pch); \
        if (MODE) pg = *(const u32x4*)(proj + (size_t)(tb + (t0_) + prow) * NIN + C_GB + n * BLK + 8 * pch); } while (0)
    LRU_PREFETCH(s0);
    __syncthreads();
    const int jc = 32 * tn + jl;
    const float gbias = PAR[gsel * 64 + jc], sp8 = -8.0f * PAR[128 + jc];
#pragma unroll 1
    for (int ck = 0; ck < 4; ++ck) {
        const int t0 = s0 + ck * 64, par = ck & 1;
        { float f[8]; unpack8(pxa, f);
            *(LAS f32x4*)(XB + prow * 64 + 8 * pch) = (f32x4){f[0], f[1], f[2], f[3]}; *(LAS f32x4*)(XB + prow * 64 + 8 * pch + 4) = (f32x4){f[4], f[5], f[6], f[7]};
            if (tid < 24) { unpack8(pxb, f); *(LAS f32x4*)(XB + (64 + prow) * 64 + 8 * pch) = (f32x4){f[0], f[1], f[2], f[3]}; *(LAS f32x4*)(XB + (64 + prow) * 64 + 8 * pch + 4) = (f32x4){f[4], f[5], f[6], f[7]}; }
            if (MODE) { unpack8(pg, f);
#pragma unroll
                for (int q = 0; q < 8; ++q) f[q] = gelu_tanh(f[q]);
                *(LAS f32x4*)(GBL + prow * 64 + 8 * pch) = (f32x4){f[0], f[1], f[2], f[3]}; *(LAS f32x4*)(GBL + prow * 64 + 8 * pch + 4) = (f32x4){f[4], f[5], f[6], f[7]}; } }
        if (ck < 3) LRU_PREFETCH(t0 + 64);
        __syncthreads();
        { const int t = tid >> 3, c0 = 8 * (tid & 7); float xc[8];
#pragma unroll
            for (int i = 0; i < 8; ++i) { const int c = c0 + i; float v = CW[4 * 64 + c];
#pragma unroll
                for (int k = 0; k < 4; ++k) v += CW[k * 64 + c] * XB[(t + k) * 64 + c];
                xc[i] = v; }
            *(LAS f32x4*)(XCF + t * 64 + c0) = (f32x4){xc[0], xc[1], xc[2], xc[3]}; *(LAS f32x4*)(XCF + t * 64 + c0 + 4) = (f32x4){xc[4], xc[5], xc[6], xc[7]};
            u32x4 o; o.x = pkbf(xc[0], xc[1]); o.y = pkbf(xc[2], xc[3]); o.z = pkbf(xc[4], xc[5]); o.w = pkbf(xc[6], xc[7]);
            *(LAS u32x4*)(XCB + t * XCB_STRIDE + c0) = o; }
        __syncthreads();
        { f32x16 z;
#pragma unroll
            for (int r = 0; r < 16; ++r) z[r] = 0.f;
#pragma unroll
            for (int s = 0; s < 4; ++s) { const bf16x8 A = *(const LAS bf16x8*)(XCB + (32 * tm + jl) * XCB_STRIDE + 16 * s + 8 * hh); z = MFMA32(A, Bg[s], z); }
            if (gsel == 0) {
#pragma unroll
                for (int r = 0; r < 16; ++r) { const int tt = 32 * tm + crow(r, hh); const float rg = sigmoidf(z[r] + gbias);
                    const float la = sp8 * rg, aa = __expf(la), x2 = 2.0f * la;
                    const float om = -x2 * (1.0f + x2 * (0.5f + x2 * (0.16666667f + x2 * (0.041666668f + x2 * (0.0083333338f + x2 * 0.0013888889f)))));
                    LA[tt * 64 + jc] = aa; LB[tt * 64 + jc] = __builtin_amdgcn_sqrtf(om); }
            } else {
#pragma unroll
                for (int r = 0; r < 16; ++r) { const int tt = 32 * tm + crow(r, hh); XG[tt * 64 + jc] = sigmoidf(z[r] + gbias) * XCF[tt * 64 + jc]; }
            } }
        __syncthreads();
        float Ac[8], Hl[8];
        { float A = 1.f, H = 0.f;
#pragma unroll
            for (int i = 0; i < 8; ++i) { const int t = 8 * wave + i; const float av = LA[t * 64 + lane], bv = LB[t * 64 + lane] * XG[t * 64 + lane]; H = av * H + bv; A = A * av; Ac[i] = A; Hl[i] = H; }
            TOT[(wave * 64 + lane) * 2] = A; TOT[(wave * 64 + lane) * 2 + 1] = H; }
        __syncthreads();
        { float cin = H0[par * 64 + lane], ain = ASEG[par * 64 + lane];
            for (int s = 0; s < wave; ++s) { const float ta = TOT[(s * 64 + lane) * 2]; cin = ta * cin + TOT[(s * 64 + lane) * 2 + 1]; ain *= ta; }
            if (wave == 7) { const float ta = TOT[(7 * 64 + lane) * 2]; H0[(par ^ 1) * 64 + lane] = ta * cin + TOT[(7 * 64 + lane) * 2 + 1]; ASEG[(par ^ 1) * 64 + lane] = ain * ta; }
            if (!MODE) {
                unsigned* hl = (unsigned*)(ws + WS_HLAC) + (size_t)(tb + t0 + 8 * wave) * LRU_W + n * BLK + lane;
#pragma unroll
                for (int i = 0; i < 8; ++i) hl[(size_t)i * LRU_W] = pkbf(Hl[i] + Ac[i] * cin, Ac[i] * ain);
            } else {
#pragma unroll
                for (int i = 0; i < 8; ++i) { const int t = 8 * wave + i; const float h = Hl[i] + Ac[i] * cin; const float y = h * GBL[t * 64 + lane];
                    const size_t tok = (size_t)(tb + t0 + t);
                    ((bf16*)(ws + WS_MIX))[tok * D + n * BLK + lane] = (bf16)f2bf(y);
                    const float ss = wave_sum_u(y * y);
                    if (lane == 0) ((float*)(ws + WS_SSQL))[tok * 8 + n] = ss; } } }
        __syncthreads();
    }
#undef LRU_PREFETCH
    if (!MODE && tid < 64) { agg[seg * 128 + tid] = ASEG[tid]; agg[seg * 128 + 64 + tid] = H0[tid]; }
    __syncthreads();
}

constexpr size_t WS_AGG16 = 14 * MiB + 512 * 1024;
__device__ __forceinline__ void lru_wave_task(const Ptrs& P, LAS float* cwl, int task, int lane) {
    unsigned char* ws = P.ws;
    const bf16* proj = (const bf16*)(ws + WS_PROJ);
    const int nt = task & 1, hs = (task >> 1) & 15, n = (task >> 5) & 7, b = task >> 8, tb = b * SEQ, s0 = hs * 128;
    for (int e = lane; e < 5 * 64; e += 64) { const int k = e >> 6, c = e & 63; cwl[e] = (k < 4) ? P.conv_w[k * LRU_W + n * BLK + c] : P.conv_b[n * BLK + c]; }
    const int jl = lane & 31, hh = lane >> 5, jc = 32 * nt + jl, cg = n * BLK + jc;
    const bf16* wga = (const bf16*)(ws + WS_WGT) + ((size_t)(0 * NBLK + n) * BLK + jc) * BLK + 8 * hh;
    const bf16* wgx = (const bf16*)(ws + WS_WGT) + ((size_t)(1 * NBLK + n) * BLK + jc) * BLK + 8 * hh;
    const float ba = P.b_gate_a[cg], bxg = P.b_gate_x[cg], sp8 = -8.0f * log1pf(expf(-P.lru_L[cg]));
    float cin = 0.f, ain = 1.f;
    LAS bf16* xbl = (LAS bf16*)(cwl + 5 * 64);
    u32x4 pr[5];
#define LRU_PREF(ti_) do { _Pragma("unroll") for (int i = 0; i < 5; ++i) { const int p = lane + 64 * i, row = p >> 3, ch = p & 7, pos = s0 + 32 * (ti_) - 3 + row; pr[i] = (u32x4){0u, 0u, 0u, 0u}; \
        if (p < 35 * 8 && pos >= 0 && (ti_) < 4) pr[i] = *(const u32x4*)(proj + (size_t)(tb + pos) * NIN + C_XB + n * BLK + 8 * ch); } } while (0)
    LRU_PREF(0);
    bf16x8 Ba = *(const bf16x8*)wga, Bx = *(const bf16x8*)wgx;
#pragma unroll 1
    for (int ti = 0; ti < 4; ++ti) {
        const int t0 = s0 + 32 * ti;
#pragma unroll
        for (int i = 0; i < 5; ++i) { const int p = lane + 64 * i; if (p < 35 * 8) *(LAS u32x4*)(xbl + (p >> 3) * 72 + 8 * (p & 7)) = pr[i]; }
        LRU_PREF(ti + 1);
        f32x16 za, zx, zc;
#pragma unroll
        for (int r = 0; r < 16; ++r) { za[r] = 0.f; zx[r] = 0.f; zc[r] = 0.f; }
#pragma unroll
        for (int s = 0; s < 4; ++s) { const int ch0 = 16 * s + 8 * hh;
            const bf16x8 Ban = *(const bf16x8*)(wga + 16 * ((s + 1) & 3)), Bxn = *(const bf16x8*)(wgx + 16 * ((s + 1) & 3));
            float xc[8];
            { const f32x4 b0 = *(const LAS f32x4*)(cwl + 4 * 64 + ch0), b1 = *(const LAS f32x4*)(cwl + 4 * 64 + ch0 + 4);
              xc[0] = b0.x; xc[1] = b0.y; xc[2] = b0.z; xc[3] = b0.w; xc[4] = b1.x; xc[5] = b1.y; xc[6] = b1.z; xc[7] = b1.w; }
#pragma unroll
            for (int tap = 0; tap < 4; ++tap) { const f32x4 w0 = *(const LAS f32x4*)(cwl + tap * 64 + ch0), w1 = *(const LAS f32x4*)(cwl + tap * 64 + ch0 + 4);
                float xf[8]; unpack8(*(const LAS u32x4*)(xbl + (jl + tap) * 72 + ch0), xf);
                xc[0] += w0.x * xf[0]; xc[1] += w0.y * xf[1]; xc[2] += w0.z * xf[2]; xc[3] += w0.w * xf[3]; xc[4] += w1.x * xf[4]; xc[5] += w1.y * xf[5]; xc[6] += w1.z * xf[6]; xc[7] += w1.w * xf[7]; }
            u32x4 o; o.x = pkbf(xc[0], xc[1]); o.y = pkbf(xc[2], xc[3]); o.z = pkbf(xc[4], xc[5]); o.w = pkbf(xc[6], xc[7]);
            const bf16x8 Af = __builtin_bit_cast(bf16x8, o);
            u32x4 idw;
#pragma unroll
            for (int w = 0; w < 4; ++w) { const int k0 = 16 * s + 8 * hh + 2 * w; idw[w] = (k0 == jc ? 0x3F80u : 0u) | (k0 + 1 == jc ? 0x3F800000u : 0u); }
            za = MFMA32(Af, Ba, za); zx = MFMA32(Af, Bx, zx); zc = MFMA32(Af, __builtin_bit_cast(bf16x8, idw), zc);
            Ba = Ban; Bx = Bxn;
            __builtin_amdgcn_sched_barrier(0); }
        float av[16], bv[16];
#pragma unroll
        for (int r = 0; r < 16; ++r) { const float zar = za[r], zxr = zx[r], zcr = zc[r];
            const float rg = sigmoidf(zar + ba), ig = sigmoidf(zxr + bxg), la = sp8 * rg, x2 = 2.0f * la;
            const float om = -x2 * (1.0f + x2 * (0.5f + x2 * (0.16666667f + x2 * (0.041666668f + x2 * (0.0083333338f + x2 * 0.0013888889f)))));
            av[r] = __expf(la); bv[r] = __builtin_amdgcn_sqrtf(om) * ig * zcr; }
        float RA[4], RH[4];
#pragma unroll
        for (int q = 0; q < 4; ++q) { float A = 1.f, H = 0.f;
#pragma unroll
            for (int i = 0; i < 4; ++i) { const int r = 4 * q + i; H = av[r] * H + bv[r]; A = A * av[r]; av[r] = A; bv[r] = H; }
            RA[q] = A; RH[q] = H; }
        const int hm = hh ? -1 : 0;
        float cH[4], cA[4];
#pragma unroll
        for (int q = 0; q < 4; ++q) { const float pa = __shfl_xor(RA[q], 32), ph = __shfl_xor(RH[q], 32);
            const float r0a = fsel(hm, pa, RA[q]), r0h = fsel(hm, ph, RH[q]), r1a = fsel(hm, RA[q], pa), r1h = fsel(hm, RH[q], ph);
            const float mid = r0a * cin + r0h, amid = ain * r0a;
            cH[q] = fsel(hm, mid, cin); cA[q] = fsel(hm, amid, ain);
            cin = r1a * mid + r1h; ain = amid * r1a; }
        unsigned* hl = (unsigned*)(ws + WS_HLAC) + (size_t)(tb + t0 + 4 * hh) * LRU_W + cg;
#pragma unroll
        for (int r = 0; r < 16; ++r) { const int q = r >> 2; hl[(size_t)((r & 3) + 8 * q) * LRU_W] = pkbf(bv[r] + av[r] * cH[q], av[r] * cA[q]); }
    }
#undef LRU_PREF
    if (hh == 0) { float* agg = (float*)(ws + WS_AGG16) + (size_t)((b * NBLK + n) * 16 + hs) * 128; agg[jc] = ain; agg[64 + jc] = cin; }
}

__device__ __forceinline__ void p2_mixer_a(const Ptrs& P, LAS unsigned char* lds, volatile LAS unsigned* MISC, unsigned* ctl, int tid, int lane, int wave, int gw, int NGW) {
    if (wave < 4) {
        unsigned btgt = 0u;
        for (int item = (int)blockIdx.x; item < BATCH * 32 * NKV; item += (int)gridDim.x) attn_item4(P, lds, item, tid, lane, wave, MISC + 24, btgt);
    } else {
        const int lw = (gw >> 3) * 4 + (wave - 4), NLW = NGW / 2;
        for (int task = lw; task < BATCH * NBLK * 16 * 2; task += NLW) lru_wave_task(P, (LAS float*)(lds + 65536 + (wave - 4) * 8192), task, lane);
    }
}
__device__ __forceinline__ void p2_mixer_b(const Ptrs& P, LAS unsigned char* lds, int bx, int G, int tid, int lane, int wave) {
    unsigned char* ws = P.ws;
    LAS float* CAR = (LAS float*)lds;
    for (int item = bx; item < BATCH * 8 * 4; item += G) {
        const int q = item & 3, seg = (item >> 2) & 7, b = item >> 5;
        { const int c = tid, n = c >> 6, j = c & 63, hs = 2 * seg + (q >> 1); const float* agg = (const float*)(ws + WS_AGG16) + (size_t)((b * NBLK + n) * 16) * 128;
            float h = 0.f;
            for (int sp = 0; sp < hs; ++sp) h = agg[sp * 128 + j] * h + agg[sp * 128 + 64 + j];
            CAR[c] = h; }
        __syncthreads();
        const f32x4 c0 = *(const LAS f32x4*)(CAR + 8 * lane), c1 = *(const LAS f32x4*)(CAR + 8 * lane + 4);
        const float car[8] = {c0.x, c0.y, c0.z, c0.w, c1.x, c1.y, c1.z, c1.w};
        const int tok0 = b * SEQ + seg * 256 + q * 64 + wave * 8;
        u32x4 H0[8], H1[8], G4[8];
#pragma unroll
        for (int i = 0; i < 8; ++i) { const size_t tok = (size_t)(tok0 + i);
            const unsigned* hl = (const unsigned*)(ws + WS_HLAC) + tok * LRU_W + 8 * lane;
            H0[i] = *(const u32x4*)hl; H1[i] = *(const u32x4*)(hl + 4);
            G4[i] = *(const u32x4*)((const bf16*)(ws + WS_PROJ) + tok * NIN + C_GB + 8 * lane); }
#pragma unroll
        for (int i = 0; i < 8; ++i) { const size_t tok = (size_t)(tok0 + i);
            const u32x4 h0 = H0[i], h1 = H1[i];
            float gf[8]; unpack8(G4[i], gf);
            const unsigned hw[8] = {h0.x, h0.y, h0.z, h0.w, h1.x, h1.y, h1.z, h1.w};
            float y[8], ss = 0.f;
#pragma unroll
            for (int k = 0; k < 8; ++k) { y[k] = (bflo(hw[k]) + bfhi(hw[k]) * car[k]) * gelu_tanh(gf[k]); ss += y[k] * y[k]; }
            u32x4 o; o.x = pkbf(y[0], y[1]); o.y = pkbf(y[2], y[3]); o.z = pkbf(y[4], y[5]); o.w = pkbf(y[6], y[7]);
            *(u32x4*)((bf16*)(ws + WS_MIX) + tok * D + 8 * lane) = o;
            ss += DPP_F(ss, 0xB1); ss += DPP_F(ss, 0x4E); ss += DPP_F(ss, 0x141);
            if ((lane & 7) == 0) ((float*)(ws + WS_SSQL))[tok * 8 + (lane >> 3)] = ss; }
        __syncthreads();
    }
}

template <int N> __device__ __forceinline__ void bitonic_sort_desc(int (&v)[N]) {
#pragma unroll
    for (int k = 2; k <= N; k <<= 1)
#pragma unroll
        for (int j = k >> 1; j > 0; j >>= 1)
#pragma unroll
            for (int i = 0; i < N; ++i) { const int l = i ^ j; if (l > i) { const bool desc = ((i & k) == 0); const int hi = max(v[i], v[l]), lo = min(v[i], v[l]); v[i] = desc ? hi : lo; v[l] = desc ? lo : hi; } }
}
__device__ __forceinline__ void sort16_desc(int (&a)[16]) {
#define CE(i, j) { const int hi_ = max(a[i], a[j]), lo_ = min(a[i], a[j]); a[i] = hi_; a[j] = lo_; }
    CE(0,13) CE(1,12) CE(2,15) CE(3,14) CE(4,8) CE(5,6) CE(7,11) CE(9,10) CE(0,5) CE(1,7) CE(2,9) CE(3,4) CE(6,13) CE(8,14) CE(10,15) CE(11,12) CE(0,1) CE(2,3) CE(4,5) CE(6,8) CE(7,9) CE(10,11) CE(12,13) CE(14,15) CE(0,2) CE(1,3) CE(4,10) CE(5,11) CE(6,7) CE(8,9) CE(12,14) CE(13,15) CE(1,2) CE(3,12) CE(4,6) CE(5,7) CE(8,10) CE(9,11) CE(13,14) CE(1,4) CE(2,6) CE(5,8) CE(7,10) CE(9,13) CE(11,14) CE(2,4) CE(3,6) CE(9,12) CE(11,13) CE(3,5) CE(6,8) CE(7,9) CE(10,12) CE(3,4) CE(5,6) CE(7,8) CE(9,10) CE(11,12) CE(6,7) CE(8,9)
#undef CE
}
__device__ __forceinline__ void merge_top16(int (&a)[16], const int (&b)[16]) {
#pragma unroll
    for (int i = 0; i < 16; ++i) a[i] = max(a[i], b[15 - i]);
#pragma unroll
    for (int j = 8; j > 0; j >>= 1)
#pragma unroll
        for (int i = 0; i < 16; ++i) { const int l = i ^ j; if (l > i) { const int hi = max(a[i], a[l]), lo = min(a[i], a[l]); a[i] = hi; a[l] = lo; } }
}
__device__ __forceinline__ int f2key(unsigned bits) { const int b = (int)bits; return b ^ ((b >> 31) & 0x7fffffff); }
struct CandTab { int i[64], j[64], n; constexpr CandTab() : i{}, j{}, n(0) { for (int a = 0; a < 16; ++a) for (int b = 0; b < 16; ++b) if ((a + 1) * (b + 1) <= 16) { i[n] = a; j[n] = b; ++n; } } };
constexpr int SKL_STRIDE = 136;
constexpr int SKL_BYTES = 256 * SKL_STRIDE * 2;
__device__ __forceinline__ void p5_topk(const Ptrs& P, LAS unsigned char* lds, const pg8::StaticOrder& S, int tid, int lane, int wave, int gw, int NGW) {
    const unsigned char* ws = P.ws;
    constexpr CandTab CT;
    static_assert(CT.n <= 64, "candidate table");
    const bf16* Q = (const bf16*)(ws + WS_Q); const bf16* SK = (const bf16*)(ws + WS_SKB);
    LAS bf16* SKL = (LAS bf16*)lds;
    LAS unsigned char* ib = lds + SKL_BYTES + (wave * 64 + lane) * 32;
    const int tl = lane & 31, hh = lane >> 5;
    const bool conv = wave >= 4;
    const int NCW = NGW / 2;
    int cvn = (gw >> 3) * 4 + (wave & 3);
#pragma unroll 1
    for (int round = 0; ; ++round) {
        pg8::Unit u; if (!S.next(round, u)) break;
        const int h = u.pn;
#pragma unroll
        for (int i = 0; i < 8; ++i) { const int p = tid + 512 * i, row = p >> 4, ch = p & 15;
            const u32x4 w = *(const u32x4*)(SK + ((size_t)(h * 2) * NKEYS + row) * DHALF + 8 * ch); *(LAS u32x4*)(SKL + row * SKL_STRIDE + 8 * ch) = w; }
        __syncthreads();
        if (conv) {
            constexpr int NGRP = 2 * NEXP / 4;
            ExpRows EA, EB;
            EA.load(P, 4 * min(cvn, NGRP - 1), lane); EB.load(P, 4 * min(cvn + NCW, NGRP - 1), lane);
            EA.finish(P, lane); EA.load(P, 4 * min(cvn + 2 * NCW, NGRP - 1), lane);
            EB.finish(P, lane); EB.load(P, 4 * min(cvn + 3 * NCW, NGRP - 1), lane);
            EA.finish(P, lane); EB.finish(P, lane);
            cvn += 4 * NCW;
        } else
#pragma unroll 1
        for (int sub = 0; sub < 2; ++sub) {
        const int tg = u.pm * 8 + wave + 4 * sub;
        const int t = tg * 32 + tl;
        float r2;
        { const float* sp = (const float*)(ws + WS_SSQ2) + (size_t)t * 16; const f32x4 s0 = *(const f32x4*)sp, s1 = *(const f32x4*)(sp + 4), s2 = *(const f32x4*)(sp + 8), s3 = *(const f32x4*)(sp + 12);
            const float ss = (((s0.x + s0.y) + (s0.z + s0.w)) + ((s1.x + s1.y) + (s1.z + s1.w))) + (((s2.x + s2.y) + (s2.z + s2.w)) + ((s3.x + s3.y) + (s3.z + s3.w)));
            r2 = __builtin_amdgcn_rsqf(ss * (1.0f / D) + EPS); if (h == 0 && hh == 0) ((float*)(ws + WS_R2))[t] = r2; }
        int KS[2][16];
#pragma unroll
        for (int c = 0; c < 2; ++c) {
            f32x16 acc[4];
#pragma unroll
            for (int kt = 0; kt < 4; ++kt)
#pragma unroll
                for (int r = 0; r < 16; ++r) acc[kt][r] = 0.f;
            int hq2 = hh; asm volatile("" : "+v"(hq2));
            const bf16* qrow = Q + (unsigned)(t * NQ + h * DQ + c * DHALF + 8 * hq2);
            bf16x8 Bf[8];
#pragma unroll
            for (int s = 0; s < 8; ++s) Bf[s] = *(const bf16x8*)(qrow + 16 * s);
            const LAS bf16* krow = SKL + (c * NKEYS + tl) * SKL_STRIDE + 8 * hh;
#pragma unroll
            for (int s = 0; s < 8; ++s)
#pragma unroll
                for (int kt = 0; kt < 4; ++kt) { const bf16x8 Af = *(const LAS bf16x8*)(krow + kt * 32 * SKL_STRIDE + 16 * s); acc[kt] = MFMA32(Af, Bf[s], acc[kt]); }
            int kk[4][16];
#pragma unroll
            for (int kt = 0; kt < 4; ++kt) {
#pragma unroll
                for (int r = 0; r < 16; ++r) { const float av = acc[kt][r];
                    kk[kt][r] = f2key((__float_as_uint(av) & ~0x7Fu) | (unsigned)(32 * kt + crow(r, hh))); }
                sort16_desc(kk[kt]); }
            merge_top16(kk[0], kk[1]); merge_top16(kk[2], kk[3]); merge_top16(kk[0], kk[2]);
            int pp[16];
#pragma unroll
            for (int i = 0; i < 16; ++i) pp[i] = __shfl_xor(kk[0][i], 32);
            merge_top16(kk[0], pp);
#pragma unroll
            for (int i = 0; i < 16; ++i) KS[c][i] = kk[0][i];
        }
        float fa[16], fb[16];
        { unsigned wa[4], wb[4];
#pragma unroll
            for (int i = 0; i < 4; ++i) { wa[i] = 0u; wb[i] = 0u; }
#pragma unroll
            for (int i = 0; i < 16; ++i) { const unsigned ua = (unsigned)f2key((unsigned)KS[0][i]), ub = (unsigned)f2key((unsigned)KS[1][i]);
                fa[i] = __builtin_bit_cast(float, ua & ~0x7Fu); fb[i] = __builtin_bit_cast(float, ub & ~0x7Fu);
                wa[i >> 2] |= (ua & 0x7Fu) << (8 * (i & 3)); wb[i >> 2] |= (ub & 0x7Fu) << (8 * (i & 3)); }
            *(LAS u32x4*)ib = (u32x4){wa[0], wa[1], wa[2], wa[3]}; *(LAS u32x4*)(ib + 16) = (u32x4){wb[0], wb[1], wb[2], wb[3]}; }
        int cv[4][16];
#pragma unroll
        for (int q = 0; q < 64; ++q) {
            if (q < CT.n) { const float sum = fa[CT.i[q]] + fb[CT.j[q]]; cv[q >> 4][q & 15] = f2key((__builtin_bit_cast(unsigned, sum) & ~0xFFu) | (unsigned)(CT.i[q] * 16 + CT.j[q])); }
            else cv[q >> 4][q & 15] = (int)0x80000000;
        }
#pragma unroll
        for (int gq = 0; gq < 4; ++gq) sort16_desc(cv[gq]);
        merge_top16(cv[0], cv[1]); merge_top16(cv[2], cv[3]); merge_top16(cv[0], cv[2]);
        asm volatile("s_waitcnt lgkmcnt(0)" ::: "memory");
        int ex[16]; float gv[16]; float den = 0.f; float v0 = 0.f;
#pragma unroll
        for (int k = 0; k < 16; ++k) { const unsigned ub = (unsigned)f2key((unsigned)cv[0][k]); const float val = __builtin_bit_cast(float, ub & ~0xFFu); const unsigned ij = ub & 0xFFu;
            if (k == 0) v0 = val;
            const int n1 = ib[ij >> 4], n2 = ib[16 + (ij & 15u)];
            ex[k] = n1 * NKEYS + n2; gv[k] = __expf(r2 * (val - v0)); den += gv[k]; }
        const float rden = 1.0f / den;
        int hq = hh; asm volatile("" : "+v"(hq));
        float* gp = (float*)(ws + WS_GW) + (unsigned)(t * 128 + h * 16 + 8 * hq);
        int e8[8]; float g8[8];
#pragma unroll
        for (int k = 0; k < 8; ++k) { const int msk = -hh;
            e8[k] = (ex[8 + k] & msk) | (ex[k] & ~msk);
            g8[k] = __builtin_bit_cast(float, (__builtin_bit_cast(int, gv[8 + k]) & msk) | (__builtin_bit_cast(int, gv[k]) & ~msk)) * rden; }
        *(u32x4*)((unsigned short*)(ws + WS_IDX16) + (unsigned)(t * 128 + h * 16 + 8 * hq)) = (u32x4){(unsigned)e8[0] | ((unsigned)e8[1] << 16), (unsigned)e8[2] | ((unsigned)e8[3] << 16), (unsigned)e8[4] | ((unsigned)e8[5] << 16), (unsigned)e8[6] | ((unsigned)e8[7] << 16)};
        *(f32x4*)gp = (f32x4){g8[0], g8[1], g8[2], g8[3]}; *(f32x4*)(gp + 4) = (f32x4){g8[4], g8[5], g8[6], g8[7]};
        }
        __syncthreads();
    }
    if (conv) for (; cvn < 2 * NEXP / 4; cvn += NCW) expert_rows4(P, 4 * cvn, lane);
}

struct Args { Ptrs P; int ph_lo, ph_hi, li, pad; };
constexpr int NPH = 9;
__global__ void __launch_bounds__(NWAVES * 64, 2) fwd(Args a) {
    extern __shared__ __attribute__((aligned(16))) unsigned char lds_raw[];
    LAS unsigned char* lds = (LAS unsigned char*)lds_raw;
    volatile LAS unsigned* MISC = (volatile LAS unsigned*)(lds + MISC_OFF);
    const Ptrs& P = a.P;
    unsigned char* ws = P.ws;
    const int tid = threadIdx.x, lane = tid & 63, wave = __builtin_amdgcn_readfirstlane(tid >> 6);
    const int G = gridDim.x, bx = blockIdx.x, vcu = (G % 8 == 0) ? (bx % 8) * (G / 8) + bx / 8 : bx;
    if (tid < 32) MISC[tid] = 0u;
    __syncthreads();
    unsigned* ctl = (unsigned*)(ws + WS_CTL);
    XcdBarrier bar = xcd_barrier_post(ctl + CW_BAR + a.li * XCD_BAR_WORDS, MISC + 8);
    const int lo = a.ph_lo, hi = a.ph_hi;
#define IN(k) (lo <= (k) && (k) < hi)
#define SEAM(k) do { if (IN(k) && IN((k) + 1)) xcd_barrier(bar); } while (0)
    const int gw = vcu * NWAVES + wave, NGW = G * NWAVES;

    if (IN(0)) { p0_prep(P, gw, NGW, lane, (LAS float*)(lds + wave * 16384)); }
    SEAM(0);
    if (IN(1)) { {
        pg8::Gemm g{(const bf16*)(ws + WS_XBF), (const bf16*)(ws + WS_WINT), T, NIN, D}; pg8::StaticOrder S; S.init(T, NIN, G, bx);
        pg8::EpiRowBf16 E{(bf16*)(ws + WS_PROJ), NIN, nullptr};
        pg8::gemm_phase<pg8::EpiRowBf16, pg8::StaticOrder, true, true>(lds, g, S, E);
    } }
    SEAM(1);
    if (IN(2)) { p2_mixer_a(P, lds, MISC, ctl, tid, lane, wave, gw, NGW); xcd_barrier(bar); p2_mixer_b(P, lds, bx, G, tid, lane, wave); }
    SEAM(2);
    if (IN(3)) {
        pg8::Gemm g{(const bf16*)(ws + WS_MIX), (const bf16*)(ws + WS_WOUTT), T, D, D}; pg8::StaticOrder S; S.init(T, D, G, bx);
        LAS pg8::f32x2v* rsl = (LAS pg8::f32x2v*)(lds + RS_OFF); LAS float* rxl = (LAS float*)(lds + RS_OFF + 2048);
        pg8::Unit u;
        for (int round = 0; S.next(round, u); ++round) {
            if (tid < 256) { const int row = u.pm * 256 + tid; const float* sl = (const float*)(ws + WS_SSQL) + (size_t)row * 8; const float* sa = (const float*)(ws + WS_SSQA) + (size_t)row * 8;
                const f32x4 l0 = *(const f32x4*)sl, l1 = *(const f32x4*)(sl + 4), a0 = *(const f32x4*)sa, a1 = *(const f32x4*)(sa + 4);
                const float sL = ((l0.x + l0.y) + (l0.z + l0.w)) + ((l1.x + l1.y) + (l1.z + l1.w)), sA = ((a0.x + a0.y) + (a0.z + a0.w)) + ((a1.x + a1.y) + (a1.z + a1.w));
                const float rl = __builtin_amdgcn_rsqf(sL * (1.0f / LRU_W) + EPS), ra = __builtin_amdgcn_rsqf(sA * (1.0f / ATT_W) + EPS);
                rsl[tid] = (pg8::f32x2v){rl * __builtin_amdgcn_rcpf(ra), ra}; rxl[tid] = __builtin_amdgcn_rcpf(((const float*)(ws + WS_R1X))[row]); }
            __syncthreads();
            pg8::OneUnit S1{u};
            pg8::EpiOut E{(const bf16*)(ws + WS_XBF), P.out, (bf16*)(ws + WS_X1BF), (float*)(ws + WS_SSQ2), rsl, rxl};
            pg8::gemm_phase<pg8::EpiOut, pg8::OneUnit, false, true>(lds, g, S1, E);
            __syncthreads();
        }
    }
    SEAM(3);
    if (IN(4)) { {
        pg8::Gemm g{(const bf16*)(ws + WS_X1BF), (const bf16*)(ws + WS_WQT), T, NQ, D}; pg8::StaticOrder S; S.init(T, NQ, G, bx);
        pg8::EpiRowBf16 E{(bf16*)(ws + WS_Q), NQ, nullptr};
        pg8::gemm_phase<pg8::EpiRowBf16, pg8::StaticOrder, true, true>(lds, g, S, E);
    } }
    if (IN(5)) { pg8::StaticOrder S; S.init(T, NQ, G, bx); p5_topk(P, lds, S, tid, lane, wave, gw, NGW); }
    SEAM(5);
    if (IN(6)) { if (G == 256) p6_u3(P, lds, bx, lane, wave); else p6_sliced<0>(P, lds, MISC, ctl, tid, lane, wave); }
    SEAM(6);
    if (IN(7)) { p6_combine(P, bx * (NWAVES * 64) + tid, G * NWAVES * 64); }
    SEAM(7);
    if (IN(8)) { if (G == 256) p6_v3(P, lds, bx, lane, wave); else p6_v2(P, MISC, ctl, tid, lane, wave); }
#undef IN
#undef SEAM
}

extern "C" void kernel_launch(void* const* d_in, const int* in_sizes, int n_in, void* d_out, int out_size, void* d_ws, size_t ws_size, hipStream_t stream) {
    static int grid = 0;
    if (grid == 0) {
        if (n_in != 22 || out_size != T * D || ws_size < WS_END) { fprintf(stderr, "kernel_launch: unexpected shapes (n_in %d, out %d, ws %zu)\n", n_in, out_size, ws_size); grid = -1; return; }
        int dev = 0, cus = 0, per_cu = 0;
        if (hipGetDevice(&dev) != hipSuccess || hipDeviceGetAttribute(&cus, hipDeviceAttributeMultiprocessorCount, dev) != hipSuccess) { grid = -1; return; }
        if (hipFuncSetAttribute((const void*)fwd, hipFuncAttributeMaxDynamicSharedMemorySize, LDS_BYTES) != hipSuccess) { fprintf(stderr, "kernel_launch: hipFuncSetAttribute failed\n"); grid = -1; return; }
        if (hipOccupancyMaxActiveBlocksPerMultiprocessor(&per_cu, (const void*)fwd, NWAVES * 64, LDS_BYTES) != hipSuccess || per_cu < 1) fprintf(stderr, "kernel_launch: occupancy query says %d\n", per_cu);
        (void)hipGetLastError();
        grid = cus;
        if (grid != 256) fprintf(stderr, "kernel_launch: %d CUs (built for 256)\n", grid);
    }
    if (grid < 0) return;
    Ptrs P{};
    const float** pp = (const float**)&P;
    for (int i = 0; i < 22; ++i) pp[i] = (const float*)d_in[i];
    P.out = (float*)d_out; P.ws = (unsigned char*)d_ws;
    unsigned char* ws = P.ws;
    (void)hipMemsetAsync(ws + WS_CTL, 0, CTL_BYTES, stream);
    Args a{}; a.P = P;
    int li = 0;
#define FWD(lo_, hi_) do { a.ph_lo = (lo_); a.ph_hi = (hi_); a.li = li++; hipLaunchKernelGGL(fwd, dim3(grid), dim3(NWAVES * 64), LDS_BYTES, stream, a); } while (0)
    FWD(0, NPH);
}
```

```cpp
#include <hip/hip_runtime.h>
#include <cstdio>
#include <cstdint>

#define LAS __attribute__((address_space(3)))
typedef unsigned short bf16;
typedef short bf16x8 __attribute__((ext_vector_type(8)));
typedef float f32x4 __attribute__((ext_vector_type(4)));
typedef unsigned u32x4 __attribute__((ext_vector_type(4)));
typedef unsigned u32x2 __attribute__((ext_vector_type(2)));

constexpr int D = 1024, BATCH = 8, SEQ = 2048, T = BATCH * SEQ;
constexpr int LRU_W = 512, NBLK = 8, BLK = 64;
constexpr int NH = 8, NKV = 2, HD = 64, ATT_W = 512, KV_W = 128, WIN = 128;
constexpr int PH = 8, NKEYS = 128, DQ = 256, DHALF = 128, TOPK = 16, NEXP = NKEYS * NKEYS;
constexpr int NIN = 1792, NQ = PH * DQ;
constexpr int C_XB = 0, C_GB = 512, C_Q = 1024, C_K = 1536, C_V = 1664;
constexpr float EPS = 1e-6f;

constexpr size_t MiB = 1u << 20;
constexpr size_t WS_CTL = 0, CTL_BYTES = 1 * MiB;
constexpr size_t WS_WINT = 1 * MiB;
constexpr size_t WS_WOUTT = 5 * MiB;
constexpr size_t WS_WQT = 7 * MiB;
constexpr size_t WS_SKB = 11 * MiB;
constexpr size_t WS_WGT = 11 * MiB + 512 * 1024;
constexpr size_t WS_BL = 11 * MiB + 768 * 1024;
constexpr size_t WS_SUS = 11 * MiB + 832 * 1024;
constexpr size_t WS_SVS = 11 * MiB + 896 * 1024;
constexpr size_t WS_R1 = 12 * MiB;
constexpr size_t WS_R1X = 12 * MiB + 64 * 1024;
constexpr size_t WS_R2 = 12 * MiB + 256 * 1024;
constexpr size_t WS_SSQL = 12 * MiB + 512 * 1024;
constexpr size_t WS_SSQA = 13 * MiB;
constexpr size_t WS_SSQ2 = 13 * MiB + 512 * 1024;
constexpr size_t WS_EU = 16 * MiB;
constexpr size_t WS_EV = 48 * MiB;
constexpr size_t WS_X1BF = 80 * MiB;
constexpr size_t WS_MIX = 112 * MiB;
constexpr size_t WS_IDX = 144 * MiB;
constexpr size_t WS_GW = 152 * MiB;
constexpr size_t WS_XBF = 160 * MiB;
constexpr size_t WS_PROJ = 192 * MiB;
constexpr size_t WS_Q = 160 * MiB;
constexpr size_t WS_IDX16 = 240 * MiB;
constexpr size_t WS_W = 232 * MiB;
constexpr size_t WS_PART = 160 * MiB;
constexpr size_t WS_END = 248 * MiB;

__device__ __forceinline__ unsigned f2bf(float f) { unsigned u = __builtin_bit_cast(unsigned, f); return (u + 0x7fffu + ((u >> 16) & 1u)) >> 16; }
__device__ __forceinline__ unsigned pk2(float lo, float hi) { return f2bf(lo) | (f2bf(hi) << 16); }
__device__ __forceinline__ float bf2f(unsigned short b) { return __builtin_bit_cast(float, ((unsigned)b) << 16); }
__device__ __forceinline__ float bflo(unsigned w) { return __builtin_bit_cast(float, w << 16); }
__device__ __forceinline__ float bfhi(unsigned w) { return __builtin_bit_cast(float, w & 0xffff0000u); }
__device__ __forceinline__ float wave_sum(float v) {
#pragma unroll
    for (int o = 1; o < 64; o <<= 1) v += __shfl_xor(v, o);
    return v;
}
__device__ __forceinline__ float gelu_tanh(float x) {
    const float u = 0.7978845608028654f * (x + 0.044715f * x * x * x);
    return x * __builtin_amdgcn_rcpf(1.0f + __expf(-2.0f * u));
}
__device__ __forceinline__ float sigmoidf(float z) { return __builtin_amdgcn_rcpf(1.0f + __expf(-z)); }
typedef int i32x4 __attribute__((ext_vector_type(4)));
#define DPP_I(v, ctrl) __builtin_amdgcn_update_dpp(0, (v), (ctrl), 0xf, 0xf, true)
#define DPP_F(v, ctrl) __builtin_bit_cast(float, __builtin_amdgcn_update_dpp(0, __builtin_bit_cast(int, (v)), (ctrl), 0xf, 0xf, true))
__device__ __forceinline__ int t5_bucket(int n) {
    if (n < 16) return n;
    const int th[15] = {19, 21, 24, 27, 31, 35, 40, 46, 52, 59, 67, 77, 87, 99, 113};
    int b = 16;
#pragma unroll
    for (int i = 0; i < 15; ++i) b += (n >= th[i]) ? 1 : 0;
    return b;
}

struct Ptrs {
    const float *x, *ln_mix_g, *w_in, *conv_w, *conv_b, *w_gate_a, *b_gate_a, *w_gate_x, *b_gate_x, *lru_L, *q_norm_g, *k_norm_g, *sinks, *lru_out_g, *attn_out_g, *w_out, *ln_ffn_g, *w_query, *sub_keys, *expert_u, *expert_v, *rel_bias;
    float* out; unsigned char* ws;
};

__device__ __forceinline__ float row_to_bf16(const float* src, const float* g, bf16* dst, int lane) {
    float ss = 0.f;
#pragma unroll
    for (int j = 0; j < 4; ++j) {
        f32x4 v = *(const f32x4*)(src + 4 * lane + 256 * j);
        ss += (v.x * v.x + v.y * v.y) + (v.z * v.z + v.w * v.w);
        if (g) { const f32x4 gg = *(const f32x4*)(g + 4 * lane + 256 * j); v = v * gg; }
        u32x2 o; o.x = pk2(v.x, v.y); o.y = pk2(v.z, v.w);
        *(u32x2*)(dst + 4 * lane + 256 * j) = o;
    }
    return ss;
}
constexpr float FP8_SU = 256.0f, FP8_SV = 64.0f;
__device__ __forceinline__ void row_to_fp8(const float* src, const float* g, float scale, unsigned char* dst, int lane) {
    u32x4 o;
#pragma unroll
    for (int j = 0; j < 4; ++j) {
        f32x4 v = *(const f32x4*)(src + 16 * lane + 4 * j);
        if (g) { const f32x4 gg = *(const f32x4*)(g + 16 * lane + 4 * j); v = v * gg; }
        v = v * scale;
        int w = 0; w = __builtin_amdgcn_cvt_pk_fp8_f32(v.x, v.y, w, false); w = __builtin_amdgcn_cvt_pk_fp8_f32(v.z, v.w, w, true);
        o[j] = (unsigned)w;
    }
    *(u32x4*)(dst + 16 * lane) = o;
}
__device__ __forceinline__ void expert_rows4(const Ptrs& P, int r0, int lane);
constexpr size_t SLICE_BYTES = (size_t)NEXP * 128;
__device__ __forceinline__ void row_to_fp8_sliced(const float* src, const float* g, float scale, unsigned char* base, int e, int lane) {
    u32x4 o;
#pragma unroll
    for (int j = 0; j < 4; ++j) {
        f32x4 v = *(const f32x4*)(src + 16 * lane + 4 * j) * scale;
        if (g) v = v * *(const f32x4*)(g + 16 * lane + 4 * j);
        int w = 0; w = __builtin_amdgcn_cvt_pk_fp8_f32(v.x, v.y, w, false); w = __builtin_amdgcn_cvt_pk_fp8_f32(v.z, v.w, w, true);
        o[j] = (unsigned)w;
    }
    *(u32x4*)(base + (size_t)(lane >> 3) * SLICE_BYTES + (size_t)e * 128 + 16 * (lane & 7)) = o;
}
__device__ __forceinline__ float wave_max_u(float v) {
    v = fmaxf(v, DPP_F(v, 0xB1)); v = fmaxf(v, DPP_F(v, 0x4E)); v = fmaxf(v, DPP_F(v, 0x141)); v = fmaxf(v, DPP_F(v, 0x140));
    const int i = __builtin_bit_cast(int, v);
    return fmaxf(fmaxf(__builtin_bit_cast(float, __builtin_amdgcn_readlane(i, 0)), __builtin_bit_cast(float, __builtin_amdgcn_readlane(i, 16))),
                 fmaxf(__builtin_bit_cast(float, __builtin_amdgcn_readlane(i, 32)), __builtin_bit_cast(float, __builtin_amdgcn_readlane(i, 48))));
}
struct ExpRows {
    f32x4 v[4][4]; int r0;
    __device__ __forceinline__ void load(const Ptrs& P, int r0_, int lane_) {
        r0 = r0_; int lane = lane_; asm volatile("" : "+v"(lane));
        const bool isv = r0 >= NEXP; const int e0 = isv ? r0 - NEXP : r0;
        const float* src = (isv ? P.expert_v : P.expert_u) + (size_t)e0 * D + 16 * lane;
#pragma unroll
        for (int k = 0; k < 4; ++k)
#pragma unroll
            for (int j = 0; j < 4; ++j) v[k][j] = *(const f32x4*)(src + (size_t)k * D + 4 * j);
    }
    __device__ __forceinline__ void finish(const Ptrs& P, int lane_) {
        int lane = lane_; asm volatile("" : "+v"(lane));
        const bool isv = r0 >= NEXP; const int e0 = isv ? r0 - NEXP : r0;
        unsigned char* base = P.ws + (isv ? WS_EV : WS_EU) + (size_t)(lane >> 3) * SLICE_BYTES + 16 * (lane & 7);
        f32x4 g[4];
        if (!isv) {
#pragma unroll
            for (int j = 0; j < 4; ++j) g[j] = *(const f32x4*)(P.ln_ffn_g + 16 * lane + 4 * j); }
        float* scl = (float*)(P.ws + WS_SUS) + (isv ? 1 : 0);
#pragma unroll
        for (int k = 0; k < 4; ++k) { float m = 0.f;
#pragma unroll
            for (int j = 0; j < 4; ++j) { if (!isv) v[k][j] = v[k][j] * g[j]; m = fmaxf(m, fmaxf(fmaxf(fabsf(v[k][j].x), fabsf(v[k][j].y)), fmaxf(fabsf(v[k][j].z), fabsf(v[k][j].w)))); }
            m = fmaxf(wave_max_u(m), 1e-30f);
            const float inv = 127.0f * __builtin_amdgcn_rcpf(m);
            if (lane == 0) scl[2 * (e0 + k)] = m * (1.0f / 127.0f);
            u32x4 o;
#pragma unroll
            for (int j = 0; j < 4; ++j) { const int q0 = (int)rintf(v[k][j].x * inv), q1 = (int)rintf(v[k][j].y * inv), q2 = (int)rintf(v[k][j].z * inv), q3 = (int)rintf(v[k][j].w * inv);
                o[j] = (unsigned)(q0 & 0xff) | ((unsigned)(q1 & 0xff) << 8) | ((unsigned)(q2 & 0xff) << 16) | ((unsigned)q3 << 24); }
            *(u32x4*)(base + (size_t)(e0 + k) * 128) = o; }
    }
};
__device__ __forceinline__ void expert_rows4(const Ptrs& P, int r0, int lane) { ExpRows A; A.load(P, r0, lane); A.finish(P, lane); }
__device__ __forceinline__ void transpose_item(const float* W, int K, int N, const float* g0, const float* g1, int gsplit, bf16* WT, LAS float* scr, int item, int lane) {
    const int nblk = N / 32, kb = item / nblk, nb = item % nblk, k0 = 64 * kb, n0 = 32 * nb;
#pragma unroll
    for (int i = 0; i < 32; ++i) { const int kk = 2 * i + (lane >> 5); const int k = k0 + kk; const float gk = (k < gsplit) ? g0[k] : g1[k - gsplit];
        scr[kk * 33 + (lane & 31)] = W[(size_t)k * N + n0 + (lane & 31)] * gk; }
    asm volatile("s_waitcnt lgkmcnt(0)" ::: "memory");
    const int c = lane & 7;
#pragma unroll
    for (int j = 0; j < 4; ++j) { const int n = (lane >> 3) + 8 * j; const LAS float* s = scr + (8 * c) * 33 + n;
        u32x4 o; o.x = pk2(s[0 * 33], s[1 * 33]); o.y = pk2(s[2 * 33], s[3 * 33]); o.z = pk2(s[4 * 33], s[5 * 33]); o.w = pk2(s[6 * 33], s[7 * 33]);
        *(u32x4*)(WT + (size_t)(n0 + n) * K + k0 + 8 * c) = o; }
    asm volatile("s_waitcnt lgkmcnt(0)" ::: "memory");
}
__device__ __forceinline__ void p0_prep(const Ptrs& P, int gw, int NGW, int lane, LAS float* scr) {
    unsigned char* ws = P.ws;
    constexpr int I_IN = (D / 64) * (NIN / 32), I_OUT = (D / 64) * (D / 32), I_Q = (D / 64) * (NQ / 32);
    for (int it = gw; it < I_IN + I_OUT + I_Q; it += NGW) {
        int r = it;
        if (r < I_IN) { transpose_item(P.w_in, D, NIN, P.ln_mix_g, P.ln_mix_g, D, (bf16*)(ws + WS_WINT), scr, r, lane); continue; } r -= I_IN;
        if (r < I_OUT) { transpose_item(P.w_out, D, D, P.lru_out_g, P.attn_out_g, LRU_W, (bf16*)(ws + WS_WOUTT), scr, r, lane); continue; } r -= I_OUT;
        transpose_item(P.w_query, D, NQ, P.ln_ffn_g, P.ln_ffn_g, D, (bf16*)(ws + WS_WQT), scr, r, lane);
    }
    for (int r0 = gw * 4; r0 < T; r0 += NGW * 4) {
        f32x4 v[4][4];
#pragma unroll
        for (int k = 0; k < 4; ++k)
#pragma unroll
            for (int j = 0; j < 4; ++j) v[k][j] = *(const f32x4*)(P.x + (size_t)(r0 + k) * D + 4 * lane + 256 * j);
#pragma unroll
        for (int k = 0; k < 4; ++k) { float ss = 0.f;
#pragma unroll
            for (int j = 0; j < 4; ++j) ss += (v[k][j].x * v[k][j].x + v[k][j].y * v[k][j].y) + (v[k][j].z * v[k][j].z + v[k][j].w * v[k][j].w);
            const float r1 = __builtin_amdgcn_rsqf(wave_sum(ss) * (1.0f / D) + EPS);
            if (lane == 0) ((float*)(ws + WS_R1X))[r0 + k] = r1;
            bf16* dst = (bf16*)(ws + WS_XBF) + (size_t)(r0 + k) * D;
#pragma unroll
            for (int j = 0; j < 4; ++j) { u32x2 o; o.x = pk2(v[k][j].x * r1, v[k][j].y * r1); o.y = pk2(v[k][j].z * r1, v[k][j].w * r1); *(u32x2*)(dst + 4 * lane + 256 * j) = o; } }
    }
    for (int e = gw; e < 256; e += NGW) (void)row_to_bf16(P.sub_keys + (size_t)e * D, nullptr, (bf16*)(ws + WS_SKB) + (size_t)e * D, lane);
    for (int e = gw * 64 + lane; e < 2 * NBLK * BLK * BLK + NH * WIN; e += NGW * 64) {
        if (e < 2 * NBLK * BLK * BLK) { const int g = e / (NBLK * BLK * BLK), r = e % (NBLK * BLK * BLK), n = r / (BLK * BLK), j = (r / BLK) % BLK, i = r % BLK;
            const float* W = g ? P.w_gate_x : P.w_gate_a;
            ((bf16*)(ws + WS_WGT))[e] = (bf16)f2bf(W[(size_t)n * BLK * BLK + i * BLK + j]); }
        else { const int q = e - 2 * NBLK * BLK * BLK, h = q / WIN, rel = q % WIN;
            ((float*)(ws + WS_BL))[q] = P.rel_bias[t5_bucket(rel) * NH + h]; }
    }
}
namespace pg8 {
typedef unsigned short bf16_t;
constexpr int BM = 256, BK = 64, HALF = 128, HTB = HALF * BK * 2  , STAGE_BYTES = 8 * HTB, NXCD = 8, WGM = 2;
__host__ __device__ __forceinline__ int lds_byte(int r, int c) { const int st = (r >> 4) * 2 + (c >> 5), rr = r & 15, cc = c & 31, ob = rr * 64 + cc * 2; return st * 1024 + (ob ^ (((ob >> 9) & 1) << 5)); }
__host__ __device__ __forceinline__ void stage_rc(int b, int& R, int& C) { const int st = b / 1024, sb = b % 1024, swz = sb ^ (((sb >> 9) & 1) << 5); R = (st >> 1) * 16 + swz / 64; C = (st & 1) * 32 + (swz % 64) / 2; }
__host__ __device__ __forceinline__ int perm32(int rho) { const int n = rho >> 4, i = rho & 15; return 8 * (i >> 2) + 4 * n + (i & 3); }
struct Unit { int pm, pn; };
struct Gemm { const bf16_t* A; const bf16_t* Bt; int M, N, K; };
struct StaticOrder {
    int nM, nN, nwg, G, c;
    __host__ __device__ void init(int M, int N, int G_, int c_) { nM = M / BM; nN = N / BM; nwg = nM * nN; G = G_; c = c_; }
    __host__ __device__ bool next(int i, Unit& u) const {
        const long L = (long)i * G + c; if (L >= nwg) return false;
        int wgid = (int)L; { const int q = nwg / NXCD, r = nwg % NXCD, xcd = wgid % NXCD, off = wgid / NXCD; wgid = (xcd < r ? xcd * (q + 1) : r * (q + 1) + (xcd - r) * q) + off; }
        const int nig = WGM * nN, gid = wgid / nig, fm = gid * WGM, gsz = (nM - fm) < WGM ? (nM - fm) : WGM;
        u.pm = fm + ((wgid % nig) % gsz); u.pn = (wgid % nig) / gsz; return true;
    }
    __device__ __forceinline__ void a_ready(const Unit&) const {}
    __device__ __forceinline__ void done(const Unit&) const {}
};
struct OneUnit {
    Unit u;
    __device__ __forceinline__ bool next(int i, Unit& o) const { if (i != 0) return false; o = u; return true; }
    __device__ __forceinline__ void a_ready(const Unit&) const {}
    __device__ __forceinline__ void done(const Unit&) const {}
};
__device__ __forceinline__ unsigned cvt_pk_bf16(float lo, float hi) { unsigned r; asm volatile("v_cvt_pk_bf16_f32 %0, %1, %2" : "=v"(r) : "v"(lo), "v"(hi)); return r; }

struct EpiRowBf16 {
    static constexpr bool PERM = true, MID = false;
    bf16_t* O; int ldc; const float* rs;
    __device__ __forceinline__ void mid(f32x4 (&)[2][2][4][2], const Unit&, int, int, int, int) const {}
    __device__ __forceinline__ void operator()(const f32x4 (&acc)[2][2][4][2], const Unit& u, int wr, int wc, int fr, int fq) const {
        const int row0 = u.pm * BM + wr * 64 + fr, col0 = u.pn * BM + wc * 64 + 8 * fq;
#pragma unroll
        for (int ai = 0; ai < 2; ++ai)
#pragma unroll
            for (int m = 0; m < 4; ++m) { const int row = row0 + ai * HALF + m * 16; const float sc = rs ? rs[row] : 1.0f; bf16_t* rowp = O + (size_t)row * ldc + col0;
#pragma unroll
                for (int bj = 0; bj < 2; ++bj) { const f32x4 v0 = acc[ai][bj][m][0] * sc, v1 = acc[ai][bj][m][1] * sc;
                    u32x4 w; w.x = cvt_pk_bf16(v0[0], v0[1]); w.y = cvt_pk_bf16(v0[2], v0[3]); w.z = cvt_pk_bf16(v1[0], v1[1]); w.w = cvt_pk_bf16(v1[2], v1[3]);
                    *(u32x4*)(rowp + bj * 32) = w; } }
    }
};
typedef float f32x2v __attribute__((ext_vector_type(2)));
struct EpiOut {
    static constexpr bool PERM = true, MID = true;
    const bf16_t* xbf; float* x1; bf16_t* x1bf; float* ssq2; const LAS f32x2v* rsl; const LAS float* rxl;
    __device__ __forceinline__ void mid(f32x4 (&acc)[2][2][4][2], const Unit&, int wr, int, int fr, int) const {
#pragma unroll
        for (int ai = 0; ai < 2; ++ai)
#pragma unroll
            for (int m = 0; m < 4; ++m) { const float ratio = rsl[ai * HALF + wr * 64 + m * 16 + fr].x;
#pragma unroll
                for (int bj = 0; bj < 2; ++bj)
#pragma unroll
                    for (int n = 0; n < 2; ++n) acc[ai][bj][m][n] = acc[ai][bj][m][n] * ratio; }
    }
    __device__ __forceinline__ void operator()(const f32x4 (&acc)[2][2][4][2], const Unit& u, int wr, int wc, int fr, int fq) const {
        const int col0 = u.pn * BM + wc * 64 + 8 * fq;
#pragma unroll
        for (int ai = 0; ai < 2; ++ai) {
            u32x4 xw[4][2];
#pragma unroll
            for (int m = 0; m < 4; ++m) { const size_t off = (size_t)(u.pm * BM + ai * HALF + wr * 64 + m * 16 + fr) * D + col0;
#pragma unroll
                for (int bj = 0; bj < 2; ++bj) xw[m][bj] = *(const u32x4*)(xbf + off + bj * 32); }
#pragma unroll
            for (int m = 0; m < 4; ++m) { const int r = ai * HALF + wr * 64 + m * 16 + fr; const float ratt = rsl[r].y, rx = rxl[r]; const int row = u.pm * BM + r; const size_t off = (size_t)row * D + col0; float ss = 0.f;
#pragma unroll
                for (int bj = 0; bj < 2; ++bj) { u32x4 w;
#pragma unroll
                    for (int n = 0; n < 2; ++n) { const unsigned wx = xw[m][bj][2 * n], wy = xw[m][bj][2 * n + 1];
                        const f32x4 xs = (f32x4){__builtin_bit_cast(float, wx << 16), __builtin_bit_cast(float, wx & 0xffff0000u), __builtin_bit_cast(float, wy << 16), __builtin_bit_cast(float, wy & 0xffff0000u)} * rx;
                        const f32x4 o = xs + acc[ai][bj][m][n] * ratt;
                        w[2 * n] = cvt_pk_bf16(o[0], o[1]); w[2 * n + 1] = cvt_pk_bf16(o[2], o[3]);
                        ss += (o[0] * o[0] + o[1] * o[1]) + (o[2] * o[2] + o[3] * o[3]); }
                    *(u32x4*)(x1bf + off + bj * 32) = w; }
                ss += __shfl_xor(ss, 16); ss += __shfl_xor(ss, 32);
                if (fq == 0) ssq2[(size_t)row * 16 + u.pn * 4 + wc] = ss; }
        }
    }
};

template <class Epi, class Sched, bool ALIGN_EPI = false, bool SP2 = false>
__device__ __forceinline__ void gemm_phase(LAS unsigned char* lds, const Gemm g, const Sched& S, const Epi& E) {
    const int tid = threadIdx.x, wid = __builtin_amdgcn_readfirstlane(tid >> 6), lane = tid & 63, wr = wid >> 2, wc = wid & 3, fr = lane & 15, fq = lane >> 4;
    const int K = g.K, nt = K / BK;
    unsigned voffA[2], voffB[2];
#pragma unroll
    for (int i = 0; i < 2; ++i) { int R, C; stage_rc(tid * 16 + i * 8192, R, C); const int Rb = Epi::PERM ? (64 * (R >> 5) + perm32(R & 31)) : R;
        voffA[i] = (unsigned)(R * K + C) * 2u; voffB[i] = (unsigned)(Rb * K + C) * 2u; }
    const size_t kstep = (size_t)(BK * 2);
    const size_t hstep = (size_t)HALF * K * 2;
    const size_t hstepB = Epi::PERM ? (size_t)32 * K * 2 : hstep;
    const size_t tstep = 2 * hstep;
    const unsigned ldsw = (unsigned)wid * 1024u;
    const int aoff = lds_byte(wr * 64 + fr, fq * 8), boff = lds_byte(wc * 32 + fr, fq * 8);
#define PG8_SA(b, h) (((b) * 2 + (h)) * HTB)
#define PG8_SB(b, h) ((4 + (b) * 2 + (h)) * HTB)
#define PG8_STAGE(bufoff, gbase, voff) do { _Pragma("unroll") for (int _i = 0; _i < 2; ++_i) \
        __builtin_amdgcn_global_load_lds((const unsigned*)((const char*)(gbase) + (voff)[_i]), (LAS unsigned*)(lds + (bufoff) + ldsw + _i * 8192), 16, 0, 0); } while (0)
#define PG8_LDA(dst, b, h) do { _Pragma("unroll") for (int m = 0; m < 4; ++m) _Pragma("unroll") for (int k = 0; k < 2; ++k) dst[m][k] = *(const LAS bf16x8*)(lds + PG8_SA(b, h) + aoff + m * 2048 + k * 1024); } while (0)
#define PG8_LDB(dst, b, h) do { _Pragma("unroll") for (int n = 0; n < 2; ++n) _Pragma("unroll") for (int k = 0; k < 2; ++k) dst[n][k] = *(const LAS bf16x8*)(lds + PG8_SB(b, h) + boff + n * 2048 + k * 1024); } while (0)
#define PG8_MMA(ai, bj, At, Bt) do { __builtin_amdgcn_s_setprio(1); _Pragma("unroll") for (int m = 0; m < 4; ++m) _Pragma("unroll") for (int n = 0; n < 2; ++n) _Pragma("unroll") for (int k = 0; k < 2; ++k) \
        acc[ai][bj][m][n] = __builtin_amdgcn_mfma_f32_16x16x32_bf16(Bt[n][k], At[m][k], acc[ai][bj][m][n], 0, 0, 0); __builtin_amdgcn_s_setprio(0); } while (0)
#define PG8_WAIT_V(n) asm volatile("s_waitcnt vmcnt(" #n ")" ::: "memory")
#define PG8_WAIT_L(n) asm volatile("s_waitcnt lgkmcnt(" #n ")" ::: "memory")
#define PG8_BAR __builtin_amdgcn_s_barrier()
#define PG8_SCHED __builtin_amdgcn_sched_barrier(0)
    Unit cur, nxt; int ui = 0;
    if (!S.next(0, cur)) return;
    f32x4 acc[2][2][4][2];
#pragma unroll
    for (int a = 0; a < 2; ++a)
#pragma unroll
        for (int b = 0; b < 2; ++b)
#pragma unroll
            for (int m = 0; m < 4; ++m)
#pragma unroll
                for (int n = 0; n < 2; ++n) acc[a][b][m][n] = (f32x4){0.f, 0.f, 0.f, 0.f};
    bf16x8 At[4][2], B0[2][2], B1[2][2];
    const char* cA = (const char*)g.A + (size_t)cur.pm * tstep; const char* cB = (const char*)g.Bt + (size_t)cur.pn * tstep;
    S.a_ready(cur);
    if constexpr (SP2) {
        PG8_STAGE(PG8_SB(0, 0), cB, voffB); PG8_STAGE(PG8_SB(0, 1), cB + hstepB, voffB); PG8_STAGE(PG8_SA(0, 0), cA, voffA); PG8_STAGE(PG8_SA(0, 1), cA + hstep, voffA);
        if (wr == 1) PG8_BAR;
        PG8_WAIT_V(2); PG8_BAR;
        PG8_STAGE(PG8_SB(1, 0), cB + kstep, voffB); PG8_STAGE(PG8_SA(1, 0), cA + kstep, voffA); PG8_STAGE(PG8_SB(1, 1), cB + hstepB + kstep, voffB);
        PG8_WAIT_V(6); PG8_BAR;
    } else {
        PG8_STAGE(PG8_SB(0, 0), cB, voffB); PG8_STAGE(PG8_SA(0, 0), cA, voffA); PG8_STAGE(PG8_SB(0, 1), cB + hstepB, voffB); PG8_STAGE(PG8_SA(0, 1), cA + hstep, voffA);
        if (wr == 1) PG8_BAR;
        PG8_WAIT_V(4); PG8_BAR;
        PG8_STAGE(PG8_SB(1, 0), cB + kstep, voffB); PG8_STAGE(PG8_SA(1, 0), cA + kstep, voffA); PG8_STAGE(PG8_SB(1, 1), cB + hstepB + kstep, voffB);
        PG8_WAIT_V(6); PG8_BAR;
    }
    for (;;) {
        const bool has_next = S.next(ui + 1, nxt);
        const char* nA = has_next ? (const char*)g.A + (size_t)nxt.pm * tstep : cA; const char* nB = has_next ? (const char*)g.Bt + (size_t)nxt.pn * tstep : cB;
        for (int t = 0; t < nt; t += 2) {
            const bool last = (t == nt - 2);
            const char* a1 = cA + (size_t)(t + 1) * kstep;
            const char* a2 = last ? nA : cA + (size_t)(t + 2) * kstep; const char* b2 = last ? nB : cB + (size_t)(t + 2) * kstep;
            const char* a3 = a2 + kstep; const char* b3 = b2 + kstep;
            if (last && has_next) S.a_ready(nxt);
            if (Epi::MID && t == nt / 2) { E.mid(acc, cur, wr, wc, fr, fq); PG8_WAIT_L(0); PG8_SCHED; }
            if constexpr (SP2) {
            PG8_LDB(B0, 0, 0); PG8_LDB(B1, 0, 1); PG8_SCHED; PG8_LDA(At, 0, 0); PG8_STAGE(PG8_SA(1, 1), a1 + hstep, voffA);
            PG8_WAIT_V(8); PG8_WAIT_L(0); PG8_BAR; PG8_MMA(0, 0, At, B0); PG8_MMA(0, 1, At, B1); PG8_BAR; PG8_SCHED;
            PG8_LDA(At, 0, 1); PG8_STAGE(PG8_SB(0, 0), b2, voffB); PG8_STAGE(PG8_SB(0, 1), b2 + hstepB, voffB); PG8_STAGE(PG8_SA(0, 0), a2, voffA);
            PG8_WAIT_V(8); PG8_WAIT_L(0); PG8_BAR; PG8_MMA(1, 0, At, B0); PG8_MMA(1, 1, At, B1); PG8_BAR; PG8_SCHED;
            PG8_LDB(B0, 1, 0); PG8_LDB(B1, 1, 1); PG8_SCHED; PG8_LDA(At, 1, 0); PG8_STAGE(PG8_SA(0, 1), a2 + hstep, voffA);
            PG8_WAIT_V(8); PG8_WAIT_L(0); PG8_BAR; PG8_MMA(0, 0, At, B0); PG8_MMA(0, 1, At, B1); PG8_BAR; PG8_SCHED;
            PG8_LDA(At, 1, 1); PG8_STAGE(PG8_SB(1, 0), b3, voffB); PG8_STAGE(PG8_SB(1, 1), b3 + hstepB, voffB); PG8_STAGE(PG8_SA(1, 0), a3, voffA);
            PG8_WAIT_V(8); PG8_WAIT_L(0); PG8_BAR; PG8_MMA(1, 0, At, B0); PG8_MMA(1, 1, At, B1); PG8_BAR; PG8_SCHED;
            } else {
            PG8_LDB(B0, 0, 0); PG8_SCHED; PG8_LDA(At, 0, 0); PG8_STAGE(PG8_SA(1, 1), a1 + hstep, voffA);
            PG8_WAIT_L(8); PG8_BAR; PG8_WAIT_L(0); PG8_MMA(0, 0, At, B0); PG8_BAR; PG8_SCHED;
            PG8_LDB(B1, 0, 1); PG8_STAGE(PG8_SB(0, 0), b2, voffB);
            PG8_BAR; PG8_WAIT_L(0); PG8_MMA(0, 1, At, B1); PG8_BAR;
            PG8_LDA(At, 0, 1); PG8_STAGE(PG8_SA(0, 0), a2, voffA);
            PG8_BAR; PG8_WAIT_L(0); PG8_MMA(1, 0, At, B0); PG8_BAR; PG8_SCHED;
            PG8_STAGE(PG8_SB(0, 1), b2 + hstepB, voffB);
            PG8_WAIT_V(6); PG8_BAR; PG8_MMA(1, 1, At, B1); PG8_BAR;
            PG8_LDB(B0, 1, 0); PG8_SCHED; PG8_LDA(At, 1, 0); PG8_STAGE(PG8_SA(0, 1), a2 + hstep, voffA);
            PG8_WAIT_L(8); PG8_BAR; PG8_WAIT_L(0); PG8_MMA(0, 0, At, B0); PG8_BAR; PG8_SCHED;
            PG8_LDB(B1, 1, 1); PG8_STAGE(PG8_SB(1, 0), b3, voffB);
            PG8_BAR; PG8_WAIT_L(0); PG8_MMA(0, 1, At, B1); PG8_BAR;
            PG8_LDA(At, 1, 1); PG8_STAGE(PG8_SA(1, 0), a3, voffA);
            PG8_BAR; PG8_WAIT_L(0); PG8_MMA(1, 0, At, B0); PG8_BAR; PG8_SCHED;
            PG8_STAGE(PG8_SB(1, 1), b3 + hstepB, voffB);
            PG8_WAIT_V(6); PG8_BAR; PG8_MMA(1, 1, At, B1); PG8_BAR;
            }
        }
        if constexpr (ALIGN_EPI) { if (wr == 0) PG8_BAR; }
        E(acc, cur, wr, wc, fr, fq); S.done(cur);
        if (!has_next) break;
#pragma unroll
        for (int a = 0; a < 2; ++a)
#pragma unroll
            for (int b = 0; b < 2; ++b)
#pragma unroll
                for (int m = 0; m < 4; ++m)
#pragma unroll
                    for (int n = 0; n < 2; ++n) acc[a][b][m][n] = (f32x4){0.f, 0.f, 0.f, 0.f};
        cur = nxt; cA = nA; cB = nB; ++ui;
        if constexpr (ALIGN_EPI) { if (wr == 1) PG8_BAR; }
    }
    PG8_WAIT_V(0);
    if constexpr (!ALIGN_EPI) { if (wr == 0) PG8_BAR; }
    PG8_BAR;
#undef PG8_SA
#undef PG8_SB
#undef PG8_STAGE
#undef PG8_LDA
#undef PG8_LDB
#undef PG8_MMA
#undef PG8_WAIT_V
#undef PG8_WAIT_L
#undef PG8_BAR
#undef PG8_SCHED
}
}

#define XB_TMO      128
#define XB_XCNT(j)  (256  + 64 * (j))
#define XB_XSUB(j)  (1280 + 64 * (j))
#define XB_XGEN(j)  (2304 + 64 * (j))
#define XB_TOP      3328
#define XB_TOPGEN   3392
#define XCD_BAR_WORDS 3456
#define XB_SPIN_CAP (1u << 18)
__device__ __forceinline__ unsigned xb_ld(unsigned* p)              { return __hip_atomic_load(p, __ATOMIC_RELAXED, __HIP_MEMORY_SCOPE_AGENT); }
__device__ __forceinline__ unsigned xb_add(unsigned* p, unsigned v) { return __hip_atomic_fetch_add(p, v, __ATOMIC_RELAXED, __HIP_MEMORY_SCOPE_AGENT); }
__device__ __forceinline__ unsigned xb_xcc_id() { return (unsigned)__builtin_amdgcn_s_getreg((3 << 11) | 20) & 0xFu; }
#define XB_SPIN(cond, bar) do { unsigned _sp = 0; while (cond) { __builtin_amdgcn_s_sleep(1); \
    if ((++_sp & 255u) == 0u) { if (xb_ld(&(bar)[XB_TMO])) break; if (_sp > XB_SPIN_CAP) { atomicAdd(&(bar)[XB_TMO], 1u); break; } } } } while (0)
struct XcdBarrier { unsigned* bar; unsigned x; volatile LAS unsigned* st; };
__device__ __forceinline__ XcdBarrier xcd_barrier_post(unsigned* bar, volatile LAS unsigned* st) {
    XcdBarrier b; b.bar = bar; b.x = xb_xcc_id(); b.st = st;
    if (threadIdx.x == 0) (void)xb_add(&bar[XB_XCNT(b.x)], 1u);
    return b;
}
__device__ __forceinline__ void xcd_barrier_complete(unsigned* bar, unsigned x, unsigned& nloc, unsigned& nx) {
    const unsigned G = gridDim.x * gridDim.y * gridDim.z;
    unsigned sum, cnt, mine, sp = 0u;
    for (;;) {
        sum = 0u; cnt = 0u; mine = 0u;
#pragma unroll
        for (unsigned j = 0; j < 16; ++j) { const unsigned c = xb_ld(&bar[XB_XCNT(j)]); sum += c; cnt += (c > 0u) ? 1u : 0u; mine = (j == x) ? c : mine; }
        if (sum == G) break;
        __builtin_amdgcn_s_sleep(1);
        if ((++sp & 255u) == 0u) { if (xb_ld(&bar[XB_TMO])) break; if (sp > XB_SPIN_CAP) { atomicAdd(&bar[XB_TMO], 1u); break; } }
    }
    nloc = mine > 0u ? mine : 1u; nx = cnt > 0u ? cnt : 1u;
}
__device__ __forceinline__ void xcd_barrier(const XcdBarrier& b) {
    asm volatile("s_waitcnt vmcnt(0)" ::: "memory");
    __syncthreads();
    if (threadIdx.x == 0) {
        unsigned* bar = b.bar;
        __builtin_amdgcn_s_waitcnt(0);
        unsigned nloc = b.st[0], nx = b.st[1];
        if (nloc == 0u) { xcd_barrier_complete(bar, b.x, nloc, nx); b.st[0] = nloc; b.st[1] = nx; }
        const unsigned old = xb_add(&bar[XB_XSUB(b.x)], 1u);
        const unsigned gen = old / nloc;
        if (old + 1u == (gen + 1u) * nloc) {
            __builtin_amdgcn_fence(__ATOMIC_RELEASE, "agent");
            asm volatile("s_waitcnt vmcnt(0)" ::: "memory");
            const unsigned og = xb_add(&bar[XB_TOP], 1u);
            const unsigned tg = og / nx;
            if (og + 1u == (tg + 1u) * nx) xb_add(&bar[XB_TOPGEN], 1u);
            else XB_SPIN(xb_ld(&bar[XB_TOPGEN]) == tg, bar);
            __builtin_amdgcn_fence(__ATOMIC_ACQUIRE, "agent");
            xb_add(&bar[XB_XGEN(b.x)], 1u);
            asm volatile("s_waitcnt vmcnt(0)" ::: "memory");
        } else {
            XB_SPIN(xb_ld(&bar[XB_XGEN(b.x)]) == gen, bar);
            __builtin_amdgcn_fence(__ATOMIC_ACQUIRE, "agent");
            asm volatile("s_waitcnt vmcnt(0)" ::: "memory");
        }
    }
    __syncthreads();
}

constexpr int NWAVES = 8;
constexpr int RING_BYTES = 131072, MISC_OFF = RING_BYTES, RS_OFF = RING_BYTES + 512, LDS_BYTES = 147456;
constexpr int CW_BAR = 4096;
constexpr int CW_ATTQ = 64;

__device__ __forceinline__ float dpp_add(float v, float o) { return v + o; }
__device__ __forceinline__ float row16_sum(float v) {
    v += DPP_F(v, 0xB1); v += DPP_F(v, 0x4E); v += DPP_F(v, 0x141); v += DPP_F(v, 0x140); return v;
}
__device__ __forceinline__ float wave_sum_u(float v) {
    v = row16_sum(v);
    const int i = __builtin_bit_cast(int, v);
    return (__builtin_bit_cast(float, __builtin_amdgcn_readlane(i, 0)) + __builtin_bit_cast(float, __builtin_amdgcn_readlane(i, 16))) +
           (__builtin_bit_cast(float, __builtin_amdgcn_readlane(i, 32)) + __builtin_bit_cast(float, __builtin_amdgcn_readlane(i, 48)));
}
typedef __bf16 bf16x2_t __attribute__((ext_vector_type(2)));
__device__ __forceinline__ float dot2(unsigned a, unsigned b, float acc) { return __builtin_amdgcn_fdot2_f32_bf16(__builtin_bit_cast(bf16x2_t, a), __builtin_bit_cast(bf16x2_t, b), acc, false); }

__device__ __forceinline__ void unpack8(const u32x4 w, float (&f)[8]) {
#pragma unroll
    for (int i = 0; i < 4; ++i) { f[2 * i] = bflo(w[i]); f[2 * i + 1] = bfhi(w[i]); }
}
typedef float f32x2 __attribute__((ext_vector_type(2)));
constexpr int CW_QU = 8192, CW_QV = 8192 + 512;
template <int M> __device__ __forceinline__ float xor_lane(float v) {
    if (M < 32) return __builtin_bit_cast(float, __builtin_amdgcn_ds_swizzle(__builtin_bit_cast(int, v), (M << 10) | 0x1f));
    return __shfl_xor(v, M);
}
__device__ __forceinline__ float fsel(int m, float a, float b) { return __builtin_bit_cast(float, (__builtin_bit_cast(int, a) & m) | (__builtin_bit_cast(int, b) & ~m)); }
__device__ __forceinline__ void fp8x16_to_f32(const u32x4 w, float (&f)[16]) {
#pragma unroll
    for (int q = 0; q < 4; ++q) { const f32x2 lo = __builtin_amdgcn_cvt_pk_f32_fp8((int)w[q], false), hi = __builtin_amdgcn_cvt_pk_f32_fp8((int)w[q], true);
        f[4 * q] = lo.x; f[4 * q + 1] = lo.y; f[4 * q + 2] = hi.x; f[4 * q + 3] = hi.y; }
}
template <int WHICH> struct SliceTok {
    u32x4 vv[16]; f32x2 o; float r0, r1, wsc; int t, ia, ib, wd;
    __device__ __forceinline__ void idx(const Ptrs& P, int t_, int lane) { const unsigned short* ip = (const unsigned short*)(P.ws + WS_IDX16) + (size_t)t_ * 128; ia = ip[(unsigned)lane]; ib = ip[(unsigned)(64 + lane)]; }
    __device__ __forceinline__ void load(const Ptrs& P, int t_, int j, int lane) {
        t = t_;
        const unsigned char* ws = P.ws;
        const int sl = lane >> 3, p = lane & 7;
        const unsigned char* TAB = ws + (WHICH ? WS_EV : WS_EU) + (size_t)j * SLICE_BYTES;
        const int baddr = 4 * sl;
        if (WHICH == 1) { wd = ((const int*)(ws + WS_W))[(unsigned)(t * 32 + (lane & 31))]; wsc = ((const float*)(ws + WS_R1))[t];
            const int col = 128 * j + 16 * p + 8 * ((lane >> 5) & 1) + 4 * ((lane >> 4) & 1) + 2 * ((lane >> 3) & 1); { const unsigned xw = *(const unsigned*)((const bf16*)(ws + WS_X1BF) + (size_t)t * D + (unsigned)col); o = (f32x2){bflo(xw), bfhi(xw)}; } }
#pragma unroll
        for (int i = 0; i < 16; ++i) { const int e = __builtin_amdgcn_ds_bpermute(baddr + 32 * (i & 7), (i < 8) ? ia : ib); vv[i] = *(const u32x4*)(TAB + (unsigned)(e * 128 + 16 * p)); }
    }
    __device__ __forceinline__ void compute(int lane, const LAS unsigned char* xqp, float sx) {
        const int sl = lane >> 3;
        const int baddr = 4 * sl;
        if (WHICH == 0) {
            const i32x4 xq = *(const LAS i32x4*)xqp;
            int d[16];
#pragma unroll
            for (int i = 0; i < 16; ++i) { int a = 0;
#pragma unroll
                for (int q = 0; q < 4; ++q) a = __builtin_amdgcn_sdot4((int)vv[i][q], xq[q], a, false);
                d[i] = a; }
#pragma unroll
            for (int st = 0; st < 3; ++st) { const int M = 1 << st, n = 8 >> st; const int hm = (lane & M) ? -1 : 0;
#pragma unroll
                for (int i = 0; i < 8; ++i) if (i < n) { const int keep = (d[n + i] & hm) | (d[i] & ~hm), send = (d[i] & hm) | (d[n + i] & ~hm);
                    d[i] = keep + ((st == 0) ? DPP_I(send, 0xB1) : (st == 1) ? DPP_I(send, 0x4E) : __builtin_amdgcn_ds_swizzle(send, (4 << 10) | 0x1f)); } }
            r0 = (float)d[0] * sx; r1 = (float)d[1] * sx;
            (void)baddr;
        } else {
            int wq[4];
#pragma unroll
            for (int b = 0; b < 4; ++b) wq[b] = __builtin_amdgcn_ds_bpermute(16 * sl + 4 * b, wd);
            int acc[16];
#pragma unroll
            for (int c = 0; c < 16; ++c) acc[c] = 0;
#pragma unroll
            for (int b = 0; b < 4; ++b)
#pragma unroll
                for (int q = 0; q < 4; ++q) { const unsigned r0_ = vv[4 * b][q], r1_ = vv[4 * b + 1][q], r2_ = vv[4 * b + 2][q], r3_ = vv[4 * b + 3][q];
                    const unsigned t01l = __builtin_amdgcn_perm(r1_, r0_, 0x05010400u), t01h = __builtin_amdgcn_perm(r1_, r0_, 0x07030602u);
                    const unsigned t23l = __builtin_amdgcn_perm(r3_, r2_, 0x05010400u), t23h = __builtin_amdgcn_perm(r3_, r2_, 0x07030602u);
                    const unsigned c0 = __builtin_amdgcn_perm(t23l, t01l, 0x05040100u), c1 = __builtin_amdgcn_perm(t23l, t01l, 0x07060302u);
                    const unsigned c2 = __builtin_amdgcn_perm(t23h, t01h, 0x05040100u), c3 = __builtin_amdgcn_perm(t23h, t01h, 0x07060302u);
                    acc[4 * q] = __builtin_amdgcn_sdot4((int)c0, wq[b], acc[4 * q], false); acc[4 * q + 1] = __builtin_amdgcn_sdot4((int)c1, wq[b], acc[4 * q + 1], false);
                    acc[4 * q + 2] = __builtin_amdgcn_sdot4((int)c2, wq[b], acc[4 * q + 2], false); acc[4 * q + 3] = __builtin_amdgcn_sdot4((int)c3, wq[b], acc[4 * q + 3], false); }
#pragma unroll
            for (int st = 0; st < 3; ++st) { const int M = 32 >> st, n = 8 >> st; const int hm = (lane & M) ? -1 : 0;
#pragma unroll
                for (int i = 0; i < 8; ++i) if (i < n) { const int keep = (acc[n + i] & hm) | (acc[i] & ~hm), send = (acc[i] & hm) | (acc[n + i] & ~hm);
                    acc[i] = keep + ((st == 0) ? __shfl_xor(send, 32) : (st == 1) ? __builtin_amdgcn_ds_swizzle(send, (16 << 10) | 0x1f) : __builtin_amdgcn_ds_swizzle(send, (8 << 10) | 0x1f)); } }
            r0 = (float)acc[0] * wsc; r1 = (float)acc[1] * wsc;
        }
    }
    __device__ __forceinline__ void store(const Ptrs& P, int j, int lane) {
        const int sl = lane >> 3, p = lane & 7;
        if (WHICH == 0) { const int i0 = 8 * (lane & 1) + 4 * ((lane >> 1) & 1) + 2 * ((lane >> 2) & 1);
            unsigned short* pp = (unsigned short*)(P.ws + WS_PART) + ((size_t)j * T + t) * 128;
            pp[(unsigned)(8 * i0 + sl)] = (unsigned short)f2bf(r0); pp[(unsigned)(8 * i0 + 8 + sl)] = (unsigned short)f2bf(r1); }
        else { const int col = 128 * j + 16 * p + 8 * ((lane >> 5) & 1) + 4 * ((lane >> 4) & 1) + 2 * ((lane >> 3) & 1);
            f32x2 q = o; q.x += r0; q.y += r1; *(f32x2*)(P.out + (size_t)t * D + (unsigned)col) = q; }
    }
};
template <int WHICH> __device__ __forceinline__ void p6_sliced(const Ptrs& P, LAS unsigned char* lds, volatile LAS unsigned* MISC, unsigned* ctl, int tid, int lane, int wave) {
    const int my = (int)(xb_xcc_id() & 7u);
    LAS unsigned char* XQ = lds + wave * 1024;
    LAS float* SX = (LAS float*)(lds + 8192 + wave * 32);
    for (int off = 0; off < 8; ++off) {
        const int j = (my + off) & 7;
        unsigned* head = ctl + (WHICH ? CW_QV : CW_QU) + 64 * j;
        for (;;) {
            if (tid == 0) MISC[1] = atomicAdd(head, 1u);
            __syncthreads();
            const int blk = (int)MISC[1];
            __syncthreads();
            if (blk >= T / 64) break;
            const int t0 = blk * 64 + wave * 8;
            int la = lane; asm volatile("" : "+v"(la));
            SliceTok<WHICH> A, B;
            A.idx(P, t0, la); B.idx(P, t0 + 1, la);
            A.load(P, t0, j, la);
            if (WHICH == 0) {
                const bf16* xb = (const bf16*)(P.ws + WS_X1BF) + (size_t)(t0 + (la >> 3)) * D + (unsigned)(128 * j + 16 * (la & 7));
                const u32x4 xw0 = *(const u32x4*)xb, xw1 = *(const u32x4*)(xb + 8);
                float xf[16]; { float t8[8]; unpack8(xw0, t8);
#pragma unroll
                    for (int i = 0; i < 8; ++i) xf[i] = t8[i];
                    unpack8(xw1, t8);
#pragma unroll
                    for (int i = 0; i < 8; ++i) xf[8 + i] = t8[i]; }
                float mx = 0.f;
#pragma unroll
                for (int i = 0; i < 16; ++i) mx = fmaxf(mx, fabsf(xf[i]));
                mx = fmaxf(mx, DPP_F(mx, 0xB1)); mx = fmaxf(mx, DPP_F(mx, 0x4E)); mx = fmaxf(mx, DPP_F(mx, 0x141));
                mx = fmaxf(mx, 1e-30f);
                const float xinv = 127.0f * __builtin_amdgcn_rcpf(mx);
                i32x4 xq;
#pragma unroll
                for (int q = 0; q < 4; ++q) { const int q0 = (int)rintf(xf[4 * q] * xinv), q1 = (int)rintf(xf[4 * q + 1] * xinv), q2 = (int)rintf(xf[4 * q + 2] * xinv), q3 = (int)rintf(xf[4 * q + 3] * xinv);
                    xq[q] = (int)((unsigned)(q0 & 0xff) | ((unsigned)(q1 & 0xff) << 8) | ((unsigned)(q2 & 0xff) << 16) | ((unsigned)q3 << 24)); }
                *(LAS i32x4*)(XQ + 16 * la) = xq;
                if ((la & 7) == 0) SX[la >> 3] = mx * (1.0f / 127.0f);
            }
            const LAS unsigned char* xqp = XQ + 16 * (la & 7);
#pragma unroll
            for (int n = 0; n < 8; n += 2) {
                B.load(P, t0 + n + 1, j, la);
                if (n + 2 < 8) A.idx(P, t0 + n + 2, la);
                A.compute(la, xqp + 128 * n, (WHICH == 0) ? SX[n] : 0.f); A.store(P, j, la);
                if (n + 2 < 8) { A.load(P, t0 + n + 2, j, la); B.idx(P, t0 + n + 3, la); }
                B.compute(la, xqp + 128 * (n + 1), (WHICH == 0) ? SX[n + 1] : 0.f); B.store(P, j, la);
            }
        }
    }
}

__device__ __forceinline__ void p6_v2(const Ptrs& P, volatile LAS unsigned* MISC, unsigned* ctl, int tid, int lane, int wave) {
    const int my = (int)(xb_xcc_id() & 7u);
    const unsigned char* ws = P.ws;
    constexpr int PD = 6;
    for (int off = 0; off < 8; ++off) {
        const int j = (my + off) & 7;
        unsigned* head = ctl + CW_QV + 64 * j;
        const unsigned char* TAB = ws + WS_EV + (size_t)j * SLICE_BYTES;
        for (;;) {
            if (tid == 0) MISC[1] = atomicAdd(head, 1u);
            __syncthreads();
            const int blk = (int)MISC[1];
            __syncthreads();
            if (blk >= T / 64) break;
            int la = lane; asm volatile("" : "+v"(la));
            const int t = blk * 64 + wave * 8 + (la >> 3);
            const unsigned pb = 16u * (unsigned)(la & 7);
            const unsigned char* idp = ws + WS_IDX16 + (unsigned)(t * 256);
            const unsigned char* wp = ws + WS_W + (unsigned)(t * 128);
            u32x4 ids[16];
#pragma unroll
            for (int c = 0; c < 16; ++c) ids[c] = *(const u32x4*)(idp + 16 * c);
            u32x4 vv[PD + 1][4];
#define P6V_ISSUE(q_) do { _Pragma("unroll") for (int e_ = 0; e_ < 4; ++e_) { const int k_ = 4 * (q_) + e_; const unsigned word = ids[k_ >> 3][(k_ & 7) >> 1]; \
                const unsigned ex = (k_ & 1) ? (word >> 16) : (word & 0xffffu); vv[(q_) % (PD + 1)][e_] = *(const u32x4*)(TAB + (ex * 128u + pb)); } } while (0)
#pragma unroll
            for (int q = 0; q < PD; ++q) P6V_ISSUE(q);
            const u32x4 xr0 = *(const u32x4*)((const bf16*)(ws + WS_X1BF) + (size_t)t * D + (unsigned)(128 * j) + pb), xr1 = *(const u32x4*)((const bf16*)(ws + WS_X1BF) + (size_t)t * D + (unsigned)(128 * j) + pb + 8);
            const float wsc = ((const float*)(ws + WS_R1))[t];
            u32x4 wq[8];
#pragma unroll
            for (int c = 0; c < 8; ++c) wq[c] = *(const u32x4*)(wp + 16 * c);
            int acc[16];
#pragma unroll
            for (int c = 0; c < 16; ++c) acc[c] = 0;
#pragma unroll
            for (int q = 0; q < 32; ++q) {
                if (q + PD < 32) P6V_ISSUE(q + PD);
                const int wv = (int)wq[q >> 2][q & 3];
#pragma unroll
                for (int d = 0; d < 4; ++d) { const unsigned r0_ = vv[q % (PD + 1)][0][d], r1_ = vv[q % (PD + 1)][1][d], r2_ = vv[q % (PD + 1)][2][d], r3_ = vv[q % (PD + 1)][3][d];
                    const unsigned t01l = __builtin_amdgcn_perm(r1_, r0_, 0x05010400u), t01h = __builtin_amdgcn_perm(r1_, r0_, 0x07030602u);
                    const unsigned t23l = __builtin_amdgcn_perm(r3_, r2_, 0x05010400u), t23h = __builtin_amdgcn_perm(r3_, r2_, 0x07030602u);
                    const unsigned c0 = __builtin_amdgcn_perm(t23l, t01l, 0x05040100u), c1 = __builtin_amdgcn_perm(t23l, t01l, 0x07060302u);
                    const unsigned c2 = __builtin_amdgcn_perm(t23h, t01h, 0x05040100u), c3 = __builtin_amdgcn_perm(t23h, t01h, 0x07060302u);
                    acc[4 * d] = __builtin_amdgcn_sdot4((int)c0, wv, acc[4 * d], false); acc[4 * d + 1] = __builtin_amdgcn_sdot4((int)c1, wv, acc[4 * d + 1], false);
                    acc[4 * d + 2] = __builtin_amdgcn_sdot4((int)c2, wv, acc[4 * d + 2], false); acc[4 * d + 3] = __builtin_amdgcn_sdot4((int)c3, wv, acc[4 * d + 3], false); }
            }
#undef P6V_ISSUE
            float xf[16]; { float t8[8]; unpack8(xr0, t8);
#pragma unroll
                for (int i = 0; i < 8; ++i) xf[i] = t8[i];
                unpack8(xr1, t8);
#pragma unroll
                for (int i = 0; i < 8; ++i) xf[8 + i] = t8[i]; }
            float* op = P.out + (size_t)t * D + (unsigned)(128 * j) + pb;
#pragma unroll
            for (int c4 = 0; c4 < 4; ++c4) *(f32x4*)(op + 4 * c4) = (f32x4){xf[4 * c4] + (float)acc[4 * c4] * wsc, xf[4 * c4 + 1] + (float)acc[4 * c4 + 1] * wsc, xf[4 * c4 + 2] + (float)acc[4 * c4 + 2] * wsc, xf[4 * c4 + 3] + (float)acc[4 * c4 + 3] * wsc};
        }
    }
}

__device__ __forceinline__ void p6_v3(const Ptrs& P, LAS unsigned char* lds, int bx, int lane, int wave) {
    const unsigned char* ws = P.ws;
    constexpr int NB = 8;
    const int j = bx & 7, wi = (bx >> 3) * 8 + wave, T0 = wi * 64;
    const unsigned char* TAB = ws + WS_EV + (size_t)j * SLICE_BYTES;
    LAS unsigned char* buf = lds + wave * 6144;
    int la = lane; asm volatile("" : "+v"(la));
    const int g = la >> 3;
    const unsigned pb = 16u * (unsigned)(la & 7);
#define V3_FETCH(b_, r0_, r1_, r2_) do { const unsigned char* ip_ = ws + WS_IDX16 + (unsigned)((T0 + 8 * (b_)) * 256) + 16u * (unsigned)la; r0_ = *(const u32x4*)ip_; r1_ = *(const u32x4*)(ip_ + 1024); \
        r2_ = *(const u32x4*)(ws + WS_W + (unsigned)((T0 + 8 * (b_)) * 128) + 16u * (unsigned)la); } while (0)
#define V3_PARK(b_, r0_, r1_, r2_) do { LAS unsigned char* d_ = buf + ((b_) & 1) * 3072; *(LAS u32x4*)(d_ + 16 * la) = r0_; *(LAS u32x4*)(d_ + 1024 + 16 * la) = r1_; *(LAS u32x4*)(d_ + 2048 + 16 * la) = r2_; asm volatile("" ::: "memory"); } while (0)
    u32x4 f0, f1, f2;
    V3_FETCH(0, f0, f1, f2); V3_PARK(0, f0, f1, f2);
    u32x4 V00, V01, V02, V03, V10, V11, V12, V13, V20, V21, V22, V23, V30, V31, V32, V33, V40, V41, V42, V43, V50, V51, V52, V53, V60, V61, V62, V63, V70, V71, V72, V73;
#define V3_ISSUE(S_, bsel_, tq_) do { const u32x2 e2_ = *(const LAS u32x2*)(buf + (bsel_) * 3072 + g * 256 + 8 * (tq_)); \
        V##S_##0 = *(const u32x4*)(TAB + ((e2_.x & 0xffffu) * 128u + pb)); V##S_##1 = *(const u32x4*)(TAB + ((e2_.x >> 16) * 128u + pb)); \
        V##S_##2 = *(const u32x4*)(TAB + ((e2_.y & 0xffffu) * 128u + pb)); V##S_##3 = *(const u32x4*)(TAB + ((e2_.y >> 16) * 128u + pb)); } while (0)
#define V3_MAC(S_, q_) do { const int wv = *(const LAS int*)(buf + bs * 3072 + 2048 + g * 128 + 4 * (q_)); \
        _Pragma("unroll") for (int d = 0; d < 4; ++d) { const unsigned r0_ = V##S_##0[d], r1_ = V##S_##1[d], r2_ = V##S_##2[d], r3_ = V##S_##3[d]; \
            const unsigned t01l = __builtin_amdgcn_perm(r1_, r0_, 0x05010400u), t01h = __builtin_amdgcn_perm(r1_, r0_, 0x07030602u); \
            const unsigned t23l = __builtin_amdgcn_perm(r3_, r2_, 0x05010400u), t23h = __builtin_amdgcn_perm(r3_, r2_, 0x07030602u); \
            const unsigned c0 = __builtin_amdgcn_perm(t23l, t01l, 0x05040100u), c1 = __builtin_amdgcn_perm(t23l, t01l, 0x07060302u); \
            const unsigned c2 = __builtin_amdgcn_perm(t23h, t01h, 0x05040100u), c3 = __builtin_amdgcn_perm(t23h, t01h, 0x07060302u); \
            acc[4 * d] = __builtin_amdgcn_sdot4((int)c0, wv, acc[4 * d], false); acc[4 * d + 1] = __builtin_amdgcn_sdot4((int)c1, wv, acc[4 * d + 1], false); \
            acc[4 * d + 2] = __builtin_amdgcn_sdot4((int)c2, wv, acc[4 * d + 2], false); acc[4 * d + 3] = __builtin_amdgcn_sdot4((int)c3, wv, acc[4 * d + 3], false); } } while (0)
    V3_ISSUE(0, 0, 0);
    V3_ISSUE(1, 0, 1);
    V3_ISSUE(2, 0, 2);
    V3_ISSUE(3, 0, 3);
    V3_ISSUE(4, 0, 4);
    V3_ISSUE(5, 0, 5);
#pragma unroll 1
    for (int b = 0; b < NB; ++b) {
        int acc[16];
#pragma unroll
        for (int c = 0; c < 16; ++c) acc[c] = 0;
        const int bs = b & 1, t = T0 + 8 * b + g;
        const bf16* xrp = (const bf16*)(ws + WS_X1BF) + (size_t)t * D + (unsigned)(128 * j) + (pb >> 1);
        const u32x4 xr0 = *(const u32x4*)xrp, xr1 = *(const u32x4*)(xrp + 64);
        const float wsc = ((const float*)(ws + WS_R1))[t];
        V3_FETCH((b + 1) & 7, f0, f1, f2);
        V3_ISSUE(6, bs, 6); V3_MAC(0, 0);
        V3_ISSUE(7, bs, 7); V3_MAC(1, 1);
        V3_ISSUE(0, bs, 8); V3_MAC(2, 2);
        V3_ISSUE(1, bs, 9); V3_MAC(3, 3);
        V3_ISSUE(2, bs, 10); V3_MAC(4, 4);
        V3_ISSUE(3, bs, 11); V3_MAC(5, 5);
        V3_ISSUE(4, bs, 12); V3_MAC(6, 6);
        V3_ISSUE(5, bs, 13); V3_MAC(7, 7);
        V3_PARK(b + 1, f0, f1, f2);
        V3_ISSUE(6, bs, 14); V3_MAC(0, 8);
        V3_ISSUE(7, bs, 15); V3_MAC(1, 9);
        V3_ISSUE(0, bs, 16); V3_MAC(2, 10);
        V3_ISSUE(1, bs, 17); V3_MAC(3, 11);
        V3_ISSUE(2, bs, 18); V3_MAC(4, 12);
        V3_ISSUE(3, bs, 19); V3_MAC(5, 13);
        V3_ISSUE(4, bs, 20); V3_MAC(6, 14);
        V3_ISSUE(5, bs, 21); V3_MAC(7, 15);
        V3_ISSUE(6, bs, 22); V3_MAC(0, 16);
        V3_ISSUE(7, bs, 23); V3_MAC(1, 17);
        V3_ISSUE(0, bs, 24); V3_MAC(2, 18);
        V3_ISSUE(1, bs, 25); V3_MAC(3, 19);
        V3_ISSUE(2, bs, 26); V3_MAC(4, 20);
        V3_ISSUE(3, bs, 27); V3_MAC(5, 21);
        V3_ISSUE(4, bs, 28); V3_MAC(6, 22);
        V3_ISSUE(5, bs, 29); V3_MAC(7, 23);
        V3_ISSUE(6, bs, 30); V3_MAC(0, 24);
        V3_ISSUE(7, bs, 31); V3_MAC(1, 25);
        V3_ISSUE(0, bs ^ 1, 0); V3_MAC(2, 26);
        V3_ISSUE(1, bs ^ 1, 1); V3_MAC(3, 27);
        V3_ISSUE(2, bs ^ 1, 2); V3_MAC(4, 28);
        V3_ISSUE(3, bs ^ 1, 3); V3_MAC(5, 29);
        V3_ISSUE(4, bs ^ 1, 4); V3_MAC(6, 30);
        V3_ISSUE(5, bs ^ 1, 5); V3_MAC(7, 31);
        LAS float* ob = (LAS float*)(lds + 49152 + wave * 4096) + g * 128;
        LAS unsigned char* xbp = lds + 81920 + wave * 2048 + g * 256;
        *(LAS u32x4*)(xbp + pb) = xr0; *(LAS u32x4*)(xbp + 128 + pb) = xr1;
#pragma unroll
        for (int c4 = 0; c4 < 4; ++c4) *(LAS f32x4*)(ob + (pb + 4 * c4)) = (f32x4){(float)acc[4 * c4] * wsc, (float)acc[4 * c4 + 1] * wsc, (float)acc[4 * c4 + 2] * wsc, (float)acc[4 * c4 + 3] * wsc};
        asm volatile("s_waitcnt lgkmcnt(0)" ::: "memory");
        float* op = P.out + (size_t)t * D + (unsigned)(128 * j) + (pb >> 2);
#pragma unroll
        for (int c4 = 0; c4 < 4; ++c4) { const u32x2 xw = *(const LAS u32x2*)(xbp + 64 * c4 + (pb >> 1)); const f32x4 y = *(const LAS f32x4*)(ob + 32 * c4 + (pb >> 2));
            *(f32x4*)(op + 32 * c4) = (f32x4){bflo(xw.x) + y.x, bfhi(xw.x) + y.y, bflo(xw.y) + y.z, bfhi(xw.y) + y.w}; }
        asm volatile("" ::: "memory");
    }
#undef V3_MAC
#undef V3_FETCH
#undef V3_PARK
#undef V3_ISSUE
}

__device__ __forceinline__ void p6_u3(const Ptrs& P, LAS unsigned char* lds, int bx, int lane, int wave) {
    const unsigned char* ws = P.ws;
    constexpr int NB = 8;
    const int j = bx & 7, wi = (bx >> 3) * 8 + wave, T0 = wi * 64;
    const unsigned char* TAB = ws + WS_EU + (size_t)j * SLICE_BYTES;
    LAS unsigned char* buf = lds + wave * 8192;
    int la = lane; asm volatile("" : "+v"(la));
    const int sl = la >> 3, pc = la & 7;
    const unsigned pb = 16u * (unsigned)pc;
    const int i0 = 8 * (la & 1) + 4 * ((la >> 1) & 1) + 2 * ((la >> 2) & 1);
#define U3_FETCH(b_) do { const unsigned char* ip_ = ws + WS_IDX16 + (unsigned)((T0 + 8 * (b_)) * 256) + 16u * (unsigned)la; f0 = *(const u32x4*)ip_; f1 = *(const u32x4*)(ip_ + 1024); \
        const bf16* xb_ = (const bf16*)(ws + WS_X1BF) + (size_t)(T0 + 8 * (b_) + (la >> 3)) * D + (unsigned)(128 * j + 16 * (la & 7)); x0 = *(const u32x4*)xb_; x1 = *(const u32x4*)(xb_ + 8); } while (0)
#define U3_PARK(b_) do { LAS unsigned char* d_ = buf + ((b_) & 1) * 4096; *(LAS u32x4*)(d_ + 16 * la) = f0; *(LAS u32x4*)(d_ + 1024 + 16 * la) = f1; \
        float xf[16]; { float t8[8]; unpack8(x0, t8); _Pragma("unroll") for (int i = 0; i < 8; ++i) xf[i] = t8[i]; unpack8(x1, t8); _Pragma("unroll") for (int i = 0; i < 8; ++i) xf[8 + i] = t8[i]; } \
        float mx = 0.f; _Pragma("unroll") for (int i = 0; i < 16; ++i) mx = fmaxf(mx, fabsf(xf[i])); \
        mx = fmaxf(mx, DPP_F(mx, 0xB1)); mx = fmaxf(mx, DPP_F(mx, 0x4E)); mx = fmaxf(mx, DPP_F(mx, 0x141)); mx = fmaxf(mx, 1e-30f); \
        const float xinv = 127.0f * __builtin_amdgcn_rcpf(mx); i32x4 xq_; \
        _Pragma("unroll") for (int q = 0; q < 4; ++q) { const int q0 = (int)rintf(xf[4 * q] * xinv), q1 = (int)rintf(xf[4 * q + 1] * xinv), q2 = (int)rintf(xf[4 * q + 2] * xinv), q3 = (int)rintf(xf[4 * q + 3] * xinv); \
            xq_[q] = (int)((unsigned)(q0 & 0xff) | ((unsigned)(q1 & 0xff) << 8) | ((unsigned)(q2 & 0xff) << 16) | ((unsigned)q3 << 24)); } \
        *(LAS i32x4*)(d_ + 2048 + 16 * la) = xq_; if ((la & 7) == 0) *(LAS float*)(d_ + 3072 + 4 * (la >> 3)) = mx * (1.0f / 127.0f); asm volatile("" ::: "memory"); } while (0)
    u32x4 f0, f1, x0, x1;
    u32x4 A0, A1, A2, A3, A4, A5, A6, A7, A8, A9, A10, A11, A12, A13, A14, A15;
    u32x4 B0, B1, B2, B3, B4, B5, B6, B7, B8, B9, B10, B11, B12, B13, B14, B15;
    U3_FETCH(0); U3_PARK(0);
    { const LAS unsigned char* ip_ = buf + (0) * 4096 + 0 * 256 + 32 * sl; const u32x4 e0_ = *(const LAS u32x4*)ip_, e1_ = *(const LAS u32x4*)(ip_ + 16);
        A0 = *(const u32x4*)(TAB + ((e0_[0] & 0xffffu) * 128u + pb));
        A1 = *(const u32x4*)(TAB + ((e0_[0] >> 16) * 128u + pb));
        A2 = *(const u32x4*)(TAB + ((e0_[1] & 0xffffu) * 128u + pb));
        A3 = *(const u32x4*)(TAB + ((e0_[1] >> 16) * 128u + pb));
        A4 = *(const u32x4*)(TAB + ((e0_[2] & 0xffffu) * 128u + pb));
        A5 = *(const u32x4*)(TAB + ((e0_[2] >> 16) * 128u + pb));
        A6 = *(const u32x4*)(TAB + ((e0_[3] & 0xffffu) * 128u + pb));
        A7 = *(const u32x4*)(TAB + ((e0_[3] >> 16) * 128u + pb));
        A8 = *(const u32x4*)(TAB + ((e1_[0] & 0xffffu) * 128u + pb));
        A9 = *(const u32x4*)(TAB + ((e1_[0] >> 16) * 128u + pb));
        A10 = *(const u32x4*)(TAB + ((e1_[1] & 0xffffu) * 128u + pb));
        A11 = *(const u32x4*)(TAB + ((e1_[1] >> 16) * 128u + pb));
        A12 = *(const u32x4*)(TAB + ((e1_[2] & 0xffffu) * 128u + pb));
        A13 = *(const u32x4*)(TAB + ((e1_[2] >> 16) * 128u + pb));
        A14 = *(const u32x4*)(TAB + ((e1_[3] & 0xffffu) * 128u + pb));
        A15 = *(const u32x4*)(TAB + ((e1_[3] >> 16) * 128u + pb));
    }
#pragma unroll 1
    for (int b = 0; b < NB; ++b) {
        const int bs = b & 1;
        U3_FETCH((b + 1) & 7);
        { const LAS unsigned char* ip_ = buf + (bs) * 4096 + 1 * 256 + 32 * sl; const u32x4 e0_ = *(const LAS u32x4*)ip_, e1_ = *(const LAS u32x4*)(ip_ + 16);
            B0 = *(const u32x4*)(TAB + ((e0_[0] & 0xffffu) * 128u + pb));
            B1 = *(const u32x4*)(TAB + ((e0_[0] >> 16) * 128u + pb));
            B2 = *(const u32x4*)(TAB + ((e0_[1] & 0xffffu) * 128u + pb));
            B3 = *(const u32x4*)(TAB + ((e0_[1] >> 16) * 128u + pb));
            B4 = *(const u32x4*)(TAB + ((e0_[2] & 0xffffu) * 128u + pb));
            B5 = *(const u32x4*)(TAB + ((e0_[2] >> 16) * 128u + pb));
            B6 = *(const u32x4*)(TAB + ((e0_[3] & 0xffffu) * 128u + pb));
            B7 = *(const u32x4*)(TAB + ((e0_[3] >> 16) * 128u + pb));
            B8 = *(const u32x4*)(TAB + ((e1_[0] & 0xffffu) * 128u + pb));
            B9 = *(const u32x4*)(TAB + ((e1_[0] >> 16) * 128u + pb));
            B10 = *(const u32x4*)(TAB + ((e1_[1] & 0xffffu) * 128u + pb));
            B11 = *(const u32x4*)(TAB + ((e1_[1] >> 16) * 128u + pb));
            B12 = *(const u32x4*)(TAB + ((e1_[2] & 0xffffu) * 128u + pb));
            B13 = *(const u32x4*)(TAB + ((e1_[2] >> 16) * 128u + pb));
            B14 = *(const u32x4*)(TAB + ((e1_[3] & 0xffffu) * 128u + pb));
            B15 = *(const u32x4*)(TAB + ((e1_[3] >> 16) * 128u + pb));
        }
        { const i32x4 xq = *(const LAS i32x4*)(buf + bs * 4096 + 2048 + 0 * 128 + 16 * pc); const float sx = *(const LAS float*)(buf + bs * 4096 + 3072 + 4 * 0);
            int d[16];
            d[0] = __builtin_amdgcn_sdot4((int)A0[3], xq[3], __builtin_amdgcn_sdot4((int)A0[2], xq[2], __builtin_amdgcn_sdot4((int)A0[1], xq[1], __builtin_amdgcn_sdot4((int)A0[0], xq[0], 0, false), false), false), false);
            d[1] = __builtin_amdgcn_sdot4((int)A1[3], xq[3], __builtin_amdgcn_sdot4((int)A1[2], xq[2], __builtin_amdgcn_sdot4((int)A1[1], xq[1], __builtin_amdgcn_sdot4((int)A1[0], xq[0], 0, false), false), false), false);
            d[2] = __builtin_amdgcn_sdot4((int)A2[3], xq[3], __builtin_amdgcn_sdot4((int)A2[2], xq[2], __builtin_amdgcn_sdot4((int)A2[1], xq[1], __builtin_amdgcn_sdot4((int)A2[0], xq[0], 0, false), false), false), false);
            d[3] = __builtin_amdgcn_sdot4((int)A3[3], xq[3], __builtin_amdgcn_sdot4((int)A3[2], xq[2], __builtin_amdgcn_sdot4((int)A3[1], xq[1], __builtin_amdgcn_sdot4((int)A3[0], xq[0], 0, false), false), false), false);
            d[4] = __builtin_amdgcn_sdot4((int)A4[3], xq[3], __builtin_amdgcn_sdot4((int)A4[2], xq[2], __builtin_amdgcn_sdot4((int)A4[1], xq[1], __builtin_amdgcn_sdot4((int)A4[0], xq[0], 0, false), false), false), false);
            d[5] = __builtin_amdgcn_sdot4((int)A5[3], xq[3], __builtin_amdgcn_sdot4((int)A5[2], xq[2], __builtin_amdgcn_sdot4((int)A5[1], xq[1], __builtin_amdgcn_sdot4((int)A5[0], xq[0], 0, false), false), false), false);
            d[6] = __builtin_amdgcn_sdot4((int)A6[3], xq[3], __builtin_amdgcn_sdot4((int)A6[2], xq[2], __builtin_amdgcn_sdot4((int)A6[1], xq[1], __builtin_amdgcn_sdot4((int)A6[0], xq[0], 0, false), false), false), false);
            d[7] = __builtin_amdgcn_sdot4((int)A7[3], xq[3], __builtin_amdgcn_sdot4((int)A7[2], xq[2], __builtin_amdgcn_sdot4((int)A7[1], xq[1], __builtin_amdgcn_sdot4((int)A7[0], xq[0], 0, false), false), false), false);
            d[8] = __builtin_amdgcn_sdot4((int)A8[3], xq[3], __builtin_amdgcn_sdot4((int)A8[2], xq[2], __builtin_amdgcn_sdot4((int)A8[1], xq[1], __builtin_amdgcn_sdot4((int)A8[0], xq[0], 0, false), false), false), false);
            d[9] = __builtin_amdgcn_sdot4((int)A9[3], xq[3], __builtin_amdgcn_sdot4((int)A9[2], xq[2], __builtin_amdgcn_sdot4((int)A9[1], xq[1], __builtin_amdgcn_sdot4((int)A9[0], xq[0], 0, false), false), false), false);
            d[10] = __builtin_amdgcn_sdot4((int)A10[3], xq[3], __builtin_amdgcn_sdot4((int)A10[2], xq[2], __builtin_amdgcn_sdot4((int)A10[1], xq[1], __builtin_amdgcn_sdot4((int)A10[0], xq[0], 0, false), false), false), false);
            d[11] = __builtin_amdgcn_sdot4((int)A11[3], xq[3], __builtin_amdgcn_sdot4((int)A11[2], xq[2], __builtin_amdgcn_sdot4((int)A11[1], xq[1], __builtin_amdgcn_sdot4((int)A11[0], xq[0], 0, false), false), false), false);
            d[12] = __builtin_amdgcn_sdot4((int)A12[3], xq[3], __builtin_amdgcn_sdot4((int)A12[2], xq[2], __builtin_amdgcn_sdot4((int)A12[1], xq[1], __builtin_amdgcn_sdot4((int)A12[0], xq[0], 0, false), false), false), false);
            d[13] = __builtin_amdgcn_sdot4((int)A13[3], xq[3], __builtin_amdgcn_sdot4((int)A13[2], xq[2], __builtin_amdgcn_sdot4((int)A13[1], xq[1], __builtin_amdgcn_sdot4((int)A13[0], xq[0], 0, false), false), false), false);
            d[14] = __builtin_amdgcn_sdot4((int)A14[3], xq[3], __builtin_amdgcn_sdot4((int)A14[2], xq[2], __builtin_amdgcn_sdot4((int)A14[1], xq[1], __builtin_amdgcn_sdot4((int)A14[0], xq[0], 0, false), false), false), false);
            d[15] = __builtin_amdgcn_sdot4((int)A15[3], xq[3], __builtin_amdgcn_sdot4((int)A15[2], xq[2], __builtin_amdgcn_sdot4((int)A15[1], xq[1], __builtin_amdgcn_sdot4((int)A15[0], xq[0], 0, false), false), false), false);
            _Pragma("unroll") for (int st = 0; st < 3; ++st) { const int M = 1 << st, nn = 8 >> st; const int hm = (la & M) ? -1 : 0;
                _Pragma("unroll") for (int i = 0; i < 8; ++i) if (i < nn) { const int keep = (d[nn + i] & hm) | (d[i] & ~hm), send = (d[i] & hm) | (d[nn + i] & ~hm);
                    d[i] = keep + ((st == 0) ? DPP_I(send, 0xB1) : (st == 1) ? DPP_I(send, 0x4E) : __builtin_amdgcn_ds_swizzle(send, (4 << 10) | 0x1f)); } }
            unsigned short* pp = (unsigned short*)(P.ws + WS_PART) + ((size_t)j * T + (unsigned)(T0 + 8 * b + 0)) * 128;
            *(unsigned*)(pp + (unsigned)(16 * sl + i0)) = pk2((float)d[0] * sx, (float)d[1] * sx); }
        { const LAS unsigned char* ip_ = buf + (bs) * 4096 + 2 * 256 + 32 * sl; const u32x4 e0_ = *(const LAS u32x4*)ip_, e1_ = *(const LAS u32x4*)(ip_ + 16);
            A0 = *(const u32x4*)(TAB + ((e0_[0] & 0xffffu) * 128u + pb));
            A1 = *(const u32x4*)(TAB + ((e0_[0] >> 16) * 128u + pb));
            A2 = *(const u32x4*)(TAB + ((e0_[1] & 0xffffu) * 128u + pb));
            A3 = *(const u32x4*)(TAB + ((e0_[1] >> 16) * 128u + pb));
            A4 = *(const u32x4*)(TAB + ((e0_[2] & 0xffffu) * 128u + pb));
            A5 = *(const u32x4*)(TAB + ((e0_[2] >> 16) * 128u + pb));
            A6 = *(const u32x4*)(TAB + ((e0_[3] & 0xffffu) * 128u + pb));
            A7 = *(const u32x4*)(TAB + ((e0_[3] >> 16) * 128u + pb));
            A8 = *(const u32x4*)(TAB + ((e1_[0] & 0xffffu) * 128u + pb));
            A9 = *(const u32x4*)(TAB + ((e1_[0] >> 16) * 128u + pb));
            A10 = *(const u32x4*)(TAB + ((e1_[1] & 0xffffu) * 128u + pb));
            A11 = *(const u32x4*)(TAB + ((e1_[1] >> 16) * 128u + pb));
            A12 = *(const u32x4*)(TAB + ((e1_[2] & 0xffffu) * 128u + pb));
            A13 = *(const u32x4*)(TAB + ((e1_[2] >> 16) * 128u + pb));
            A14 = *(const u32x4*)(TAB + ((e1_[3] & 0xffffu) * 128u + pb));
            A15 = *(const u32x4*)(TAB + ((e1_[3] >> 16) * 128u + pb));
        }
        { const i32x4 xq = *(const LAS i32x4*)(buf + bs * 4096 + 2048 + 1 * 128 + 16 * pc); const float sx = *(const LAS float*)(buf + bs * 4096 + 3072 + 4 * 1);
            int d[16];
            d[0] = __builtin_amdgcn_sdot4((int)B0[3], xq[3], __builtin_amdgcn_sdot4((int)B0[2], xq[2], __builtin_amdgcn_sdot4((int)B0[1], xq[1], __builtin_amdgcn_sdot4((int)B0[0], xq[0], 0, false), false), false), false);
            d[1] = __builtin_amdgcn_sdot4((int)B1[3], xq[3], __builtin_amdgcn_sdot4((int)B1[2], xq[2], __builtin_amdgcn_sdot4((int)B1[1], xq[1], __builtin_amdgcn_sdot4((int)B1[0], xq[0], 0, false), false), false), false);
            d[2] = __builtin_amdgcn_sdot4((int)B2[3], xq[3], __builtin_amdgcn_sdot4((int)B2[2], xq[2], __builtin_amdgcn_sdot4((int)B2[1], xq[1], __builtin_amdgcn_sdot4((int)B2[0], xq[0], 0, false), false), false), false);
            d[3] = __builtin_amdgcn_sdot4((int)B3[3], xq[3], __builtin_amdgcn_sdot4((int)B3[2], xq[2], __builtin_amdgcn_sdot4((int)B3[1], xq[1], __builtin_amdgcn_sdot4((int)B3[0], xq[0], 0, false), false), false), false);
            d[4] = __builtin_amdgcn_sdot4((int)B4[3], xq[3], __builtin_amdgcn_sdot4((int)B4[2], xq[2], __builtin_amdgcn_sdot4((int)B4[1], xq[1], __builtin_amdgcn_sdot4((int)B4[0], xq[0], 0, false), false), false), false);
            d[5] = __builtin_amdgcn_sdot4((int)B5[3], xq[3], __builtin_amdgcn_sdot4((int)B5[2], xq[2], __builtin_amdgcn_sdot4((int)B5[1], xq[1], __builtin_amdgcn_sdot4((int)B5[0], xq[0], 0, false), false), false), false);
            d[6] = __builtin_amdgcn_sdot4((int)B6[3], xq[3], __builtin_amdgcn_sdot4((int)B6[2], xq[2], __builtin_amdgcn_sdot4((int)B6[1], xq[1], __builtin_amdgcn_sdot4((int)B6[0], xq[0], 0, false), false), false), false);
            d[7] = __builtin_amdgcn_sdot4((int)B7[3], xq[3], __builtin_amdgcn_sdot4((int)B7[2], xq[2], __builtin_amdgcn_sdot4((int)B7[1], xq[1], __builtin_amdgcn_sdot4((int)B7[0], xq[0], 0, false), false), false), false);
            d[8] = __builtin_amdgcn_sdot4((int)B8[3], xq[3], __builtin_amdgcn_sdot4((int)B8[2], xq[2], __builtin_amdgcn_sdot4((int)B8[1], xq[1], __builtin_amdgcn_sdot4((int)B8[0], xq[0], 0, false), false), false), false);
            d[9] = __builtin_amdgcn_sdot4((int)B9[3], xq[3], __builtin_amdgcn_sdot4((int)B9[2], xq[2], __builtin_amdgcn_sdot4((int)B9[1], xq[1], __builtin_amdgcn_sdot4((int)B9[0], xq[0], 0, false), false), false), false);
            d[10] = __builtin_amdgcn_sdot4((int)B10[3], xq[3], __builtin_amdgcn_sdot4((int)B10[2], xq[2], __builtin_amdgcn_sdot4((int)B10[1], xq[1], __builtin_amdgcn_sdot4((int)B10[0], xq[0], 0, false), false), false), false);
            d[11] = __builtin_amdgcn_sdot4((int)B11[3], xq[3], __builtin_amdgcn_sdot4((int)B11[2], xq[2], __builtin_amdgcn_sdot4((int)B11[1], xq[1], __builtin_amdgcn_sdot4((int)B11[0], xq[0], 0, false), false), false), false);
            d[12] = __builtin_amdgcn_sdot4((int)B12[3], xq[3], __builtin_amdgcn_sdot4((int)B12[2], xq[2], __builtin_amdgcn_sdot4((int)B12[1], xq[1], __builtin_amdgcn_sdot4((int)B12[0], xq[0], 0, false), false), false), false);
            d[13] = __builtin_amdgcn_sdot4((int)B13[3], xq[3], __builtin_amdgcn_sdot4((int)B13[2], xq[2], __builtin_amdgcn_sdot4((int)B13[1], xq[1], __builtin_amdgcn_sdot4((int)B13[0], xq[0], 0, false), false), false), false);
            d[14] = __builtin_amdgcn_sdot4((int)B14[3], xq[3], __builtin_amdgcn_sdot4((int)B14[2], xq[2], __builtin_amdgcn_sdot4((int)B14[1], xq[1], __builtin_amdgcn_sdot4((int)B14[0], xq[0], 0, false), false), false), false);
            d[15] = __builtin_amdgcn_sdot4((int)B15[3], xq[3], __builtin_amdgcn_sdot4((int)B15[2], xq[2], __builtin_amdgcn_sdot4((int)B15[1], xq[1], __builtin_amdgcn_sdot4((int)B15[0], xq[0], 0, false), false), false), false);
            _Pragma("unroll") for (int st = 0; st < 3; ++st) { const int M = 1 << st, nn = 8 >> st; const int hm = (la & M) ? -1 : 0;
                _Pragma("unroll") for (int i = 0; i < 8; ++i) if (i < nn) { const int keep = (d[nn + i] & hm) | (d[i] & ~hm), send = (d[i] & hm) | (d[nn + i] & ~hm);
                    d[i] = keep + ((st == 0) ? DPP_I(send, 0xB1) : (st == 1) ? DPP_I(send, 0x4E) : __builtin_amdgcn_ds_swizzle(send, (4 << 10) | 0x1f)); } }
            unsigned short* pp = (unsigned short*)(P.ws + WS_PART) + ((size_t)j * T + (unsigned)(T0 + 8 * b + 1)) * 128;
            *(unsigned*)(pp + (unsigned)(16 * sl + i0)) = pk2((float)d[0] * sx, (float)d[1] * sx); }
        U3_PARK(b + 1);
        { const LAS unsigned char* ip_ = buf + (bs) * 4096 + 3 * 256 + 32 * sl; const u32x4 e0_ = *(const LAS u32x4*)ip_, e1_ = *(const LAS u32x4*)(ip_ + 16);
            B0 = *(const u32x4*)(TAB + ((e0_[0] & 0xffffu) * 128u + pb));
            B1 = *(const u32x4*)(TAB + ((e0_[0] >> 16) * 128u + pb));
            B2 = *(const u32x4*)(TAB + ((e0_[1] & 0xffffu) * 128u + pb));
            B3 = *(const u32x4*)(TAB + ((e0_[1] >> 16) * 128u + pb));
            B4 = *(const u32x4*)(TAB + ((e0_[2] & 0xffffu) * 128u + pb));
            B5 = *(const u32x4*)(TAB + ((e0_[2] >> 16) * 128u + pb));
            B6 = *(const u32x4*)(TAB + ((e0_[3] & 0xffffu) * 128u + pb));
            B7 = *(const u32x4*)(TAB + ((e0_[3] >> 16) * 128u + pb));
            B8 = *(const u32x4*)(TAB + ((e1_[0] & 0xffffu) * 128u + pb));
            B9 = *(const u32x4*)(TAB + ((e1_[0] >> 16) * 128u + pb));
            B10 = *(const u32x4*)(TAB + ((e1_[1] & 0xffffu) * 128u + pb));
            B11 = *(const u32x4*)(TAB + ((e1_[1] >> 16) * 128u + pb));
            B12 = *(const u32x4*)(TAB + ((e1_[2] & 0xffffu) * 128u + pb));
            B13 = *(const u32x4*)(TAB + ((e1_[2] >> 16) * 128u + pb));
            B14 = *(const u32x4*)(TAB + ((e1_[3] & 0xffffu) * 128u + pb));
            B15 = *(const u32x4*)(TAB + ((e1_[3] >> 16) * 128u + pb));
        }
        { const i32x4 xq = *(const LAS i32x4*)(buf + bs * 4096 + 2048 + 2 * 128 + 16 * pc); const float sx = *(const LAS float*)(buf + bs * 4096 + 3072 + 4 * 2);
            int d[16];
            d[0] = __builtin_amdgcn_sdot4((int)A0[3], xq[3], __builtin_amdgcn_sdot4((int)A0[2], xq[2], __builtin_amdgcn_sdot4((int)A0[1], xq[1], __builtin_amdgcn_sdot4((int)A0[0], xq[0], 0, false), false), false), false);
            d[1] = __builtin_amdgcn_sdot4((int)A1[3], xq[3], __builtin_amdgcn_sdot4((int)A1[2], xq[2], __builtin_amdgcn_sdot4((int)A1[1], xq[1], __builtin_amdgcn_sdot4((int)A1[0], xq[0], 0, false), false), false), false);
            d[2] = __builtin_amdgcn_sdot4((int)A2[3], xq[3], __builtin_amdgcn_sdot4((int)A2[2], xq[2], __builtin_amdgcn_sdot4((int)A2[1], xq[1], __builtin_amdgcn_sdot4((int)A2[0], xq[0], 0, false), false), false), false);
            d[3] = __builtin_amdgcn_sdot4((int)A3[3], xq[3], __builtin_amdgcn_sdot4((int)A3[2], xq[2], __builtin_amdgcn_sdot4((int)A3[1], xq[1], __builtin_amdgcn_sdot4((int)A3[0], xq[0], 0, false), false), false), false);
            d[4] = __builtin_amdgcn_sdot4((int)A4[3], xq[3], __builtin_amdgcn_sdot4((int)A4[2], xq[2], __builtin_amdgcn_sdot4((int)A4[1], xq[1], __builtin_amdgcn_sdot4((int)A4[0], xq[0], 0, false), false), false), false);
            d[5] = __builtin_amdgcn_sdot4((int)A5[3], xq[3], __builtin_amdgcn_sdot4((int)A5[2], xq[2], __builtin_amdgcn_sdot4((int)A5[1], xq[1], __builtin_amdgcn_sdot4((int)A5[0], xq[0], 0, false), false), false), false);
            d[6] = __builtin_amdgcn_sdot4((int)A6[3], xq[3], __builtin_amdgcn_sdot4((int)A6[2], xq[2], __builtin_amdgcn_sdot4((int)A6[1], xq[1], __builtin_amdgcn_sdot4((int)A6[0], xq[0], 0, false), false), false), false);
            d[7] = __builtin_amdgcn_sdot4((int)A7[3], xq[3], __builtin_amdgcn_sdot4((int)A7[2], xq[2], __builtin_amdgcn_sdot4((int)A7[1], xq[1], __builtin_amdgcn_sdot4((int)A7[0], xq[0], 0, false), false), false), false);
            d[8] = __builtin_amdgcn_sdot4((int)A8[3], xq[3], __builtin_amdgcn_sdot4((int)A8[2], xq[2], __builtin_amdgcn_sdot4((int)A8[1], xq[1], __builtin_amdgcn_sdot4((int)A8[0], xq[0], 0, false), false), false), false);
            d[9] = __builtin_amdgcn_sdot4((int)A9[3], xq[3], __builtin_amdgcn_sdot4((int)A9[2], xq[2], __builtin_amdgcn_sdot4((int)A9[1], xq[1], __builtin_amdgcn_sdot4((int)A9[0], xq[0], 0, false), false), false), false);
            d[10] = __builtin_amdgcn_sdot4((int)A10[3], xq[3], __builtin_amdgcn_sdot4((int)A10[2], xq[2], __builtin_amdgcn_sdot4((int)A10[1], xq[1], __builtin_amdgcn_sdot4((int)A10[0], xq[0], 0, false), false), false), false);
            d[11] = __builtin_amdgcn_sdot4((int)A11[3], xq[3], __builtin_amdgcn_sdot4((int)A11[2], xq[2], __builtin_amdgcn_sdot4((int)A11[1], xq[1], __builtin_amdgcn_sdot4((int)A11[0], xq[0], 0, false), false), false), false);
            d[12] = __builtin_amdgcn_sdot4((int)A12[3], xq[3], __builtin_amdgcn_sdot4((int)A12[2], xq[2], __builtin_amdgcn_sdot4((int)A12[1], xq[1], __builtin_amdgcn_sdot4((int)A12[0], xq[0], 0, false), false), false), false);
            d[13] = __builtin_amdgcn_sdot4((int)A13[3], xq[3], __builtin_amdgcn_sdot4((int)A13[2], xq[2], __builtin_amdgcn_sdot4((int)A13[1], xq[1], __builtin_amdgcn_sdot4((int)A13[0], xq[0], 0, false), false), false), false);
            d[14] = __builtin_amdgcn_sdot4((int)A14[3], xq[3], __builtin_amdgcn_sdot4((int)A14[2], xq[2], __builtin_amdgcn_sdot4((int)A14[1], xq[1], __builtin_amdgcn_sdot4((int)A14[0], xq[0], 0, false), false), false), false);
            d[15] = __builtin_amdgcn_sdot4((int)A15[3], xq[3], __builtin_amdgcn_sdot4((int)A15[2], xq[2], __builtin_amdgcn_sdot4((int)A15[1], xq[1], __builtin_amdgcn_sdot4((int)A15[0], xq[0], 0, false), false), false), false);
            _Pragma("unroll") for (int st = 0; st < 3; ++st) { const int M = 1 << st, nn = 8 >> st; const int hm = (la & M) ? -1 : 0;
                _Pragma("unroll") for (int i = 0; i < 8; ++i) if (i < nn) { const int keep = (d[nn + i] & hm) | (d[i] & ~hm), send = (d[i] & hm) | (d[nn + i] & ~hm);
                    d[i] = keep + ((st == 0) ? DPP_I(send, 0xB1) : (st == 1) ? DPP_I(send, 0x4E) : __builtin_amdgcn_ds_swizzle(send, (4 << 10) | 0x1f)); } }
            unsigned short* pp = (unsigned short*)(P.ws + WS_PART) + ((size_t)j * T + (unsigned)(T0 + 8 * b + 2)) * 128;
            *(unsigned*)(pp + (unsigned)(16 * sl + i0)) = pk2((float)d[0] * sx, (float)d[1] * sx); }
        { const LAS unsigned char* ip_ = buf + (bs) * 4096 + 4 * 256 + 32 * sl; const u32x4 e0_ = *(const LAS u32x4*)ip_, e1_ = *(const LAS u32x4*)(ip_ + 16);
            A0 = *(const u32x4*)(TAB + ((e0_[0] & 0xffffu) * 128u + pb));
            A1 = *(const u32x4*)(TAB + ((e0_[0] >> 16) * 128u + pb));
            A2 = *(const u32x4*)(TAB + ((e0_[1] & 0xffffu) * 128u + pb));
            A3 = *(const u32x4*)(TAB + ((e0_[1] >> 16) * 128u + pb));
            A4 = *(const u32x4*)(TAB + ((e0_[2] & 0xffffu) * 128u + pb));
            A5 = *(const u32x4*)(TAB + ((e0_[2] >> 16) * 128u + pb));
            A6 = *(const u32x4*)(TAB + ((e0_[3] & 0xffffu) * 128u + pb));
            A7 = *(const u32x4*)(TAB + ((e0_[3] >> 16) * 128u + pb));
            A8 = *(const u32x4*)(TAB + ((e1_[0] & 0xffffu) * 128u + pb));
            A9 = *(const u32x4*)(TAB + ((e1_[0] >> 16) * 128u + pb));
            A10 = *(const u32x4*)(TAB + ((e1_[1] & 0xffffu) * 128u + pb));
            A11 = *(const u32x4*)(TAB + ((e1_[1] >> 16) * 128u + pb));
            A12 = *(const u32x4*)(TAB + ((e1_[2] & 0xffffu) * 128u + pb));
            A13 = *(const u32x4*)(TAB + ((e1_[2] >> 16) * 128u + pb));
            A14 = *(const u32x4*)(TAB + ((e1_[3] & 0xffffu) * 128u + pb));
            A15 = *(const u32x4*)(TAB + ((e1_[3] >> 16) * 128u + pb));
        }
        { const i32x4 xq = *(const LAS i32x4*)(buf + bs * 4096 + 2048 + 3 * 128 + 16 * pc); const float sx = *(const LAS float*)(buf + bs * 4096 + 3072 + 4 * 3);
            int d[16];
            d[0] = __builtin_amdgcn_sdot4((int)B0[3], xq[3], __builtin_amdgcn_sdot4((int)B0[2], xq[2], __builtin_amdgcn_sdot4((int)B0[1], xq[1], __builtin_amdgcn_sdot4((int)B0[0], xq[0], 0, false), false), false), false);
            d[1] = __builtin_amdgcn_sdot4((int)B1[3], xq[3], __builtin_amdgcn_sdot4((int)B1[2], xq[2], __builtin_amdgcn_sdot4((int)B1[1], xq[1], __builtin_amdgcn_sdot4((int)B1[0], xq[0], 0, false), false), false), false);
            d[2] = __builtin_amdgcn_sdot4((int)B2[3], xq[3], __builtin_amdgcn_sdot4((int)B2[2], xq[2], __builtin_amdgcn_sdot4((int)B2[1], xq[1], __builtin_amdgcn_sdot4((int)B2[0], xq[0], 0, false), false), false), false);
            d[3] = __builtin_amdgcn_sdot4((int)B3[3], xq[3], __builtin_amdgcn_sdot4((int)B3[2], xq[2], __builtin_amdgcn_sdot4((int)B3[1], xq[1], __builtin_amdgcn_sdot4((int)B3[0], xq[0], 0, false), false), false), false);
            d[4] = __builtin_amdgcn_sdot4((int)B4[3], xq[3], __builtin_amdgcn_sdot4((int)B4[2], xq[2], __builtin_amdgcn_sdot4((int)B4[1], xq[1], __builtin_amdgcn_sdot4((int)B4[0], xq[0], 0, false), false), false), false);
            d[5] = __builtin_amdgcn_sdot4((int)B5[3], xq[3], __builtin_amdgcn_sdot4((int)B5[2], xq[2], __builtin_amdgcn_sdot4((int)B5[1], xq[1], __builtin_amdgcn_sdot4((int)B5[0], xq[0], 0, false), false), false), false);
            d[6] = __builtin_amdgcn_sdot4((int)B6[3], xq[3], __builtin_amdgcn_sdot4((int)B6[2], xq[2], __builtin_amdgcn_sdot4((int)B6[1], xq[1], __builtin_amdgcn_sdot4((int)B6[0], xq[0], 0, false), false), false), false);
            d[7] = __builtin_amdgcn_sdot4((int)B7[3], xq[3], __builtin_amdgcn_sdot4((int)B7[2], xq[2], __builtin_amdgcn_sdot4((int)B7[1], xq[1], __builtin_amdgcn_sdot4((int)B7[0], xq[0], 0, false), false), false), false);
            d[8] = __builtin_amdgcn_sdot4((int)B8[3], xq[3], __builtin_amdgcn_sdot4((int)B8[2], xq[2], __builtin_amdgcn_sdot4((int)B8[1], xq[1], __builtin_amdgcn_sdot4((int)B8[0], xq[0], 0, false), false), false), false);
            d[9] = __builtin_amdgcn_sdot4((int)B9[3], xq[3], __builtin_amdgcn_sdot4((int)B9[2], xq[2], __builtin_amdgcn_sdot4((int)B9[1], xq[1], __builtin_amdgcn_sdot4((int)B9[0], xq[0], 0, false), false), false), false);
            d[10] = __builtin_amdgcn_sdot4((int)B10[3], xq[3], __builtin_amdgcn_sdot4((int)B10[2], xq[2], __builtin_amdgcn_sdot4((int)B10[1], xq[1], __builtin_amdgcn_sdot4((int)B10[0], xq[0], 0, false), false), false), false);
            d[11] = __builtin_amdgcn_sdot4((int)B11[3], xq[3], __builtin_amdgcn_sdot4((int)B11[2], xq[2], __builtin_amdgcn_sdot4((int)B11[1], xq[1], __builtin_amdgcn_sdot4((int)B11[0], xq[0], 0, false), false), false), false);
            d[12] = __builtin_amdgcn_sdot4((int)B12[3], xq[3], __builtin_amdgcn_sdot4((int)B12[2], xq[2], __builtin_amdgcn_sdot4((int)B12[1], xq[1], __builtin_amdgcn_sdot4((int)B12[0], xq[0], 0, false), false), false), false);
            d[13] = __builtin_amdgcn_sdot4((int)B13[3], xq[3], __builtin_amdgcn_sdot4((int)B13[2], xq[2], __builtin_amdgcn_sdot4((int)B13[1], xq[1], __builtin_amdgcn_sdot4((int)B13[0], xq[0], 0, false), false), false), false);
            d[14] = __builtin_amdgcn_sdot4((int)B14[3], xq[3], __builtin_amdgcn_sdot4((int)B14[2], xq[2], __builtin_amdgcn_sdot4((int)B14[1], xq[1], __builtin_amdgcn_sdot4((int)B14[0], xq[0], 0, false), false), false), false);
            d[15] = __builtin_amdgcn_sdot4((int)B15[3], xq[3], __builtin_amdgcn_sdot4((int)B15[2], xq[2], __builtin_amdgcn_sdot4((int)B15[1], xq[1], __builtin_amdgcn_sdot4((int)B15[0], xq[0], 0, false), false), false), false);
            _Pragma("unroll") for (int st = 0; st < 3; ++st) { const int M = 1 << st, nn = 8 >> st; const int hm = (la & M) ? -1 : 0;
                _Pragma("unroll") for (int i = 0; i < 8; ++i) if (i < nn) { const int keep = (d[nn + i] & hm) | (d[i] & ~hm), send = (d[i] & hm) | (d[nn + i] & ~hm);
                    d[i] = keep + ((st == 0) ? DPP_I(send, 0xB1) : (st == 1) ? DPP_I(send, 0x4E) : __builtin_amdgcn_ds_swizzle(send, (4 << 10) | 0x1f)); } }
            unsigned short* pp = (unsigned short*)(P.ws + WS_PART) + ((size_t)j * T + (unsigned)(T0 + 8 * b + 3)) * 128;
            *(unsigned*)(pp + (unsigned)(16 * sl + i0)) = pk2((float)d[0] * sx, (float)d[1] * sx); }
        { const LAS unsigned char* ip_ = buf + (bs) * 4096 + 5 * 256 + 32 * sl; const u32x4 e0_ = *(const LAS u32x4*)ip_, e1_ = *(const LAS u32x4*)(ip_ + 16);
            B0 = *(const u32x4*)(TAB + ((e0_[0] & 0xffffu) * 128u + pb));
            B1 = *(const u32x4*)(TAB + ((e0_[0] >> 16) * 128u + pb));
            B2 = *(const u32x4*)(TAB + ((e0_[1] & 0xffffu) * 128u + pb));
            B3 = *(const u32x4*)(TAB + ((e0_[1] >> 16) * 128u + pb));
            B4 = *(const u32x4*)(TAB + ((e0_[2] & 0xffffu) * 128u + pb));
            B5 = *(const u32x4*)(TAB + ((e0_[2] >> 16) * 128u + pb));
            B6 = *(const u32x4*)(TAB + ((e0_[3] & 0xffffu) * 128u + pb));
            B7 = *(const u32x4*)(TAB + ((e0_[3] >> 16) * 128u + pb));
            B8 = *(const u32x4*)(TAB + ((e1_[0] & 0xffffu) * 128u + pb));
            B9 = *(const u32x4*)(TAB + ((e1_[0] >> 16) * 128u + pb));
            B10 = *(const u32x4*)(TAB + ((e1_[1] & 0xffffu) * 128u + pb));
            B11 = *(const u32x4*)(TAB + ((e1_[1] >> 16) * 128u + pb));
            B12 = *(const u32x4*)(TAB + ((e1_[2] & 0xffffu) * 128u + pb));
            B13 = *(const u32x4*)(TAB + ((e1_[2] >> 16) * 128u + pb));
            B14 = *(const u32x4*)(TAB + ((e1_[3] & 0xffffu) * 128u + pb));
            B15 = *(const u32x4*)(TAB + ((e1_[3] >> 16) * 128u + pb));
        }
        { const i32x4 xq = *(const LAS i32x4*)(buf + bs * 4096 + 2048 + 4 * 128 + 16 * pc); const float sx = *(const LAS float*)(buf + bs * 4096 + 3072 + 4 * 4);
            int d[16];
            d[0] = __builtin_amdgcn_sdot4((int)A0[3], xq[3], __builtin_amdgcn_sdot4((int)A0[2], xq[2], __builtin_amdgcn_sdot4((int)A0[1], xq[1], __builtin_amdgcn_sdot4((int)A0[0], xq[0], 0, false), false), false), false);
            d[1] = __builtin_amdgcn_sdot4((int)A1[3], xq[3], __builtin_amdgcn_sdot4((int)A1[2], xq[2], __builtin_amdgcn_sdot4((int)A1[1], xq[1], __builtin_amdgcn_sdot4((int)A1[0], xq[0], 0, false), false), false), false);
            d[2] = __builtin_amdgcn_sdot4((int)A2[3], xq[3], __builtin_amdgcn_sdot4((int)A2[2], xq[2], __builtin_amdgcn_sdot4((int)A2[1], xq[1], __builtin_amdgcn_sdot4((int)A2[0], xq[0], 0, false), false), false), false);
            d[3] = __builtin_amdgcn_sdot4((int)A3[3], xq[3], __builtin_amdgcn_sdot4((int)A3[2], xq[2], __builtin_amdgcn_sdot4((int)A3[1], xq[1], __builtin_amdgcn_sdot4((int)A3[0], xq[0], 0, false), false), false), false);
            d[4] = __builtin_amdgcn_sdot4((int)A4[3], xq[3], __builtin_amdgcn_sdot4((int)A4[2], xq[2], __builtin_amdgcn_sdot4((int)A4[1], xq[1], __builtin_amdgcn_sdot4((int)A4[0], xq[0], 0, false), false), false), false);
            d[5] = __builtin_amdgcn_sdot4((int)A5[3], xq[3], __builtin_amdgcn_sdot4((int)A5[2], xq[2], __builtin_amdgcn_sdot4((int)A5[1], xq[1], __builtin_amdgcn_sdot4((int)A5[0], xq[0], 0, false), false), false), false);
            d[6] = __builtin_amdgcn_sdot4((int)A6[3], xq[3], __builtin_amdgcn_sdot4((int)A6[2], xq[2], __builtin_amdgcn_sdot4((int)A6[1], xq[1], __builtin_amdgcn_sdot4((int)A6[0], xq[0], 0, false), false), false), false);
            d[7] = __builtin_amdgcn_sdot4((int)A7[3], xq[3], __builtin_amdgcn_sdot4((int)A7[2], xq[2], __builtin_amdgcn_sdot4((int)A7[1], xq[1], __builtin_amdgcn_sdot4((int)A7[0], xq[0], 0, false), false), false), false);
            d[8] = __builtin_amdgcn_sdot4((int)A8[3], xq[3], __builtin_amdgcn_sdot4((int)A8[2], xq[2], __builtin_amdgcn_sdot4((int)A8[1], xq[1], __builtin_amdgcn_sdot4((int)A8[0], xq[0], 0, false), false), false), false);
            d[9] = __builtin_amdgcn_sdot4((int)A9[3], xq[3], __builtin_amdgcn_sdot4((int)A9[2], xq[2], __builtin_amdgcn_sdot4((int)A9[1], xq[1], __builtin_amdgcn_sdot4((int)A9[0], xq[0], 0, false), false), false), false);
            d[10] = __builtin_amdgcn_sdot4((int)A10[3], xq[3], __builtin_amdgcn_sdot4((int)A10[2], xq[2], __builtin_amdgcn_sdot4((int)A10[1], xq[1], __builtin_amdgcn_sdot4((int)A10[0], xq[0], 0, false), false), false), false);
            d[11] = __builtin_amdgcn_sdot4((int)A11[3], xq[3], __builtin_amdgcn_sdot4((int)A11[2], xq[2], __builtin_amdgcn_sdot4((int)A11[1], xq[1], __builtin_amdgcn_sdot4((int)A11[0], xq[0], 0, false), false), false), false);
            d[12] = __builtin_amdgcn_sdot4((int)A12[3], xq[3], __builtin_amdgcn_sdot4((int)A12[2], xq[2], __builtin_amdgcn_sdot4((int)A12[1], xq[1], __builtin_amdgcn_sdot4((int)A12[0], xq[0], 0, false), false), false), false);
            d[13] = __builtin_amdgcn_sdot4((int)A13[3], xq[3], __builtin_amdgcn_sdot4((int)A13[2], xq[2], __builtin_amdgcn_sdot4((int)A13[1], xq[1], __builtin_amdgcn_sdot4((int)A13[0], xq[0], 0, false), false), false), false);
            d[14] = __builtin_amdgcn_sdot4((int)A14[3], xq[3], __builtin_amdgcn_sdot4((int)A14[2], xq[2], __builtin_amdgcn_sdot4((int)A14[1], xq[1], __builtin_amdgcn_sdot4((int)A14[0], xq[0], 0, false), false), false), false);
            d[15] = __builtin_amdgcn_sdot4((int)A15[3], xq[3], __builtin_amdgcn_sdot4((int)A15[2], xq[2], __builtin_amdgcn_sdot4((int)A15[1], xq[1], __builtin_amdgcn_sdot4((int)A15[0], xq[0], 0, false), false), false), false);
            _Pragma("unroll") for (int st = 0; st < 3; ++st) { const int M = 1 << st, nn = 8 >> st; const int hm = (la & M) ? -1 : 0;
                _Pragma("unroll") for (int i = 0; i < 8; ++i) if (i < nn) { const int keep = (d[nn + i] & hm) | (d[i] & ~hm), send = (d[i] & hm) | (d[nn + i] & ~hm);
                    d[i] = keep + ((st == 0) ? DPP_I(send, 0xB1) : (st == 1) ? DPP_I(send, 0x4E) : __builtin_amdgcn_ds_swizzle(send, (4 << 10) | 0x1f)); } }
            unsigned short* pp = (unsigned short*)(P.ws + WS_PART) + ((size_t)j * T + (unsigned)(T0 + 8 * b + 4)) * 128;
            *(unsigned*)(pp + (unsigned)(16 * sl + i0)) = pk2((float)d[0] * sx, (float)d[1] * sx); }
        { const LAS unsigned char* ip_ = buf + (bs) * 4096 + 6 * 256 + 32 * sl; const u32x4 e0_ = *(const LAS u32x4*)ip_, e1_ = *(const LAS u32x4*)(ip_ + 16);
            A0 = *(const u32x4*)(TAB + ((e0_[0] & 0xffffu) * 128u + pb));
            A1 = *(const u32x4*)(TAB + ((e0_[0] >> 16) * 128u + pb));
            A2 = *(const u32x4*)(TAB + ((e0_[1] & 0xffffu) * 128u + pb));
            A3 = *(const u32x4*)(TAB + ((e0_[1] >> 16) * 128u + pb));
            A4 = *(const u32x4*)(TAB + ((e0_[2] & 0xffffu) * 128u + pb));
            A5 = *(const u32x4*)(TAB + ((e0_[2] >> 16) * 128u + pb));
            A6 = *(const u32x4*)(TAB + ((e0_[3] & 0xffffu) * 128u + pb));
            A7 = *(const u32x4*)(TAB + ((e0_[3] >> 16) * 128u + pb));
            A8 = *(const u32x4*)(TAB + ((e1_[0] & 0xffffu) * 128u + pb));
            A9 = *(const u32x4*)(TAB + ((e1_[0] >> 16) * 128u + pb));
            A10 = *(const u32x4*)(TAB + ((e1_[1] & 0xffffu) * 128u + pb));
            A11 = *(const u32x4*)(TAB + ((e1_[1] >> 16) * 128u + pb));
            A12 = *(const u32x4*)(TAB + ((e1_[2] & 0xffffu) * 128u + pb));
            A13 = *(const u32x4*)(TAB + ((e1_[2] >> 16) * 128u + pb));
            A14 = *(const u32x4*)(TAB + ((e1_[3] & 0xffffu) * 128u + pb));
            A15 = *(const u32x4*)(TAB + ((e1_[3] >> 16) * 128u + pb));
        }
        { const i32x4 xq = *(const LAS i32x4*)(buf + bs * 4096 + 2048 + 5 * 128 + 16 * pc); const float sx = *(const LAS float*)(buf + bs * 4096 + 3072 + 4 * 5);
            int d[16];
            d[0] = __builtin_amdgcn_sdot4((int)B0[3], xq[3], __builtin_amdgcn_sdot4((int)B0[2], xq[2], __builtin_amdgcn_sdot4((int)B0[1], xq[1], __builtin_amdgcn_sdot4((int)B0[0], xq[0], 0, false), false), false), false);
            d[1] = __builtin_amdgcn_sdot4((int)B1[3], xq[3], __builtin_amdgcn_sdot4((int)B1[2], xq[2], __builtin_amdgcn_sdot4((int)B1[1], xq[1], __builtin_amdgcn_sdot4((int)B1[0], xq[0], 0, false), false), false), false);
            d[2] = __builtin_amdgcn_sdot4((int)B2[3], xq[3], __builtin_amdgcn_sdot4((int)B2[2], xq[2], __builtin_amdgcn_sdot4((int)B2[1], xq[1], __builtin_amdgcn_sdot4((int)B2[0], xq[0], 0, false), false), false), false);
            d[3] = __builtin_amdgcn_sdot4((int)B3[3], xq[3], __builtin_amdgcn_sdot4((int)B3[2], xq[2], __builtin_amdgcn_sdot4((int)B3[1], xq[1], __builtin_amdgcn_sdot4((int)B3[0], xq[0], 0, false), false), false), false);
            d[4] = __builtin_amdgcn_sdot4((int)B4[3], xq[3], __builtin_amdgcn_sdot4((int)B4[2], xq[2], __builtin_amdgcn_sdot4((int)B4[1], xq[1], __builtin_amdgcn_sdot4((int)B4[0], xq[0], 0, false), false), false), false);
            d[5] = __builtin_amdgcn_sdot4((int)B5[3], xq[3], __builtin_amdgcn_sdot4((int)B5[2], xq[2], __builtin_amdgcn_sdot4((int)B5[1], xq[1], __builtin_amdgcn_sdot4((int)B5[0], xq[0], 0, false), false), false), false);
            d[6] = __builtin_amdgcn_sdot4((int)B6[3], xq[3], __builtin_amdgcn_sdot4((int)B6[2], xq[2], __builtin_amdgcn_sdot4((int)B6[1], xq[1], __builtin_amdgcn_sdot4((int)B6[0], xq[0], 0, false), false), false), false);
            d[7] = __builtin_amdgcn_sdot4((int)B7[3], xq[3], __builtin_amdgcn_sdot4((int)B7[2], xq[2], __builtin_amdgcn_sdot4((int)B7[1], xq[1], __builtin_amdgcn_sdot4((int)B7[0], xq[0], 0, false), false), false), false);
            d[8] = __builtin_amdgcn_sdot4((int)B8[3], xq[3], __builtin_amdgcn_sdot4((int)B8[2], xq[2], __builtin_amdgcn_sdot4((int)B8[1], xq[1], __builtin_amdgcn_sdot4((int)B8[0], xq[0], 0, false), false), false), false);
            d[9] = __builtin_amdgcn_sdot4((int)B9[3], xq[3], __builtin_amdgcn_sdot4((int)B9[2], xq[2], __builtin_amdgcn_sdot4((int)B9[1], xq[1], __builtin_amdgcn_sdot4((int)B9[0], xq[0], 0, false), false), false), false);
            d[10] = __builtin_amdgcn_sdot4((int)B10[3], xq[3], __builtin_amdgcn_sdot4((int)B10[2], xq[2], __builtin_amdgcn_sdot4((int)B10[1], xq[1], __builtin_amdgcn_sdot4((int)B10[0], xq[0], 0, false), false), false), false);
            d[11] = __builtin_amdgcn_sdot4((int)B11[3], xq[3], __builtin_amdgcn_sdot4((int)B11[2], xq[2], __builtin_amdgcn_sdot4((int)B11[1], xq[1], __builtin_amdgcn_sdot4((int)B11[0], xq[0], 0, false), false), false), false);
            d[12] = __builtin_amdgcn_sdot4((int)B12[3], xq[3], __builtin_amdgcn_sdot4((int)B12[2], xq[2], __builtin_amdgcn_sdot4((int)B12[1], xq[1], __builtin_amdgcn_sdot4((int)B12[0], xq[0], 0, false), false), false), false);
            d[13] = __builtin_amdgcn_sdot4((int)B13[3], xq[3], __builtin_amdgcn_sdot4((int)B13[2], xq[2], __builtin_amdgcn_sdot4((int)B13[1], xq[1], __builtin_amdgcn_sdot4((int)B13[0], xq[0], 0, false), false), false), false);
            d[14] = __builtin_amdgcn_sdot4((int)B14[3], xq[3], __builtin_amdgcn_sdot4((int)B14[2], xq[2], __builtin_amdgcn_sdot4((int)B14[1], xq[1], __builtin_amdgcn_sdot4((int)B14[0], xq[0], 0, false), false), false), false);
            d[15] = __builtin_amdgcn_sdot4((int)B15[3], xq[3], __builtin_amdgcn_sdot4((int)B15[2], xq[2], __builtin_amdgcn_sdot4((int)B15[1], xq[1], __builtin_amdgcn_sdot4((int)B15[0], xq[0], 0, false), false), false), false);
            _Pragma("unroll") for (int st = 0; st < 3; ++st) { const int M = 1 << st, nn = 8 >> st; const int hm = (la & M) ? -1 : 0;
                _Pragma("unroll") for (int i = 0; i < 8; ++i) if (i < nn) { const int keep = (d[nn + i] & hm) | (d[i] & ~hm), send = (d[i] & hm) | (d[nn + i] & ~hm);
                    d[i] = keep + ((st == 0) ? DPP_I(send, 0xB1) : (st == 1) ? DPP_I(send, 0x4E) : __builtin_amdgcn_ds_swizzle(send, (4 << 10) | 0x1f)); } }
            unsigned short* pp = (unsigned short*)(P.ws + WS_PART) + ((size_t)j * T + (unsigned)(T0 + 8 * b + 5)) * 128;
            *(unsigned*)(pp + (unsigned)(16 * sl + i0)) = pk2((float)d[0] * sx, (float)d[1] * sx); }
        { const LAS unsigned char* ip_ = buf + (bs) * 4096 + 7 * 256 + 32 * sl; const u32x4 e0_ = *(const LAS u32x4*)ip_, e1_ = *(const LAS u32x4*)(ip_ + 16);
            B0 = *(const u32x4*)(TAB + ((e0_[0] & 0xffffu) * 128u + pb));
            B1 = *(const u32x4*)(TAB + ((e0_[0] >> 16) * 128u + pb));
            B2 = *(const u32x4*)(TAB + ((e0_[1] & 0xffffu) * 128u + pb));
            B3 = *(const u32x4*)(TAB + ((e0_[1] >> 16) * 128u + pb));
            B4 = *(const u32x4*)(TAB + ((e0_[2] & 0xffffu) * 128u + pb));
            B5 = *(const u32x4*)(TAB + ((e0_[2] >> 16) * 128u + pb));
            B6 = *(const u32x4*)(TAB + ((e0_[3] & 0xffffu) * 128u + pb));
            B7 = *(const u32x4*)(TAB + ((e0_[3] >> 16) * 128u + pb));
            B8 = *(const u32x4*)(TAB + ((e1_[0] & 0xffffu) * 128u + pb));
            B9 = *(const u32x4*)(TAB + ((e1_[0] >> 16) * 128u + pb));
            B10 = *(const u32x4*)(TAB + ((e1_[1] & 0xffffu) * 128u + pb));
            B11 = *(const u32x4*)(TAB + ((e1_[1] >> 16) * 128u + pb));
            B12 = *(const u32x4*)(TAB + ((e1_[2] & 0xffffu) * 128u + pb));
            B13 = *(const u32x4*)(TAB + ((e1_[2] >> 16) * 128u + pb));
            B14 = *(const u32x4*)(TAB + ((e1_[3] & 0xffffu) * 128u + pb));
            B15 = *(const u32x4*)(TAB + ((e1_[3] >> 16) * 128u + pb));
        }
        { const i32x4 xq = *(const LAS i32x4*)(buf + bs * 4096 + 2048 + 6 * 128 + 16 * pc); const float sx = *(const LAS float*)(buf + bs * 4096 + 3072 + 4 * 6);
            int d[16];
            d[0] = __builtin_amdgcn_sdot4((int)A0[3], xq[3], __builtin_amdgcn_sdot4((int)A0[2], xq[2], __builtin_amdgcn_sdot4((int)A0[1], xq[1], __builtin_amdgcn_sdot4((int)A0[0], xq[0], 0, false), false), false), false);
            d[1] = __builtin_amdgcn_sdot4((int)A1[3], xq[3], __builtin_amdgcn_sdot4((int)A1[2], xq[2], __builtin_amdgcn_sdot4((int)A1[1], xq[1], __builtin_amdgcn_sdot4((int)A1[0], xq[0], 0, false), false), false), false);
            d[2] = __builtin_amdgcn_sdot4((int)A2[3], xq[3], __builtin_amdgcn_sdot4((int)A2[2], xq[2], __builtin_amdgcn_sdot4((int)A2[1], xq[1], __builtin_amdgcn_sdot4((int)A2[0], xq[0], 0, false), false), false), false);
            d[3] = __builtin_amdgcn_sdot4((int)A3[3], xq[3], __builtin_amdgcn_sdot4((int)A3[2], xq[2], __builtin_amdgcn_sdot4((int)A3[1], xq[1], __builtin_amdgcn_sdot4((int)A3[0], xq[0], 0, false), false), false), false);
            d[4] = __builtin_amdgcn_sdot4((int)A4[3], xq[3], __builtin_amdgcn_sdot4((int)A4[2], xq[2], __builtin_amdgcn_sdot4((int)A4[1], xq[1], __builtin_amdgcn_sdot4((int)A4[0], xq[0], 0, false), false), false), false);
            d[5] = __builtin_amdgcn_sdot4((int)A5[3], xq[3], __builtin_amdgcn_sdot4((int)A5[2], xq[2], __builtin_amdgcn_sdot4((int)A5[1], xq[1], __builtin_amdgcn_sdot4((int)A5[0], xq[0], 0, false), false), false), false);
            d[6] = __builtin_amdgcn_sdot4((int)A6[3], xq[3], __builtin_amdgcn_sdot4((int)A6[2], xq[2], __builtin_amdgcn_sdot4((int)A6[1], xq[1], __builtin_amdgcn_sdot4((int)A6[0], xq[0], 0, false), false), false), false);
            d[7] = __builtin_amdgcn_sdot4((int)A7[3], xq[3], __builtin_amdgcn_sdot4((int)A7[2], xq[2], __builtin_amdgcn_sdot4((int)A7[1], xq[1], __builtin_amdgcn_sdot4((int)A7[0], xq[0], 0, false), false), false), false);
            d[8] = __builtin_amdgcn_sdot4((int)A8[3], xq[3], __builtin_amdgcn_sdot4((int)A8[2], xq[2], __builtin_amdgcn_sdot4((int)A8[1], xq[1], __builtin_amdgcn_sdot4((int)A8[0], xq[0], 0, false), false), false), false);
            d[9] = __builtin_amdgcn_sdot4((int)A9[3], xq[3], __builtin_amdgcn_sdot4((int)A9[2], xq[2], __builtin_amdgcn_sdot4((int)A9[1], xq[1], __builtin_amdgcn_sdot4((int)A9[0], xq[0], 0, false), false), false), false);
            d[10] = __builtin_amdgcn_sdot4((int)A10[3], xq[3], __builtin_amdgcn_sdot4((int)A10[2], xq[2], __builtin_amdgcn_sdot4((int)A10[1], xq[1], __builtin_amdgcn_sdot4((int)A10[0], xq[0], 0, false), false), false), false);
            d[11] = __builtin_amdgcn_sdot4((int)A11[3], xq[3], __builtin_amdgcn_sdot4((int)A11[2], xq[2], __builtin_amdgcn_sdot4((int)A11[1], xq[1], __builtin_amdgcn_sdot4((int)A11[0], xq[0], 0, false), false), false), false);
            d[12] = __builtin_amdgcn_sdot4((int)A12[3], xq[3], __builtin_amdgcn_sdot4((int)A12[2], xq[2], __builtin_amdgcn_sdot4((int)A12[1], xq[1], __builtin_amdgcn_sdot4((int)A12[0], xq[0], 0, false), false), false), false);
            d[13] = __builtin_amdgcn_sdot4((int)A13[3], xq[3], __builtin_amdgcn_sdot4((int)A13[2], xq[2], __builtin_amdgcn_sdot4((int)A13[1], xq[1], __builtin_amdgcn_sdot4((int)A13[0], xq[0], 0, false), false), false), false);
            d[14] = __builtin_amdgcn_sdot4((int)A14[3], xq[3], __builtin_amdgcn_sdot4((int)A14[2], xq[2], __builtin_amdgcn_sdot4((int)A14[1], xq[1], __builtin_amdgcn_sdot4((int)A14[0], xq[0], 0, false), false), false), false);
            d[15] = __builtin_amdgcn_sdot4((int)A15[3], xq[3], __builtin_amdgcn_sdot4((int)A15[2], xq[2], __builtin_amdgcn_sdot4((int)A15[1], xq[1], __builtin_amdgcn_sdot4((int)A15[0], xq[0], 0, false), false), false), false);
            _Pragma("unroll") for (int st = 0; st < 3; ++st) { const int M = 1 << st, nn = 8 >> st; const int hm = (la & M) ? -1 : 0;
                _Pragma("unroll") for (int i = 0; i < 8; ++i) if (i < nn) { const int keep = (d[nn + i] & hm) | (d[i] & ~hm), send = (d[i] & hm) | (d[nn + i] & ~hm);
                    d[i] = keep + ((st == 0) ? DPP_I(send, 0xB1) : (st == 1) ? DPP_I(send, 0x4E) : __builtin_amdgcn_ds_swizzle(send, (4 << 10) | 0x1f)); } }
            unsigned short* pp = (unsigned short*)(P.ws + WS_PART) + ((size_t)j * T + (unsigned)(T0 + 8 * b + 6)) * 128;
            *(unsigned*)(pp + (unsigned)(16 * sl + i0)) = pk2((float)d[0] * sx, (float)d[1] * sx); }
        { const LAS unsigned char* ip_ = buf + (bs ^ 1) * 4096 + 0 * 256 + 32 * sl; const u32x4 e0_ = *(const LAS u32x4*)ip_, e1_ = *(const LAS u32x4*)(ip_ + 16);
            A0 = *(const u32x4*)(TAB + ((e0_[0] & 0xffffu) * 128u + pb));
            A1 = *(const u32x4*)(TAB + ((e0_[0] >> 16) * 128u + pb));
            A2 = *(const u32x4*)(TAB + ((e0_[1] & 0xffffu) * 128u + pb));
            A3 = *(const u32x4*)(TAB + ((e0_[1] >> 16) * 128u + pb));
            A4 = *(const u32x4*)(TAB + ((e0_[2] & 0xffffu) * 128u + pb));
            A5 = *(const u32x4*)(TAB + ((e0_[2] >> 16) * 128u + pb));
            A6 = *(const u32x4*)(TAB + ((e0_[3] & 0xffffu) * 128u + pb));
            A7 = *(const u32x4*)(TAB + ((e0_[3] >> 16) * 128u + pb));
            A8 = *(const u32x4*)(TAB + ((e1_[0] & 0xffffu) * 128u + pb));
            A9 = *(const u32x4*)(TAB + ((e1_[0] >> 16) * 128u + pb));
            A10 = *(const u32x4*)(TAB + ((e1_[1] & 0xffffu) * 128u + pb));
            A11 = *(const u32x4*)(TAB + ((e1_[1] >> 16) * 128u + pb));
            A12 = *(const u32x4*)(TAB + ((e1_[2] & 0xffffu) * 128u + pb));
            A13 = *(const u32x4*)(TAB + ((e1_[2] >> 16) * 128u + pb));
            A14 = *(const u32x4*)(TAB + ((e1_[3] & 0xffffu) * 128u + pb));
            A15 = *(const u32x4*)(TAB + ((e1_[3] >> 16) * 128u + pb));
        }
        { const i32x4 xq = *(const LAS i32x4*)(buf + bs * 4096 + 2048 + 7 * 128 + 16 * pc); const float sx = *(const LAS float*)(buf + bs * 4096 + 3072 + 4 * 7);
            int d[16];
            d[0] = __builtin_amdgcn_sdot4((int)B0[3], xq[3], __builtin_amdgcn_sdot4((int)B0[2], xq[2], __builtin_amdgcn_sdot4((int)B0[1], xq[1], __builtin_amdgcn_sdot4((int)B0[0], xq[0], 0, false), false), false), false);
            d[1] = __builtin_amdgcn_sdot4((int)B1[3], xq[3], __builtin_amdgcn_sdot4((int)B1[2], xq[2], __builtin_amdgcn_sdot4((int)B1[1], xq[1], __builtin_amdgcn_sdot4((int)B1[0], xq[0], 0, false), false), false), false);
            d[2] = __builtin_amdgcn_sdot4((int)B2[3], xq[3], __builtin_amdgcn_sdot4((int)B2[2], xq[2], __builtin_amdgcn_sdot4((int)B2[1], xq[1], __builtin_amdgcn_sdot4((int)B2[0], xq[0], 0, false), false), false), false);
            d[3] = __builtin_amdgcn_sdot4((int)B3[3], xq[3], __builtin_amdgcn_sdot4((int)B3[2], xq[2], __builtin_amdgcn_sdot4((int)B3[1], xq[1], __builtin_amdgcn_sdot4((int)B3[0], xq[0], 0, false), false), false), false);
            d[4] = __builtin_amdgcn_sdot4((int)B4[3], xq[3], __builtin_amdgcn_sdot4((int)B4[2], xq[2], __builtin_amdgcn_sdot4((int)B4[1], xq[1], __builtin_amdgcn_sdot4((int)B4[0], xq[0], 0, false), false), false), false);
            d[5] = __builtin_amdgcn_sdot4((int)B5[3], xq[3], __builtin_amdgcn_sdot4((int)B5[2], xq[2], __builtin_amdgcn_sdot4((int)B5[1], xq[1], __builtin_amdgcn_sdot4((int)B5[0], xq[0], 0, false), false), false), false);
            d[6] = __builtin_amdgcn_sdot4((int)B6[3], xq[3], __builtin_amdgcn_sdot4((int)B6[2], xq[2], __builtin_amdgcn_sdot4((int)B6[1], xq[1], __builtin_amdgcn_sdot4((int)B6[0], xq[0], 0, false), false), false), false);
            d[7] = __builtin_amdgcn_sdot4((int)B7[3], xq[3], __builtin_amdgcn_sdot4((int)B7[2], xq[2], __builtin_amdgcn_sdot4((int)B7[1], xq[1], __builtin_amdgcn_sdot4((int)B7[0], xq[0], 0, false), false), false), false);
            d[8] = __builtin_amdgcn_sdot4((int)B8[3], xq[3], __builtin_amdgcn_sdot4((int)B8[2], xq[2], __builtin_amdgcn_sdot4((int)B8[1], xq[1], __builtin_amdgcn_sdot4((int)B8[0], xq[0], 0, false), false), false), false);
            d[9] = __builtin_amdgcn_sdot4((int)B9[3], xq[3], __builtin_amdgcn_sdot4((int)B9[2], xq[2], __builtin_amdgcn_sdot4((int)B9[1], xq[1], __builtin_amdgcn_sdot4((int)B9[0], xq[0], 0, false), false), false), false);
            d[10] = __builtin_amdgcn_sdot4((int)B10[3], xq[3], __builtin_amdgcn_sdot4((int)B10[2], xq[2], __builtin_amdgcn_sdot4((int)B10[1], xq[1], __builtin_amdgcn_sdot4((int)B10[0], xq[0], 0, false), false), false), false);
            d[11] = __builtin_amdgcn_sdot4((int)B11[3], xq[3], __builtin_amdgcn_sdot4((int)B11[2], xq[2], __builtin_amdgcn_sdot4((int)B11[1], xq[1], __builtin_amdgcn_sdot4((int)B11[0], xq[0], 0, false), false), false), false);
            d[12] = __builtin_amdgcn_sdot4((int)B12[3], xq[3], __builtin_amdgcn_sdot4((int)B12[2], xq[2], __builtin_amdgcn_sdot4((int)B12[1], xq[1], __builtin_amdgcn_sdot4((int)B12[0], xq[0], 0, false), false), false), false);
            d[13] = __builtin_amdgcn_sdot4((int)B13[3], xq[3], __builtin_amdgcn_sdot4((int)B13[2], xq[2], __builtin_amdgcn_sdot4((int)B13[1], xq[1], __builtin_amdgcn_sdot4((int)B13[0], xq[0], 0, false), false), false), false);
            d[14] = __builtin_amdgcn_sdot4((int)B14[3], xq[3], __builtin_amdgcn_sdot4((int)B14[2], xq[2], __builtin_amdgcn_sdot4((int)B14[1], xq[1], __builtin_amdgcn_sdot4((int)B14[0], xq[0], 0, false), false), false), false);
            d[15] = __builtin_amdgcn_sdot4((int)B15[3], xq[3], __builtin_amdgcn_sdot4((int)B15[2], xq[2], __builtin_amdgcn_sdot4((int)B15[1], xq[1], __builtin_amdgcn_sdot4((int)B15[0], xq[0], 0, false), false), false), false);
            _Pragma("unroll") for (int st = 0; st < 3; ++st) { const int M = 1 << st, nn = 8 >> st; const int hm = (la & M) ? -1 : 0;
                _Pragma("unroll") for (int i = 0; i < 8; ++i) if (i < nn) { const int keep = (d[nn + i] & hm) | (d[i] & ~hm), send = (d[i] & hm) | (d[nn + i] & ~hm);
                    d[i] = keep + ((st == 0) ? DPP_I(send, 0xB1) : (st == 1) ? DPP_I(send, 0x4E) : __builtin_amdgcn_ds_swizzle(send, (4 << 10) | 0x1f)); } }
            unsigned short* pp = (unsigned short*)(P.ws + WS_PART) + ((size_t)j * T + (unsigned)(T0 + 8 * b + 7)) * 128;
            *(unsigned*)(pp + (unsigned)(16 * sl + i0)) = pk2((float)d[0] * sx, (float)d[1] * sx); }
    }
#undef U3_FETCH
#undef U3_PARK
}
__device__ __forceinline__ void p6_combine(const Ptrs& P, int gtid, int nthreads) {
    const unsigned char* ws = P.ws;
    for (int i = gtid; i < T * 128 / 4; i += nthreads) {
        const int t = i >> 5;
        f32x4 a = (f32x4){0.f, 0.f, 0.f, 0.f};
#pragma unroll
        for (int j = 0; j < 8; ++j) { const u32x2 pw = *(const u32x2*)((const unsigned short*)(ws + WS_PART) + ((size_t)j * T * 128) + (size_t)i * 4); a += (f32x4){bflo(pw.x), bfhi(pw.x), bflo(pw.y), bfhi(pw.y)}; }
        const float r2u = ((const float*)(ws + WS_R2))[t];
        const u32x2 gq = *(const u32x2*)((const bf16*)(ws + WS_GW) + (size_t)i * 4); const f32x4 g = (f32x4){bflo(gq.x), bfhi(gq.x), bflo(gq.y), bfhi(gq.y)};
        const u32x2 e2 = *(const u32x2*)((const unsigned short*)(ws + WS_IDX16) + (size_t)i * 4); const int4 ei = make_int4((int)(e2.x & 0xffffu), (int)(e2.x >> 16), (int)(e2.y & 0xffffu), (int)(e2.y >> 16));
        const f32x2* suv = (const f32x2*)(ws + WS_SUS);
        const f32x2 s0 = suv[ei.x], s1 = suv[ei.y], s2 = suv[ei.z], s3 = suv[ei.w];
        f32x4 w; w.x = s0.y * g.x * gelu_tanh(r2u * s0.x * a.x); w.y = s1.y * g.y * gelu_tanh(r2u * s1.x * a.y); w.z = s2.y * g.z * gelu_tanh(r2u * s2.x * a.z); w.w = s3.y * g.w * gelu_tanh(r2u * s3.x * a.w);
        float mx = fmaxf(fmaxf(fabsf(w.x), fabsf(w.y)), fmaxf(fabsf(w.z), fabsf(w.w)));
        mx = fmaxf(mx, DPP_F(mx, 0xB1)); mx = fmaxf(mx, DPP_F(mx, 0x4E)); mx = fmaxf(mx, DPP_F(mx, 0x141)); mx = fmaxf(mx, DPP_F(mx, 0x140)); mx = fmaxf(mx, xor_lane<16>(mx));
        mx = fmaxf(mx, 1e-30f);
        const float inv = 127.0f * __builtin_amdgcn_rcpf(mx);
        const int m = i & 31;
        ((unsigned*)(P.ws + WS_W))[i] = (unsigned)((int)rintf(w.x * inv) & 0xff) | ((unsigned)((int)rintf(w.y * inv) & 0xff) << 8) | ((unsigned)((int)rintf(w.z * inv) & 0xff) << 16) | ((unsigned)(int)rintf(w.w * inv) << 24);
        if (m == 0) ((float*)(P.ws + WS_R1))[t] = mx * (1.0f / 127.0f);
    }
}

typedef float f32x16 __attribute__((ext_vector_type(16)));
#define MFMA32(a, b, c) __builtin_amdgcn_mfma_f32_32x32x16_bf16((a), (b), (c), 0, 0, 0)
__device__ __forceinline__ int crow(int reg, int h) { return (reg & 3) + 8 * (reg >> 2) + 4 * h; }
__device__ __forceinline__ unsigned pkbf(float lo, float hi) { const bf16x2_t v = {(__bf16)lo, (__bf16)hi}; return __builtin_bit_cast(unsigned, v); }

constexpr int KL_STRIDE = 72, VT_STRIDE = 196;
constexpr int KL_OFF = 0, VT_OFF = 192 * KL_STRIDE * 2, BIASL_OFF = VT_OFF + 64 * VT_STRIDE * 2;
__device__ __forceinline__ void attn_item(const Ptrs& P, LAS unsigned char* lds, int item, int tid, int lane, int wave) {
    const unsigned char* ws = P.ws;
    const bf16* proj = (const bf16*)(ws + WS_PROJ);
    const int kvh = item & 1, qb = (item >> 1) & 31, b = item >> 6;
    const int tb = b * SEQ, p0 = qb * 64;
    LAS bf16* KL = (LAS bf16*)(lds + KL_OFF); LAS bf16* VT = (LAS bf16*)(lds + VT_OFF); LAS float* BIASL = (LAS float*)(lds + BIASL_OFF);
#pragma unroll
    for (int i = 0; i < 3; ++i) {
        const int p = tid + 512 * i, key = p >> 3, ch = p & 7, kpos = p0 - 128 + key;
        u32x4 kw = (u32x4){0u, 0u, 0u, 0u}, vw = (u32x4){0u, 0u, 0u, 0u};
        if (kpos >= 0) { const bf16* src = proj + (size_t)(tb + kpos) * NIN + kvh * HD + 8 * ch; kw = *(const u32x4*)(src + C_K); vw = *(const u32x4*)(src + C_V); }
        float kf[8]; unpack8(kw, kf);
        float ss = 0.f;
#pragma unroll
        for (int j = 0; j < 8; ++j) ss += kf[j] * kf[j];
        ss += DPP_F(ss, 0xB1); ss += DPP_F(ss, 0x4E); ss += DPP_F(ss, 0x141);
        const float rinv = __builtin_amdgcn_rsqf(ss * (1.0f / HD) + EPS);
        const f32x4 g0 = *(const f32x4*)(P.k_norm_g + 8 * ch), g1 = *(const f32x4*)(P.k_norm_g + 8 * ch + 4);
        u32x4 o; o.x = pkbf(kf[0] * rinv * g0.x, kf[1] * rinv * g0.y); o.y = pkbf(kf[2] * rinv * g0.z, kf[3] * rinv * g0.w);
        o.z = pkbf(kf[4] * rinv * g1.x, kf[5] * rinv * g1.y); o.w = pkbf(kf[6] * rinv * g1.z, kf[7] * rinv * g1.w);
        *(LAS u32x4*)(KL + key * KL_STRIDE + 8 * ch) = o;
#pragma unroll
        for (int j = 0; j < 4; ++j) { VT[(8 * ch + 2 * j) * VT_STRIDE + key] = (bf16)(vw[j] & 0xffffu); VT[(8 * ch + 2 * j + 1) * VT_STRIDE + key] = (bf16)(vw[j] >> 16); }
    }
    for (int e = tid; e < 4 * 192; e += 512) { const int gg = e / 192, rel = e % 192 - 32;
        BIASL[e] = (rel >= 0 && rel < WIN) ? ((const float*)(ws + WS_BL))[(kvh * 4 + gg) * WIN + rel] : -1.0e30f; }
    __syncthreads();
    const int g = wave >> 1, a = wave & 1, head = kvh * 4 + g, q = lane & 31, hh = lane >> 5;
    const int tq = tb + p0 + 32 * a + q;
    bf16x8 Bq[4];
    {
        float qf[4][8]; float ss = 0.f;
#pragma unroll
        for (int s = 0; s < 4; ++s) { const u32x4 w = *(const u32x4*)(proj + (size_t)tq * NIN + C_Q + head * HD + 16 * s + 8 * hh); unpack8(w, qf[s]);
#pragma unroll
            for (int j = 0; j < 8; ++j) ss += qf[s][j] * qf[s][j]; }
        ss += __shfl_xor(ss, 32);
        const float rinv = 0.125f * __builtin_amdgcn_rsqf(ss * (1.0f / HD) + EPS);
#pragma unroll
        for (int s = 0; s < 4; ++s) { const f32x4 g0 = *(const f32x4*)(P.q_norm_g + 16 * s + 8 * hh), g1 = *(const f32x4*)(P.q_norm_g + 16 * s + 8 * hh + 4);
            u32x4 o; o.x = pkbf(qf[s][0] * rinv * g0.x, qf[s][1] * rinv * g0.y); o.y = pkbf(qf[s][2] * rinv * g0.z, qf[s][3] * rinv * g0.w);
            o.z = pkbf(qf[s][4] * rinv * g1.x, qf[s][5] * rinv * g1.y); o.w = pkbf(qf[s][6] * rinv * g1.z, qf[s][7] * rinv * g1.w);
            Bq[s] = __builtin_bit_cast(bf16x8, o); }
    }
    f32x16 sc[5];
#pragma unroll
    for (int c = 0; c < 5; ++c) {
#pragma unroll
        for (int r = 0; r < 16; ++r) sc[c][r] = 0.f;
#pragma unroll
        for (int s = 0; s < 4; ++s) { const bf16x8 A = *(const LAS bf16x8*)(KL + (32 * (a + c) + q) * KL_STRIDE + 16 * s + 8 * hh); sc[c] = MFMA32(A, Bq[s], sc[c]); }
    }
    const float sink = P.sinks[head];
    float m = sink;
    const LAS float* bias_base = BIASL + g * 192 + q + 160 - 4 * hh;
    const int kneg = p0 - 128 + 32 * a + 4 * hh;
#pragma unroll
    for (int c = 0; c < 5; ++c)
#pragma unroll
        for (int r = 0; r < 16; ++r) { const int kw0 = 32 * c + (r & 3) + 8 * (r >> 2);
            const float bv = bias_base[-kw0];
            float v = sc[c][r] + bv; v = (kneg + kw0 >= 0) ? v : -1.0e30f; sc[c][r] = v; m = fmaxf(m, v); }
    m = fmaxf(m, __shfl_xor(m, 32));
    float l = 0.f;
#pragma unroll
    for (int c = 0; c < 5; ++c)
#pragma unroll
        for (int r = 0; r < 16; ++r) { const float p = __expf(sc[c][r] - m); sc[c][r] = p; l += p; }
    l += __shfl_xor(l, 32);
    const float inv = 1.0f / (l + __expf(sink - m));
    f32x16 oacc[2];
#pragma unroll
    for (int dt = 0; dt < 2; ++dt)
#pragma unroll
        for (int r = 0; r < 16; ++r) oacc[dt][r] = 0.f;
#pragma unroll
    for (int c = 0; c < 5; ++c)
#pragma unroll
        for (int s2 = 0; s2 < 2; ++s2) {
            u32x4 pw; pw.x = pkbf(sc[c][8 * s2 + 0], sc[c][8 * s2 + 1]); pw.y = pkbf(sc[c][8 * s2 + 2], sc[c][8 * s2 + 3]); pw.z = pkbf(sc[c][8 * s2 + 4], sc[c][8 * s2 + 5]); pw.w = pkbf(sc[c][8 * s2 + 6], sc[c][8 * s2 + 7]);
            const bf16x8 Pb = __builtin_bit_cast(bf16x8, pw);
            const int kb = 32 * (a + c) + 16 * s2 + 4 * hh;
#pragma unroll
            for (int dt = 0; dt < 2; ++dt) { const LAS bf16* vr = VT + (32 * dt + q) * VT_STRIDE + kb;
                const u32x2 lo = *(const LAS u32x2*)vr, hi = *(const LAS u32x2*)(vr + 8);
                const bf16x8 Av = __builtin_bit_cast(bf16x8, (u32x4){lo.x, lo.y, hi.x, hi.y});
                oacc[dt] = MFMA32(Av, Pb, oacc[dt]); }
        }
    float ss = 0.f;
    bf16* orow = (bf16*)(ws + WS_MIX) + (size_t)tq * D + LRU_W + head * HD + 4 * hh;
#pragma unroll
    for (int dt = 0; dt < 2; ++dt)
#pragma unroll
        for (int r4 = 0; r4 < 4; ++r4) { const float o0 = oacc[dt][4 * r4] * inv, o1 = oacc[dt][4 * r4 + 1] * inv, o2 = oacc[dt][4 * r4 + 2] * inv, o3 = oacc[dt][4 * r4 + 3] * inv;
            ss += (o0 * o0 + o1 * o1) + (o2 * o2 + o3 * o3);
            u32x2 w; w.x = pkbf(o0, o1); w.y = pkbf(o2, o3); *(u32x2*)(orow + 32 * dt + 8 * r4) = w; }
    ss += __shfl_xor(ss, 32);
    if (hh == 0) ((float*)(ws + WS_SSQA))[(size_t)tq * 8 + head] = ss;
    __syncthreads();
}

__device__ __forceinline__ void bar4(volatile LAS unsigned* cnt, unsigned& target, int lane) {
    asm volatile("s_waitcnt vmcnt(0) lgkmcnt(0)" ::: "memory");
    target += 4u;
    if (lane == 0) (void)__hip_atomic_fetch_add((LAS unsigned*)cnt, 1u, __ATOMIC_RELAXED, __HIP_MEMORY_SCOPE_WORKGROUP);
    while (*cnt < target) __builtin_amdgcn_s_sleep(1);
    asm volatile("" ::: "memory");
}
__device__ __forceinline__ void attn_item4(const Ptrs& P, LAS unsigned char* lds, int item, int tid, int lane, int wave, volatile LAS unsigned* bcnt, unsigned& btgt) {
    const unsigned char* ws = P.ws;
    const bf16* proj = (const bf16*)(ws + WS_PROJ);
    const int kvh = item & 1, qb = (item >> 1) & 31, b = item >> 6;
    const int tb = b * SEQ, p0 = qb * 64;
    LAS bf16* KL = (LAS bf16*)(lds + KL_OFF); LAS bf16* VT = (LAS bf16*)(lds + VT_OFF); LAS float* BIASL = (LAS float*)(lds + BIASL_OFF);
#pragma unroll
    for (int i = 0; i < 6; ++i) {
        const int p = tid + 256 * i, key = p >> 3, ch = p & 7, kpos = p0 - 128 + key;
        u32x4 kw = (u32x4){0u, 0u, 0u, 0u}, vw = (u32x4){0u, 0u, 0u, 0u};
        if (kpos >= 0) { const bf16* src = proj + (size_t)(tb + kpos) * NIN + kvh * HD + 8 * ch; kw = *(const u32x4*)(src + C_K); vw = *(const u32x4*)(src + C_V); }
        float kf[8]; unpack8(kw, kf);
        float ss = 0.f;
#pragma unroll
        for (int j = 0; j < 8; ++j) ss += kf[j] * kf[j];
        ss += DPP_F(ss, 0xB1); ss += DPP_F(ss, 0x4E); ss += DPP_F(ss, 0x141);
        const float rinv = __builtin_amdgcn_rsqf(ss * (1.0f / HD) + EPS);
        const f32x4 g0 = *(const f32x4*)(P.k_norm_g + 8 * ch), g1 = *(const f32x4*)(P.k_norm_g + 8 * ch + 4);
        u32x4 o; o.x = pkbf(kf[0] * rinv * g0.x, kf[1] * rinv * g0.y); o.y = pkbf(kf[2] * rinv * g0.z, kf[3] * rinv * g0.w);
        o.z = pkbf(kf[4] * rinv * g1.x, kf[5] * rinv * g1.y); o.w = pkbf(kf[6] * rinv * g1.z, kf[7] * rinv * g1.w);
        *(LAS u32x4*)(KL + key * KL_STRIDE + 8 * ch) = o;
#pragma unroll
        for (int j = 0; j < 4; ++j) { VT[(8 * ch + 2 * j) * VT_STRIDE + key] = (bf16)(vw[j] & 0xffffu); VT[(8 * ch + 2 * j + 1) * VT_STRIDE + key] = (bf16)(vw[j] >> 16); }
    }
    for (int e = tid; e < 4 * 192; e += 256) { const int gg = e / 192, rel = e % 192 - 32;
        BIASL[e] = (rel >= 0 && rel < WIN) ? ((const float*)(ws + WS_BL))[(kvh * 4 + gg) * WIN + rel] : -1.0e30f; }
    bar4(bcnt, btgt, lane);
#pragma unroll 1
    for (int a = 0; a < 2; ++a) {
    const int g = wave, head = kvh * 4 + g, q = lane & 31, hh = lane >> 5;
    const int tq = tb + p0 + 32 * a + q;
    bf16x8 Bq[4];
    {
        float qf[4][8]; float ss = 0.f;
#pragma unroll
        for (int s = 0; s < 4; ++s) { const u32x4 w = *(const u32x4*)(proj + (size_t)tq * NIN + C_Q + head * HD + 16 * s + 8 * hh); unpack8(w, qf[s]);
#pragma unroll
            for (int j = 0; j < 8; ++j) ss += qf[s][j] * qf[s][j]; }
        ss += __shfl_xor(ss, 32);
        const float rinv = 0.125f * __builtin_amdgcn_rsqf(ss * (1.0f / HD) + EPS);
#pragma unroll
        for (int s = 0; s < 4; ++s) { const f32x4 g0 = *(const f32x4*)(P.q_norm_g + 16 * s + 8 * hh), g1 = *(const f32x4*)(P.q_norm_g + 16 * s + 8 * hh + 4);
            u32x4 o; o.x = pkbf(qf[s][0] * rinv * g0.x, qf[s][1] * rinv * g0.y); o.y = pkbf(qf[s][2] * rinv * g0.z, qf[s][3] * rinv * g0.w);
            o.z = pkbf(qf[s][4] * rinv * g1.x, qf[s][5] * rinv * g1.y); o.w = pkbf(qf[s][6] * rinv * g1.z, qf[s][7] * rinv * g1.w);
            Bq[s] = __builtin_bit_cast(bf16x8, o); }
    }
    f32x16 sc[5];
#pragma unroll
    for (int c = 0; c < 5; ++c) {
#pragma unroll
        for (int r = 0; r < 16; ++r) sc[c][r] = 0.f;
#pragma unroll
        for (int s = 0; s < 4; ++s) { const bf16x8 A = *(const LAS bf16x8*)(KL + (32 * (a + c) + q) * KL_STRIDE + 16 * s + 8 * hh); sc[c] = MFMA32(A, Bq[s], sc[c]); }
    }
    const float sink = P.sinks[head];
    float m = sink;
    const LAS float* bias_base = BIASL + g * 192 + q + 160 - 4 * hh;
    const int kneg = p0 - 128 + 32 * a + 4 * hh;
#pragma unroll
    for (int c = 0; c < 5; ++c)
#pragma unroll
        for (int r = 0; r < 16; ++r) { const int kw0 = 32 * c + (r & 3) + 8 * (r >> 2);
            const float bv = bias_base[-kw0];
            float v = sc[c][r] + bv; v = (kneg + kw0 >= 0) ? v : -1.0e30f; sc[c][r] = v; m = fmaxf(m, v); }
    m = fmaxf(m, __shfl_xor(m, 32));
    float l = 0.f;
#pragma unroll
    for (int c = 0; c < 5; ++c)
#pragma unroll
        for (int r = 0; r < 16; ++r) { const float p = __expf(sc[c][r] - m); sc[c][r] = p; l += p; }
    l += __shfl_xor(l, 32);
    const float inv = 1.0f / (l + __expf(sink - m));
    f32x16 oacc[2];
#pragma unroll
    for (int dt = 0; dt < 2; ++dt)
#pragma unroll
        for (int r = 0; r < 16; ++r) oacc[dt][r] = 0.f;
#pragma unroll
    for (int c = 0; c < 5; ++c)
#pragma unroll
        for (int s2 = 0; s2 < 2; ++s2) {
            u32x4 pw; pw.x = pkbf(sc[c][8 * s2 + 0], sc[c][8 * s2 + 1]); pw.y = pkbf(sc[c][8 * s2 + 2], sc[c][8 * s2 + 3]); pw.z = pkbf(sc[c][8 * s2 + 4], sc[c][8 * s2 + 5]); pw.w = pkbf(sc[c][8 * s2 + 6], sc[c][8 * s2 + 7]);
            const bf16x8 Pb = __builtin_bit_cast(bf16x8, pw);
            const int kb = 32 * (a + c) + 16 * s2 + 4 * hh;
#pragma unroll
            for (int dt = 0; dt < 2; ++dt) { const LAS bf16* vr = VT + (32 * dt + q) * VT_STRIDE + kb;
                const u32x2 lo = *(const LAS u32x2*)vr, hi = *(const LAS u32x2*)(vr + 8);
                const bf16x8 Av = __builtin_bit_cast(bf16x8, (u32x4){lo.x, lo.y, hi.x, hi.y});
                oacc[dt] = MFMA32(Av, Pb, oacc[dt]); }
        }
    float ss = 0.f;
    bf16* orow = (bf16*)(ws + WS_MIX) + (size_t)tq * D + LRU_W + head * HD + 4 * hh;
#pragma unroll
    for (int dt = 0; dt < 2; ++dt)
#pragma unroll
        for (int r4 = 0; r4 < 4; ++r4) { const float o0 = oacc[dt][4 * r4] * inv, o1 = oacc[dt][4 * r4 + 1] * inv, o2 = oacc[dt][4 * r4 + 2] * inv, o3 = oacc[dt][4 * r4 + 3] * inv;
            ss += (o0 * o0 + o1 * o1) + (o2 * o2 + o3 * o3);
            u32x2 w; w.x = pkbf(o0, o1); w.y = pkbf(o2, o3); *(u32x2*)(orow + 32 * dt + 8 * r4) = w; }
    ss += __shfl_xor(ss, 32);
    if (hh == 0) ((float*)(ws + WS_SSQA))[(size_t)tq * 8 + head] = ss;
    }
    bar4(bcnt, btgt, lane);
}

constexpr int LR_XB = 0, LR_XCF = 17408, LR_XCB = 33792, LR_LA = 43008, LR_LB = 59392, LR_XG = 75776, LR_GB = 92160, LR_TOT = 108544, LR_H0 = 112640, LR_CW = 113152, LR_PAR = 114432, LR_ASEG = 115200  ;
constexpr int XCB_STRIDE = 72;
constexpr size_t WS_AGG = 14 * MiB + 512 * 1024;
constexpr size_t WS_HLAC = 80 * MiB;
template <int MODE> __device__ __forceinline__ void lru_seg(const Ptrs& P, LAS unsigned char* lds, int item, int tid, int lane, int wave) {
    unsigned char* ws = P.ws;
    const bf16* proj = (const bf16*)(ws + WS_PROJ);
    const int n = item & 7, seg = (item >> 3) & 7, b = item >> 6, tb = b * SEQ, s0 = seg * 256;
    LAS float* XB = (LAS float*)(lds + LR_XB); LAS float* XCF = (LAS float*)(lds + LR_XCF); LAS bf16* XCB = (LAS bf16*)(lds + LR_XCB);
    LAS float* LA = (LAS float*)(lds + LR_LA); LAS float* LB = (LAS float*)(lds + LR_LB); LAS float* XG = (LAS float*)(lds + LR_XG); LAS float* GBL = (LAS float*)(lds + LR_GB);
    LAS float* TOT = (LAS float*)(lds + LR_TOT); LAS float* H0 = (LAS float*)(lds + LR_H0); LAS float* CW = (LAS float*)(lds + LR_CW); LAS float* PAR = (LAS float*)(lds + LR_PAR); LAS float* ASEG = (LAS float*)(lds + LR_ASEG);
    float* agg = (float*)(ws + WS_AGG) + (size_t)((b * NBLK + n) * 8) * 128;
    if (tid < 64) { const int c = n * BLK + tid;
#pragma unroll
        for (int k = 0; k < 4; ++k) CW[k * 64 + tid] = P.conv_w[k * LRU_W + c];
        CW[4 * 64 + tid] = P.conv_b[c];
        PAR[tid] = P.b_gate_a[c]; PAR[64 + tid] = P.b_gate_x[c]; PAR[128 + tid] = log1pf(expf(-P.lru_L[c]));
        float h = 0.f;
        if (MODE) for (int sp = 0; sp < seg; ++sp) h = agg[sp * 128 + tid] * h + agg[sp * 128 + 64 + tid];
        H0[tid] = h; ASEG[tid] = 1.f; ASEG[64 + tid] = 1.f; }
    const int gsel = wave >> 2, tm = (wave >> 1) & 1, tn = wave & 1, jl = lane & 31, hh = lane >> 5;
    bf16x8 Bg[4];
#pragma unroll
    for (int s = 0; s < 4; ++s) Bg[s] = *(const bf16x8*)((const bf16*)(ws + WS_WGT) + ((size_t)(gsel * NBLK + n) * BLK + 32 * tn + jl) * BLK + 16 * s + 8 * hh);
    const int prow = tid >> 3, pch = tid & 7;
    u32x4 pxa, pxb = (u32x4){0u, 0u, 0u, 0u}, pg = (u32x4){0u, 0u, 0u, 0u};
#define LRU_PREFETCH(t0_) do { const int sp_ = (t0_) - 3 + prow; pxa = (u32x4){0u, 0u, 0u, 0u}; \
        if (sp_ >= 0) pxa = *(const u32x4*)(proj + (size_t)(tb + sp_) * NIN + C_XB + n * BLK + 8 * pch); \
        if (tid < 24) pxb = *(const u32x4*)(proj + (size_t)(tb + (t0_) - 3 + 64 + prow) * NIN + C_XB + n * BLK + 8 * pch); \
        if (MODE) pg = *(const u32x4*)(proj + (size_t)(tb + (t0_) + prow) * NIN + C_GB + n * BLK + 8 * pch); } while (0)
    LRU_PREFETCH(s0);
    __syncthreads();
    const int jc = 32 * tn + jl;
    const float gbias = PAR[gsel * 64 + jc], sp8 = -8.0f * PAR[128 + jc];
#pragma unroll 1
    for (int ck = 0; ck < 4; ++ck) {
        const int t0 = s0 + ck * 64, par = ck & 1;
        { float f[8]; unpack8(pxa, f);
            *(LAS f32x4*)(XB + prow * 64 + 8 * pch) = (f32x4){f[0], f[1], f[2], f[3]}; *(LAS f32x4*)(XB + prow * 64 + 8 * pch + 4) = (f32x4){f[4], f[5], f[6], f[7]};
            if (tid < 24) { unpack8(pxb, f); *(LAS f32x4*)(XB + (64 + prow) * 64 + 8 * pch) = (f32x4){f[0], f[1], f[2], f[3]}; *(LAS f32x4*)(XB + (64 + prow) * 64 + 8 * pch + 4) = (f32x4){f[4], f[5], f[6], f[7]}; }
            if (MODE) { unpack8(pg, f);
#pragma unroll
                for (int q = 0; q < 8; ++q) f[q] = gelu_tanh(f[q]);
                *(LAS f32x4*)(GBL + prow * 64 + 8 * pch) = (f32x4){f[0], f[1], f[2], f[3]}; *(LAS f32x4*)(GBL + prow * 64 + 8 * pch + 4) = (f32x4){f[4], f[5], f[6], f[7]}; } }
        if (ck < 3) LRU_PREFETCH(t0 + 64);
        __syncthreads();
        { const int t = tid >> 3, c0 = 8 * (tid & 7); float xc[8];
#pragma unroll
            for (int i = 0; i < 8; ++i) { const int c = c0 + i; float v = CW[4 * 64 + c];
#pragma unroll
                for (int k = 0; k < 4; ++k) v += CW[k * 64 + c] * XB[(t + k) * 64 + c];
                xc[i] = v; }
            *(LAS f32x4*)(XCF + t * 64 + c0) = (f32x4){xc[0], xc[1], xc[2], xc[3]}; *(LAS f32x4*)(XCF + t * 64 + c0 + 4) = (f32x4){xc[4], xc[5], xc[6], xc[7]};
            u32x4 o; o.x = pkbf(xc[0], xc[1]); o.y = pkbf(xc[2], xc[3]); o.z = pkbf(xc[4], xc[5]); o.w = pkbf(xc[6], xc[7]);
            *(LAS u32x4*)(XCB + t * XCB_STRIDE + c0) = o; }
        __syncthreads();
        { f32x16 z;
#pragma unroll
            for (int r = 0; r < 16; ++r) z[r] = 0.f;
#pragma unroll
            for (int s = 0; s < 4; ++s) { const bf16x8 A = *(const LAS bf16x8*)(XCB + (32 * tm + jl) * XCB_STRIDE + 16 * s + 8 * hh); z = MFMA32(A, Bg[s], z); }
            if (gsel == 0) {
#pragma unroll
                for (int r = 0; r < 16; ++r) { const int tt = 32 * tm + crow(r, hh); const float rg = sigmoidf(z[r] + gbias);
                    const float la = sp8 * rg, aa = __expf(la), x2 = 2.0f * la;
                    const float om = -x2 * (1.0f + x2 * (0.5f + x2 * (0.16666667f + x2 * (0.041666668f + x2 * (0.0083333338f + x2 * 0.0013888889f)))));
                    LA[tt * 64 + jc] = aa; LB[tt * 64 + jc] = __builtin_amdgcn_sqrtf(om); }
            } else {
#pragma unroll
                for (int r = 0; r < 16; ++r) { const int tt = 32 * tm + crow(r, hh); XG[tt * 64 + jc] = sigmoidf(z[r] + gbias) * XCF[tt * 64 + jc]; }
            } }
        __syncthreads();
        float Ac[8], Hl[8];
        { float A = 1.f, H = 0.f;
#pragma unroll
            for (int i = 0; i < 8; ++i) { const int t = 8 * wave + i; const float av = LA[t * 64 + lane], bv = LB[t * 64 + lane] * XG[t * 64 + lane]; H = av * H + bv; A = A * av; Ac[i] = A; Hl[i] = H; }
            TOT[(wave * 64 + lane) * 2] = A; TOT[(wave * 64 + lane) * 2 + 1] = H; }
        __syncthreads();
        { float cin = H0[par * 64 + lane], ain = ASEG[par * 64 + lane];
            for (int s = 0; s < wave; ++s) { const float ta = TOT[(s * 64 + lane) * 2]; cin = ta * cin + TOT[(s * 64 + lane) * 2 + 1]; ain *= ta; }
            if (wave == 7) { const float ta = TOT[(7 * 64 + lane) * 2]; H0[(par ^ 1) * 64 + lane] = ta * cin + TOT[(7 * 64 + lane) * 2 + 1]; ASEG[(par ^ 1) * 64 + lane] = ain * ta; }
            if (!MODE) {
                unsigned* hl = (unsigned*)(ws + WS_HLAC) + (size_t)(tb + t0 + 8 * wave) * LRU_W + n * BLK + lane;
#pragma unroll
                for (int i = 0; i < 8; ++i) hl[(size_t)i * LRU_W] = pkbf(Hl[i] + Ac[i] * cin, Ac[i] * ain);
            } else {
#pragma unroll
                for (int i = 0; i < 8; ++i) { const int t = 8 * wave + i; const float h = Hl[i] + Ac[i] * cin; const float y = h * GBL[t * 64 + lane];
                    const size_t tok = (size_t)(tb + t0 + t);
                    ((bf16*)(ws + WS_MIX))[tok * D + n * BLK + lane] = (bf16)f2bf(y);
                    const float ss = wave_sum_u(y * y);
                    if (lane == 0) ((float*)(ws + WS_SSQL))[tok * 8 + n] = ss; } } }
        __syncthreads();
    }
#undef LRU_PREFETCH
    if (!MODE && tid < 64) { agg[seg * 128 + tid] = ASEG[tid]; agg[seg * 128 + 64 + tid] = H0[tid]; }
    __syncthreads();
}

constexpr size_t WS_AGG16 = 14 * MiB + 512 * 1024;
__device__ __forceinline__ void lru_wave_task(const Ptrs& P, LAS float* cwl, int task, int lane) {
    unsigned char* ws = P.ws;
    const bf16* proj = (const bf16*)(ws + WS_PROJ);
    const int nt = task & 1, hs = (task >> 1) & 15, n = (task >> 5) & 7, b = task >> 8, tb = b * SEQ, s0 = hs * 128;
    for (int e = lane; e < 5 * 64; e += 64) { const int k = e >> 6, c = e & 63; cwl[e] = (k < 4) ? P.conv_w[k * LRU_W + n * BLK + c] : P.conv_b[n * BLK + c]; }
    const int jl = lane & 31, hh = lane >> 5, jc = 32 * nt + jl, cg = n * BLK + jc;
    const bf16* wga = (const bf16*)(ws + WS_WGT) + ((size_t)(0 * NBLK + n) * BLK + jc) * BLK + 8 * hh;
    const bf16* wgx = (const bf16*)(ws + WS_WGT) + ((size_t)(1 * NBLK + n) * BLK + jc) * BLK + 8 * hh;
    const float ba = P.b_gate_a[cg], bxg = P.b_gate_x[cg], sp8 = -8.0f * log1pf(expf(-P.lru_L[cg]));
    float cin = 0.f, ain = 1.f;
    LAS bf16* xbl = (LAS bf16*)(cwl + 5 * 64);
    u32x4 pr[5];
#define LRU_PREF(ti_) do { _Pragma("unroll") for (int i = 0; i < 5; ++i) { const int p = lane + 64 * i, row = p >> 3, ch = p & 7, pos = s0 + 32 * (ti_) - 3 + row; pr[i] = (u32x4){0u, 0u, 0u, 0u}; \
        if (p < 35 * 8 && pos >= 0 && (ti_) < 4) pr[i] = *(const u32x4*)(proj + (size_t)(tb + pos) * NIN + C_XB + n * BLK + 8 * ch); } } while (0)
    LRU_PREF(0);
    bf16x8 Ba = *(const bf16x8*)wga, Bx = *(const bf16x8*)wgx;
#pragma unroll 1
    for (int ti = 0; ti < 4; ++ti) {
        const int t0 = s0 + 32 * ti;
#pragma unroll
        for (int i = 0; i < 5; ++i) { const int p = lane + 64 * i; if (p < 35 * 8) *(LAS u32x4*)(xbl + (p >> 3) * 72 + 8 * (p & 7)) = pr[i]; }
        LRU_PREF(ti + 1);
        f32x16 za, zx, zc;
#pragma unroll
        for (int r = 0; r < 16; ++r) { za[r] = 0.f; zx[r] = 0.f; zc[r] = 0.f; }
#pragma unroll
        for (int s = 0; s < 4; ++s) { const int ch0 = 16 * s + 8 * hh;
            const bf16x8 Ban = *(const bf16x8*)(wga + 16 * ((s + 1) & 3)), Bxn = *(const bf16x8*)(wgx + 16 * ((s + 1) & 3));
            float xc[8];
            { const f32x4 b0 = *(const LAS f32x4*)(cwl + 4 * 64 + ch0), b1 = *(const LAS f32x4*)(cwl + 4 * 64 + ch0 + 4);
              xc[0] = b0.x; xc[1] = b0.y; xc[2] = b0.z; xc[3] = b0.w; xc[4] = b1.x; xc[5] = b1.y; xc[6] = b1.z; xc[7] = b1.w; }
#pragma unroll
            for (int tap = 0; tap < 4; ++tap) { const f32x4 w0 = *(const LAS f32x4*)(cwl + tap * 64 + ch0), w1 = *(const LAS f32x4*)(cwl + tap * 64 + ch0 + 4);
                float xf[8]; unpack8(*(const LAS u32x4*)(xbl + (jl + tap) * 72 + ch0), xf);
                xc[0] += w0.x * xf[0]; xc[1] += w0.y * xf[1]; xc[2] += w0.z * xf[2]; xc[3] += w0.w * xf[3]; xc[4] += w1.x * xf[4]; xc[5] += w1.y * xf[5]; xc[6] += w1.z * xf[6]; xc[7] += w1.w * xf[7]; }
            u32x4 o; o.x = pkbf(xc[0], xc[1]); o.y = pkbf(xc[2], xc[3]); o.z = pkbf(xc[4], xc[5]); o.w = pkbf(xc[6], xc[7]);
            const bf16x8 Af = __builtin_bit_cast(bf16x8, o);
            u32x4 idw;
#pragma unroll
            for (int w = 0; w < 4; ++w) { const int k0 = 16 * s + 8 * hh + 2 * w; idw[w] = (k0 == jc ? 0x3F80u : 0u) | (k0 + 1 == jc ? 0x3F800000u : 0u); }
            za = MFMA32(Af, Ba, za); zx = MFMA32(Af, Bx, zx); zc = MFMA32(Af, __builtin_bit_cast(bf16x8, idw), zc);
            Ba = Ban; Bx = Bxn;
            __builtin_amdgcn_sched_barrier(0); }
        float av[16], bv[16];
#pragma unroll
        for (int r = 0; r < 16; ++r) { const float zar = za[r], zxr = zx[r], zcr = zc[r];
            const float rg = sigmoidf(zar + ba), ig = sigmoidf(zxr + bxg), la = sp8 * rg, x2 = 2.0f * la;
            const float om = -x2 * (1.0f + x2 * (0.5f + x2 * (0.16666667f + x2 * (0.041666668f + x2 * (0.0083333338f + x2 * 0.0013888889f)))));
            av[r] = __expf(la); bv[r] = __builtin_amdgcn_sqrtf(om) * ig * zcr; }
        float RA[4], RH[4];
#pragma unroll
        for (int q = 0; q < 4; ++q) { float A = 1.f, H = 0.f;
#pragma unroll
            for (int i = 0; i < 4; ++i) { const int r = 4 * q + i; H = av[r] * H + bv[r]; A = A * av[r]; av[r] = A; bv[r] = H; }
            RA[q] = A; RH[q] = H; }
        const int hm = hh ? -1 : 0;
        float cH[4], cA[4];
#pragma unroll
        for (int q = 0; q < 4; ++q) { const float pa = __shfl_xor(RA[q], 32), ph = __shfl_xor(RH[q], 32);
            const float r0a = fsel(hm, pa, RA[q]), r0h = fsel(hm, ph, RH[q]), r1a = fsel(hm, RA[q], pa), r1h = fsel(hm, RH[q], ph);
            const float mid = r0a * cin + r0h, amid = ain * r0a;
            cH[q] = fsel(hm, mid, cin); cA[q] = fsel(hm, amid, ain);
            cin = r1a * mid + r1h; ain = amid * r1a; }
        unsigned* hl = (unsigned*)(ws + WS_HLAC) + (size_t)(tb + t0 + 4 * hh) * LRU_W + cg;
#pragma unroll
        for (int r = 0; r < 16; ++r) { const int q = r >> 2; hl[(size_t)((r & 3) + 8 * q) * LRU_W] = pkbf(bv[r] + av[r] * cH[q], av[r] * cA[q]); }
    }
#undef LRU_PREF
    if (hh == 0) { float* agg = (float*)(ws + WS_AGG16) + (size_t)((b * NBLK + n) * 16 + hs) * 128; agg[jc] = ain; agg[64 + jc] = cin; }
}

__device__ __forceinline__ void p2_mixer_a(const Ptrs& P, LAS unsigned char* lds, volatile LAS unsigned* MISC, unsigned* ctl, int tid, int lane, int wave, int gw, int NGW) {
    if (wave < 4) {
        unsigned btgt = 0u;
        for (int item = (int)blockIdx.x; item < BATCH * 32 * NKV; item += (int)gridDim.x) attn_item4(P, lds, item, tid, lane, wave, MISC + 24, btgt);
    } else {
        const int lw = (gw >> 3) * 4 + (wave - 4), NLW = NGW / 2;
        for (int task = lw; task < BATCH * NBLK * 16 * 2; task += NLW) lru_wave_task(P, (LAS float*)(lds + 65536 + (wave - 4) * 8192), task, lane);
    }
}
__device__ __forceinline__ void p2_mixer_b(const Ptrs& P, LAS unsigned char* lds, int bx, int G, int tid, int lane, int wave) {
    unsigned char* ws = P.ws;
    LAS float* CAR = (LAS float*)lds;
    for (int item = bx; item < BATCH * 8 * 4; item += G) {
        const int q = item & 3, seg = (item >> 2) & 7, b = item >> 5;
        { const int c = tid, n = c >> 6, j = c & 63, hs = 2 * seg + (q >> 1); const float* agg = (const float*)(ws + WS_AGG16) + (size_t)((b * NBLK + n) * 16) * 128;
            float h = 0.f;
            for (int sp = 0; sp < hs; ++sp) h = agg[sp * 128 + j] * h + agg[sp * 128 + 64 + j];
            CAR[c] = h; }
        __syncthreads();
        const f32x4 c0 = *(const LAS f32x4*)(CAR + 8 * lane), c1 = *(const LAS f32x4*)(CAR + 8 * lane + 4);
        const float car[8] = {c0.x, c0.y, c0.z, c0.w, c1.x, c1.y, c1.z, c1.w};
        const int tok0 = b * SEQ + seg * 256 + q * 64 + wave * 8;
        u32x4 H0[8], H1[8], G4[8];
#pragma unroll
        for (int i = 0; i < 8; ++i) { const size_t tok = (size_t)(tok0 + i);
            const unsigned* hl = (const unsigned*)(ws + WS_HLAC) + tok * LRU_W + 8 * lane;
            H0[i] = *(const u32x4*)hl; H1[i] = *(const u32x4*)(hl + 4);
            G4[i] = *(const u32x4*)((const bf16*)(ws + WS_PROJ) + tok * NIN + C_GB + 8 * lane); }
#pragma unroll
        for (int i = 0; i < 8; ++i) { const size_t tok = (size_t)(tok0 + i);
            const u32x4 h0 = H0[i], h1 = H1[i];
            float gf[8]; unpack8(G4[i], gf);
            const unsigned hw[8] = {h0.x, h0.y, h0.z, h0.w, h1.x, h1.y, h1.z, h1.w};
            float y[8], ss = 0.f;
#pragma unroll
            for (int k = 0; k < 8; ++k) { y[k] = (bflo(hw[k]) + bfhi(hw[k]) * car[k]) * gelu_tanh(gf[k]); ss += y[k] * y[k]; }
            u32x4 o; o.x = pkbf(y[0], y[1]); o.y = pkbf(y[2], y[3]); o.z = pkbf(y[4], y[5]); o.w = pkbf(y[6], y[7]);
            *(u32x4*)((bf16*)(ws + WS_MIX) + tok * D + 8 * lane) = o;
            ss += DPP_F(ss, 0xB1); ss += DPP_F(ss, 0x4E); ss += DPP_F(ss, 0x141);
            if ((lane & 7) == 0) ((float*)(ws + WS_SSQL))[tok * 8 + (lane >> 3)] = ss; }
        __syncthreads();
    }
}

template <int N> __device__ __forceinline__ void bitonic_sort_desc(int (&v)[N]) {
#pragma unroll
    for (int k = 2; k <= N; k <<= 1)
#pragma unroll
        for (int j = k >> 1; j > 0; j >>= 1)
#pragma unroll
            for (int i = 0; i < N; ++i) { const int l = i ^ j; if (l > i) { const bool desc = ((i & k) == 0); const int hi = max(v[i], v[l]), lo = min(v[i], v[l]); v[i] = desc ? hi : lo; v[l] = desc ? lo : hi; } }
}
__device__ __forceinline__ void sort16_desc(int (&a)[16]) {
#define CE(i, j) { const int hi_ = max(a[i], a[j]), lo_ = min(a[i], a[j]); a[i] = hi_; a[j] = lo_; }
    CE(0,13) CE(1,12) CE(2,15) CE(3,14) CE(4,8) CE(5,6) CE(7,11) CE(9,10) CE(0,5) CE(1,7) CE(2,9) CE(3,4) CE(6,13) CE(8,14) CE(10,15) CE(11,12) CE(0,1) CE(2,3) CE(4,5) CE(6,8) CE(7,9) CE(10,11) CE(12,13) CE(14,15) CE(0,2) CE(1,3) CE(4,10) CE(5,11) CE(6,7) CE(8,9) CE(12,14) CE(13,15) CE(1,2) CE(3,12) CE(4,6) CE(5,7) CE(8,10) CE(9,11) CE(13,14) CE(1,4) CE(2,6) CE(5,8) CE(7,10) CE(9,13) CE(11,14) CE(2,4) CE(3,6) CE(9,12) CE(11,13) CE(3,5) CE(6,8) CE(7,9) CE(10,12) CE(3,4) CE(5,6) CE(7,8) CE(9,10) CE(11,12) CE(6,7) CE(8,9)
#undef CE
}
__device__ __forceinline__ void merge_top16(int (&a)[16], const int (&b)[16]) {
#pragma unroll
    for (int i = 0; i < 16; ++i) a[i] = max(a[i], b[15 - i]);
#pragma unroll
    for (int j = 8; j > 0; j >>= 1)
#pragma unroll
        for (int i = 0; i < 16; ++i) { const int l = i ^ j; if (l > i) { const int hi = max(a[i], a[l]), lo = min(a[i], a[l]); a[i] = hi; a[l] = lo; } }
}
__device__ __forceinline__ int f2key(unsigned bits) { const int b = (int)bits; return b ^ ((b >> 31) & 0x7fffffff); }
struct CandTab { int i[64], j[64], n; constexpr CandTab() : i{}, j{}, n(0) { for (int a = 0; a < 16; ++a) for (int b = 0; b < 16; ++b) if ((a + 1) * (b + 1) <= 16) { i[n] = a; j[n] = b; ++n; } } };
constexpr int SKL_STRIDE = 136;
constexpr int SKL_BYTES = 256 * SKL_STRIDE * 2;
__device__ __forceinline__ void p5_topk(const Ptrs& P, LAS unsigned char* lds, const pg8::StaticOrder& S, int tid, int lane, int wave, int gw, int NGW) {
    const unsigned char* ws = P.ws;
    constexpr CandTab CT;
    static_assert(CT.n <= 64, "candidate table");
    const bf16* Q = (const bf16*)(ws + WS_Q); const bf16* SK = (const bf16*)(ws + WS_SKB);
    LAS bf16* SKL = (LAS bf16*)lds;
    LAS unsigned char* ib = lds + SKL_BYTES + (wave * 64 + lane) * 32;
    const int tl = lane & 31, hh = lane >> 5;
    const bool conv = wave >= 4;
    const int NCW = NGW / 2;
    int cvn = (gw >> 3) * 4 + (wave & 3);
#pragma unroll 1
    for (int round = 0; ; ++round) {
        pg8::Unit u; if (!S.next(round, u)) break;
        const int h = u.pn;
#pragma unroll
        for (int i = 0; i < 8; ++i) { const int p = tid + 512 * i, row = p >> 4, ch = p & 15;
            const u32x4 w = *(const u32x4*)(SK + ((size_t)(h * 2) * NKEYS + row) * DHALF + 8 * ch); *(LAS u32x4*)(SKL + row * SKL_STRIDE + 8 * ch) = w; }
        __syncthreads();
        if (conv) {
            constexpr int NGRP = 2 * NEXP / 4;
            ExpRows EA, EB;
            EA.load(P, 4 * min(cvn, NGRP - 1), lane); EB.load(P, 4 * min(cvn + NCW, NGRP - 1), lane);
            EA.finish(P, lane); EA.load(P, 4 * min(cvn + 2 * NCW, NGRP - 1), lane);
            EB.finish(P, lane); EB.load(P, 4 * min(cvn + 3 * NCW, NGRP - 1), lane);
            EA.finish(P, lane); EB.finish(P, lane);
            cvn += 4 * NCW;
        } else
#pragma unroll 1
        for (int sub = 0; sub < 2; ++sub) {
        const int tg = u.pm * 8 + wave + 4 * sub;
        const int t = tg * 32 + tl;
        float r2;
        { const float* sp = (const float*)(ws + WS_SSQ2) + (size_t)t * 16; const f32x4 s0 = *(const f32x4*)sp, s1 = *(const f32x4*)(sp + 4), s2 = *(const f32x4*)(sp + 8), s3 = *(const f32x4*)(sp + 12);
            const float ss = (((s0.x + s0.y) + (s0.z + s0.w)) + ((s1.x + s1.y) + (s1.z + s1.w))) + (((s2.x + s2.y) + (s2.z + s2.w)) + ((s3.x + s3.y) + (s3.z + s3.w)));
            r2 = __builtin_amdgcn_rsqf(ss * (1.0f / D) + EPS); if (h == 0 && hh == 0) ((float*)(ws + WS_R2))[t] = r2; }
        int KS[2][16];
#pragma unroll
        for (int c = 0; c < 2; ++c) {
            f32x16 acc[4];
#pragma unroll
            for (int kt = 0; kt < 4; ++kt)
#pragma unroll
                for (int r = 0; r < 16; ++r) acc[kt][r] = 0.f;
            int hq2 = hh; asm volatile("" : "+v"(hq2));
            const bf16* qrow = Q + (unsigned)(t * NQ + h * DQ + c * DHALF + 8 * hq2);
            bf16x8 Bf[8];
#pragma unroll
            for (int s = 0; s < 8; ++s) Bf[s] = *(const bf16x8*)(qrow + 16 * s);
            const LAS bf16* krow = SKL + (c * NKEYS + tl) * SKL_STRIDE + 8 * hh;
#pragma unroll
            for (int s = 0; s < 8; ++s)
#pragma unroll
                for (int kt = 0; kt < 4; ++kt) { const bf16x8 Af = *(const LAS bf16x8*)(krow + kt * 32 * SKL_STRIDE + 16 * s); acc[kt] = MFMA32(Af, Bf[s], acc[kt]); }
            int kk[4][16];
#pragma unroll
            for (int kt = 0; kt < 4; ++kt) {
#pragma unroll
                for (int r = 0; r < 16; ++r) { const float av = acc[kt][r];
                    kk[kt][r] = f2key((__float_as_uint(av) & ~0x7Fu) | (unsigned)(32 * kt + crow(r, hh))); }
                sort16_desc(kk[kt]); }
            merge_top16(kk[0], kk[1]); merge_top16(kk[2], kk[3]); merge_top16(kk[0], kk[2]);
            int pp[16];
#pragma unroll
            for (int i = 0; i < 16; ++i) pp[i] = __shfl_xor(kk[0][i], 32);
            merge_top16(kk[0], pp);
#pragma unroll
            for (int i = 0; i < 16; ++i) KS[c][i] = kk[0][i];
        }
        float fa[16], fb[16];
        { unsigned wa[4], wb[4];
#pragma unroll
            for (int i = 0; i < 4; ++i) { wa[i] = 0u; wb[i] = 0u; }
#pragma unroll
            for (int i = 0; i < 16; ++i) { const unsigned ua = (unsigned)f2key((unsigned)KS[0][i]), ub = (unsigned)f2key((unsigned)KS[1][i]);
                fa[i] = __builtin_bit_cast(float, ua & ~0x7Fu); fb[i] = __builtin_bit_cast(float, ub & ~0x7Fu);
                wa[i >> 2] |= (ua & 0x7Fu) << (8 * (i & 3)); wb[i >> 2] |= (ub & 0x7Fu) << (8 * (i & 3)); }
            *(LAS u32x4*)ib = (u32x4){wa[0], wa[1], wa[2], wa[3]}; *(LAS u32x4*)(ib + 16) = (u32x4){wb[0], wb[1], wb[2], wb[3]}; }
        int cv[4][16];
#pragma unroll
        for (int q = 0; q < 64; ++q) {
            if (q < CT.n) { const float sum = fa[CT.i[q]] + fb[CT.j[q]]; cv[q >> 4][q & 15] = f2key((__builtin_bit_cast(unsigned, sum) & ~0xFFu) | (unsigned)(CT.i[q] * 16 + CT.j[q])); }
            else cv[q >> 4][q & 15] = (int)0x80000000;
        }
#pragma unroll
        for (int gq = 0; gq < 4; ++gq) sort16_desc(cv[gq]);
        merge_top16(cv[0], cv[1]); merge_top16(cv[2], cv[3]); merge_top16(cv[0], cv[2]);
        asm volatile("s_waitcnt lgkmcnt(0)" ::: "memory");
        int ex[16]; float gv[16]; float den = 0.f; float v0 = 0.f;
#pragma unroll
        for (int k = 0; k < 16; ++k) { const unsigned ub = (unsigned)f2key((unsigned)cv[0][k]); const float val = __builtin_bit_cast(float, ub & ~0xFFu); const unsigned ij = ub & 0xFFu;
            if (k == 0) v0 = val;
            const int n1 = ib[ij >> 4], n2 = ib[16 + (ij & 15u)];
            ex[k] = n1 * NKEYS + n2; gv[k] = __expf(r2 * (val - v0)); den += gv[k]; }
        const float rden = 1.0f / den;
        int hq = hh; asm volatile("" : "+v"(hq));
        bf16* gp = (bf16*)(ws + WS_GW) + (unsigned)(t * 128 + h * 16 + 8 * hq);
        int e8[8]; float g8[8];
#pragma unroll
        for (int k = 0; k < 8; ++k) { const int msk = -hh;
            e8[k] = (ex[8 + k] & msk) | (ex[k] & ~msk);
            g8[k] = __builtin_bit_cast(float, (__builtin_bit_cast(int, gv[8 + k]) & msk) | (__builtin_bit_cast(int, gv[k]) & ~msk)) * rden; }
        *(u32x4*)((unsigned short*)(ws + WS_IDX16) + (unsigned)(t * 128 + h * 16 + 8 * hq)) = (u32x4){(unsigned)e8[0] | ((unsigned)e8[1] << 16), (unsigned)e8[2] | ((unsigned)e8[3] << 16), (unsigned)e8[4] | ((unsigned)e8[5] << 16), (unsigned)e8[6] | ((unsigned)e8[7] << 16)};
        *(u32x4*)gp = (u32x4){pk2(g8[0], g8[1]), pk2(g8[2], g8[3]), pk2(g8[4], g8[5]), pk2(g8[6], g8[7])};
        }
        __syncthreads();
    }
    if (conv) for (; cvn < 2 * NEXP / 4; cvn += NCW) expert_rows4(P, 4 * cvn, lane);
}

struct Args { Ptrs P; int ph_lo, ph_hi, li, pad; };
constexpr int NPH = 9;
__global__ void __launch_bounds__(NWAVES * 64, 2) fwd(Args a) {
    extern __shared__ __attribute__((aligned(16))) unsigned char lds_raw[];
    LAS unsigned char* lds = (LAS unsigned char*)lds_raw;
    volatile LAS unsigned* MISC = (volatile LAS unsigned*)(lds + MISC_OFF);
    const Ptrs& P = a.P;
    unsigned char* ws = P.ws;
    const int tid = threadIdx.x, lane = tid & 63, wave = __builtin_amdgcn_readfirstlane(tid >> 6);
    const int G = gridDim.x, bx = blockIdx.x, vcu = (G % 8 == 0) ? (bx % 8) * (G / 8) + bx / 8 : bx;
    if (tid < 32) MISC[tid] = 0u;
    __syncthreads();
    unsigned* ctl = (unsigned*)(ws + WS_CTL);
    XcdBarrier bar = xcd_barrier_post(ctl + CW_BAR + a.li * XCD_BAR_WORDS, MISC + 8);
    const int lo = a.ph_lo, hi = a.ph_hi;
#define IN(k) (lo <= (k) && (k) < hi)
#define SEAM(k) do { if (IN(k) && IN((k) + 1)) xcd_barrier(bar); } while (0)
    const int gw = vcu * NWAVES + wave, NGW = G * NWAVES;

    if (IN(0)) { p0_prep(P, gw, NGW, lane, (LAS float*)(lds + wave * 16384)); }
    SEAM(0);
    if (IN(1)) { {
        pg8::Gemm g{(const bf16*)(ws + WS_XBF), (const bf16*)(ws + WS_WINT), T, NIN, D}; pg8::StaticOrder S; S.init(T, NIN, G, bx);
        pg8::EpiRowBf16 E{(bf16*)(ws + WS_PROJ), NIN, nullptr};
        pg8::gemm_phase<pg8::EpiRowBf16, pg8::StaticOrder, true, true>(lds, g, S, E);
    } }
    SEAM(1);
    if (IN(2)) { p2_mixer_a(P, lds, MISC, ctl, tid, lane, wave, gw, NGW); xcd_barrier(bar); p2_mixer_b(P, lds, bx, G, tid, lane, wave); }
    SEAM(2);
    if (IN(3)) {
        pg8::Gemm g{(const bf16*)(ws + WS_MIX), (const bf16*)(ws + WS_WOUTT), T, D, D}; pg8::StaticOrder S; S.init(T, D, G, bx);
        LAS pg8::f32x2v* rsl = (LAS pg8::f32x2v*)(lds + RS_OFF); LAS float* rxl = (LAS float*)(lds + RS_OFF + 2048);
        pg8::Unit u;
        for (int round = 0; S.next(round, u); ++round) {
            if (tid < 256) { const int row = u.pm * 256 + tid; const float* sl = (const float*)(ws + WS_SSQL) + (size_t)row * 8; const float* sa = (const float*)(ws + WS_SSQA) + (size_t)row * 8;
                const f32x4 l0 = *(const f32x4*)sl, l1 = *(const f32x4*)(sl + 4), a0 = *(const f32x4*)sa, a1 = *(const f32x4*)(sa + 4);
                const float sL = ((l0.x + l0.y) + (l0.z + l0.w)) + ((l1.x + l1.y) + (l1.z + l1.w)), sA = ((a0.x + a0.y) + (a0.z + a0.w)) + ((a1.x + a1.y) + (a1.z + a1.w));
                const float rl = __builtin_amdgcn_rsqf(sL * (1.0f / LRU_W) + EPS), ra = __builtin_amdgcn_rsqf(sA * (1.0f / ATT_W) + EPS);
                rsl[tid] = (pg8::f32x2v){rl * __builtin_amdgcn_rcpf(ra), ra}; rxl[tid] = __builtin_amdgcn_rcpf(((const float*)(ws + WS_R1X))[row]); }
            __syncthreads();
            pg8::OneUnit S1{u};
            pg8::EpiOut E{(const bf16*)(ws + WS_XBF), P.out, (bf16*)(ws + WS_X1BF), (float*)(ws + WS_SSQ2), rsl, rxl};
            pg8::gemm_phase<pg8::EpiOut, pg8::OneUnit, false, true>(lds, g, S1, E);
            __syncthreads();
        }
    }
    SEAM(3);
    if (IN(4)) { {
        pg8::Gemm g{(const bf16*)(ws + WS_X1BF), (const bf16*)(ws + WS_WQT), T, NQ, D}; pg8::StaticOrder S; S.init(T, NQ, G, bx);
        pg8::EpiRowBf16 E{(bf16*)(ws + WS_Q), NQ, nullptr};
        pg8::gemm_phase<pg8::EpiRowBf16, pg8::StaticOrder, true, true>(lds, g, S, E);
    } }
    if (IN(5)) { pg8::StaticOrder S; S.init(T, NQ, G, bx); p5_topk(P, lds, S, tid, lane, wave, gw, NGW); }
    SEAM(5);
    if (IN(6)) { if (G == 256) p6_u3(P, lds, bx, lane, wave); else p6_sliced<0>(P, lds, MISC, ctl, tid, lane, wave); }
    SEAM(6);
    if (IN(7)) { p6_combine(P, bx * (NWAVES * 64) + tid, G * NWAVES * 64); }
    SEAM(7);
    if (IN(8)) { if (G == 256) p6_v3(P, lds, bx, lane, wave); else p6_v2(P, MISC, ctl, tid, lane, wave); }
#undef IN
#undef SEAM
}

extern "C" void kernel_launch(void* const* d_in, const int* in_sizes, int n_in, void* d_out, int out_size, void* d_ws, size_t ws_size, hipStream_t stream) {
    static int grid = 0;
    if (grid == 0) {
        if (n_in != 22 || out_size != T * D || ws_size < WS_END) { fprintf(stderr, "kernel_launch: unexpected shapes (n_in %d, out %d, ws %zu)\n", n_in, out_size, ws_size); grid = -1; return; }
        int dev = 0, cus = 0, per_cu = 0;
        if (hipGetDevice(&dev) != hipSuccess || hipDeviceGetAttribute(&cus, hipDeviceAttributeMultiprocessorCount, dev) != hipSuccess) { grid = -1; return; }
        if (hipFuncSetAttribute((const void*)fwd, hipFuncAttributeMaxDynamicSharedMemorySize, LDS_BYTES) != hipSuccess) { fprintf(stderr, "kernel_launch: hipFuncSetAttribute failed\n"); grid = -1; return; }
        if (hipOccupancyMaxActiveBlocksPerMultiprocessor(&per_cu, (const void*)fwd, NWAVES * 64, LDS_BYTES) != hipSuccess || per_cu < 1) fprintf(stderr, "kernel_launch: occupancy query says %d\n", per_cu);
        (void)hipGetLastError();
        grid = cus;
        if (grid != 256) fprintf(stderr, "kernel_launch: %d CUs (built for 256)\n", grid);
    }
    if (grid < 0) return;
    Ptrs P{};
    const float** pp = (const float**)&P;
    for (int i = 0; i < 22; ++i) pp[i] = (const float*)d_in[i];
    P.out = (float*)d_out; P.ws = (unsigned char*)d_ws;
    unsigned char* ws = P.ws;
    (void)hipMemsetAsync(ws + WS_CTL, 0, CTL_BYTES, stream);
    Args a{}; a.P = P;
    int li = 0;
#define FWD(lo_, hi_) do { a.ph_lo = (lo_); a.ph_hi = (hi_); a.li = li++; hipLaunchKernelGGL(fwd, dim3(grid), dim3(NWAVES * 64), LDS_BYTES, stream, a); } while (0)
    FWD(0, NPH);
}
```
